# Optimizing an MI355X kernel written in HIP

```python
import math
import jax, jax.numpy as jnp
from jax import lax
import numpy as np

D_MODEL = 2048
BATCH = 4
SEQ = 4096
DEPTH = 2

CTX_LEN = 256
GRID_W = 64
NORM_EPS = 1e-6

HY_WIDTH = D_MODEL
HY_EMB = 33
HY_BANDS = (HY_EMB - 1) // 2
HY_FILTER_HIDDEN = 64
HY_FAST_DECAY_PCT = 0.3
HY_SLOW_DECAY_PCT = 1.5
HY_DECAY_TARGET = 1e-2

RET_HEADS = 8
RET_QK_DIM = D_MODEL // RET_HEADS
RET_V_DIM = 2 * D_MODEL // RET_HEADS
RET_QK_WIDTH = RET_HEADS * RET_QK_DIM
RET_V_WIDTH = RET_HEADS * RET_V_DIM
RET_CHUNK = 128
ROPE_BASE = 10000.0

SPLIT_SIZES = (RET_QK_WIDTH, RET_QK_WIDTH, RET_V_WIDTH, RET_V_WIDTH, 3 * HY_WIDTH, HY_WIDTH, 2 * D_MODEL)
IN_WIDTH = sum(SPLIT_SIZES)
ADA_WIDTH = 3 * D_MODEL

kernel_name = "hyena_retention_hybrid_dit"


def rmsnorm(x, g):
    xf = x.astype(jnp.float32)
    y = xf * lax.rsqrt(jnp.mean(xf * xf, axis=-1, keepdims=True) + NORM_EPS)
    return (y * g.astype(jnp.float32)).astype(x.dtype)


def ada_modulation(cond, ada_w, ada_b):
    mod = jax.nn.silu(cond) @ ada_w + ada_b
    return jnp.split(mod, 3, axis=-1)


def short_conv(u, w, b):
    L = u.shape[1]
    up = jnp.pad(u, ((0, 0), (1, 1), (0, 0)))
    return up[:, 0:L] * w[0] + up[:, 1:L + 1] * w[1] + up[:, 2:L + 2] * w[2] + b


def hyena_filters(L, w1, b1, w2, b2, w3, b3, freq, w_out):
    t = jnp.linspace(0.0, 1.0, L, dtype=jnp.float32)[:, None]
    ang = 2.0 * math.pi * jnp.arange(L, dtype=jnp.float32)[:, None] / L
    f = jnp.linspace(1e-4, HY_BANDS - 1, HY_BANDS, dtype=jnp.float32)[None, :]
    z = jnp.concatenate([t, jnp.cos(f * ang), -jnp.sin(f * ang)], axis=-1).astype(w1.dtype)
    h = jnp.sin(freq * (z @ w1 + b1))
    h = jnp.sin(freq * (h @ w2 + b2))
    h = jnp.sin(freq * (h @ w3 + b3))
    h = (h @ w_out).astype(jnp.float32)
    max_decay = math.log(HY_DECAY_TARGET) / HY_FAST_DECAY_PCT
    min_decay = math.log(HY_DECAY_TARGET) / HY_SLOW_DECAY_PCT
    deltas = jnp.abs(jnp.linspace(min_decay, max_decay, HY_WIDTH, dtype=jnp.float32))
    window = jnp.exp(-t * deltas[None, :])
    return h[:, :HY_WIDTH] * window, h[:, HY_WIDTH:] * window


def fft_long_conv(u, hf, hb):
    L, C = hf.shape
    k = jnp.concatenate([hf, jnp.zeros((1, C), jnp.float32), hb[1:][::-1]], axis=0)
    kf = jnp.fft.rfft(k, n=2 * L, axis=0)
    uf = jnp.fft.rfft(u.astype(jnp.float32), n=2 * L, axis=1)
    y = jnp.fft.irfft(uf * kf[None], n=2 * L, axis=1)[:, :L]
    return y.astype(u.dtype)


def to_heads(u, d):
    B, L, _ = u.shape
    return u.reshape(B, L, RET_HEADS, d).transpose(0, 2, 1, 3).astype(jnp.float32)


def rotary_2d(u, row, col):
    dh = u.shape[-1]
    half, quarter = dh // 2, dh // 4
    inv = 1.0 / (ROPE_BASE ** (jnp.arange(quarter, dtype=jnp.float32) / quarter))

    def rot(part, pos):
        a = pos[:, None] * inv[None, :]
        cos, sin = jnp.cos(a), jnp.sin(a)
        p1, p2 = part[..., :quarter], part[..., quarter:]
        return jnp.concatenate([p1 * cos - p2 * sin, p1 * sin + p2 * cos], axis=-1)

    return jnp.concatenate([rot(u[..., :half], row), rot(u[..., half:], col)], axis=-1)


def retention_scan(q, k, v, log_gamma, s0):
    B, H, L, _ = q.shape
    dv = v.shape[-1]
    n = L // RET_CHUNK

    def chunks(u):
        return u.reshape(B, H, n, RET_CHUNK, u.shape[-1]).transpose(2, 0, 1, 3, 4)

    idx = jnp.arange(RET_CHUNK, dtype=jnp.float32)
    lg = log_gamma.astype(jnp.float32)[:, None]
    diff = idx[:, None] - idx[None, :]
    inner_decay = jnp.where(diff >= 0, jnp.exp(lg[:, :, None] * jnp.maximum(diff, 0.0)), 0.0)
    q_decay = jnp.exp(lg * (idx + 1.0))[:, :, None]
    k_decay = jnp.exp(lg * (RET_CHUNK - 1.0 - idx))[:, :, None]
    chunk_decay = jnp.exp(lg * RET_CHUNK)[:, :, None]

    def step(s, blk):
        qi, ki, vi = blk
        scores = jnp.einsum('bhqd,bhkd->bhqk', qi, ki) * inner_decay
        o = jnp.einsum('bhqk,bhkv->bhqv', scores, vi) + jnp.einsum('bhqd,bhdv->bhqv', qi * q_decay, s)
        s = s * chunk_decay + jnp.einsum('bhkd,bhkv->bhdv', ki * k_decay, vi)
        return s, o

    s, o = lax.scan(step, s0, (chunks(q), chunks(k), chunks(v)))
    return o.transpose(1, 2, 0, 3, 4).reshape(B, H, L, dv), s


def head_rmsnorm(o):
    return o * lax.rsqrt(jnp.mean(o * o, axis=-1, keepdims=True) + NORM_EPS)


def mixer(h, rope_pos, s0_f, s0_b, w_in, conv_w, conv_b, f_w1, f_b1, f_w2, f_b2, f_w3, f_b3,
          f_freq, f_wout, hy_bias, log_decay, w_hy_out, w_ret_out, w_o):
    B, L, _ = h.shape
    points = np.cumsum(SPLIT_SIZES)[:-1].tolist()
    q, k, v, ret_gate, hy_in, hy_gate, merge_gate = jnp.split(h @ w_in, points, axis=-1)

    hf, hb = hyena_filters(L, f_w1, f_b1, f_w2, f_b2, f_w3, f_b3, f_freq, f_wout)
    hv, hx0, hx1 = jnp.split(short_conv(hy_in, conv_w, conv_b), 3, axis=-1)
    hv = hv * hx1
    hv = fft_long_conv(hv, hf, hb) + hy_bias * hv
    hy_y = hv * hx0

    q = to_heads(q, RET_QK_DIM)
    k = to_heads(k, RET_QK_DIM) * (RET_QK_DIM ** -0.5)
    v = to_heads(v, RET_V_DIM)
    if rope_pos is not None:
        q = rotary_2d(q, rope_pos[0], rope_pos[1])
        k = rotary_2d(k, rope_pos[0], rope_pos[1])
    o_f, s_f = retention_scan(q, k, v, log_decay[0], s0_f)
    o_b, s_b = retention_scan(jnp.flip(q, 2), jnp.flip(k, 2), jnp.flip(v, 2), log_decay[1], s0_b)
    o = head_rmsnorm(o_f + jnp.flip(o_b, 2))
    ret_y = o.transpose(0, 2, 1, 3).reshape(B, L, RET_V_WIDTH).astype(h.dtype)

    g_hy, g_ret = jnp.split(merge_gate, 2, axis=-1)
    hy_out = (hy_y * jax.nn.silu(hy_gate)) @ w_hy_out
    ret_out = (ret_y * jax.nn.silu(ret_gate)) @ w_ret_out
    out = (jax.nn.sigmoid(g_hy) * hy_out + jax.nn.sigmoid(g_ret) * ret_out) @ w_o
    return out, s_f, s_b


def context_states(h_ctx, w_in, log_decay):
    kv = h_ctx @ w_in[:, RET_QK_WIDTH:2 * RET_QK_WIDTH + RET_V_WIDTH]
    k, v = jnp.split(kv, [RET_QK_WIDTH], axis=-1)
    k = to_heads(k, RET_QK_DIM) * (RET_QK_DIM ** -0.5)
    v = to_heads(v, RET_V_DIM)
    L = k.shape[2]
    pos = jnp.arange(L, dtype=jnp.float32)
    w_f = jnp.exp(log_decay[0][:, None] * (L - 1.0 - pos))
    w_b = jnp.exp(log_decay[1][:, None] * pos)
    s_f = jnp.einsum('bhld,hl,bhlv->bhdv', k, w_f, v)
    s_b = jnp.einsum('bhld,hl,bhlv->bhdv', k, w_b, v)
    return s_f, s_b


def setup_inputs(seed: int = 0) -> dict:
    key = jax.random.key(seed)
    ks = jax.random.split(key, 24)
    f32 = jnp.float32

    def nrm(k, shape, s):
        return jax.random.normal(k, shape, f32) * s

    base_decay = np.log(-np.log(1.0 - 2.0 ** (-5.0 - np.arange(RET_HEADS)))).astype(np.float32)
    return {
        "x": nrm(ks[0], (BATCH, SEQ, D_MODEL), 1.0),
        "c": nrm(ks[1], (BATCH, D_MODEL), 1.0),
        "ctx": nrm(ks[2], (BATCH, CTX_LEN, D_MODEL), 1.0),
        "c_ctx": nrm(ks[3], (D_MODEL,), 1.0),
        "ln_g": 1.0 + nrm(ks[4], (DEPTH, D_MODEL), 0.02),
        "ada_w": nrm(ks[5], (DEPTH, D_MODEL, ADA_WIDTH), 0.5 * D_MODEL ** -0.5),
        "ada_b": nrm(ks[6], (DEPTH, ADA_WIDTH), 0.02),
        "w_in": nrm(ks[7], (DEPTH, D_MODEL, IN_WIDTH), D_MODEL ** -0.5),
        "hy_conv_w": nrm(ks[8], (DEPTH, 3, 3 * HY_WIDTH), 3.0 ** -0.5),
        "hy_conv_b": nrm(ks[9], (DEPTH, 3 * HY_WIDTH), 0.02),
        "hy_filt_w1": nrm(ks[10], (DEPTH, HY_EMB, HY_FILTER_HIDDEN), HY_EMB ** -0.5),
        "hy_filt_b1": nrm(ks[11], (DEPTH, HY_FILTER_HIDDEN), 0.02),
        "hy_filt_w2": nrm(ks[12], (DEPTH, HY_FILTER_HIDDEN, HY_FILTER_HIDDEN), HY_FILTER_HIDDEN ** -0.5),
        "hy_filt_b2": nrm(ks[13], (DEPTH, HY_FILTER_HIDDEN), 0.02),
        "hy_filt_w3": nrm(ks[14], (DEPTH, HY_FILTER_HIDDEN, HY_FILTER_HIDDEN), HY_FILTER_HIDDEN ** -0.5),
        "hy_filt_b3": nrm(ks[15], (DEPTH, HY_FILTER_HIDDEN), 0.02),
        "hy_filt_freq": 1.0 + nrm(ks[16], (DEPTH, HY_FILTER_HIDDEN), 0.02),
        "hy_filt_wout": nrm(ks[17], (DEPTH, HY_FILTER_HIDDEN, 2 * HY_WIDTH), 0.2 * HY_FILTER_HIDDEN ** -0.5),
        "hy_bias": nrm(ks[18], (DEPTH, HY_WIDTH), 0.1),
        "ret_decay": jnp.asarray(base_decay)[None, None, :] + nrm(ks[19], (DEPTH, 2, RET_HEADS), 0.01),
        "w_hy_out": nrm(ks[20], (DEPTH, HY_WIDTH, D_MODEL), HY_WIDTH ** -0.5),
        "w_ret_out": nrm(ks[21], (DEPTH, RET_V_WIDTH, D_MODEL), RET_V_WIDTH ** -0.5),
        "w_o": nrm(ks[22], (DEPTH, D_MODEL, D_MODEL), D_MODEL ** -0.5),
        "final_g": 1.0 + nrm(ks[23], (D_MODEL,), 0.02),
    }


def reference(x, c, ctx, c_ctx, ln_g, ada_w, ada_b, w_in, hy_conv_w, hy_conv_b, hy_filt_w1,
              hy_filt_b1, hy_filt_w2, hy_filt_b2, hy_filt_w3, hy_filt_b3, hy_filt_freq,
              hy_filt_wout, hy_bias, ret_decay, w_hy_out, w_ret_out, w_o, final_g):
    B, L, _ = x.shape
    rows = L // GRID_W
    row = jnp.repeat(jnp.arange(rows, dtype=jnp.float32), GRID_W)
    col = jnp.tile(jnp.arange(GRID_W, dtype=jnp.float32), rows)
    zero_state = jnp.zeros((B, RET_HEADS, RET_QK_DIM, RET_V_DIM), jnp.float32)

    for i in range(DEPTH):
        log_decay = -jnp.exp(ret_decay[i].astype(jnp.float32))
        mixer_params = (w_in[i], hy_conv_w[i], hy_conv_b[i], hy_filt_w1[i], hy_filt_b1[i],
                        hy_filt_w2[i], hy_filt_b2[i], hy_filt_w3[i], hy_filt_b3[i],
                        hy_filt_freq[i], hy_filt_wout[i], hy_bias[i], log_decay,
                        w_hy_out[i], w_ret_out[i], w_o[i])

        sh_c, sc_c, g_c = ada_modulation(c_ctx[None, None, :], ada_w[i], ada_b[i])
        h_ctx = rmsnorm(ctx, ln_g[i]) * (1.0 + sc_c) + sh_c
        if i < DEPTH - 1:
            out_c, s_ctx_f, s_ctx_b = mixer(h_ctx, None, zero_state, zero_state, *mixer_params)
            ctx_next = ctx + g_c * out_c
        else:
            s_ctx_f, s_ctx_b = context_states(h_ctx, w_in[i], log_decay)
            ctx_next = ctx

        sh, sc, g = ada_modulation(c[:, None, :], ada_w[i], ada_b[i])
        h = rmsnorm(x, ln_g[i]) * (1.0 + sc) + sh
        out, _, _ = mixer(h, (row, col), s_ctx_f, s_ctx_b, *mixer_params)
        x = x + g * out
        ctx = ctx_next

    return rmsnorm(x, final_g)
```

```cpp
#include <hip/hip_runtime.h>
#include <hip/hip_cooperative_groups.h>
#include <cstdio>
namespace cg = cooperative_groups;

typedef unsigned short bf16_t;
typedef short bf16x8 __attribute__((ext_vector_type(8)));
typedef float f32x4 __attribute__((ext_vector_type(4)));
typedef float f32x16 __attribute__((ext_vector_type(16)));
typedef unsigned u32x4 __attribute__((ext_vector_type(4)));
typedef unsigned u32x2 __attribute__((ext_vector_type(2)));
#define DI __device__ __forceinline__

DI int otid(int wid) { int t; asm volatile("v_mbcnt_lo_u32_b32 %0, -1, 0\n\tv_mbcnt_hi_u32_b32 %0, -1, %0" : "=v"(t)); return wid * 64 + t; }
DI float wsum(float v, int lane) {
#pragma unroll
  for (int o = 32; o > 0; o >>= 1) v += __int_as_float(__builtin_amdgcn_ds_bpermute((lane ^ o) << 2, __float_as_int(v)));
  return v; }
DI float bf2f(bf16_t u) { return __uint_as_float(((unsigned)u) << 16); }
typedef __bf16 bf16v2 __attribute__((ext_vector_type(2)));
typedef float f32v2 __attribute__((ext_vector_type(2)));
DI unsigned pk2(float lo, float hi) { f32v2 v = {lo, hi}; bf16v2 b = __builtin_convertvector(v, bf16v2); return __builtin_bit_cast(unsigned, b); }
DI bf16_t f2bf(float f) { return (bf16_t)(pk2(f, 0.f) & 0xffffu); }
DI float lo2f(unsigned u) { return __uint_as_float(u << 16); }
DI float hi2f(unsigned u) { return __uint_as_float(u & 0xffff0000u); }
DI float sigmoidf_(float v) { return 1.f / (1.f + __expf(-v)); }
DI float siluf_(float v) { return v / (1.f + __expf(-v)); }

constexpr int DM = 2048, NB = 4, SEQ = 4096, CTXL = 256, NLAT = NB * SEQ, NCTX = NB * CTXL, MT = NLAT + NCTX;
constexpr int INW = 24576, NH = 8, DK = 256, DV = 512, TT = SEQ + CTXL;
constexpr int LOFF = 4128, GLEN = 8320;
constexpr int USTR = 6560;

constexpr size_t AL(size_t x) { return (x + 255) & ~(size_t)255; }
constexpr size_t OFF_WTIN = 0;
constexpr size_t OFF_WTHY = OFF_WTIN + AL((size_t)INW * DM * 2);
constexpr size_t OFF_WTRET = OFF_WTHY + AL((size_t)DM * DM * 2);
constexpr size_t OFF_WTO = OFF_WTRET + AL((size_t)DM * 4096 * 2);
constexpr size_t OFF_G = OFF_WTO + AL((size_t)DM * DM * 2);
constexpr size_t OFF_GC = OFF_G + AL((size_t)DM * GLEN * 2);
constexpr size_t OFF_MOD = OFF_GC + AL((size_t)DM * 512 * 4);
constexpr size_t OFF_H = OFF_MOD + AL((size_t)2 * 5 * 6144 * 4);
constexpr size_t OFF_PQ = OFF_H + AL((size_t)MT * DM * 2);
constexpr size_t OFF_PK = OFF_PQ + AL((size_t)MT * DM * 2);
constexpr size_t OFF_PV = OFF_PK + AL((size_t)MT * DM * 2);
constexpr size_t OFF_PRG = OFF_PV + AL((size_t)MT * 4096 * 2);
constexpr size_t OFF_PHY = OFF_PRG + AL((size_t)MT * 4096 * 2);
constexpr size_t OFF_PHG = OFF_PHY + AL((size_t)MT * 6144 * 2);
constexpr size_t OFF_PMG = OFF_PHG + AL((size_t)MT * DM * 2);
constexpr size_t OFF_KT = OFF_PMG + AL((size_t)MT * 4096 * 2);
constexpr size_t OFF_VT = OFF_KT + AL((size_t)NB * NH * DK * TT * 2);
constexpr size_t OFF_UT = OFF_VT + AL((size_t)NB * NH * DV * TT * 2);
constexpr size_t OFF_UTC = OFF_UT + AL((size_t)DM * NB * SEQ * 2);
constexpr size_t OFF_HV = OFF_UTC + AL((size_t)DM * NB * CTXL * 2);
constexpr size_t OFF_HX0 = OFF_HV + AL((size_t)MT * DM * 2);
constexpr size_t OFF_CTXR = OFF_HX0 + AL((size_t)MT * DM * 2);
constexpr size_t WS_NEED = OFF_CTXR + AL((size_t)NCTX * DM * 4);
constexpr size_t OFF_OF = OFF_PV, OFF_OB = OFF_PHY, OFF_T1 = OFF_PHY + AL((size_t)MT * 4096 * 2);

struct Params {
  const float *x, *c, *ctx, *c_ctx, *ln_g, *ada_w, *ada_b, *w_in, *conv_w, *conv_b, *fw1, *fb1, *fw2, *fb2, *fw3, *fb3, *ffreq, *fwout, *hy_bias, *ret_decay, *w_hy_out, *w_ret_out, *w_o, *final_g;
  float* out;
  unsigned char* ws;
  int wid, pad_;
};

namespace pg8 {
#define PG8_LAS __attribute__((address_space(3)))
constexpr int BM = 256, BK = 64, HALF = 128, HTB = HALF * BK * 2, STAGE_BYTES = 8 * HTB, NXCD = 8, WGM = 8;
__host__ __device__ __forceinline__ int lds_byte(int r, int c) { const int st = (r >> 4) * 2 + (c >> 5), rr = r & 15, cc = c & 31, ob = rr * 64 + cc * 2; return st * 1024 + (ob ^ (((ob >> 9) & 1) << 5)); }
__host__ __device__ __forceinline__ void stage_rc(int b, int& R, int& C) { const int st = b / 1024, sb = b % 1024, swz = sb ^ (((sb >> 9) & 1) << 5); R = (st >> 1) * 16 + swz / 64; C = (st & 1) * 32 + (swz % 64) / 2; }
__host__ __device__ __forceinline__ int perm32(int rho) { const int n = rho >> 4, i = rho & 15; return 8 * (i >> 2) + 4 * n + (i & 3); }
struct Unit { int pm, pn; };
struct Gemm { const bf16_t* A; const bf16_t* Bt; int M, N, K, wid; };
struct Order {
    int nM, nN, nwg, G, c, nx_m, nx_n, x_pn0;
    __device__ void init(int nM_, int nN_, int G_, int c_, int nx_m_, int nx_n_, int x_pn0_) { nM = nM_; nN = nN_; nwg = nM * nN; G = G_; c = c_; nx_m = nx_m_; nx_n = nx_n_; x_pn0 = x_pn0_; }
    __device__ bool next(int i, Unit& u) const {
        const long L = (long)i * G + c;
        if (L >= nwg) { const int e = (int)(L - nwg); if (e >= nx_m * nx_n) return false; u.pm = nM + e % nx_m; u.pn = x_pn0 + e / nx_m; return true; }
        int wgid = (int)L; { const int q = nwg / NXCD, r = nwg % NXCD, xcd = wgid % NXCD, off = wgid / NXCD; wgid = (xcd < r ? xcd * (q + 1) : r * (q + 1) + (xcd - r) * q) + off; }
        const int nig = WGM * nN, gid = wgid / nig, fm = gid * WGM, gsz = (nM - fm) < WGM ? (nM - fm) : WGM;
        u.pm = fm + ((wgid % nig) % gsz); u.pn = (wgid % nig) / gsz; return true;
    }
    __device__ __forceinline__ void a_ready(const Unit&) const {}
    __device__ __forceinline__ void done(const Unit&) const {}
};
template <class Epi, class Sched>
__device__ __forceinline__ void gemm_phase(PG8_LAS unsigned char* lds, const Gemm g, const Sched& S, const Epi& E) {
    const int tid = otid(g.wid), wid = __builtin_amdgcn_readfirstlane(tid >> 6), lane = tid & 63, wr = wid >> 2, wc = wid & 3, fr = lane & 15, fq = lane >> 4;
    const int K = g.K, nt = K / BK;
    unsigned voffA[2], voffB[2];
#pragma unroll
    for (int i = 0; i < 2; ++i) { int R, C; stage_rc(tid * 16 + i * 8192, R, C); const int Rb = Epi::PERM ? ((R & ~31) + perm32(R & 31)) : R;
        voffA[i] = (unsigned)(R * K + C) * 2u; voffB[i] = (unsigned)(Rb * K + C) * 2u; }
    const size_t kstep = (size_t)(BK * 2);
    const size_t hstep = (size_t)HALF * K * 2;
    const size_t tstep = 2 * hstep;
    const unsigned ldsw = (unsigned)wid * 1024u;
    const int aoff = lds_byte(wr * 64 + fr, fq * 8), boff = lds_byte(wc * 32 + fr, fq * 8);
#define PG8_SA(b, h) (((b) * 2 + (h)) * HTB)
#define PG8_SB(b, h) ((4 + (b) * 2 + (h)) * HTB)
#define PG8_STAGE(bufoff, gbase, voff) do { _Pragma("unroll") for (int _i = 0; _i < 2; ++_i) \
        __builtin_amdgcn_global_load_lds((const unsigned*)((const char*)(gbase) + (voff)[_i]), (PG8_LAS unsigned*)(lds + (bufoff) + ldsw + _i * 8192), 16, 0, 0); } while (0)
#define PG8_LDA(dst, b, h) do { _Pragma("unroll") for (int m = 0; m < 4; ++m) _Pragma("unroll") for (int k = 0; k < 2; ++k) dst[m][k] = *(const PG8_LAS bf16x8*)(lds + PG8_SA(b, h) + aoff + m * 2048 + k * 1024); } while (0)
#define PG8_LDB(dst, b, h) do { _Pragma("unroll") for (int n = 0; n < 2; ++n) _Pragma("unroll") for (int k = 0; k < 2; ++k) dst[n][k] = *(const PG8_LAS bf16x8*)(lds + PG8_SB(b, h) + boff + n * 2048 + k * 1024); } while (0)
#define PG8_MMA(ai, bj, At, Bt) do { __builtin_amdgcn_s_setprio(1); _Pragma("unroll") for (int m = 0; m < 4; ++m) _Pragma("unroll") for (int n = 0; n < 2; ++n) _Pragma("unroll") for (int k = 0; k < 2; ++k) \
        acc[ai][bj][m][n] = __builtin_amdgcn_mfma_f32_16x16x32_bf16(Bt[n][k], At[m][k], acc[ai][bj][m][n], 0, 0, 0); __builtin_amdgcn_s_setprio(0); } while (0)
#define PG8_WAIT_V(n) asm volatile("s_waitcnt vmcnt(" #n ")" ::: "memory")
#define PG8_WAIT_L(n) asm volatile("s_waitcnt lgkmcnt(" #n ")" ::: "memory")
#define PG8_BAR __builtin_amdgcn_s_barrier()
#define PG8_SCHED __builtin_amdgcn_sched_barrier(0)
    Unit cur, nxt; int ui = 0;
    if (!S.next(0, cur)) return;
    f32x4 acc[2][2][4][2];
#pragma unroll
    for (int a = 0; a < 2; ++a)
#pragma unroll
        for (int b = 0; b < 2; ++b)
#pragma unroll
            for (int m = 0; m < 4; ++m)
#pragma unroll
                for (int n = 0; n < 2; ++n) acc[a][b][m][n] = (f32x4){0.f, 0.f, 0.f, 0.f};
    bf16x8 At[4][2], B0[2][2], B1[2][2];
    const char* cA = (const char*)g.A + (size_t)cur.pm * tstep; const char* cB = (const char*)g.Bt + (size_t)cur.pn * tstep;
    S.a_ready(cur);
    PG8_STAGE(PG8_SB(0, 0), cB, voffB); PG8_STAGE(PG8_SA(0, 0), cA, voffA); PG8_STAGE(PG8_SB(0, 1), cB + hstep, voffB); PG8_STAGE(PG8_SA(0, 1), cA + hstep, voffA);
    if (wr == 1) PG8_BAR;
    PG8_WAIT_V(4); PG8_BAR;
    PG8_STAGE(PG8_SB(1, 0), cB + kstep, voffB); PG8_STAGE(PG8_SA(1, 0), cA + kstep, voffA); PG8_STAGE(PG8_SB(1, 1), cB + hstep + kstep, voffB);
    PG8_WAIT_V(6); PG8_BAR;
    for (;;) {
        const bool has_next = S.next(ui + 1, nxt);
        const char* nA = has_next ? (const char*)g.A + (size_t)nxt.pm * tstep : cA; const char* nB = has_next ? (const char*)g.Bt + (size_t)nxt.pn * tstep : cB;
        for (int t = 0; t < nt; t += 2) {
            const bool last = (t == nt - 2);
            const char* a1 = cA + (size_t)(t + 1) * kstep;
            const char* a2 = last ? nA : cA + (size_t)(t + 2) * kstep; const char* b2 = last ? nB : cB + (size_t)(t + 2) * kstep;
            const char* a3 = a2 + kstep; const char* b3 = b2 + kstep;
            if (last && has_next) S.a_ready(nxt);
            PG8_LDB(B0, 0, 0); PG8_SCHED; PG8_LDA(At, 0, 0); PG8_STAGE(PG8_SA(1, 1), a1 + hstep, voffA);
            PG8_WAIT_L(8); PG8_BAR; PG8_WAIT_L(0); PG8_MMA(0, 0, At, B0); PG8_BAR; PG8_SCHED;
            PG8_LDB(B1, 0, 1); PG8_STAGE(PG8_SB(0, 0), b2, voffB);
            PG8_BAR; PG8_WAIT_L(0); PG8_MMA(0, 1, At, B1); PG8_BAR;
            PG8_LDA(At, 0, 1); PG8_STAGE(PG8_SA(0, 0), a2, voffA);
            PG8_BAR; PG8_WAIT_L(0); PG8_MMA(1, 0, At, B0); PG8_BAR; PG8_SCHED;
            PG8_STAGE(PG8_SB(0, 1), b2 + hstep, voffB);
            PG8_WAIT_V(6); PG8_BAR; PG8_MMA(1, 1, At, B1); PG8_BAR;
            PG8_LDB(B0, 1, 0); PG8_SCHED; PG8_LDA(At, 1, 0); PG8_STAGE(PG8_SA(0, 1), a2 + hstep, voffA);
            PG8_WAIT_L(8); PG8_BAR; PG8_WAIT_L(0); PG8_MMA(0, 0, At, B0); PG8_BAR; PG8_SCHED;
            PG8_LDB(B1, 1, 1); PG8_STAGE(PG8_SB(1, 0), b3, voffB);
            PG8_BAR; PG8_WAIT_L(0); PG8_MMA(0, 1, At, B1); PG8_BAR;
            PG8_LDA(At, 1, 1); PG8_STAGE(PG8_SA(1, 0), a3, voffA);
            PG8_BAR; PG8_WAIT_L(0); PG8_MMA(1, 0, At, B0); PG8_BAR; PG8_SCHED;
            PG8_STAGE(PG8_SB(1, 1), b3 + hstep, voffB);
            PG8_WAIT_V(6); PG8_BAR; PG8_MMA(1, 1, At, B1); PG8_BAR;
        }
        if constexpr (!Epi::AFTER_DRAIN) { E(acc, cur, wr, wc, fr, fq); S.done(cur); }
        if (!has_next) break;
#pragma unroll
        for (int a = 0; a < 2; ++a)
#pragma unroll
            for (int b = 0; b < 2; ++b)
#pragma unroll
                for (int m = 0; m < 4; ++m)
#pragma unroll
                    for (int n = 0; n < 2; ++n) acc[a][b][m][n] = (f32x4){0.f, 0.f, 0.f, 0.f};
        cur = nxt; cA = nA; cB = nB; ++ui;
    }
    PG8_WAIT_V(0);
    if (wr == 0) PG8_BAR;
    PG8_BAR;
    if constexpr (Epi::AFTER_DRAIN) { E.fused(acc, cur, wr, wc, fr, fq, lds, wid, lane); S.done(cur); }
#undef PG8_SA
#undef PG8_SB
#undef PG8_STAGE
#undef PG8_LDA
#undef PG8_LDB
#undef PG8_MMA

#undef PG8_WAIT_V
#undef PG8_WAIT_L
#undef PG8_BAR
#undef PG8_SCHED
}
}

struct EpiG1 {
  static constexpr bool PERM = true, AFTER_DRAIN = false;
  unsigned char* ws;
  DI void operator()(const f32x4 (&acc)[2][2][4][2], const pg8::Unit& u, int wr, int wc, int fr, int fq) const {
    const int pn = u.pn; size_t off; int ld, c0;
    if (pn < 8) { off = OFF_PQ; ld = 2048; c0 = pn * 256; }
    else if (pn < 16) { off = OFF_PK; ld = 2048; c0 = (pn - 8) * 256; }
    else if (pn < 32) { off = OFF_PV; ld = 4096; c0 = (pn - 16) * 256; }
    else if (pn < 48) { off = OFF_PRG; ld = 4096; c0 = (pn - 32) * 256; }
    else if (pn < 72) { off = OFF_PHY; ld = 6144; c0 = (pn - 48) * 256; }
    else if (pn < 80) { off = OFF_PHG; ld = 2048; c0 = (pn - 72) * 256; }
    else { off = OFF_PMG; ld = 4096; c0 = (pn - 80) * 256; }
    bf16_t* base = (bf16_t*)(ws + off);
    const int row0 = u.pm * 256 + wr * 64 + fr, col0 = c0 + wc * 32 + 8 * fq;
#pragma unroll
    for (int ai = 0; ai < 2; ++ai)
#pragma unroll
      for (int m = 0; m < 4; ++m) { bf16_t* rowp = base + (size_t)(row0 + ai * 128 + m * 16) * ld + col0;
#pragma unroll
        for (int bj = 0; bj < 2; ++bj) { const f32x4 v0 = acc[ai][bj][m][0], v1 = acc[ai][bj][m][1];
          u32x4 o; o[0] = pk2(v0[0], v0[1]); o[1] = pk2(v0[2], v0[3]); o[2] = pk2(v1[0], v1[1]); o[3] = pk2(v1[2], v1[3]);
          *(u32x4*)(rowp + bj * 128) = o; } }
  }
};
template <int SECOND> struct EpiG23 {
  static constexpr bool PERM = true, AFTER_DRAIN = false;
  unsigned char* ws;
  DI void operator()(const f32x4 (&acc)[2][2][4][2], const pg8::Unit& u, int wr, int wc, int fr, int fq) const {
    bf16_t* T1 = (bf16_t*)(ws + OFF_T1); const bf16_t* MG = (const bf16_t*)(ws + OFF_PMG) + (SECOND ? 2048 : 0);
    const int row0 = u.pm * 256 + wr * 64 + fr, col0 = u.pn * 256 + wc * 32 + 8 * fq;
#pragma unroll
    for (int ai = 0; ai < 2; ++ai)
#pragma unroll
      for (int m = 0; m < 4; ++m) { const size_t row = (size_t)(row0 + ai * 128 + m * 16);
#pragma unroll
        for (int bj = 0; bj < 2; ++bj) { const int col = col0 + bj * 128;
          const u32x4 g = *(const u32x4*)(MG + row * 4096 + col);
          const f32x4 v0 = acc[ai][bj][m][0], v1 = acc[ai][bj][m][1];
          float r[8];
          r[0] = sigmoidf_(lo2f(g[0])) * v0[0]; r[1] = sigmoidf_(hi2f(g[0])) * v0[1]; r[2] = sigmoidf_(lo2f(g[1])) * v0[2]; r[3] = sigmoidf_(hi2f(g[1])) * v0[3];
          r[4] = sigmoidf_(lo2f(g[2])) * v1[0]; r[5] = sigmoidf_(hi2f(g[2])) * v1[1]; r[6] = sigmoidf_(lo2f(g[3])) * v1[2]; r[7] = sigmoidf_(hi2f(g[3])) * v1[3];
          if (SECOND) { const u32x4 t = *(const u32x4*)(T1 + row * 2048 + col);
            r[0] += lo2f(t[0]); r[1] += hi2f(t[0]); r[2] += lo2f(t[1]); r[3] += hi2f(t[1]); r[4] += lo2f(t[2]); r[5] += hi2f(t[2]); r[6] += lo2f(t[3]); r[7] += hi2f(t[3]); }
          u32x4 o; o[0] = pk2(r[0], r[1]); o[1] = pk2(r[2], r[3]); o[2] = pk2(r[4], r[5]); o[3] = pk2(r[6], r[7]);
          *(u32x4*)(T1 + row * 2048 + col) = o; } }
  }
};
struct EpiG4 {
  static constexpr bool PERM = false, AFTER_DRAIN = false;
  const float* xin; const float* cin; float* xout; float* cout; const float* mod;
  DI void operator()(const f32x4 (&acc)[2][2][4][2], const pg8::Unit& u, int wr, int wc, int fr, int fq) const {
    const int row0 = u.pm * 256 + wr * 64 + fr, col0 = u.pn * 256 + wc * 32 + 4 * fq;
#pragma unroll
    for (int ai = 0; ai < 2; ++ai)
#pragma unroll
      for (int m = 0; m < 4; ++m) { const int row = row0 + ai * 128 + m * 16;
        const float* src; float* dst; const float* gate;
        if (row < NLAT) { src = xin + (size_t)row * 2048; dst = xout + (size_t)row * 2048; gate = mod + (row >> 12) * 6144 + 4096; }
        else { src = cin + (size_t)(row - NLAT) * 2048; dst = cout + (size_t)(row - NLAT) * 2048; gate = mod + 4 * 6144 + 4096; }
#pragma unroll
        for (int bj = 0; bj < 2; ++bj)
#pragma unroll
          for (int n = 0; n < 2; ++n) { const int col = col0 + bj * 128 + n * 16;
            const f32x4 xv = *(const f32x4*)(src + col), gv = *(const f32x4*)(gate + col);
            *(f32x4*)(dst + col) = xv + gv * acc[ai][bj][m][n]; } }
  }
};

__device__ void phase_mod(const Params& p, unsigned char* shm) {
  float* sc = (float*)shm; float* red = sc + 5 * 2048;
  const int tid = otid(p.wid);
  for (int i = tid; i < 5 * 2048; i += 512) { const int j = i >> 11, k = i & 2047; const float v = (j < 4) ? p.c[j * 2048 + k] : p.c_ctx[k]; sc[i] = v / (1.f + expf(-v)); }
  __syncthreads();
  float* mod = (float*)(p.ws + OFF_MOD);
  const int cq = tid & 7, ks = tid >> 3;
  for (int it = blockIdx.x; it < 384; it += gridDim.x) {
    const int l = it / 192, nb = (it % 192) * 32;
    const float* W = p.ada_w + (size_t)l * 2048 * 6144 + nb + cq * 4;
    float acc[5][4];
#pragma unroll
    for (int j = 0; j < 5; ++j) { acc[j][0] = 0.f; acc[j][1] = 0.f; acc[j][2] = 0.f; acc[j][3] = 0.f; }
#pragma unroll 4
    for (int kk = 0; kk < 32; ++kk) { const int k = ks * 32 + kk; const float4 w = *(const float4*)(W + (size_t)k * 6144);
#pragma unroll
      for (int j = 0; j < 5; ++j) { const float s = sc[j * 2048 + k]; acc[j][0] += s * w.x; acc[j][1] += s * w.y; acc[j][2] += s * w.z; acc[j][3] += s * w.w; } }
#pragma unroll
    for (int j = 0; j < 5; ++j)
#pragma unroll
      for (int e = 0; e < 4; ++e) red[ks * 160 + j * 32 + cq * 4 + e] = acc[j][e];
    __syncthreads();
    if (tid < 160) { float s = 0.f; for (int q = 0; q < 64; ++q) s += red[q * 160 + tid]; const int j = tid >> 5, n = nb + (tid & 31); mod[(l * 5 + j) * 6144 + n] = s + p.ada_b[l * 6144 + n]; }
    __syncthreads();
  }
}

__device__ void cvt_tile(int wid, const float* W, bf16_t* Wt, int K, int N, int k0, int n0, float scale, float* tile) {
  const int tid = otid(wid);
#pragma unroll
  for (int rr = 0; rr < 2; ++rr) { const int k = (tid >> 4) + 32 * rr, n = (tid & 15) * 4; const float4 v = *(const float4*)(W + (size_t)(k0 + k) * N + n0 + n);
    tile[k * 65 + n] = v.x; tile[k * 65 + n + 1] = v.y; tile[k * 65 + n + 2] = v.z; tile[k * 65 + n + 3] = v.w; }
  __syncthreads();
  { const int n = tid >> 3, k8 = (tid & 7) * 8; u32x4 o;
#pragma unroll
    for (int e = 0; e < 4; ++e) o[e] = pk2(tile[(k8 + 2 * e) * 65 + n] * scale, tile[(k8 + 2 * e + 1) * 65 + n] * scale);
    *(u32x4*)(Wt + (size_t)(n0 + n) * K + k0 + k8) = o; }
  __syncthreads();
}
__device__ void phase_cvt(const Params& p, int l, unsigned char* shm) {
  float* tile = (float*)shm;
  for (int it = blockIdx.x; it < 16384; it += gridDim.x) {
    if (it < 12288) { const int kt = it & 31, ntl = it >> 5; const int n0 = ntl * 64;
      cvt_tile(p.wid, p.w_in + (size_t)l * DM * INW, (bf16_t*)(p.ws + OFF_WTIN), DM, INW, kt * 64, n0, (n0 >= 2048 && n0 < 4096) ? 0.0625f : 1.f, tile); }
    else if (it < 13312) { const int e = it - 12288; cvt_tile(p.wid, p.w_hy_out + (size_t)l * DM * DM, (bf16_t*)(p.ws + OFF_WTHY), DM, DM, (e & 31) * 64, (e >> 5) * 64, 1.f, tile); }
    else if (it < 15360) { const int e = it - 13312; cvt_tile(p.wid, p.w_ret_out + (size_t)l * 4096 * DM, (bf16_t*)(p.ws + OFF_WTRET), 4096, DM, (e & 63) * 64, (e >> 6) * 64, 1.f, tile); }
    else { const int e = it - 15360; cvt_tile(p.wid, p.w_o + (size_t)l * DM * DM, (bf16_t*)(p.ws + OFF_WTO), DM, DM, (e & 31) * 64, (e >> 5) * 64, 1.f, tile); }
  }
}

__device__ void filt_item(const Params& p, int l, int Ls, int T, bool isctx, unsigned char* shm) {
  float* z = (float*)shm; float* ha = z + 33 * 36; float* hb = ha + 33 * 64;
  const int tid = otid(p.wid);
  const float* w1 = p.fw1 + l * 33 * 64; const float* b1 = p.fb1 + l * 64; const float* w2 = p.fw2 + l * 4096; const float* b2 = p.fb2 + l * 64;
  const float* w3 = p.fw3 + l * 4096; const float* b3 = p.fb3 + l * 64; const float* fq = p.ffreq + l * 64; const float* wout = p.fwout + (size_t)l * 64 * 4096;
  for (int i = tid; i < 33 * 33; i += 512) { const int pl = i / 33, f = i % 33; int pp = T * 32 + pl; if (pp > Ls - 1) pp = Ls - 1;
    float val;
    if (f == 0) val = (float)pp / (float)(Ls - 1);
    else { const int j = (f - 1) & 15; const float fj = 1e-4f + (float)j * ((15.f - 1e-4f) / 15.f); const float ang = 6.283185307179586f * (float)pp / (float)Ls; const float a = fj * ang; val = (f <= 16) ? cosf(a) : -sinf(a); }
    z[pl * 36 + f] = val; }
  __syncthreads();
  for (int idx = tid; idx < 33 * 16; idx += 512) { const int pl = idx >> 4, j0 = (idx & 15) * 4; float a[4] = {0.f, 0.f, 0.f, 0.f};
#pragma unroll 3
    for (int k = 0; k < 33; ++k) { const float v = z[pl * 36 + k]; const float4 w = *(const float4*)(w1 + k * 64 + j0); a[0] += v * w.x; a[1] += v * w.y; a[2] += v * w.z; a[3] += v * w.w; }
#pragma unroll
    for (int e = 0; e < 4; ++e) ha[pl * 64 + j0 + e] = sinf(fq[j0 + e] * (a[e] + b1[j0 + e])); }
  __syncthreads();
  for (int idx = tid; idx < 33 * 16; idx += 512) { const int pl = idx >> 4, j0 = (idx & 15) * 4; float a[4] = {0.f, 0.f, 0.f, 0.f};
#pragma unroll 4
    for (int k = 0; k < 64; ++k) { const float v = ha[pl * 64 + k]; const float4 w = *(const float4*)(w2 + k * 64 + j0); a[0] += v * w.x; a[1] += v * w.y; a[2] += v * w.z; a[3] += v * w.w; }
#pragma unroll
    for (int e = 0; e < 4; ++e) hb[pl * 64 + j0 + e] = sinf(fq[j0 + e] * (a[e] + b2[j0 + e])); }
  __syncthreads();
  for (int idx = tid; idx < 33 * 16; idx += 512) { const int pl = idx >> 4, j0 = (idx & 15) * 4; float a[4] = {0.f, 0.f, 0.f, 0.f};
#pragma unroll 4
    for (int k = 0; k < 64; ++k) { const float v = hb[pl * 64 + k]; const float4 w = *(const float4*)(w3 + k * 64 + j0); a[0] += v * w.x; a[1] += v * w.y; a[2] += v * w.z; a[3] += v * w.w; }
#pragma unroll
    for (int e = 0; e < 4; ++e) ha[pl * 64 + j0 + e] = sinf(fq[j0 + e] * (a[e] + b3[j0 + e])); }
  __syncthreads();
  const int c2 = tid * 8; const bool isb = c2 >= 2048; const int cb = c2 & 2047;
  const float mind = logf(0.01f) / 1.5f, maxd = logf(0.01f) / 0.3f;
  bf16_t* G = (bf16_t*)(p.ws + OFF_G); float* GC = (float*)(p.ws + OFF_GC);
  for (int pgh = 0; pgh < 8; ++pgh) {
    const int pg = pgh >> 1, c4 = c2 + (pgh & 1) * 4;
    const int plb = pg * 8 + (isb ? 0 : 1);
    float acc[8][4];
#pragma unroll
    for (int e = 0; e < 8; ++e) { acc[e][0] = 0.f; acc[e][1] = 0.f; acc[e][2] = 0.f; acc[e][3] = 0.f; }
#pragma unroll 2
    for (int k = 0; k < 64; ++k) { const float4 wa = *(const float4*)(wout + k * 4096 + c4);
#pragma unroll
      for (int e = 0; e < 8; ++e) { const float h = ha[(plb + e) * 64 + k]; acc[e][0] += h * wa.x; acc[e][1] += h * wa.y; acc[e][2] += h * wa.z; acc[e][3] += h * wa.w; } }
    const int pp0 = T * 32 + plb;
#pragma unroll
    for (int cc = 0; cc < 4; ++cc) { const int c = (c4 & 2047) + cc; const float delta = fabsf(mind + (float)c * ((maxd - mind) / 2047.f));
      float v[8];
#pragma unroll
      for (int e = 0; e < 8; ++e) { const int pp = pp0 + e; v[e] = (pp < Ls) ? acc[e][cc] * __expf(-((float)pp / (float)(Ls - 1)) * delta) : 0.f; }
      if (!isctx) {
        bf16_t* Gc = G + (size_t)c * GLEN;
        if (isb) {
          if (pp0 == 0) { for (int e = 1; e < 8; ++e) Gc[LOFF + e] = f2bf(v[e]); }
          else { u32x4 o; o[0] = pk2(v[0], v[1]); o[1] = pk2(v[2], v[3]); o[2] = pk2(v[4], v[5]); o[3] = pk2(v[6], v[7]); *(u32x4*)(Gc + LOFF + pp0) = o; }
        } else {
          u32x4 o; o[0] = pk2(v[7], v[6]); o[1] = pk2(v[5], v[4]); o[2] = pk2(v[3], v[2]); o[3] = pk2(v[1], v[0]); *(u32x4*)(Gc + LOFF - pp0 - 7) = o;
        }
      } else {
        float* Gc = GC + (size_t)c * 512;
#pragma unroll
        for (int e = 0; e < 8; ++e) { const int pp = pp0 + e; if (isb) { if (pp >= 1 && pp < Ls) Gc[256 - pp] = v[e]; } else { if (pp < Ls) Gc[256 + pp] = v[e]; } }
      }
    }
  }
  if (T == 0 && !isb) {
#pragma unroll 1
    for (int cc = 0; cc < 8; ++cc) { float a = 0.f;
#pragma unroll 4
      for (int k = 0; k < 64; ++k) a += ha[k] * wout[k * 4096 + c2 + cc];
      if (!isctx) G[(size_t)(cb + cc) * GLEN + LOFF] = f2bf(a); else GC[(size_t)(cb + cc) * 512 + 256] = a; }
  }
  __syncthreads();
}
__device__ void phase_filters(const Params& p, int l, unsigned char* shm) {
  const int nit = 128 + (l == 0 ? 8 : 0);
  for (int it = blockIdx.x; it < nit; it += gridDim.x) { if (it < 128) filt_item(p, l, SEQ, it, false, shm); else filt_item(p, l, CTXL, it - 128, true, shm); }
}

__device__ void phase_norm(const Params& p, int l) {
  const int lane = otid(p.wid) & 63, gw = blockIdx.x * 8 + (otid(p.wid) >> 6), nw = gridDim.x * 8;
  const float* mod = (const float*)(p.ws + OFF_MOD) + (size_t)l * 5 * 6144; const float* lng = p.ln_g + l * 2048;
  bf16_t* H = (bf16_t*)(p.ws + OFF_H);
  for (int r = gw; r < MT; r += nw) {
    const float* src; int j;
    if (r < NLAT) { src = (l == 0 ? p.x : p.out) + (size_t)r * 2048; j = r >> 12; }
    else { src = (l == 0 ? p.ctx : (const float*)(p.ws + OFF_CTXR)) + (size_t)(r - NLAT) * 2048; j = 4; }
    const float* sh = mod + j * 6144; const float* sc = sh + 2048;
    float4 v[8]; float ss = 0.f;
#pragma unroll
    for (int i = 0; i < 8; ++i) { v[i] = *(const float4*)(src + i * 256 + lane * 4); ss += v[i].x * v[i].x + v[i].y * v[i].y + v[i].z * v[i].z + v[i].w * v[i].w; }
    ss = wsum(ss, lane);
    const float rs = rsqrtf(ss * (1.f / 2048.f) + 1e-6f);
#pragma unroll
    for (int i = 0; i < 8; ++i) { const int col = i * 256 + lane * 4; const float4 g = *(const float4*)(lng + col), a = *(const float4*)(sc + col), b = *(const float4*)(sh + col);
      u32x2 o; o[0] = pk2(v[i].x * rs * g.x * (1.f + a.x) + b.x, v[i].y * rs * g.y * (1.f + a.y) + b.y); o[1] = pk2(v[i].z * rs * g.z * (1.f + a.z) + b.z, v[i].w * rs * g.w * (1.f + a.w) + b.w);
      *(u32x2*)(H + (size_t)r * 2048 + col) = o; }
  }
}
__device__ void phase_final(const Params& p) {
  const int lane = otid(p.wid) & 63, gw = blockIdx.x * 8 + (otid(p.wid) >> 6), nw = gridDim.x * 8;
  for (int r = gw; r < NLAT; r += nw) {
    float* src = p.out + (size_t)r * 2048; float4 v[8]; float ss = 0.f;
#pragma unroll
    for (int i = 0; i < 8; ++i) { v[i] = *(const float4*)(src + i * 256 + lane * 4); ss += v[i].x * v[i].x + v[i].y * v[i].y + v[i].z * v[i].z + v[i].w * v[i].w; }
    ss = wsum(ss, lane);
    const float rs = rsqrtf(ss * (1.f / 2048.f) + 1e-6f);
#pragma unroll
    for (int i = 0; i < 8; ++i) { const int col = i * 256 + lane * 4; const float4 g = *(const float4*)(p.final_g + col); float4 o; o.x = v[i].x * rs * g.x; o.y = v[i].y * rs * g.y; o.z = v[i].z * rs * g.z; o.w = v[i].w * rs * g.w; *(float4*)(src + col) = o; }
  }
}

DI void tok_tile(int tk, int& b, int& t0, bool& isctx) { if (tk < 256) { b = tk >> 6; t0 = (tk & 63) * 64; isctx = false; } else { b = (tk - 256) >> 2; t0 = ((tk - 256) & 3) * 64; isctx = true; } }
DI int tok_row(int b, int t, bool isctx) { return isctx ? NLAT + b * CTXL + t : b * SEQ + t; }

__device__ void phase_prep(const Params& p, int l, unsigned char* shm) {
  const int tid = otid(p.wid), lane = tid & 63;
  float2* cs = (float2*)shm;
  unsigned char* reg2 = shm + 32768;
  for (int i = tid; i < 4096; i += 512) { const int pos = i >> 6, j = i & 63; const float inv = 1.f / powf(10000.f, (float)j / 64.f); float s, c; sincosf((float)pos * inv, &s, &c); cs[i] = make_float2(c, s); }
  __syncthreads();
  { bf16_t* PQ = (bf16_t*)(p.ws + OFF_PQ); const int gw = blockIdx.x * 8 + (tid >> 6), nw = gridDim.x * 8;
    for (int r = gw; r < NLAT; r += nw) { const int t = r & 4095, rp = t >> 6, cp = t & 63; bf16_t* row = PQ + (size_t)r * 2048;
#pragma unroll 4
      for (int e = 0; e < 16; ++e) { const int i1 = (e >> 1) * 256 + (e & 1) * 128 + lane; const float2 v = cs[((e & 1) ? cp : rp) * 64 + lane];
        const float p1 = bf2f(row[i1]), p2 = bf2f(row[i1 + 64]); row[i1] = f2bf(p1 * v.x - p2 * v.y); row[i1 + 64] = f2bf(p1 * v.y + p2 * v.x); } } }
  { unsigned* tl = (unsigned*)reg2;
    bf16_t* tls = (bf16_t*)reg2;
    for (int it = blockIdx.x; it < 272 * 24; it += gridDim.x) {
      const int tk = it / 24, sub = it % 24; int b, t0; bool isctx; tok_tile(tk, b, t0, isctx);
      bf16_t* src; int ld, co; bf16_t* dst; const bool isk = sub < 8;
      if (isk) { src = (bf16_t*)(p.ws + OFF_PK); ld = 2048; co = sub * 256; dst = (bf16_t*)(p.ws + OFF_KT) + (size_t)((b * 8 + sub) * 256) * TT; }
      else { const int hh = (sub - 8) >> 1, hf = (sub - 8) & 1; src = (bf16_t*)(p.ws + OFF_PV); ld = 4096; co = hh * 512 + hf * 256; dst = (bf16_t*)(p.ws + OFF_VT) + (size_t)((b * 8 + hh) * 512 + hf * 256) * TT; }
      const int row0 = tok_row(b, t0, isctx), tt0 = isctx ? t0 : CTXL + t0;
#pragma unroll
      for (int e = 0; e < 4; ++e) { const int id = tid + 512 * e, row = id >> 5, pc = id & 31; const u32x4 v = *(const u32x4*)(src + (size_t)(row0 + row) * ld + co + pc * 8);
        unsigned* d = tl + row * 129 + pc * 4; d[0] = v[0]; d[1] = v[1]; d[2] = v[2]; d[3] = v[3]; }
      __syncthreads();
      if (isk && !isctx) {
#pragma unroll 4
        for (int e = 0; e < 16; ++e) { const int id = tid + 512 * e, tok = id >> 7, pr = id & 127, hf = pr >> 6, j = pr & 63; const int t = t0 + tok;
          const float2 v = cs[(hf ? (t & 63) : (t >> 6)) * 64 + j]; bf16_t* q = tls + tok * 258 + hf * 128 + j;
          const float p1 = bf2f(q[0]), p2 = bf2f(q[64]); q[0] = f2bf(p1 * v.x - p2 * v.y); q[64] = f2bf(p1 * v.y + p2 * v.x); }
        __syncthreads();
#pragma unroll
        for (int e = 0; e < 4; ++e) { const int id = tid + 512 * e, row = id >> 5, pc = id & 31; const unsigned* d = tl + row * 129 + pc * 4; u32x4 v; v[0] = d[0]; v[1] = d[1]; v[2] = d[2]; v[3] = d[3];
          *(u32x4*)(src + (size_t)(row0 + row) * ld + co + pc * 8) = v; }
      }
      { const int d = tid >> 1, th = (tid & 1) * 32;
#pragma unroll
        for (int q = 0; q < 4; ++q) { u32x4 o;
#pragma unroll
          for (int e = 0; e < 4; ++e) { const int tok = th + q * 8 + 2 * e; o[e] = (unsigned)tls[tok * 258 + d] | ((unsigned)tls[(tok + 1) * 258 + d] << 16); }
          *(u32x4*)(dst + (size_t)d * TT + tt0 + th + q * 8) = o; } }
      __syncthreads();
    }
  }
  { float* in = (float*)reg2;
    bf16_t* ut = (bf16_t*)(reg2 + 3 * 66 * 64 * 4);
    const bf16_t* PHY = (const bf16_t*)(p.ws + OFF_PHY); bf16_t* HV = (bf16_t*)(p.ws + OFF_HV); bf16_t* HX0 = (bf16_t*)(p.ws + OFF_HX0);
    const float* cw = p.conv_w + (size_t)l * 3 * 6144; const float* cb = p.conv_b + (size_t)l * 6144;
    const int ntk = (l == 0) ? 272 : 256;
    for (int it = blockIdx.x; it < ntk * 32; it += gridDim.x) {
      const int tk = it >> 5, c0 = (it & 31) * 64; int b, t0; bool isctx; tok_tile(tk, b, t0, isctx); const int Ls = isctx ? CTXL : SEQ; const int row0 = tok_row(b, t0, isctx);
      for (int id = tid; id < 3 * 66 * 8; id += 512) { const int pi = id / 528, rem = id % 528, rr = rem >> 3, pc = rem & 7; const int t = t0 - 1 + rr;
        u32x4 v; v[0] = 0u; v[1] = 0u; v[2] = 0u; v[3] = 0u;
        if (t >= 0 && t < Ls) v = *(const u32x4*)(PHY + (size_t)(row0 - 1 + rr) * 6144 + pi * 2048 + c0 + pc * 8);
        float* d = in + (pi * 66 + rr) * 64 + pc * 8;
        d[0] = lo2f(v[0]); d[1] = hi2f(v[0]); d[2] = lo2f(v[1]); d[3] = hi2f(v[1]); d[4] = lo2f(v[2]); d[5] = hi2f(v[2]); d[6] = lo2f(v[3]); d[7] = hi2f(v[3]); }
      __syncthreads();
      { const int c = tid & 63, tg = tid >> 6; float w[3][3], bb[3];
#pragma unroll
        for (int pi = 0; pi < 3; ++pi) { bb[pi] = cb[pi * 2048 + c0 + c];
#pragma unroll
          for (int k = 0; k < 3; ++k) w[pi][k] = cw[k * 6144 + pi * 2048 + c0 + c]; }
#pragma unroll
        for (int e = 0; e < 8; ++e) { const int tok = tg * 8 + e; float cv[3];
#pragma unroll
          for (int pi = 0; pi < 3; ++pi) cv[pi] = in[(pi * 66 + tok) * 64 + c] * w[pi][0] + in[(pi * 66 + tok + 1) * 64 + c] * w[pi][1] + in[(pi * 66 + tok + 2) * 64 + c] * w[pi][2] + bb[pi];
          const bf16_t hv = f2bf(cv[0] * cv[2]);
          HV[(size_t)(row0 + tok) * 2048 + c0 + c] = hv; HX0[(size_t)(row0 + tok) * 2048 + c0 + c] = f2bf(cv[1]); ut[c * 66 + tok] = hv; } }
      __syncthreads();
      { const int c = tid >> 3, pc = tid & 7; u32x4 o;
#pragma unroll
        for (int e = 0; e < 4; ++e) o[e] = (unsigned)ut[c * 66 + pc * 8 + 2 * e] | ((unsigned)ut[c * 66 + pc * 8 + 2 * e + 1] << 16);
        bf16_t* dst = isctx ? (bf16_t*)(p.ws + OFF_UTC) + ((size_t)(c0 + c) * NB + b) * CTXL + t0 + pc * 8 : (bf16_t*)(p.ws + OFF_UT) + ((size_t)(c0 + c) * NB + b) * SEQ + t0 + pc * 8;
        *(u32x4*)dst = o; }
      __syncthreads();
    }
  }
}

__device__ void phase_post(const Params& p, int l, unsigned char* shm) {
  const int tid = otid(p.wid), lane = tid & 63;
  const bf16_t* HV = (const bf16_t*)(p.ws + OFF_HV); const bf16_t* HX0 = (const bf16_t*)(p.ws + OFF_HX0); const bf16_t* PHG = (const bf16_t*)(p.ws + OFF_PHG);
  bf16_t* AH = (bf16_t*)(p.ws + OFF_H); const float* hbias = p.hy_bias + l * 2048;
  { float* yt = (float*)shm;
    const bf16_t* UT = (const bf16_t*)(p.ws + OFF_UT);
    for (int it = blockIdx.x; it < 256 * 32; it += gridDim.x) {
      const int tk = it >> 5, c0 = (it & 31) * 64, b = tk >> 6, t0 = (tk & 63) * 64, row0 = b * SEQ + t0;
      { const int c = tid >> 3, pc = tid & 7; const u32x4 v = *(const u32x4*)(UT + ((size_t)(c0 + c) * NB + b) * SEQ + t0 + pc * 8); float* d = yt + c * 65 + pc * 8;
        d[0] = lo2f(v[0]); d[1] = hi2f(v[0]); d[2] = lo2f(v[1]); d[3] = hi2f(v[1]); d[4] = lo2f(v[2]); d[5] = hi2f(v[2]); d[6] = lo2f(v[3]); d[7] = hi2f(v[3]); }
      __syncthreads();
      { const int c = tid & 63, tg = tid >> 6; const float hb = hbias[c0 + c];
#pragma unroll
        for (int e = 0; e < 8; ++e) { const int tok = tg * 8 + e; const size_t o = (size_t)(row0 + tok) * 2048 + c0 + c;
          const float hv = bf2f(HV[o]); AH[o] = f2bf((yt[c * 65 + tok] + hb * hv) * bf2f(HX0[o]) * siluf_(bf2f(PHG[o]))); } }
      __syncthreads();
    }
  }
  if (l == 0) { float* gc = (float*)shm; float* us = gc + 32 * 512;
    const bf16_t* UTC = (const bf16_t*)(p.ws + OFF_UTC); const float* GC = (const float*)(p.ws + OFF_GC);
    for (int it = blockIdx.x; it < 16 * 64; it += gridDim.x) {
      const int tk = it >> 6, c0 = (it & 63) * 32, b = tk >> 2, t0 = (tk & 3) * 64, row0 = NLAT + b * CTXL + t0;
      for (int i = tid; i < 32 * 512; i += 512) gc[i] = GC[(size_t)(c0 + (i >> 9)) * 512 + (i & 511)];
      for (int i = tid; i < 32 * 256; i += 512) us[i] = bf2f(UTC[((size_t)(c0 + (i >> 8)) * NB + b) * CTXL + (i & 255)]);
      __syncthreads();
      { const int t = tid & 63, cg4 = tid >> 6;
#pragma unroll 1
        for (int e = 0; e < 4; ++e) { const int c = cg4 * 4 + e; const float* g = gc + c * 512 + 256 + t0 + t; const float* u = us + c * 256; float a = 0.f;
          for (int s = 0; s < 256; ++s) a += u[s] * g[-s];
          const size_t o = (size_t)(row0 + t) * 2048 + c0 + c; const float hv = bf2f(HV[o]);
          AH[o] = f2bf((a + hbias[c0 + c] * hv) * bf2f(HX0[o]) * siluf_(bf2f(PHG[o]))); } }
      __syncthreads();
    }
  }
  { bf16_t* OF = (bf16_t*)(p.ws + OFF_OF); const bf16_t* OB = (const bf16_t*)(p.ws + OFF_OB); const bf16_t* RG = (const bf16_t*)(p.ws + OFF_PRG);
    const int gw = blockIdx.x * 8 + (tid >> 6), nw = gridDim.x * 8; const int nrows = (l == 0) ? MT : NLAT;
    for (int it = gw; it < nrows * 8; it += nw) { const size_t o = (size_t)(it >> 3) * 4096 + (it & 7) * 512 + lane * 8;
      const u32x4 a = *(const u32x4*)(OF + o), bq = *(const u32x4*)(OB + o), g = *(const u32x4*)(RG + o);
      float v[8]; float ss = 0.f;
#pragma unroll
      for (int e = 0; e < 4; ++e) { v[2 * e] = lo2f(a[e]) + lo2f(bq[e]); v[2 * e + 1] = hi2f(a[e]) + hi2f(bq[e]); ss += v[2 * e] * v[2 * e] + v[2 * e + 1] * v[2 * e + 1]; }
      ss = wsum(ss, lane);
      const float rs = rsqrtf(ss * (1.f / 512.f) + 1e-6f);
      u32x4 r;
#pragma unroll
      for (int e = 0; e < 4; ++e) r[e] = pk2(v[2 * e] * rs * siluf_(lo2f(g[e])), v[2 * e + 1] * rs * siluf_(hi2f(g[e])));
      *(u32x4*)(OF + o) = r; }
  }
}

__device__ void phase_conv(const Params& p, unsigned char* shm) {
  const int tid = otid(p.wid), lane = tid & 63, wid = tid >> 6;
  bf16_t* Gs = (bf16_t*)shm;
  bf16_t* Us = (bf16_t*)(shm + 2 * GLEN * 2);
  { unsigned zz = 0u; asm volatile("" : "+v"(zz)); u32x4 z; z[0] = zz; z[1] = zz; z[2] = zz; z[3] = zz; for (int i = tid; i < 2 * 4 * USTR / 8; i += 512) ((u32x4*)Us)[i] = z; }
  __syncthreads();
  const int ch = wid >> 2, q = wid & 3, i = lane & 31, g = lane >> 5, a_l = i >> 2, b = i & 3;
  const bf16_t* G = (const bf16_t*)(p.ws + OFF_G); bf16_t* UT = (bf16_t*)(p.ws + OFF_UT);
  const int mb = LOFF - i + 8 * g - 128 * (8 * q + 7);
  const unsigned sh = (unsigned)(mb & 1) * 16u;
  const unsigned* Gd = (const unsigned*)(Gs + ch * GLEN) + (mb >> 1);
  const bf16_t* Ub = Us + (ch * 4 + b) * USTR + 136 * (a_l + 1) + 8 * g;
#define CONV_LDFRAG(dst, n) do { const unsigned* q_ = Gd + 8 * (n); const unsigned d0 = q_[0], d1 = q_[1], d2 = q_[2], d3 = q_[3], d4 = q_[4]; u32x4 r_; \
    r_[0] = __builtin_amdgcn_alignbit(d1, d0, sh); r_[1] = __builtin_amdgcn_alignbit(d2, d1, sh); r_[2] = __builtin_amdgcn_alignbit(d3, d2, sh); r_[3] = __builtin_amdgcn_alignbit(d4, d3, sh); \
    dst = __builtin_bit_cast(bf16x8, r_); } while (0)
  for (int pr = blockIdx.x; pr < 1024; pr += gridDim.x) {
    for (int id = tid; id < 2 * (GLEN / 2); id += 512) { const int cc = id / (GLEN / 2), dw = id % (GLEN / 2);
      unsigned v = ((const unsigned*)(G + (size_t)(pr * 2 + cc) * GLEN))[dw]; const int m = dw * 2;
      if (m < 33 || m > 8223) v &= 0xffff0000u; if (m + 1 < 33 || m + 1 > 8223) v &= 0x0000ffffu;
      ((unsigned*)Gs)[cc * (GLEN / 2) + dw] = v; }
    for (int id = tid; id < 2 * 4 * 512; id += 512) { const int cc = id >> 11, bb = (id >> 9) & 3, s8 = id & 511;
      const u32x4 v = *(const u32x4*)(UT + ((size_t)(pr * 2 + cc) * 4 + bb) * SEQ + s8 * 8); const int sp = 1024 + s8 * 8;
      *(u32x4*)(Us + (cc * 4 + bb) * USTR + sp + 8 * (sp >> 7)) = v; }
    __syncthreads();
    bf16x8 W[8]; f32x16 acc[4];
#pragma unroll
    for (int h = 0; h < 4; ++h)
#pragma unroll
      for (int e = 0; e < 16; ++e) acc[h][e] = 0.f;
    CONV_LDFRAG(W[2], -6); CONV_LDFRAG(W[3], -5); CONV_LDFRAG(W[4], -4); CONV_LDFRAG(W[5], -3); CONV_LDFRAG(W[6], -2); CONV_LDFRAG(W[7], -1);
#pragma unroll 1
    for (int it = 0; it < 39; ++it) {
#pragma unroll
      for (int u = 0; u < 8; ++u) {
        CONV_LDFRAG(W[u], it * 8 + u);
        const bf16x8 bf = *(const bf16x8*)(Ub + 136 * it + 16 * u);
#pragma unroll
        for (int h = 0; h < 4; ++h) acc[h] = __builtin_amdgcn_mfma_f32_32x32x16_bf16(W[(u - 2 * h) & 7], bf, acc[h], 0, 0, 0);
      }
    }
    { bf16_t* yrow = UT + ((size_t)(pr * 2 + ch) * 4 + b) * SEQ + 128 * (8 * q + a_l) + 4 * g;
#pragma unroll
      for (int h = 0; h < 4; ++h)
#pragma unroll
        for (int rq = 0; rq < 4; ++rq) { u32x2 o; o[0] = pk2(acc[h][4 * rq], acc[h][4 * rq + 1]); o[1] = pk2(acc[h][4 * rq + 2], acc[h][4 * rq + 3]); *(u32x2*)(yrow + 32 * h + 8 * rq) = o; } }
    __syncthreads();
  }
#undef CONV_LDFRAG
}

template <int KD> DI f32x16 mma_tile(f32x16 acc, const bf16_t* A, int lda, const bf16_t* B, int ldb, int lane) {
  const int r = lane & 31, g8 = (lane >> 5) * 8; const bf16_t* ap = A + r * lda + g8; const bf16_t* bp = B + r * ldb + g8;
#pragma unroll 4
  for (int k0 = 0; k0 < KD; k0 += 16) acc = __builtin_amdgcn_mfma_f32_32x32x16_bf16(*(const bf16x8*)(ap + k0), *(const bf16x8*)(bp + k0), acc, 0, 0, 0);
  return acc;
}
__device__ void phase_ret(const Params& p, int l, unsigned char* shm) {
  constexpr int QS = 264, TS = 72;
  const int tid = otid(p.wid), lane = tid & 63, wid = tid >> 6, g = lane >> 5;
  bf16_t* Qs = (bf16_t*)shm; bf16_t* Ks = Qs + 64 * QS; bf16_t* Kts = Ks + 64 * QS; bf16_t* Vts = Kts + 256 * TS; bf16_t* Ps = Vts + 64 * TS; bf16_t* Sts = Ps + 64 * TS;
  const bf16_t* PQ = (const bf16_t*)(p.ws + OFF_PQ); const bf16_t* PK = (const bf16_t*)(p.ws + OFF_PK);
  const bf16_t* KT = (const bf16_t*)(p.ws + OFF_KT); const bf16_t* VT = (const bf16_t*)(p.ws + OFF_VT);
  for (int it = blockIdx.x; it < 512; it += gridDim.x) {
    const int sl = it & 7, dir = (it >> 3) & 1, h = (it >> 4) & 7, b = it >> 7;
    const float lg = -expf(p.ret_decay[(l * 2 + dir) * 8 + h]);
    bf16_t* O = (bf16_t*)(p.ws + (dir ? OFF_OB : OFF_OF));
    for (int i = tid; i < 64 * QS / 2; i += 512) ((unsigned*)Sts)[i] = 0u;
    f32x16 S[4], cross;
#pragma unroll
    for (int x = 0; x < 4; ++x)
#pragma unroll
      for (int e = 0; e < 16; ++e) S[x][e] = 0.f;
#pragma unroll
    for (int e = 0; e < 16; ++e) cross[e] = 0.f;
    const float cd = __expf(lg * 64.f);
#pragma unroll 1
    for (int step = 0; step < 68; ++step) {
      bool isctx; int t0;
      if (step < 4) { isctx = true; t0 = (dir ? 3 - step : step) * 64; } else { isctx = false; const int cn = step - 4; t0 = (dir ? 63 - cn : cn) * 64; }
      const int row0 = tok_row(b, t0, isctx), tt0 = isctx ? t0 : CTXL + t0;
      __syncthreads();
      { const unsigned qoff = (unsigned)(row0 + (tid >> 5)) * 2048u + (unsigned)(h * 256 + (tid & 31) * 8);
#pragma unroll
        for (int e = 0; e < 4; ++e) { const int row = (tid >> 5) + 16 * e, pc = tid & 31;
          *(u32x4*)(Qs + row * QS + pc * 8) = *(const u32x4*)(PQ + (qoff + (unsigned)e * 32768u));
          *(u32x4*)(Ks + row * QS + pc * 8) = *(const u32x4*)(PK + (qoff + (unsigned)e * 32768u)); } }
      { const unsigned koff = (unsigned)((b * 8 + h) * 256 + (tid >> 3)) * (unsigned)TT + (unsigned)(tt0 + (tid & 7) * 8); const int pc = tid & 7;
        float dk[8];
#pragma unroll
        for (int w = 0; w < 8; ++w) { const int tok = pc * 8 + w; dk[w] = __expf(lg * (float)(dir ? tok : 63 - tok)); }
#pragma unroll
        for (int e = 0; e < 4; ++e) { const int d = (tid >> 3) + 64 * e;
          const u32x4 v = *(const u32x4*)(KT + (koff + (unsigned)e * (unsigned)(64 * TT))); u32x4 o;
#pragma unroll
          for (int w = 0; w < 4; ++w) o[w] = pk2(lo2f(v[w]) * dk[2 * w], hi2f(v[w]) * dk[2 * w + 1]);
          *(u32x4*)(Kts + d * TS + pc * 8) = o; } }
      { const int c = tid >> 3, pc = tid & 7; *(u32x4*)(Vts + c * TS + pc * 8) = *(const u32x4*)(VT + ((unsigned)((b * 8 + h) * 512 + sl * 64 + c) * (unsigned)TT + (unsigned)(tt0 + pc * 8))); }
      __syncthreads();
      if (wid < 4) {
        const int tj = wid >> 1, ti = wid & 1; f32x16 sc;
#pragma unroll
        for (int e = 0; e < 16; ++e) sc[e] = 0.f;
        sc = mma_tile<256>(sc, Ks + tj * 32 * QS, QS, Qs + ti * 32 * QS, QS, lane);
        const int i = ti * 32 + (lane & 31);
#pragma unroll
        for (int rq = 0; rq < 4; ++rq) { const int j0 = tj * 32 + 8 * rq + 4 * g; float v[4];
#pragma unroll
          for (int e = 0; e < 4; ++e) { const int j = j0 + e; const int diff = dir ? (j - i) : (i - j); v[e] = diff >= 0 ? sc[4 * rq + e] * __expf(lg * (float)diff) : 0.f; }
          u32x2 o; o[0] = pk2(v[0], v[1]); o[1] = pk2(v[2], v[3]); *(u32x2*)(Ps + i * TS + j0) = o; }
      } else {
        const int w = wid - 4, ti = w >> 1, tc = w & 1;
#pragma unroll
        for (int e = 0; e < 16; ++e) cross[e] = 0.f;
        cross = mma_tile<256>(cross, Qs + ti * 32 * QS, QS, Sts + tc * 32 * QS, QS, lane);
      }
      __syncthreads();
      if (wid < 4) {
#pragma unroll
        for (int x = 0; x < 4; ++x) { const int td = 2 * wid + (x >> 1), tc = x & 1;
#pragma unroll
          for (int e = 0; e < 16; ++e) S[x][e] *= cd;
          S[x] = mma_tile<64>(S[x], Kts + td * 32 * TS, TS, Vts + tc * 32 * TS, TS, lane);
          const int c = tc * 32 + (lane & 31);
#pragma unroll
          for (int rq = 0; rq < 4; ++rq) { u32x2 o; o[0] = pk2(S[x][4 * rq], S[x][4 * rq + 1]); o[1] = pk2(S[x][4 * rq + 2], S[x][4 * rq + 3]); *(u32x2*)(Sts + c * QS + td * 32 + 8 * rq + 4 * g) = o; } }
      } else {
        const int w = wid - 4, ti = w >> 1, tc = w & 1; f32x16 in_;
#pragma unroll
        for (int e = 0; e < 16; ++e) in_[e] = 0.f;
        in_ = mma_tile<64>(in_, Ps + ti * 32 * TS, TS, Vts + tc * 32 * TS, TS, lane);
        const unsigned ob = (unsigned)(row0 + ti * 32 + 4 * g) * 4096u + (unsigned)(h * 512 + sl * 64 + tc * 32 + (lane & 31));
#pragma unroll
        for (int e = 0; e < 16; ++e) { const int i = ti * 32 + (e & 3) + 8 * (e >> 2) + 4 * g; const float qd = __expf(lg * (float)(dir ? 64 - i : i + 1));
          O[ob + (unsigned)(((e & 3) + 8 * (e >> 2)) * 4096)] = f2bf(in_[e] + qd * cross[e]); }
      }
    }
    __syncthreads();
  }
}

__global__ void __launch_bounds__(512, 2) mega(Params p_in) {
  Params p = p_in; p.wid = __builtin_amdgcn_readfirstlane((int)(threadIdx.x >> 6));
  extern __shared__ __attribute__((aligned(16))) unsigned char shm[];
  cg::grid_group grid = cg::this_grid();
  PG8_LAS unsigned char* lds = (PG8_LAS unsigned char*)shm;
  const bf16_t* H = (const bf16_t*)(p.ws + OFF_H);
  phase_mod(p, shm);
  grid.sync();
  for (int l = 0; l < 2; ++l) {
    phase_cvt(p, l, shm); phase_filters(p, l, shm); phase_norm(p, l);
    grid.sync();
    { pg8::Gemm g; g.wid = p.wid; g.A = H; g.Bt = (const bf16_t*)(p.ws + OFF_WTIN); g.M = MT; g.N = INW; g.K = DM;
      pg8::Order S; S.init(64, 96, (int)gridDim.x, (int)blockIdx.x, 4, l == 0 ? 96 : 24, l == 0 ? 0 : 8);
      EpiG1 E; E.ws = p.ws; pg8::gemm_phase<EpiG1, pg8::Order>(lds, g, S, E); }
    grid.sync();
    phase_prep(p, l, shm);
    grid.sync();
    phase_conv(p, shm); phase_ret(p, l, shm);
    grid.sync();
    phase_post(p, l, shm);
    grid.sync();
    { const int nM = (l == 0) ? 68 : 64;
      pg8::Order S; S.init(nM, 8, (int)gridDim.x, (int)blockIdx.x, 0, 0, 0);
      { pg8::Gemm g; g.wid = p.wid; g.A = H; g.Bt = (const bf16_t*)(p.ws + OFF_WTHY); g.M = nM * 256; g.N = DM; g.K = DM; EpiG23<0> E; E.ws = p.ws; pg8::gemm_phase<EpiG23<0>, pg8::Order>(lds, g, S, E); }
      { pg8::Gemm g; g.wid = p.wid; g.A = (const bf16_t*)(p.ws + OFF_OF); g.Bt = (const bf16_t*)(p.ws + OFF_WTRET); g.M = nM * 256; g.N = DM; g.K = 4096; EpiG23<1> E; E.ws = p.ws; pg8::gemm_phase<EpiG23<1>, pg8::Order>(lds, g, S, E); }
      grid.sync();
      { pg8::Gemm g; g.wid = p.wid; g.A = (const bf16_t*)(p.ws + OFF_T1); g.Bt = (const bf16_t*)(p.ws + OFF_WTO); g.M = nM * 256; g.N = DM; g.K = DM;
        EpiG4 E; E.xin = (l == 0) ? p.x : p.out; E.cin = p.ctx; E.xout = p.out; E.cout = (float*)(p.ws + OFF_CTXR); E.mod = (const float*)(p.ws + OFF_MOD) + (size_t)l * 5 * 6144;
        pg8::gemm_phase<EpiG4, pg8::Order>(lds, g, S, E); } }
    grid.sync();
  }
  phase_final(p);
}

extern "C" void kernel_launch(void* const* d_in, const int* in_sizes, int n_in, void* d_out, int out_size, void* d_ws, size_t ws_size, hipStream_t stream) {
  constexpr size_t kDynLds = 157696;
  static int grid_blocks = 0;
  if (!grid_blocks) {
    hipFuncSetAttribute((const void*)mega, hipFuncAttributeMaxDynamicSharedMemorySize, (int)kDynLds);
    int dev = 0, cus = 0, per_cu = 0;
    hipGetDevice(&dev);
    hipDeviceGetAttribute(&cus, hipDeviceAttributeMultiprocessorCount, dev);
    hipOccupancyMaxActiveBlocksPerMultiprocessor(&per_cu, (const void*)mega, 512, kDynLds);
    grid_blocks = cus * (per_cu >= 1 ? 1 : 0);
    if (ws_size < WS_NEED || grid_blocks <= 0) { fprintf(stderr, "workspace %zu < %zu or no occupancy (%d)\n", ws_size, (size_t)WS_NEED, per_cu); grid_blocks = grid_blocks > 0 ? grid_blocks : 256; }
  }
  Params p{};
  p.x = (const float*)d_in[0]; p.c = (const float*)d_in[1]; p.ctx = (const float*)d_in[2]; p.c_ctx = (const float*)d_in[3]; p.ln_g = (const float*)d_in[4];
  p.ada_w = (const float*)d_in[5]; p.ada_b = (const float*)d_in[6]; p.w_in = (const float*)d_in[7]; p.conv_w = (const float*)d_in[8]; p.conv_b = (const float*)d_in[9];
  p.fw1 = (const float*)d_in[10]; p.fb1 = (const float*)d_in[11]; p.fw2 = (const float*)d_in[12]; p.fb2 = (const float*)d_in[13]; p.fw3 = (const float*)d_in[14]; p.fb3 = (const float*)d_in[15];
  p.ffreq = (const float*)d_in[16]; p.fwout = (const float*)d_in[17]; p.hy_bias = (const float*)d_in[18]; p.ret_decay = (const float*)d_in[19];
  p.w_hy_out = (const float*)d_in[20]; p.w_ret_out = (const float*)d_in[21]; p.w_o = (const float*)d_in[22]; p.final_g = (const float*)d_in[23];
  p.out = (float*)d_out; p.ws = (unsigned char*)d_ws;
  void* args[] = {&p};
  hipError_t e = hipLaunchCooperativeKernel((void*)mega, dim3(grid_blocks), dim3(512), args, kDynLds, stream);
  if (e != hipSuccess) fprintf(stderr, "cooperative launch failed: %s (grid %d)\n", hipGetErrorString(e), grid_blocks);
}
```

```cpp
#include <hip/hip_runtime.h>
#include <hip/hip_cooperative_groups.h>
#include <cstdio>
namespace cg = cooperative_groups;

typedef unsigned short bf16_t;
typedef short bf16x8 __attribute__((ext_vector_type(8)));
typedef float f32x4 __attribute__((ext_vector_type(4)));
typedef float f32x16 __attribute__((ext_vector_type(16)));
typedef unsigned u32x4 __attribute__((ext_vector_type(4)));
typedef unsigned u32x2 __attribute__((ext_vector_type(2)));
#define DI __device__ __forceinline__

DI int otid(int wid) { int t; asm volatile("v_mbcnt_lo_u32_b32 %0, -1, 0\n\tv_mbcnt_hi_u32_b32 %0, -1, %0" : "=v"(t)); return wid * 64 + t; }
DI float wsum(float v, int lane) {
#pragma unroll
  for (int o = 32; o > 0; o >>= 1) v += __int_as_float(__builtin_amdgcn_ds_bpermute((lane ^ o) << 2, __float_as_int(v)));
  return v; }
DI float bf2f(bf16_t u) { return __uint_as_float(((unsigned)u) << 16); }
typedef __bf16 bf16v2 __attribute__((ext_vector_type(2)));
typedef float f32v2 __attribute__((ext_vector_type(2)));
DI unsigned pk2(float lo, float hi) { f32v2 v = {lo, hi}; bf16v2 b = __builtin_convertvector(v, bf16v2); return __builtin_bit_cast(unsigned, b); }
DI bf16_t f2bf(float f) { return (bf16_t)(pk2(f, 0.f) & 0xffffu); }
DI float lo2f(unsigned u) { return __uint_as_float(u << 16); }
DI float hi2f(unsigned u) { return __uint_as_float(u & 0xffff0000u); }
DI float sigmoidf_(float v) { return 1.f / (1.f + __expf(-v)); }
DI float siluf_(float v) { return v / (1.f + __expf(-v)); }

constexpr int DM = 2048, NB = 4, SEQ = 4096, CTXL = 256, NLAT = NB * SEQ, NCTX = NB * CTXL, MT = NLAT + NCTX;
constexpr int INW = 24576, NH = 8, DK = 256, DV = 512, TT = SEQ + CTXL;
constexpr int LOFF = 4128, GLEN = 8320;      constexpr size_t G_LAYER = ((size_t)2048 * 8320 * 2 + 255) & ~(size_t)255;
constexpr int USTR = 6560;

constexpr size_t AL(size_t x) { return (x + 255) & ~(size_t)255; }
constexpr size_t OFF_WTIN = 0;
constexpr size_t OFF_WTHY = OFF_WTIN + AL((size_t)INW * DM * 2);
constexpr size_t OFF_WTRET = OFF_WTHY + AL((size_t)DM * DM * 2);
constexpr size_t OFF_WTO = OFF_WTRET + AL((size_t)DM * 4096 * 2);
constexpr size_t OFF_G = OFF_WTO + AL((size_t)DM * DM * 2);
constexpr size_t OFF_GC = OFF_G + 2 * AL((size_t)DM * GLEN * 2);
constexpr size_t OFF_MOD = OFF_GC + AL((size_t)DM * 512 * 4);
constexpr size_t OFF_H = OFF_MOD + AL((size_t)2 * 5 * 6144 * 4);
constexpr size_t OFF_PQ = OFF_H + AL((size_t)MT * DM * 2);
constexpr size_t OFF_PK = OFF_PQ + AL((size_t)MT * DM * 2);
constexpr size_t OFF_PV = OFF_PK + AL((size_t)MT * DM * 2);
constexpr size_t OFF_PRG = OFF_PV + AL((size_t)MT * 4096 * 2);
constexpr size_t OFF_PHY = OFF_PRG + AL((size_t)MT * 4096 * 2);
constexpr size_t OFF_PHG = OFF_PHY + AL((size_t)MT * 6144 * 2);
constexpr size_t OFF_PMG = OFF_PHG + AL((size_t)MT * DM * 2);
constexpr size_t OFF_KT = OFF_PMG + AL((size_t)MT * 4096 * 2);
constexpr size_t OFF_VT = OFF_KT + AL((size_t)NB * NH * DK * TT * 2);
constexpr size_t OFF_UT = OFF_VT + AL((size_t)NB * NH * DV * TT * 2);
constexpr size_t OFF_UTC = OFF_UT + AL((size_t)DM * NB * SEQ * 2);
constexpr size_t OFF_HV = OFF_UTC + AL((size_t)DM * NB * CTXL * 2);
constexpr size_t OFF_HX0 = OFF_HV + AL((size_t)MT * DM * 2);
constexpr size_t OFF_CTXR = OFF_HX0 + AL((size_t)MT * DM * 2);
constexpr size_t WS_NEED = OFF_CTXR + AL((size_t)NCTX * DM * 4);
constexpr size_t OFF_OF = OFF_PV, OFF_OB = OFF_PHY, OFF_T1 = OFF_PHY + AL((size_t)MT * 4096 * 2);

struct Params {
  const float *x, *c, *ctx, *c_ctx, *ln_g, *ada_w, *ada_b, *w_in, *conv_w, *conv_b, *fw1, *fb1, *fw2, *fb2, *fw3, *fb3, *ffreq, *fwout, *hy_bias, *ret_decay, *w_hy_out, *w_ret_out, *w_o, *final_g;
  float* out;
  unsigned char* ws;
  int wid, pad_;
};

namespace pg8 {
#define PG8_LAS __attribute__((address_space(3)))
constexpr int BM = 256, BK = 64, HALF = 128, HTB = HALF * BK * 2, STAGE_BYTES = 8 * HTB, NXCD = 8, WGM = 8;
__host__ __device__ __forceinline__ int lds_byte(int r, int c) { const int st = (r >> 4) * 2 + (c >> 5), rr = r & 15, cc = c & 31, ob = rr * 64 + cc * 2; return st * 1024 + (ob ^ (((ob >> 9) & 1) << 5)); }
__host__ __device__ __forceinline__ void stage_rc(int b, int& R, int& C) { const int st = b / 1024, sb = b % 1024, swz = sb ^ (((sb >> 9) & 1) << 5); R = (st >> 1) * 16 + swz / 64; C = (st & 1) * 32 + (swz % 64) / 2; }
__host__ __device__ __forceinline__ int perm32(int rho) { const int n = rho >> 4, i = rho & 15; return 8 * (i >> 2) + 4 * n + (i & 3); }
struct Unit { int pm, pn; };
struct Gemm { const bf16_t* A; const bf16_t* Bt; int M, N, K, wid; };
struct Order {
    int nM, nN, nwg, G, c, nx_m, nx_n, x_pn0;
    __device__ void init(int nM_, int nN_, int G_, int c_, int nx_m_, int nx_n_, int x_pn0_) { nM = nM_; nN = nN_; nwg = nM * nN; G = G_; c = c_; nx_m = nx_m_; nx_n = nx_n_; x_pn0 = x_pn0_; }
    __device__ bool next(int i, Unit& u) const {
        const long L = (long)i * G + c;
        if (L >= nwg) { const int e = (int)(L - nwg); if (e >= nx_m * nx_n) return false; u.pm = nM + e % nx_m; u.pn = x_pn0 + e / nx_m; return true; }
        int wgid = (int)L; { const int q = nwg / NXCD, r = nwg % NXCD, xcd = wgid % NXCD, off = wgid / NXCD; wgid = (xcd < r ? xcd * (q + 1) : r * (q + 1) + (xcd - r) * q) + off; }
        const int nig = WGM * nN, gid = wgid / nig, fm = gid * WGM, gsz = (nM - fm) < WGM ? (nM - fm) : WGM;
        u.pm = fm + ((wgid % nig) % gsz); u.pn = (wgid % nig) / gsz; return true;
    }
    __device__ __forceinline__ void a_ready(const Unit&) const {}
    __device__ __forceinline__ void done(const Unit&) const {}
};
template <class Epi, class Sched>
__device__ __forceinline__ void gemm_phase(PG8_LAS unsigned char* lds, const Gemm g, const Sched& S, const Epi& E) {
    const int tid = otid(g.wid), wid = __builtin_amdgcn_readfirstlane(tid >> 6), lane = tid & 63, wr = wid >> 2, wc = wid & 3, fr = lane & 15, fq = lane >> 4;
    const int K = g.K, nt = K / BK;
    unsigned voffA[2], voffB[2];
#pragma unroll
    for (int i = 0; i < 2; ++i) { int R, C; stage_rc(tid * 16 + i * 8192, R, C); const int Rb = Epi::PERM ? ((R & ~31) + perm32(R & 31)) : R;
        voffA[i] = (unsigned)(R * K + C) * 2u; voffB[i] = (unsigned)(Rb * K + C) * 2u; }
    const size_t kstep = (size_t)(BK * 2);
    const size_t hstep = (size_t)HALF * K * 2;
    const size_t tstep = 2 * hstep;
    const unsigned ldsw = (unsigned)wid * 1024u;
    const int aoff = lds_byte(wr * 64 + fr, fq * 8), boff = lds_byte(wc * 32 + fr, fq * 8);
#define PG8_SA(b, h) (((b) * 2 + (h)) * HTB)
#define PG8_SB(b, h) ((4 + (b) * 2 + (h)) * HTB)
#define PG8_STAGE(bufoff, gbase, voff) do { _Pragma("unroll") for (int _i = 0; _i < 2; ++_i) \
        __builtin_amdgcn_global_load_lds((const unsigned*)((const char*)(gbase) + (voff)[_i]), (PG8_LAS unsigned*)(lds + (bufoff) + ldsw + _i * 8192), 16, 0, 0); } while (0)
#define PG8_LDA(dst, b, h) do { _Pragma("unroll") for (int m = 0; m < 4; ++m) _Pragma("unroll") for (int k = 0; k < 2; ++k) dst[m][k] = *(const PG8_LAS bf16x8*)(lds + PG8_SA(b, h) + aoff + m * 2048 + k * 1024); } while (0)
#define PG8_LDB(dst, b, h) do { _Pragma("unroll") for (int n = 0; n < 2; ++n) _Pragma("unroll") for (int k = 0; k < 2; ++k) dst[n][k] = *(const PG8_LAS bf16x8*)(lds + PG8_SB(b, h) + boff + n * 2048 + k * 1024); } while (0)
#define PG8_MMA(ai, bj, At, Bt) do { __builtin_amdgcn_s_setprio(1); _Pragma("unroll") for (int m = 0; m < 4; ++m) _Pragma("unroll") for (int n = 0; n < 2; ++n) _Pragma("unroll") for (int k = 0; k < 2; ++k) \
        acc[ai][bj][m][n] = __builtin_amdgcn_mfma_f32_16x16x32_bf16(Bt[n][k], At[m][k], acc[ai][bj][m][n], 0, 0, 0); __builtin_amdgcn_s_setprio(0); } while (0)
#define PG8_WAIT_V(n) asm volatile("s_waitcnt vmcnt(" #n ")" ::: "memory")
#define PG8_WAIT_L(n) asm volatile("s_waitcnt lgkmcnt(" #n ")" ::: "memory")
#define PG8_BAR __builtin_amdgcn_s_barrier()
#define PG8_SCHED __builtin_amdgcn_sched_barrier(0)
    Unit cur, nxt; int ui = 0;
    if (!S.next(0, cur)) return;
    f32x4 acc[2][2][4][2];
#pragma unroll
    for (int a = 0; a < 2; ++a)
#pragma unroll
        for (int b = 0; b < 2; ++b)
#pragma unroll
            for (int m = 0; m < 4; ++m)
#pragma unroll
                for (int n = 0; n < 2; ++n) acc[a][b][m][n] = (f32x4){0.f, 0.f, 0.f, 0.f};
    bf16x8 At[4][2], B0[2][2], B1[2][2];
    const char* cA = (const char*)g.A + (size_t)cur.pm * tstep; const char* cB = (const char*)g.Bt + (size_t)cur.pn * tstep;
    S.a_ready(cur);
    PG8_STAGE(PG8_SB(0, 0), cB, voffB); PG8_STAGE(PG8_SA(0, 0), cA, voffA); PG8_STAGE(PG8_SB(0, 1), cB + hstep, voffB); PG8_STAGE(PG8_SA(0, 1), cA + hstep, voffA);
    if (wr == 1) PG8_BAR;
    PG8_WAIT_V(4); PG8_BAR;
    PG8_STAGE(PG8_SB(1, 0), cB + kstep, voffB); PG8_STAGE(PG8_SA(1, 0), cA + kstep, voffA); PG8_STAGE(PG8_SB(1, 1), cB + hstep + kstep, voffB);
    PG8_WAIT_V(6); PG8_BAR;
    for (;;) {
        const bool has_next = S.next(ui + 1, nxt);
        const char* nA = has_next ? (const char*)g.A + (size_t)nxt.pm * tstep : cA; const char* nB = has_next ? (const char*)g.Bt + (size_t)nxt.pn * tstep : cB;
        for (int t = 0; t < nt; t += 2) {
            const bool last = (t == nt - 2);
            const char* a1 = cA + (size_t)(t + 1) * kstep;
            const char* a2 = last ? nA : cA + (size_t)(t + 2) * kstep; const char* b2 = last ? nB : cB + (size_t)(t + 2) * kstep;
            const char* a3 = a2 + kstep; const char* b3 = b2 + kstep;
            if (last && has_next) S.a_ready(nxt);
            PG8_LDB(B0, 0, 0); PG8_SCHED; PG8_LDA(At, 0, 0); PG8_STAGE(PG8_SA(1, 1), a1 + hstep, voffA);
            PG8_WAIT_L(8); PG8_BAR; PG8_WAIT_L(0); PG8_MMA(0, 0, At, B0); PG8_BAR; PG8_SCHED;
            PG8_LDB(B1, 0, 1); PG8_STAGE(PG8_SB(0, 0), b2, voffB);
            PG8_BAR; PG8_WAIT_L(0); PG8_MMA(0, 1, At, B1); PG8_BAR;
            PG8_LDA(At, 0, 1); PG8_STAGE(PG8_SA(0, 0), a2, voffA);
            PG8_BAR; PG8_WAIT_L(0); PG8_MMA(1, 0, At, B0); PG8_BAR; PG8_SCHED;
            PG8_STAGE(PG8_SB(0, 1), b2 + hstep, voffB);
            PG8_WAIT_V(6); PG8_BAR; PG8_MMA(1, 1, At, B1); PG8_BAR;
            PG8_LDB(B0, 1, 0); PG8_SCHED; PG8_LDA(At, 1, 0); PG8_STAGE(PG8_SA(0, 1), a2 + hstep, voffA);
            PG8_WAIT_L(8); PG8_BAR; PG8_WAIT_L(0); PG8_MMA(0, 0, At, B0); PG8_BAR; PG8_SCHED;
            PG8_LDB(B1, 1, 1); PG8_STAGE(PG8_SB(1, 0), b3, voffB);
            PG8_BAR; PG8_WAIT_L(0); PG8_MMA(0, 1, At, B1); PG8_BAR;
            PG8_LDA(At, 1, 1); PG8_STAGE(PG8_SA(1, 0), a3, voffA);
            PG8_BAR; PG8_WAIT_L(0); PG8_MMA(1, 0, At, B0); PG8_BAR; PG8_SCHED;
            PG8_STAGE(PG8_SB(1, 1), b3 + hstep, voffB);
            PG8_WAIT_V(6); PG8_BAR; PG8_MMA(1, 1, At, B1); PG8_BAR;
        }
        if constexpr (!Epi::AFTER_DRAIN) { E(acc, cur, wr, wc, fr, fq); S.done(cur); }
        if (!has_next) break;
#pragma unroll
        for (int a = 0; a < 2; ++a)
#pragma unroll
            for (int b = 0; b < 2; ++b)
#pragma unroll
                for (int m = 0; m < 4; ++m)
#pragma unroll
                    for (int n = 0; n < 2; ++n) acc[a][b][m][n] = (f32x4){0.f, 0.f, 0.f, 0.f};
        cur = nxt; cA = nA; cB = nB; ++ui;
    }
    PG8_WAIT_V(0);
    if (wr == 0) PG8_BAR;
    PG8_BAR;
    if constexpr (Epi::AFTER_DRAIN) { E.fused(acc, cur, wr, wc, fr, fq, lds, wid, lane); S.done(cur); }
#undef PG8_SA
#undef PG8_SB
#undef PG8_STAGE
#undef PG8_LDA
#undef PG8_LDB
#undef PG8_MMA

#undef PG8_WAIT_V
#undef PG8_WAIT_L
#undef PG8_BAR
#undef PG8_SCHED
}
}

struct EpiG1 {
  static constexpr bool PERM = true, AFTER_DRAIN = false;
  unsigned char* ws;
  DI void operator()(const f32x4 (&acc)[2][2][4][2], const pg8::Unit& u, int wr, int wc, int fr, int fq) const {
    const int pn = u.pn; size_t off; int ld, c0;
    if (pn < 8) { off = OFF_PQ; ld = 2048; c0 = pn * 256; }
    else if (pn < 16) { off = OFF_PK; ld = 2048; c0 = (pn - 8) * 256; }
    else if (pn < 32) { off = OFF_PV; ld = 4096; c0 = (pn - 16) * 256; }
    else if (pn < 48) { off = OFF_PRG; ld = 4096; c0 = (pn - 32) * 256; }
    else if (pn < 72) { off = OFF_PHY; ld = 6144; c0 = (pn - 48) * 256; }
    else if (pn < 80) { off = OFF_PHG; ld = 2048; c0 = (pn - 72) * 256; }
    else { off = OFF_PMG; ld = 4096; c0 = (pn - 80) * 256; }
    bf16_t* base = (bf16_t*)(ws + off);
    const int row0 = u.pm * 256 + wr * 64 + fr, col0 = c0 + wc * 32 + 8 * fq;
#pragma unroll
    for (int ai = 0; ai < 2; ++ai)
#pragma unroll
      for (int m = 0; m < 4; ++m) { bf16_t* rowp = base + (size_t)(row0 + ai * 128 + m * 16) * ld + col0;
#pragma unroll
        for (int bj = 0; bj < 2; ++bj) { const f32x4 v0 = acc[ai][bj][m][0], v1 = acc[ai][bj][m][1];
          u32x4 o; o[0] = pk2(v0[0], v0[1]); o[1] = pk2(v0[2], v0[3]); o[2] = pk2(v1[0], v1[1]); o[3] = pk2(v1[2], v1[3]);
          *(u32x4*)(rowp + bj * 128) = o; } }
  }
};
template <int SECOND> struct EpiG23 {
  static constexpr bool PERM = true, AFTER_DRAIN = false;
  unsigned char* ws;
  DI void operator()(const f32x4 (&acc)[2][2][4][2], const pg8::Unit& u, int wr, int wc, int fr, int fq) const {
    bf16_t* T1 = (bf16_t*)(ws + OFF_T1); const bf16_t* MG = (const bf16_t*)(ws + OFF_PMG) + (SECOND ? 2048 : 0);
    const int row0 = u.pm * 256 + wr * 64 + fr, col0 = u.pn * 256 + wc * 32 + 8 * fq;
#pragma unroll
    for (int ai = 0; ai < 2; ++ai)
#pragma unroll
      for (int m = 0; m < 4; ++m) { const size_t row = (size_t)(row0 + ai * 128 + m * 16);
#pragma unroll
        for (int bj = 0; bj < 2; ++bj) { const int col = col0 + bj * 128;
          const u32x4 g = *(const u32x4*)(MG + row * 4096 + col);
          const f32x4 v0 = acc[ai][bj][m][0], v1 = acc[ai][bj][m][1];
          float r[8];
          r[0] = sigmoidf_(lo2f(g[0])) * v0[0]; r[1] = sigmoidf_(hi2f(g[0])) * v0[1]; r[2] = sigmoidf_(lo2f(g[1])) * v0[2]; r[3] = sigmoidf_(hi2f(g[1])) * v0[3];
          r[4] = sigmoidf_(lo2f(g[2])) * v1[0]; r[5] = sigmoidf_(hi2f(g[2])) * v1[1]; r[6] = sigmoidf_(lo2f(g[3])) * v1[2]; r[7] = sigmoidf_(hi2f(g[3])) * v1[3];
          if (SECOND) { const u32x4 t = *(const u32x4*)(T1 + row * 2048 + col);
            r[0] += lo2f(t[0]); r[1] += hi2f(t[0]); r[2] += lo2f(t[1]); r[3] += hi2f(t[1]); r[4] += lo2f(t[2]); r[5] += hi2f(t[2]); r[6] += lo2f(t[3]); r[7] += hi2f(t[3]); }
          u32x4 o; o[0] = pk2(r[0], r[1]); o[1] = pk2(r[2], r[3]); o[2] = pk2(r[4], r[5]); o[3] = pk2(r[6], r[7]);
          *(u32x4*)(T1 + row * 2048 + col) = o; } }
  }
};
struct EpiG4 {
  static constexpr bool PERM = false, AFTER_DRAIN = false;
  const float* xin; const float* cin; float* xout; float* cout; const float* mod;
  DI void operator()(const f32x4 (&acc)[2][2][4][2], const pg8::Unit& u, int wr, int wc, int fr, int fq) const {
    const int row0 = u.pm * 256 + wr * 64 + fr, col0 = u.pn * 256 + wc * 32 + 4 * fq;
#pragma unroll
    for (int ai = 0; ai < 2; ++ai)
#pragma unroll
      for (int m = 0; m < 4; ++m) { const int row = row0 + ai * 128 + m * 16;
        const float* src; float* dst; const float* gate;
        if (row < NLAT) { src = xin + (size_t)row * 2048; dst = xout + (size_t)row * 2048; gate = mod + (row >> 12) * 6144 + 4096; }
        else { src = cin + (size_t)(row - NLAT) * 2048; dst = cout + (size_t)(row - NLAT) * 2048; gate = mod + 4 * 6144 + 4096; }
#pragma unroll
        for (int bj = 0; bj < 2; ++bj)
#pragma unroll
          for (int n = 0; n < 2; ++n) { const int col = col0 + bj * 128 + n * 16;
            const f32x4 xv = *(const f32x4*)(src + col), gv = *(const f32x4*)(gate + col);
            *(f32x4*)(dst + col) = xv + gv * acc[ai][bj][m][n]; } }
  }
};

__device__ void phase_mod(const Params& p, unsigned char* shm) {
  float* sc = (float*)shm; float* red = sc + 5 * 2048;
  const int tid = otid(p.wid);
  for (int i = tid; i < 5 * 2048; i += 512) { const int j = i >> 11, k = i & 2047; const float v = (j < 4) ? p.c[j * 2048 + k] : p.c_ctx[k]; sc[i] = v / (1.f + expf(-v)); }
  __syncthreads();
  float* mod = (float*)(p.ws + OFF_MOD);
  const int cq = tid & 7, ks = tid >> 3;
  for (int it = blockIdx.x; it < 384; it += gridDim.x) {
    const int l = it / 192, nb = (it % 192) * 32;
    const float* W = p.ada_w + (size_t)l * 2048 * 6144 + nb + cq * 4;
    float acc[5][4];
#pragma unroll
    for (int j = 0; j < 5; ++j) { acc[j][0] = 0.f; acc[j][1] = 0.f; acc[j][2] = 0.f; acc[j][3] = 0.f; }
#pragma unroll 4
    for (int kk = 0; kk < 32; ++kk) { const int k = ks * 32 + kk; const float4 w = *(const float4*)(W + (size_t)k * 6144);
#pragma unroll
      for (int j = 0; j < 5; ++j) { const float s = sc[j * 2048 + k]; acc[j][0] += s * w.x; acc[j][1] += s * w.y; acc[j][2] += s * w.z; acc[j][3] += s * w.w; } }
#pragma unroll
    for (int j = 0; j < 5; ++j)
#pragma unroll
      for (int e = 0; e < 4; ++e) red[ks * 160 + j * 32 + cq * 4 + e] = acc[j][e];
    __syncthreads();
    if (tid < 160) { float s = 0.f; for (int q = 0; q < 64; ++q) s += red[q * 160 + tid]; const int j = tid >> 5, n = nb + (tid & 31); mod[(l * 5 + j) * 6144 + n] = s + p.ada_b[l * 6144 + n]; }
    __syncthreads();
  }
}

__device__ void cvt_group(int wid, const float* W, bf16_t* Wt, int K, int N, int k0, int n0, float scale, float* tile) {
  const int tid = otid(wid);
  float4 v[8];
#pragma unroll
  for (int q = 0; q < 4; ++q)
#pragma unroll
    for (int rr = 0; rr < 2; ++rr) { const int k = (tid >> 4) + 32 * rr, n = (tid & 15) * 4; v[q * 2 + rr] = *(const float4*)(W + (size_t)(k0 + q * 64 + k) * N + n0 + n); }
#pragma unroll
  for (int q = 0; q < 4; ++q)
#pragma unroll
    for (int rr = 0; rr < 2; ++rr) { const int k = (tid >> 4) + 32 * rr, n = (tid & 15) * 4; float* t = tile + q * 4160 + k * 65 + n; const float4 x = v[q * 2 + rr]; t[0] = x.x; t[1] = x.y; t[2] = x.z; t[3] = x.w; }
  __syncthreads();
#pragma unroll
  for (int q = 0; q < 4; ++q) { const int n = tid >> 3, k8 = (tid & 7) * 8; const float* t = tile + q * 4160; u32x4 o;
#pragma unroll
    for (int e = 0; e < 4; ++e) o[e] = pk2(t[(k8 + 2 * e) * 65 + n] * scale, t[(k8 + 2 * e + 1) * 65 + n] * scale);
    *(u32x4*)(Wt + (size_t)(n0 + n) * K + k0 + q * 64 + k8) = o; }
  __syncthreads();
}
__device__ void phase_cvt(const Params& p, int l, unsigned char* shm) {
  float* tile = (float*)shm;
  for (int it = blockIdx.x; it < 4096; it += gridDim.x) {
    if (it < 3072) { const int kg = it & 7, n0 = (it >> 3) * 64;
      cvt_group(p.wid, p.w_in + (size_t)l * DM * INW, (bf16_t*)(p.ws + OFF_WTIN), DM, INW, kg * 256, n0, (n0 >= 2048 && n0 < 4096) ? 0.0625f : 1.f, tile); }
    else if (it < 3328) { const int e = it - 3072; cvt_group(p.wid, p.w_hy_out + (size_t)l * DM * DM, (bf16_t*)(p.ws + OFF_WTHY), DM, DM, (e & 7) * 256, (e >> 3) * 64, 1.f, tile); }
    else if (it < 3840) { const int e = it - 3328; cvt_group(p.wid, p.w_ret_out + (size_t)l * 4096 * DM, (bf16_t*)(p.ws + OFF_WTRET), 4096, DM, (e & 15) * 256, (e >> 4) * 64, 1.f, tile); }
    else { const int e = it - 3840; cvt_group(p.wid, p.w_o + (size_t)l * DM * DM, (bf16_t*)(p.ws + OFF_WTO), DM, DM, (e & 7) * 256, (e >> 3) * 64, 1.f, tile); }
  }
}

__device__ void filt_item(const Params& p, int l, int Ls, int T, bool isctx, unsigned char* shm) {
  float* z = (float*)shm; float* ha = z + 33 * 36; float* hb = ha + 33 * 64;
  const int tid = otid(p.wid);
  const float* w1 = p.fw1 + l * 33 * 64; const float* b1 = p.fb1 + l * 64; const float* w2 = p.fw2 + l * 4096; const float* b2 = p.fb2 + l * 64;
  const float* w3 = p.fw3 + l * 4096; const float* b3 = p.fb3 + l * 64; const float* fq = p.ffreq + l * 64; const float* wout = p.fwout + (size_t)l * 64 * 4096;
  for (int i = tid; i < 33 * 33; i += 512) { const int pl = i / 33, f = i % 33; int pp = T * 32 + pl; if (pp > Ls - 1) pp = Ls - 1;
    float val;
    if (f == 0) val = (float)pp / (float)(Ls - 1);
    else { const int j = (f - 1) & 15; const float fj = 1e-4f + (float)j * ((15.f - 1e-4f) / 15.f); const float ang = 6.283185307179586f * (float)pp / (float)Ls; const float a = fj * ang; val = (f <= 16) ? cosf(a) : -sinf(a); }
    z[pl * 36 + f] = val; }
  __syncthreads();
  for (int idx = tid; idx < 33 * 16; idx += 512) { const int pl = idx >> 4, j0 = (idx & 15) * 4; float a[4] = {0.f, 0.f, 0.f, 0.f};
#pragma unroll 3
    for (int k = 0; k < 33; ++k) { const float v = z[pl * 36 + k]; const float4 w = *(const float4*)(w1 + k * 64 + j0); a[0] += v * w.x; a[1] += v * w.y; a[2] += v * w.z; a[3] += v * w.w; }
#pragma unroll
    for (int e = 0; e < 4; ++e) ha[pl * 64 + j0 + e] = sinf(fq[j0 + e] * (a[e] + b1[j0 + e])); }
  __syncthreads();
  for (int idx = tid; idx < 33 * 16; idx += 512) { const int pl = idx >> 4, j0 = (idx & 15) * 4; float a[4] = {0.f, 0.f, 0.f, 0.f};
#pragma unroll 4
    for (int k = 0; k < 64; ++k) { const float v = ha[pl * 64 + k]; const float4 w = *(const float4*)(w2 + k * 64 + j0); a[0] += v * w.x; a[1] += v * w.y; a[2] += v * w.z; a[3] += v * w.w; }
#pragma unroll
    for (int e = 0; e < 4; ++e) hb[pl * 64 + j0 + e] = sinf(fq[j0 + e] * (a[e] + b2[j0 + e])); }
  __syncthreads();
  for (int idx = tid; idx < 33 * 16; idx += 512) { const int pl = idx >> 4, j0 = (idx & 15) * 4; float a[4] = {0.f, 0.f, 0.f, 0.f};
#pragma unroll 4
    for (int k = 0; k < 64; ++k) { const float v = hb[pl * 64 + k]; const float4 w = *(const float4*)(w3 + k * 64 + j0); a[0] += v * w.x; a[1] += v * w.y; a[2] += v * w.z; a[3] += v * w.w; }
#pragma unroll
    for (int e = 0; e < 4; ++e) ha[pl * 64 + j0 + e] = sinf(fq[j0 + e] * (a[e] + b3[j0 + e])); }
  __syncthreads();
  const int c2 = tid * 8; const bool isb = c2 >= 2048; const int cb = c2 & 2047;
  const float mind = logf(0.01f) / 1.5f, maxd = logf(0.01f) / 0.3f;
  bf16_t* G = (bf16_t*)(p.ws + OFF_G + (size_t)l * G_LAYER); float* GC = (float*)(p.ws + OFF_GC);
  for (int pgh = 0; pgh < 8; ++pgh) {
    const int pg = pgh >> 1, c4 = c2 + (pgh & 1) * 4;
    const int plb = pg * 8 + (isb ? 0 : 1);
    float acc[8][4];
#pragma unroll
    for (int e = 0; e < 8; ++e) { acc[e][0] = 0.f; acc[e][1] = 0.f; acc[e][2] = 0.f; acc[e][3] = 0.f; }
#pragma unroll 8
    for (int k = 0; k < 64; ++k) { const float4 wa = *(const float4*)(wout + k * 4096 + c4);
#pragma unroll
      for (int e = 0; e < 8; ++e) { const float h = ha[(plb + e) * 64 + k]; acc[e][0] += h * wa.x; acc[e][1] += h * wa.y; acc[e][2] += h * wa.z; acc[e][3] += h * wa.w; } }
    const int pp0 = T * 32 + plb;
#pragma unroll
    for (int cc = 0; cc < 4; ++cc) { const int c = (c4 & 2047) + cc; const float delta = fabsf(mind + (float)c * ((maxd - mind) / 2047.f));
      float v[8];
#pragma unroll
      for (int e = 0; e < 8; ++e) { const int pp = pp0 + e; v[e] = (pp < Ls) ? acc[e][cc] * __expf(-((float)pp / (float)(Ls - 1)) * delta) : 0.f; }
      if (!isctx) {
        bf16_t* Gc = G + (size_t)c * GLEN;
        if (isb) {
          if (pp0 == 0) { for (int e = 1; e < 8; ++e) Gc[LOFF + e] = f2bf(v[e]); }
          else { u32x4 o; o[0] = pk2(v[0], v[1]); o[1] = pk2(v[2], v[3]); o[2] = pk2(v[4], v[5]); o[3] = pk2(v[6], v[7]); *(u32x4*)(Gc + LOFF + pp0) = o; }
        } else {
          u32x4 o; o[0] = pk2(v[7], v[6]); o[1] = pk2(v[5], v[4]); o[2] = pk2(v[3], v[2]); o[3] = pk2(v[1], v[0]); *(u32x4*)(Gc + LOFF - pp0 - 7) = o;
        }
      } else {
        float* Gc = GC + (size_t)c * 512;
#pragma unroll
        for (int e = 0; e < 8; ++e) { const int pp = pp0 + e; if (isb) { if (pp >= 1 && pp < Ls) Gc[256 - pp] = v[e]; } else { if (pp < Ls) Gc[256 + pp] = v[e]; } }
      }
    }
  }
  if (T == 0 && !isb) {
#pragma unroll 1
    for (int cc = 0; cc < 8; ++cc) { float a = 0.f;
#pragma unroll 4
      for (int k = 0; k < 64; ++k) a += ha[k] * wout[k * 4096 + c2 + cc];
      if (!isctx) G[(size_t)(cb + cc) * GLEN + LOFF] = f2bf(a); else GC[(size_t)(cb + cc) * 512 + 256] = a; }
  }
  __syncthreads();
}
__device__ void phase_filters(const Params& p, unsigned char* shm) {
  for (int it = blockIdx.x; it < 264; it += gridDim.x) { if (it < 256) filt_item(p, it >> 7, SEQ, it & 127, false, shm); else filt_item(p, 0, CTXL, it - 256, true, shm); }
}

__device__ void phase_norm(const Params& p, int l) {
  const int lane = otid(p.wid) & 63, gw = blockIdx.x * 8 + (otid(p.wid) >> 6), nw = gridDim.x * 8;
  const float* mod = (const float*)(p.ws + OFF_MOD) + (size_t)l * 5 * 6144; const float* lng = p.ln_g + l * 2048;
  bf16_t* H = (bf16_t*)(p.ws + OFF_H);
  for (int r = gw; r < MT; r += nw) {
    const float* src; int j;
    if (r < NLAT) { src = (l == 0 ? p.x : p.out) + (size_t)r * 2048; j = r >> 12; }
    else { src = (l == 0 ? p.ctx : (const float*)(p.ws + OFF_CTXR)) + (size_t)(r - NLAT) * 2048; j = 4; }
    const float* sh = mod + j * 6144; const float* sc = sh + 2048;
    float4 v[8]; float ss = 0.f;
#pragma unroll
    for (int i = 0; i < 8; ++i) { v[i] = *(const float4*)(src + i * 256 + lane * 4); ss += v[i].x * v[i].x + v[i].y * v[i].y + v[i].z * v[i].z + v[i].w * v[i].w; }
    ss = wsum(ss, lane);
    const float rs = rsqrtf(ss * (1.f / 2048.f) + 1e-6f);
#pragma unroll
    for (int i = 0; i < 8; ++i) { const int col = i * 256 + lane * 4; const float4 g = *(const float4*)(lng + col), a = *(const float4*)(sc + col), b = *(const float4*)(sh + col);
      u32x2 o; o[0] = pk2(v[i].x * rs * g.x * (1.f + a.x) + b.x, v[i].y * rs * g.y * (1.f + a.y) + b.y); o[1] = pk2(v[i].z * rs * g.z * (1.f + a.z) + b.z, v[i].w * rs * g.w * (1.f + a.w) + b.w);
      *(u32x2*)(H + (size_t)r * 2048 + col) = o; }
  }
}
__device__ void phase_final(const Params& p) {
  const int lane = otid(p.wid) & 63, gw = blockIdx.x * 8 + (otid(p.wid) >> 6), nw = gridDim.x * 8;
  for (int r = gw; r < NLAT; r += nw) {
    float* src = p.out + (size_t)r * 2048; float4 v[8]; float ss = 0.f;
#pragma unroll
    for (int i = 0; i < 8; ++i) { v[i] = *(const float4*)(src + i * 256 + lane * 4); ss += v[i].x * v[i].x + v[i].y * v[i].y + v[i].z * v[i].z + v[i].w * v[i].w; }
    ss = wsum(ss, lane);
    const float rs = rsqrtf(ss * (1.f / 2048.f) + 1e-6f);
#pragma unroll
    for (int i = 0; i < 8; ++i) { const int col = i * 256 + lane * 4; const float4 g = *(const float4*)(p.final_g + col); float4 o; o.x = v[i].x * rs * g.x; o.y = v[i].y * rs * g.y; o.z = v[i].z * rs * g.z; o.w = v[i].w * rs * g.w; *(float4*)(src + col) = o; }
  }
}

DI void tok_tile(int tk, int& b, int& t0, bool& isctx) { if (tk < 256) { b = tk >> 6; t0 = (tk & 63) * 64; isctx = false; } else { b = (tk - 256) >> 2; t0 = ((tk - 256) & 3) * 64; isctx = true; } }
DI int tok_row(int b, int t, bool isctx) { return isctx ? NLAT + b * CTXL + t : b * SEQ + t; }

__device__ void phase_prep(const Params& p, int l, unsigned char* shm) {
  const int tid = otid(p.wid), lane = tid & 63;
  float2* cs = (float2*)shm;
  unsigned char* reg2 = shm + 32768;
  for (int i = tid; i < 4096; i += 512) { const int pos = i >> 6, j = i & 63; const float inv = 1.f / powf(10000.f, (float)j / 64.f); float s, c; sincosf((float)pos * inv, &s, &c); cs[i] = make_float2(c, s); }
  __syncthreads();
  { bf16_t* PQ = (bf16_t*)(p.ws + OFF_PQ); const int gw = blockIdx.x * 8 + (tid >> 6), nw = gridDim.x * 8;
    for (int r = gw; r < NLAT; r += nw) { const int t = r & 4095, rp = t >> 6, cp = t & 63; bf16_t* row = PQ + (size_t)r * 2048;
#pragma unroll 4
      for (int e = 0; e < 16; ++e) { const int i1 = (e >> 1) * 256 + (e & 1) * 128 + lane; const float2 v = cs[((e & 1) ? cp : rp) * 64 + lane];
        const float p1 = bf2f(row[i1]), p2 = bf2f(row[i1 + 64]); row[i1] = f2bf(p1 * v.x - p2 * v.y); row[i1 + 64] = f2bf(p1 * v.y + p2 * v.x); } } }
  { unsigned* tl = (unsigned*)reg2;
    bf16_t* tls = (bf16_t*)reg2;
    u32x4 pre[4];
#define PB_DECODE(it_) const int tk = (it_) / 24, sub = (it_) % 24; int b, t0; bool isctx; tok_tile(tk, b, t0, isctx); \
      bf16_t* src; int ld, co; bf16_t* dst; const bool isk = sub < 8; \
      if (isk) { src = (bf16_t*)(p.ws + OFF_PK); ld = 2048; co = sub * 256; dst = (bf16_t*)(p.ws + OFF_KT) + (size_t)((b * 8 + sub) * 256) * TT; } \
      else { const int hh = (sub - 8) >> 1, hf = (sub - 8) & 1; src = (bf16_t*)(p.ws + OFF_PV); ld = 4096; co = hh * 512 + hf * 256; dst = (bf16_t*)(p.ws + OFF_VT) + (size_t)((b * 8 + hh) * 512 + hf * 256) * TT; } \
      const int row0 = tok_row(b, t0, isctx), tt0 = isctx ? t0 : CTXL + t0;
#define PB_LOAD(it_) do { PB_DECODE(it_) (void)dst; (void)tt0; _Pragma("unroll") for (int e = 0; e < 4; ++e) { const int id = tid + 512 * e, row = id >> 5, pc = id & 31; pre[e] = *(const u32x4*)(src + (size_t)(row0 + row) * ld + co + pc * 8); } } while (0)
    const int nit = 272 * 24;
    if ((int)blockIdx.x < nit) PB_LOAD((int)blockIdx.x);
    for (int it = blockIdx.x; it < nit; it += gridDim.x) {
      PB_DECODE(it)
#pragma unroll
      for (int e = 0; e < 4; ++e) { const int id = tid + 512 * e, row = id >> 5, pc = id & 31; unsigned* d = tl + row * 129 + pc * 4; d[0] = pre[e][0]; d[1] = pre[e][1]; d[2] = pre[e][2]; d[3] = pre[e][3]; }
      if (it + (int)gridDim.x < nit) PB_LOAD(it + (int)gridDim.x);
      __syncthreads();
      if (isk && !isctx) {
#pragma unroll 4
        for (int e = 0; e < 16; ++e) { const int id = tid + 512 * e, tok = id >> 7, pr = id & 127, hf = pr >> 6, j = pr & 63; const int t = t0 + tok;
          const float2 v = cs[(hf ? (t & 63) : (t >> 6)) * 64 + j]; bf16_t* q = tls + tok * 258 + hf * 128 + j;
          const float p1 = bf2f(q[0]), p2 = bf2f(q[64]); q[0] = f2bf(p1 * v.x - p2 * v.y); q[64] = f2bf(p1 * v.y + p2 * v.x); }
        __syncthreads();
#pragma unroll
        for (int e = 0; e < 4; ++e) { const int id = tid + 512 * e, row = id >> 5, pc = id & 31; const unsigned* d = tl + row * 129 + pc * 4; u32x4 v; v[0] = d[0]; v[1] = d[1]; v[2] = d[2]; v[3] = d[3];
          *(u32x4*)(src + (size_t)(row0 + row) * ld + co + pc * 8) = v; }
      }
      { const int d = tid >> 1, th = (tid & 1) * 32;
#pragma unroll
        for (int q = 0; q < 4; ++q) { u32x4 o;
#pragma unroll
          for (int e = 0; e < 4; ++e) { const int tok = th + q * 8 + 2 * e; o[e] = (unsigned)tls[tok * 258 + d] | ((unsigned)tls[(tok + 1) * 258 + d] << 16); }
          *(u32x4*)(dst + (size_t)d * TT + tt0 + th + q * 8) = o; } }
      __syncthreads();
    }
#undef PB_DECODE
#undef PB_LOAD
  }
  { float* in = (float*)reg2;
    bf16_t* ut = (bf16_t*)(reg2 + 3 * 66 * 64 * 4);
    const bf16_t* PHY = (const bf16_t*)(p.ws + OFF_PHY); bf16_t* HV = (bf16_t*)(p.ws + OFF_HV); bf16_t* HX0 = (bf16_t*)(p.ws + OFF_HX0);
    const float* cw = p.conv_w + (size_t)l * 3 * 6144; const float* cb = p.conv_b + (size_t)l * 6144;
    const int nit = ((l == 0) ? 272 : 256) * 32;
    u32x4 pre[4];
#define PC_DECODE(it_) const int tk = (it_) >> 5, c0 = ((it_) & 31) * 64; int b, t0; bool isctx; tok_tile(tk, b, t0, isctx); const int Ls = isctx ? CTXL : SEQ; const int row0 = tok_row(b, t0, isctx);
#define PC_LOAD(it_) do { PC_DECODE(it_) _Pragma("unroll") for (int e = 0; e < 4; ++e) { const int id = tid + 512 * e; const int pi = id / 528, rem = id % 528, rr = rem >> 3, pc = rem & 7; const int t = t0 - 1 + rr; \
        u32x4 v; v[0] = 0u; v[1] = 0u; v[2] = 0u; v[3] = 0u; if (id < 1584 && t >= 0 && t < Ls) v = *(const u32x4*)(PHY + (size_t)(row0 - 1 + rr) * 6144 + pi * 2048 + c0 + pc * 8); pre[e] = v; } } while (0)
    if ((int)blockIdx.x < nit) PC_LOAD((int)blockIdx.x);
    for (int it = blockIdx.x; it < nit; it += gridDim.x) {
      PC_DECODE(it) (void)Ls;
#pragma unroll
      for (int e = 0; e < 4; ++e) { const int id = tid + 512 * e; if (id < 1584) { const int pi = id / 528, rem = id % 528, rr = rem >> 3, pc = rem & 7; const u32x4 v = pre[e];
        float* d = in + (pi * 66 + rr) * 64 + pc * 8;
        d[0] = lo2f(v[0]); d[1] = hi2f(v[0]); d[2] = lo2f(v[1]); d[3] = hi2f(v[1]); d[4] = lo2f(v[2]); d[5] = hi2f(v[2]); d[6] = lo2f(v[3]); d[7] = hi2f(v[3]); } }
      if (it + (int)gridDim.x < nit) PC_LOAD(it + (int)gridDim.x);
      __syncthreads();
      { const int c = tid & 63, tg = tid >> 6; float w[3][3], bb[3];
#pragma unroll
        for (int pi = 0; pi < 3; ++pi) { bb[pi] = cb[pi * 2048 + c0 + c];
#pragma unroll
          for (int k = 0; k < 3; ++k) w[pi][k] = cw[k * 6144 + pi * 2048 + c0 + c]; }
#pragma unroll
        for (int e = 0; e < 8; ++e) { const int tok = tg * 8 + e; float cv[3];
#pragma unroll
          for (int pi = 0; pi < 3; ++pi) cv[pi] = in[(pi * 66 + tok) * 64 + c] * w[pi][0] + in[(pi * 66 + tok + 1) * 64 + c] * w[pi][1] + in[(pi * 66 + tok + 2) * 64 + c] * w[pi][2] + bb[pi];
          const bf16_t hv = f2bf(cv[0] * cv[2]);
          HV[(size_t)(row0 + tok) * 2048 + c0 + c] = hv; HX0[(size_t)(row0 + tok) * 2048 + c0 + c] = f2bf(cv[1]); ut[c * 66 + tok] = hv; } }
      __syncthreads();
      { const int c = tid >> 3, pc = tid & 7; u32x4 o;
#pragma unroll
        for (int e = 0; e < 4; ++e) o[e] = (unsigned)ut[c * 66 + pc * 8 + 2 * e] | ((unsigned)ut[c * 66 + pc * 8 + 2 * e + 1] << 16);
        bf16_t* dst = isctx ? (bf16_t*)(p.ws + OFF_UTC) + ((size_t)(c0 + c) * NB + b) * CTXL + t0 + pc * 8 : (bf16_t*)(p.ws + OFF_UT) + ((size_t)(c0 + c) * NB + b) * SEQ + t0 + pc * 8;
        *(u32x4*)dst = o; }
    }
    __syncthreads();
#undef PC_DECODE
#undef PC_LOAD
  }
}

__device__ void phase_post(const Params& p, int l, unsigned char* shm) {
  const int tid = otid(p.wid), lane = tid & 63;
  const bf16_t* HV = (const bf16_t*)(p.ws + OFF_HV); const bf16_t* HX0 = (const bf16_t*)(p.ws + OFF_HX0); const bf16_t* PHG = (const bf16_t*)(p.ws + OFF_PHG);
  bf16_t* AH = (bf16_t*)(p.ws + OFF_H); const float* hbias = p.hy_bias + l * 2048;
  { float* yt = (float*)shm;
    const bf16_t* UT = (const bf16_t*)(p.ws + OFF_UT);
    const int nit = 256 * 32; u32x4 pre;
#define PA_LOAD(it_) do { const int tk_ = (it_) >> 5, c0_ = ((it_) & 31) * 64, b_ = tk_ >> 6, t0_ = (tk_ & 63) * 64; pre = *(const u32x4*)(UT + ((size_t)(c0_ + (tid >> 3)) * NB + b_) * SEQ + t0_ + (tid & 7) * 8); } while (0)
    if ((int)blockIdx.x < nit) PA_LOAD((int)blockIdx.x);
    for (int it = blockIdx.x; it < nit; it += gridDim.x) {
      const int tk = it >> 5, c0 = (it & 31) * 64, b = tk >> 6, t0 = (tk & 63) * 64, row0 = b * SEQ + t0;
      { const int c = tid >> 3, pc = tid & 7; const u32x4 v = pre; float* d = yt + c * 65 + pc * 8;
        d[0] = lo2f(v[0]); d[1] = hi2f(v[0]); d[2] = lo2f(v[1]); d[3] = hi2f(v[1]); d[4] = lo2f(v[2]); d[5] = hi2f(v[2]); d[6] = lo2f(v[3]); d[7] = hi2f(v[3]); }
      if (it + (int)gridDim.x < nit) PA_LOAD(it + (int)gridDim.x);
      __syncthreads();
      { const int c = tid & 63, tg = tid >> 6; const float hb = hbias[c0 + c];
#pragma unroll
        for (int e = 0; e < 8; ++e) { const int tok = tg * 8 + e; const size_t o = (size_t)(row0 + tok) * 2048 + c0 + c;
          const float hv = bf2f(HV[o]); AH[o] = f2bf((yt[c * 65 + tok] + hb * hv) * bf2f(HX0[o]) * siluf_(bf2f(PHG[o]))); } }
      __syncthreads();
    }
#undef PA_LOAD
  }
  if (l == 0) { float* gc = (float*)shm; float* us = gc + 32 * 512;
    const bf16_t* UTC = (const bf16_t*)(p.ws + OFF_UTC); const float* GC = (const float*)(p.ws + OFF_GC);
    for (int it = blockIdx.x; it < 16 * 64; it += gridDim.x) {
      const int tk = it >> 6, c0 = (it & 63) * 32, b = tk >> 2, t0 = (tk & 3) * 64, row0 = NLAT + b * CTXL + t0;
      for (int i = tid; i < 32 * 512; i += 512) gc[i] = GC[(size_t)(c0 + (i >> 9)) * 512 + (i & 511)];
      for (int i = tid; i < 32 * 256; i += 512) us[i] = bf2f(UTC[((size_t)(c0 + (i >> 8)) * NB + b) * CTXL + (i & 255)]);
      __syncthreads();
      { const int t = tid & 63, cg4 = tid >> 6;
#pragma unroll 1
        for (int e = 0; e < 4; ++e) { const int c = cg4 * 4 + e; const float* g = gc + c * 512 + 256 + t0 + t; const float* u = us + c * 256; float a = 0.f;
          for (int s = 0; s < 256; ++s) a += u[s] * g[-s];
          const size_t o = (size_t)(row0 + t) * 2048 + c0 + c; const float hv = bf2f(HV[o]);
          AH[o] = f2bf((a + hbias[c0 + c] * hv) * bf2f(HX0[o]) * siluf_(bf2f(PHG[o]))); } }
      __syncthreads();
    }
  }
  { bf16_t* OF = (bf16_t*)(p.ws + OFF_OF); const bf16_t* OB = (const bf16_t*)(p.ws + OFF_OB); const bf16_t* RG = (const bf16_t*)(p.ws + OFF_PRG);
    const int gw = blockIdx.x * 8 + (tid >> 6), nw = gridDim.x * 8; const int nrows = (l == 0) ? MT : NLAT;
#pragma unroll 2
    for (int it = gw; it < nrows * 8; it += nw) { const size_t o = (size_t)(it >> 3) * 4096 + (it & 7) * 512 + lane * 8;
      const u32x4 a = *(const u32x4*)(OF + o), bq = *(const u32x4*)(OB + o), g = *(const u32x4*)(RG + o);
      float v[8]; float ss = 0.f;
#pragma unroll
      for (int e = 0; e < 4; ++e) { v[2 * e] = lo2f(a[e]) + lo2f(bq[e]); v[2 * e + 1] = hi2f(a[e]) + hi2f(bq[e]); ss += v[2 * e] * v[2 * e] + v[2 * e + 1] * v[2 * e + 1]; }
      ss = wsum(ss, lane);
      const float rs = rsqrtf(ss * (1.f / 512.f) + 1e-6f);
      u32x4 r;
#pragma unroll
      for (int e = 0; e < 4; ++e) r[e] = pk2(v[2 * e] * rs * siluf_(lo2f(g[e])), v[2 * e + 1] * rs * siluf_(hi2f(g[e])));
      *(u32x4*)(OF + o) = r; }
  }
}

__device__ void phase_conv(const Params& p, int l, unsigned char* shm) {
  const int tid = otid(p.wid), lane = tid & 63, wid = tid >> 6;
  bf16_t* Gs = (bf16_t*)shm;
  bf16_t* Us = (bf16_t*)(shm + 2 * GLEN * 2);
  { unsigned zz = 0u; asm volatile("" : "+v"(zz)); u32x4 z; z[0] = zz; z[1] = zz; z[2] = zz; z[3] = zz; for (int i = tid; i < 2 * 4 * USTR / 8; i += 512) ((u32x4*)Us)[i] = z; }
  __syncthreads();
  const int ch = wid >> 2, q = wid & 3, i = lane & 31, g = lane >> 5, a_l = i >> 2, b = i & 3;
  const bf16_t* G = (const bf16_t*)(p.ws + OFF_G + (size_t)l * G_LAYER); bf16_t* UT = (bf16_t*)(p.ws + OFF_UT);
  const int mb = LOFF - i + 8 * g - 128 * (8 * q + 7);
  const unsigned sh = (unsigned)(mb & 1) * 16u;
  const unsigned* Gd = (const unsigned*)(Gs + ch * GLEN) + (mb >> 1);
  const bf16_t* Ub = Us + (ch * 4 + b) * USTR + 136 * (a_l + 1) + 8 * g;
#define CONV_LDFRAG(dst, n) do { const unsigned* q_ = Gd + 8 * (n); const unsigned d0 = q_[0], d1 = q_[1], d2 = q_[2], d3 = q_[3], d4 = q_[4]; u32x4 r_; \
    r_[0] = __builtin_amdgcn_alignbit(d1, d0, sh); r_[1] = __builtin_amdgcn_alignbit(d2, d1, sh); r_[2] = __builtin_amdgcn_alignbit(d3, d2, sh); r_[3] = __builtin_amdgcn_alignbit(d4, d3, sh); \
    dst = __builtin_bit_cast(bf16x8, r_); } while (0)
  for (int pr = blockIdx.x; pr < 1024; pr += gridDim.x) {
    for (int id = tid; id < 2 * (GLEN / 2); id += 512) { const int cc = id / (GLEN / 2), dw = id % (GLEN / 2);
      unsigned v = ((const unsigned*)(G + (size_t)(pr * 2 + cc) * GLEN))[dw]; const int m = dw * 2;
      if (m < 33 || m > 8223) v &= 0xffff0000u; if (m + 1 < 33 || m + 1 > 8223) v &= 0x0000ffffu;
      ((unsigned*)Gs)[cc * (GLEN / 2) + dw] = v; }
    for (int id = tid; id < 2 * 4 * 512; id += 512) { const int cc = id >> 11, bb = (id >> 9) & 3, s8 = id & 511;
      const u32x4 v = *(const u32x4*)(UT + ((size_t)(pr * 2 + cc) * 4 + bb) * SEQ + s8 * 8); const int sp = 1024 + s8 * 8;
      *(u32x4*)(Us + (cc * 4 + bb) * USTR + sp + 8 * (sp >> 7)) = v; }
    __syncthreads();
    bf16x8 W[8]; f32x16 acc[4];
#pragma unroll
    for (int h = 0; h < 4; ++h)
#pragma unroll
      for (int e = 0; e < 16; ++e) acc[h][e] = 0.f;
    CONV_LDFRAG(W[2], -6); CONV_LDFRAG(W[3], -5); CONV_LDFRAG(W[4], -4); CONV_LDFRAG(W[5], -3); CONV_LDFRAG(W[6], -2); CONV_LDFRAG(W[7], -1);
#pragma unroll 1
    for (int it = 0; it < 39; ++it) {
#pragma unroll
      for (int u = 0; u < 8; ++u) {
        CONV_LDFRAG(W[u], it * 8 + u);
        const bf16x8 bf = *(const bf16x8*)(Ub + 136 * it + 16 * u);
#pragma unroll
        for (int h = 0; h < 4; ++h) acc[h] = __builtin_amdgcn_mfma_f32_32x32x16_bf16(W[(u - 2 * h) & 7], bf, acc[h], 0, 0, 0);
      }
    }
    { bf16_t* yrow = UT + ((size_t)(pr * 2 + ch) * 4 + b) * SEQ + 128 * (8 * q + a_l) + 4 * g;
#pragma unroll
      for (int h = 0; h < 4; ++h)
#pragma unroll
        for (int rq = 0; rq < 4; ++rq) { u32x2 o; o[0] = pk2(acc[h][4 * rq], acc[h][4 * rq + 1]); o[1] = pk2(acc[h][4 * rq + 2], acc[h][4 * rq + 3]); *(u32x2*)(yrow + 32 * h + 8 * rq) = o; } }
    __syncthreads();
  }
#undef CONV_LDFRAG
}

template <int KD> DI f32x16 mma_tile(f32x16 acc, const bf16_t* A, int lda, const bf16_t* B, int ldb, int lane) {
  const int r = lane & 31, g8 = (lane >> 5) * 8; const bf16_t* ap = A + r * lda + g8; const bf16_t* bp = B + r * ldb + g8;
#pragma unroll 4
  for (int k0 = 0; k0 < KD; k0 += 16) acc = __builtin_amdgcn_mfma_f32_32x32x16_bf16(*(const bf16x8*)(ap + k0), *(const bf16x8*)(bp + k0), acc, 0, 0, 0);
  return acc;
}
__device__ void phase_ret(const Params& p, int l, unsigned char* shm) {
  constexpr int QS = 264, TS = 72;
  const int tid = otid(p.wid), lane = tid & 63, wid = tid >> 6, g = lane >> 5;
  bf16_t* Qs = (bf16_t*)shm; bf16_t* Ks = Qs + 64 * QS; bf16_t* Kts = Ks + 64 * QS; bf16_t* Vts = Kts + 256 * TS; bf16_t* Ps = Vts + 64 * TS; bf16_t* Sts = Ps + 64 * TS;
  const bf16_t* PQ = (const bf16_t*)(p.ws + OFF_PQ); const bf16_t* PK = (const bf16_t*)(p.ws + OFF_PK);
  const bf16_t* KT = (const bf16_t*)(p.ws + OFF_KT); const bf16_t* VT = (const bf16_t*)(p.ws + OFF_VT);
  for (int it0 = blockIdx.x; it0 < 512; it0 += gridDim.x) {
    int it = it0;
    if (gridDim.x == 256) { const int xcd = it0 & 7, idx = (it0 >> 3) & 31, r = it0 >> 8; it = ((xcd + 8 * ((idx >> 3) + 4 * r)) << 3) | (idx & 7); }
    const int sl = it & 7, dir = (it >> 3) & 1, h = (it >> 4) & 7, b = it >> 7;
    const float lg = -expf(p.ret_decay[(l * 2 + dir) * 8 + h]);
    bf16_t* O = (bf16_t*)(p.ws + (dir ? OFF_OB : OFF_OF));
    for (int i = tid; i < 64 * QS / 2; i += 512) ((unsigned*)Sts)[i] = 0u;
    f32x16 S[4], cross;
#pragma unroll
    for (int x = 0; x < 4; ++x)
#pragma unroll
      for (int e = 0; e < 16; ++e) S[x][e] = 0.f;
#pragma unroll
    for (int e = 0; e < 16; ++e) cross[e] = 0.f;
    const float cd = __expf(lg * 64.f);
    const int tid2 = otid(p.wid), ln2 = tid2 & 63, g2 = ln2 >> 5;
    const int pc8 = tid2 & 7;
    float dk[8], mk[16];
#pragma unroll
    for (int w = 0; w < 8; ++w) { const int tok = pc8 * 8 + w; dk[w] = __expf(lg * (float)(dir ? tok : 63 - tok)); }
    const int wq = (tid2 >> 6) & 3, t_hi = wq >> 1, t_lo = wq & 1;
    { const int i = t_lo * 32 + (ln2 & 31);
#pragma unroll
      for (int e = 0; e < 16; ++e) { const int j = t_hi * 32 + (e & 3) + 8 * (e >> 2) + 4 * g2; const int diff = dir ? (j - i) : (i - j); mk[e] = diff >= 0 ? __expf(lg * (float)diff) : 0.f; } }
    const int qi = t_hi * 32 + (ln2 & 31);
    const float qd = __expf(lg * (float)(dir ? 64 - qi : qi + 1));
    u32x4 rq[4], rk[4], rt[4], rv;
    const unsigned qo_l = (unsigned)(tid >> 5) * 2048u + (unsigned)(h * 256 + (tid & 31) * 8);
    const unsigned ko_l = (unsigned)((b * 8 + h) * 256 + (tid >> 3)) * (unsigned)TT + (unsigned)(pc8 * 8);
    const unsigned vo_l = (unsigned)((b * 8 + h) * 512 + sl * 64 + (tid >> 3)) * (unsigned)TT + (unsigned)(pc8 * 8);
#define RET_CHUNK(step_, isctx_, t0_) do { if ((step_) < 4) { isctx_ = true; t0_ = (dir ? 3 - (step_) : (step_)) * 64; } else { isctx_ = false; const int cn_ = (step_) - 4; t0_ = (dir ? 63 - cn_ : cn_) * 64; } } while (0)
#define RET_LOAD(step_) do { bool ic_; int t0n_; RET_CHUNK(step_, ic_, t0n_); const unsigned r0_ = (unsigned)tok_row(b, t0n_, ic_) * 2048u + qo_l; const unsigned tt_ = (unsigned)(ic_ ? t0n_ : CTXL + t0n_); \
      _Pragma("unroll") for (int e = 0; e < 4; ++e) { rq[e] = *(const u32x4*)(PQ + (r0_ + (unsigned)e * 32768u)); rk[e] = *(const u32x4*)(PK + (r0_ + (unsigned)e * 32768u)); rt[e] = *(const u32x4*)(KT + (ko_l + tt_ + (unsigned)e * (unsigned)(64 * TT))); } \
      rv = *(const u32x4*)(VT + (vo_l + tt_)); } while (0)
    RET_LOAD(0);
#pragma unroll 1
    for (int step = 0; step < 68; ++step) {
      bool isctx; int t0; RET_CHUNK(step, isctx, t0);
      const int row0 = tok_row(b, t0, isctx);
      __syncthreads();
#pragma unroll
      for (int e = 0; e < 4; ++e) { const int row = (tid >> 5) + 16 * e, pc = tid & 31;
        *(u32x4*)(Qs + row * QS + pc * 8) = rq[e]; *(u32x4*)(Ks + row * QS + pc * 8) = rk[e];
        u32x4 o;
#pragma unroll
        for (int w = 0; w < 4; ++w) o[w] = pk2(lo2f(rt[e][w]) * dk[2 * w], hi2f(rt[e][w]) * dk[2 * w + 1]);
        *(u32x4*)(Kts + ((tid >> 3) + 64 * e) * TS + pc8 * 8) = o; }
      *(u32x4*)(Vts + (tid >> 3) * TS + pc8 * 8) = rv;
      if (step + 1 < 68) RET_LOAD(step + 1);
      __syncthreads();
      if (wid < 4) {
        f32x16 sc;
#pragma unroll
        for (int e = 0; e < 16; ++e) sc[e] = 0.f;
        sc = mma_tile<256>(sc, Ks + t_hi * 32 * QS, QS, Qs + t_lo * 32 * QS, QS, lane);
        const int i = t_lo * 32 + (lane & 31);
#pragma unroll
        for (int r4 = 0; r4 < 4; ++r4) { u32x2 o; o[0] = pk2(sc[4 * r4] * mk[4 * r4], sc[4 * r4 + 1] * mk[4 * r4 + 1]); o[1] = pk2(sc[4 * r4 + 2] * mk[4 * r4 + 2], sc[4 * r4 + 3] * mk[4 * r4 + 3]);
          *(u32x2*)(Ps + i * TS + t_hi * 32 + 8 * r4 + 4 * g) = o; }
      } else {
#pragma unroll
        for (int e = 0; e < 16; ++e) cross[e] = 0.f;
        cross = mma_tile<256>(cross, Sts + t_lo * 32 * QS, QS, Qs + t_hi * 32 * QS, QS, lane);
      }
      __syncthreads();
      if (wid < 4) {
#pragma unroll
        for (int x = 0; x < 4; ++x) { const int td = 2 * wid + (x >> 1), tc = x & 1;
#pragma unroll
          for (int e = 0; e < 16; ++e) S[x][e] *= cd;
          S[x] = mma_tile<64>(S[x], Kts + td * 32 * TS, TS, Vts + tc * 32 * TS, TS, lane);
          const int c = tc * 32 + (lane & 31);
#pragma unroll
          for (int r4 = 0; r4 < 4; ++r4) { u32x2 o; o[0] = pk2(S[x][4 * r4], S[x][4 * r4 + 1]); o[1] = pk2(S[x][4 * r4 + 2], S[x][4 * r4 + 3]); *(u32x2*)(Sts + c * QS + td * 32 + 8 * r4 + 4 * g) = o; } }
      } else {
        f32x16 in_;
#pragma unroll
        for (int e = 0; e < 16; ++e) in_[e] = 0.f;
        in_ = mma_tile<64>(in_, Vts + t_lo * 32 * TS, TS, Ps + t_hi * 32 * TS, TS, lane);
        const unsigned ob = (unsigned)(row0 + qi) * 4096u + (unsigned)(h * 512 + sl * 64 + t_lo * 32 + 4 * g);
#pragma unroll
        for (int r4 = 0; r4 < 4; ++r4) { u32x2 o; o[0] = pk2(in_[4 * r4] + qd * cross[4 * r4], in_[4 * r4 + 1] + qd * cross[4 * r4 + 1]); o[1] = pk2(in_[4 * r4 + 2] + qd * cross[4 * r4 + 2], in_[4 * r4 + 3] + qd * cross[4 * r4 + 3]);
          *(u32x2*)(O + (ob + (unsigned)(8 * r4))) = o; }
      }
    }
    __syncthreads();
  }
#undef RET_CHUNK
#undef RET_LOAD
}

__global__ void __launch_bounds__(512, 2) mega(Params p_in) {
  Params p = p_in; p.wid = __builtin_amdgcn_readfirstlane((int)(threadIdx.x >> 6));
  extern __shared__ __attribute__((aligned(16))) unsigned char shm[];
  cg::grid_group grid = cg::this_grid();
  PG8_LAS unsigned char* lds = (PG8_LAS unsigned char*)shm;
  const bf16_t* H = (const bf16_t*)(p.ws + OFF_H);
  phase_filters(p, shm); phase_mod(p, shm);
  grid.sync();
  for (int l = 0; l < 2; ++l) {
    phase_cvt(p, l, shm); phase_norm(p, l);
    grid.sync();
    { pg8::Gemm g; g.wid = p.wid; g.A = H; g.Bt = (const bf16_t*)(p.ws + OFF_WTIN); g.M = MT; g.N = INW; g.K = DM;
      pg8::Order S; S.init(64, 96, (int)gridDim.x, (int)blockIdx.x, 4, l == 0 ? 96 : 24, l == 0 ? 0 : 8);
      EpiG1 E; E.ws = p.ws; pg8::gemm_phase<EpiG1, pg8::Order>(lds, g, S, E); }
    grid.sync();
    phase_prep(p, l, shm);
    grid.sync();
    phase_conv(p, l, shm); phase_ret(p, l, shm);
    grid.sync();
    phase_post(p, l, shm);
    grid.sync();
    { const int nM = (l == 0) ? 68 : 64;
      pg8::Order S; S.init(nM, 8, (int)gridDim.x, (int)blockIdx.x, 0, 0, 0);
      { pg8::Gemm g; g.wid = p.wid; g.A = H; g.Bt = (const bf16_t*)(p.ws + OFF_WTHY); g.M = nM * 256; g.N = DM; g.K = DM; EpiG23<0> E; E.ws = p.ws; pg8::gemm_phase<EpiG23<0>, pg8::Order>(lds, g, S, E); }
      { pg8::Gemm g; g.wid = p.wid; g.A = (const bf16_t*)(p.ws + OFF_OF); g.Bt = (const bf16_t*)(p.ws + OFF_WTRET); g.M = nM * 256; g.N = DM; g.K = 4096; EpiG23<1> E; E.ws = p.ws; pg8::gemm_phase<EpiG23<1>, pg8::Order>(lds, g, S, E); }
      grid.sync();
      { pg8::Gemm g; g.wid = p.wid; g.A = (const bf16_t*)(p.ws + OFF_T1); g.Bt = (const bf16_t*)(p.ws + OFF_WTO); g.M = nM * 256; g.N = DM; g.K = DM;
        EpiG4 E; E.xin = (l == 0) ? p.x : p.out; E.cin = p.ctx; E.xout = p.out; E.cout = (float*)(p.ws + OFF_CTXR); E.mod = (const float*)(p.ws + OFF_MOD) + (size_t)l * 5 * 6144;
        pg8::gemm_phase<EpiG4, pg8::Order>(lds, g, S, E); } }
    grid.sync();
  }
  phase_final(p);
}

extern "C" void kernel_launch(void* const* d_in, const int* in_sizes, int n_in, void* d_out, int out_size, void* d_ws, size_t ws_size, hipStream_t stream) {
  constexpr size_t kDynLds = 157696;
  static int grid_blocks = 0;
  if (!grid_blocks) {
    hipFuncSetAttribute((const void*)mega, hipFuncAttributeMaxDynamicSharedMemorySize, (int)kDynLds);
    int dev = 0, cus = 0, per_cu = 0;
    hipGetDevice(&dev);
    hipDeviceGetAttribute(&cus, hipDeviceAttributeMultiprocessorCount, dev);
    hipOccupancyMaxActiveBlocksPerMultiprocessor(&per_cu, (const void*)mega, 512, kDynLds);
    grid_blocks = cus * (per_cu >= 1 ? 1 : 0);
    if (ws_size < WS_NEED || grid_blocks <= 0) { fprintf(stderr, "workspace %zu < %zu or no occupancy (%d)\n", ws_size, (size_t)WS_NEED, per_cu); grid_blocks = grid_blocks > 0 ? grid_blocks : 256; }
  }
  Params p{};
  p.x = (const float*)d_in[0]; p.c = (const float*)d_in[1]; p.ctx = (const float*)d_in[2]; p.c_ctx = (const float*)d_in[3]; p.ln_g = (const float*)d_in[4];
  p.ada_w = (const float*)d_in[5]; p.ada_b = (const float*)d_in[6]; p.w_in = (const float*)d_in[7]; p.conv_w = (const float*)d_in[8]; p.conv_b = (const float*)d_in[9];
  p.fw1 = (const float*)d_in[10]; p.fb1 = (const float*)d_in[11]; p.fw2 = (const float*)d_in[12]; p.fb2 = (const float*)d_in[13]; p.fw3 = (const float*)d_in[14]; p.fb3 = (const float*)d_in[15];
  p.ffreq = (const float*)d_in[16]; p.fwout = (const float*)d_in[17]; p.hy_bias = (const float*)d_in[18]; p.ret_decay = (const float*)d_in[19];
  p.w_hy_out = (const float*)d_in[20]; p.w_ret_out = (const float*)d_in[21]; p.w_o = (const float*)d_in[22]; p.final_g = (const float*)d_in[23];
  p.out = (float*)d_out; p.ws = (unsigned char*)d_ws;
  void* args[] = {&p};
  hipError_t e = hipLaunchCooperativeKernel((void*)mega, dim3(grid_blocks), dim3(512), args, kDynLds, stream);
  if (e != hipSuccess) fprintf(stderr, "cooperative launch failed: %s (grid %d)\n", hipGetErrorString(e), grid_blocks);
}
```

```cpp
#include <hip/hip_runtime.h>
#include <hip/hip_cooperative_groups.h>
#include <cstdio>
namespace cg = cooperative_groups;
#ifndef PROBE
#define PROBE 0
#endif

typedef unsigned short bf16_t;
typedef short bf16x8 __attribute__((ext_vector_type(8)));
typedef float f32x4 __attribute__((ext_vector_type(4)));
typedef float f32x16 __attribute__((ext_vector_type(16)));
typedef unsigned u32x4 __attribute__((ext_vector_type(4)));
typedef unsigned u32x2 __attribute__((ext_vector_type(2)));
#define DI __device__ __forceinline__

DI int otid(int wid) { int t; asm volatile("v_mbcnt_lo_u32_b32 %0, -1, 0\n\tv_mbcnt_hi_u32_b32 %0, -1, %0" : "=v"(t)); return wid * 64 + t; }
DI float wsum(float v, int lane) {
#pragma unroll
  for (int o = 32; o > 0; o >>= 1) v += __int_as_float(__builtin_amdgcn_ds_bpermute((lane ^ o) << 2, __float_as_int(v)));
  return v; }
DI float bf2f(bf16_t u) { return __uint_as_float(((unsigned)u) << 16); }
typedef __bf16 bf16v2 __attribute__((ext_vector_type(2)));
typedef float f32v2 __attribute__((ext_vector_type(2)));
DI unsigned pk2(float lo, float hi) { f32v2 v = {lo, hi}; bf16v2 b = __builtin_convertvector(v, bf16v2); return __builtin_bit_cast(unsigned, b); }
DI bf16_t f2bf(float f) { return (bf16_t)(pk2(f, 0.f) & 0xffffu); }
DI float lo2f(unsigned u) { return __uint_as_float(u << 16); }
DI float hi2f(unsigned u) { return __uint_as_float(u & 0xffff0000u); }
DI float sigmoidf_(float v) { return 1.f / (1.f + __expf(-v)); }
DI float siluf_(float v) { return v / (1.f + __expf(-v)); }

constexpr int DM = 2048, NB = 4, SEQ = 4096, CTXL = 256, NLAT = NB * SEQ, NCTX = NB * CTXL, MT = NLAT + NCTX;
constexpr int INW = 24576, NH = 8, DK = 256, DV = 512, TT = SEQ + CTXL;
constexpr int LOFF = 4128, GLEN = 8320;      constexpr size_t G_LAYER = ((size_t)2048 * 8320 * 2 + 255) & ~(size_t)255;
constexpr int USTR = 6560;

constexpr size_t AL(size_t x) { return (x + 255) & ~(size_t)255; }
constexpr size_t OFF_WTIN = 0;
constexpr size_t OFF_WTHY = OFF_WTIN + AL((size_t)INW * DM * 2);
constexpr size_t OFF_WTRET = OFF_WTHY + AL((size_t)DM * DM * 2);
constexpr size_t OFF_WTO = OFF_WTRET + AL((size_t)DM * 4096 * 2);
constexpr size_t OFF_G = OFF_WTO + AL((size_t)DM * DM * 2);
constexpr size_t OFF_GC = OFF_G + 2 * AL((size_t)DM * GLEN * 2);
constexpr size_t OFF_MOD = OFF_GC + AL((size_t)DM * 512 * 4);
constexpr size_t OFF_H = OFF_MOD + AL((size_t)2 * 5 * 6144 * 4);
constexpr size_t OFF_PQ = OFF_H + AL((size_t)MT * DM * 2);
constexpr size_t OFF_PK = OFF_PQ + AL((size_t)MT * DM * 2);
constexpr size_t OFF_PV = OFF_PK + AL((size_t)MT * DM * 2);
constexpr size_t OFF_PRG = OFF_PV + AL((size_t)MT * 4096 * 2);
constexpr size_t OFF_PHY = OFF_PRG + AL((size_t)MT * 4096 * 2);
constexpr size_t OFF_PHG = OFF_PHY + AL((size_t)MT * 6144 * 2);
constexpr size_t OFF_PMG = OFF_PHG + AL((size_t)MT * DM * 2);
constexpr size_t OFF_KT = OFF_PMG + AL((size_t)MT * 4096 * 2);
constexpr size_t OFF_VT = OFF_KT + AL((size_t)NB * NH * DK * TT * 2);
constexpr size_t OFF_UT = OFF_VT + AL((size_t)NB * NH * DV * TT * 2);
constexpr size_t OFF_UTC = OFF_UT + AL((size_t)DM * NB * SEQ * 2);
constexpr size_t OFF_HV = OFF_UTC + AL((size_t)DM * NB * CTXL * 2);
constexpr size_t OFF_HX0 = OFF_HV + AL((size_t)MT * DM * 2);
constexpr size_t OFF_CTXR = OFF_HX0 + AL((size_t)MT * DM * 2);
constexpr size_t WS_NEED = OFF_CTXR + AL((size_t)NCTX * DM * 4);
constexpr size_t OFF_OF = OFF_PV, OFF_OB = OFF_PHY, OFF_T1 = OFF_PHY + AL((size_t)MT * 4096 * 2);

struct Params {
  const float *x, *c, *ctx, *c_ctx, *ln_g, *ada_w, *ada_b, *w_in, *conv_w, *conv_b, *fw1, *fb1, *fw2, *fb2, *fw3, *fb3, *ffreq, *fwout, *hy_bias, *ret_decay, *w_hy_out, *w_ret_out, *w_o, *final_g;
  float* out;
  unsigned char* ws;
  int wid, pad_;
};

namespace pg8 {
#define PG8_LAS __attribute__((address_space(3)))
constexpr int BM = 256, BK = 64, HALF = 128, HTB = HALF * BK * 2, STAGE_BYTES = 8 * HTB, NXCD = 8, WGM = 8;
__host__ __device__ __forceinline__ int lds_byte(int r, int c) { const int st = (r >> 4) * 2 + (c >> 5), rr = r & 15, cc = c & 31, ob = rr * 64 + cc * 2; return st * 1024 + (ob ^ (((ob >> 9) & 1) << 5)); }
__host__ __device__ __forceinline__ void stage_rc(int b, int& R, int& C) { const int st = b / 1024, sb = b % 1024, swz = sb ^ (((sb >> 9) & 1) << 5); R = (st >> 1) * 16 + swz / 64; C = (st & 1) * 32 + (swz % 64) / 2; }
__host__ __device__ __forceinline__ int perm32(int rho) { const int n = rho >> 4, i = rho & 15; return 8 * (i >> 2) + 4 * n + (i & 3); }
struct Unit { int pm, pn; };
struct Gemm { const bf16_t* A; const bf16_t* Bt; int M, N, K, wid; };
struct Order {
    int nM, nN, nwg, G, c, nx_m, nx_n, x_pn0;
    __device__ void init(int nM_, int nN_, int G_, int c_, int nx_m_, int nx_n_, int x_pn0_) { nM = nM_; nN = nN_; nwg = nM * nN; G = G_; c = c_; nx_m = nx_m_; nx_n = nx_n_; x_pn0 = x_pn0_; }
    __device__ bool next(int i, Unit& u) const {
        const long L = (long)i * G + c;
        if (L >= nwg) { const int e = (int)(L - nwg); if (e >= nx_m * nx_n) return false; u.pm = nM + e % nx_m; u.pn = x_pn0 + e / nx_m; return true; }
        int wgid = (int)L; { const int q = nwg / NXCD, r = nwg % NXCD, xcd = wgid % NXCD, off = wgid / NXCD; wgid = (xcd < r ? xcd * (q + 1) : r * (q + 1) + (xcd - r) * q) + off; }
        const int nig = WGM * nN, gid = wgid / nig, fm = gid * WGM, gsz = (nM - fm) < WGM ? (nM - fm) : WGM;
        u.pm = fm + ((wgid % nig) % gsz); u.pn = (wgid % nig) / gsz; return true;
    }
    __device__ __forceinline__ void a_ready(const Unit&) const {}
    __device__ __forceinline__ void done(const Unit&) const {}
};
template <class Epi, class Sched>
__device__ __forceinline__ void gemm_phase(PG8_LAS unsigned char* lds, const Gemm g, const Sched& S, const Epi& E) {
    const int tid = otid(g.wid), wid = __builtin_amdgcn_readfirstlane(tid >> 6), lane = tid & 63, wr = wid >> 2, wc = wid & 3, fr = lane & 15, fq = lane >> 4;
    const int K = g.K, nt = K / BK;
    unsigned voffA[2], voffB[2];
#pragma unroll
    for (int i = 0; i < 2; ++i) { int R, C; stage_rc(tid * 16 + i * 8192, R, C); const int Rb = Epi::PERM ? ((R & ~31) + perm32(R & 31)) : R;
        voffA[i] = (unsigned)(R * K + C) * 2u; voffB[i] = (unsigned)(Rb * K + C) * 2u; }
    const size_t kstep = (size_t)(BK * 2);
    const size_t hstep = (size_t)HALF * K * 2;
    const size_t tstep = 2 * hstep;
    const unsigned ldsw = (unsigned)wid * 1024u;
    const int aoff = lds_byte(wr * 64 + fr, fq * 8), boff = lds_byte(wc * 32 + fr, fq * 8);
#define PG8_SA(b, h) (((b) * 2 + (h)) * HTB)
#define PG8_SB(b, h) ((4 + (b) * 2 + (h)) * HTB)
#define PG8_STAGE(bufoff, gbase, voff) do { _Pragma("unroll") for (int _i = 0; _i < 2; ++_i) \
        __builtin_amdgcn_global_load_lds((const unsigned*)((const char*)(gbase) + (voff)[_i]), (PG8_LAS unsigned*)(lds + (bufoff) + ldsw + _i * 8192), 16, 0, 0); } while (0)
#define PG8_LDA(dst, b, h) do { _Pragma("unroll") for (int m = 0; m < 4; ++m) _Pragma("unroll") for (int k = 0; k < 2; ++k) dst[m][k] = *(const PG8_LAS bf16x8*)(lds + PG8_SA(b, h) + aoff + m * 2048 + k * 1024); } while (0)
#define PG8_LDB(dst, b, h) do { _Pragma("unroll") for (int n = 0; n < 2; ++n) _Pragma("unroll") for (int k = 0; k < 2; ++k) dst[n][k] = *(const PG8_LAS bf16x8*)(lds + PG8_SB(b, h) + boff + n * 2048 + k * 1024); } while (0)
#define PG8_MMA(ai, bj, At, Bt) do { __builtin_amdgcn_s_setprio(1); _Pragma("unroll") for (int m = 0; m < 4; ++m) _Pragma("unroll") for (int n = 0; n < 2; ++n) _Pragma("unroll") for (int k = 0; k < 2; ++k) \
        acc[ai][bj][m][n] = __builtin_amdgcn_mfma_f32_16x16x32_bf16(Bt[n][k], At[m][k], acc[ai][bj][m][n], 0, 0, 0); __builtin_amdgcn_s_setprio(0); } while (0)
#define PG8_WAIT_V(n) asm volatile("s_waitcnt vmcnt(" #n ")" ::: "memory")
#define PG8_WAIT_L(n) asm volatile("s_waitcnt lgkmcnt(" #n ")" ::: "memory")
#define PG8_BAR __builtin_amdgcn_s_barrier()
#define PG8_SCHED __builtin_amdgcn_sched_barrier(0)
    Unit cur, nxt; int ui = 0;
    if (!S.next(0, cur)) return;
    f32x4 acc[2][2][4][2];
#pragma unroll
    for (int a = 0; a < 2; ++a)
#pragma unroll
        for (int b = 0; b < 2; ++b)
#pragma unroll
            for (int m = 0; m < 4; ++m)
#pragma unroll
                for (int n = 0; n < 2; ++n) acc[a][b][m][n] = (f32x4){0.f, 0.f, 0.f, 0.f};
    bf16x8 At[4][2], B0[2][2], B1[2][2];
    const char* cA = (const char*)g.A + (size_t)cur.pm * tstep; const char* cB = (const char*)g.Bt + (size_t)cur.pn * tstep;
    S.a_ready(cur);
    PG8_STAGE(PG8_SB(0, 0), cB, voffB); PG8_STAGE(PG8_SA(0, 0), cA, voffA); PG8_STAGE(PG8_SB(0, 1), cB + hstep, voffB); PG8_STAGE(PG8_SA(0, 1), cA + hstep, voffA);
    if (wr == 1) PG8_BAR;
    PG8_WAIT_V(4); PG8_BAR;
    PG8_STAGE(PG8_SB(1, 0), cB + kstep, voffB); PG8_STAGE(PG8_SA(1, 0), cA + kstep, voffA); PG8_STAGE(PG8_SB(1, 1), cB + hstep + kstep, voffB);
    PG8_WAIT_V(6); PG8_BAR;
    for (;;) {
        const bool has_next = S.next(ui + 1, nxt);
        const char* nA = has_next ? (const char*)g.A + (size_t)nxt.pm * tstep : cA; const char* nB = has_next ? (const char*)g.Bt + (size_t)nxt.pn * tstep : cB;
        for (int t = 0; t < nt; t += 2) {
            const bool last = (t == nt - 2);
            const char* a1 = cA + (size_t)(t + 1) * kstep;
            const char* a2 = last ? nA : cA + (size_t)(t + 2) * kstep; const char* b2 = last ? nB : cB + (size_t)(t + 2) * kstep;
            const char* a3 = a2 + kstep; const char* b3 = b2 + kstep;
            if (last && has_next) S.a_ready(nxt);
            PG8_LDB(B0, 0, 0); PG8_SCHED; PG8_LDA(At, 0, 0); PG8_STAGE(PG8_SA(1, 1), a1 + hstep, voffA);
            PG8_WAIT_L(8); PG8_BAR; PG8_WAIT_L(0); PG8_MMA(0, 0, At, B0); PG8_BAR; PG8_SCHED;
            PG8_LDB(B1, 0, 1); PG8_STAGE(PG8_SB(0, 0), b2, voffB);
            PG8_BAR; PG8_WAIT_L(0); PG8_MMA(0, 1, At, B1); PG8_BAR;
            PG8_LDA(At, 0, 1); PG8_STAGE(PG8_SA(0, 0), a2, voffA);
            PG8_BAR; PG8_WAIT_L(0); PG8_MMA(1, 0, At, B0); PG8_BAR; PG8_SCHED;
            PG8_STAGE(PG8_SB(0, 1), b2 + hstep, voffB);
            PG8_WAIT_V(6); PG8_BAR; PG8_MMA(1, 1, At, B1); PG8_BAR;
            PG8_LDB(B0, 1, 0); PG8_SCHED; PG8_LDA(At, 1, 0); PG8_STAGE(PG8_SA(0, 1), a2 + hstep, voffA);
            PG8_WAIT_L(8); PG8_BAR; PG8_WAIT_L(0); PG8_MMA(0, 0, At, B0); PG8_BAR; PG8_SCHED;
            PG8_LDB(B1, 1, 1); PG8_STAGE(PG8_SB(1, 0), b3, voffB);
            PG8_BAR; PG8_WAIT_L(0); PG8_MMA(0, 1, At, B1); PG8_BAR;
            PG8_LDA(At, 1, 1); PG8_STAGE(PG8_SA(1, 0), a3, voffA);
            PG8_BAR; PG8_WAIT_L(0); PG8_MMA(1, 0, At, B0); PG8_BAR; PG8_SCHED;
            PG8_STAGE(PG8_SB(1, 1), b3 + hstep, voffB);
            PG8_WAIT_V(6); PG8_BAR; PG8_MMA(1, 1, At, B1); PG8_BAR;
        }
        if constexpr (!Epi::AFTER_DRAIN) { E(acc, cur, wr, wc, fr, fq); S.done(cur); }
        if (!has_next) break;
#pragma unroll
        for (int a = 0; a < 2; ++a)
#pragma unroll
            for (int b = 0; b < 2; ++b)
#pragma unroll
                for (int m = 0; m < 4; ++m)
#pragma unroll
                    for (int n = 0; n < 2; ++n) acc[a][b][m][n] = (f32x4){0.f, 0.f, 0.f, 0.f};
        cur = nxt; cA = nA; cB = nB; ++ui;
    }
    PG8_WAIT_V(0);
    if (wr == 0) PG8_BAR;
    PG8_BAR;
    if constexpr (Epi::AFTER_DRAIN) { E.fused(acc, cur, wr, wc, fr, fq, lds, wid, lane); S.done(cur); }
#undef PG8_SA
#undef PG8_SB
#undef PG8_STAGE
#undef PG8_LDA
#undef PG8_LDB
#undef PG8_MMA

#undef PG8_WAIT_V
#undef PG8_WAIT_L
#undef PG8_BAR
#undef PG8_SCHED
}
}

struct EpiG1 {
  static constexpr bool PERM = true, AFTER_DRAIN = false;
  unsigned char* ws;
  DI void operator()(const f32x4 (&acc)[2][2][4][2], const pg8::Unit& u, int wr, int wc, int fr, int fq) const {
    const int pn = u.pn; size_t off; int ld, c0;
    if (pn < 8) { off = OFF_PQ; ld = 2048; c0 = pn * 256; }
    else if (pn < 16) { off = OFF_PK; ld = 2048; c0 = (pn - 8) * 256; }
    else if (pn < 32) { off = OFF_PV; ld = 4096; c0 = (pn - 16) * 256; }
    else if (pn < 48) { off = OFF_PRG; ld = 4096; c0 = (pn - 32) * 256; }
    else if (pn < 72) { off = OFF_PHY; ld = 6144; c0 = (pn - 48) * 256; }
    else if (pn < 80) { off = OFF_PHG; ld = 2048; c0 = (pn - 72) * 256; }
    else { off = OFF_PMG; ld = 4096; c0 = (pn - 80) * 256; }
    bf16_t* base = (bf16_t*)(ws + off);
    const int row0 = u.pm * 256 + wr * 64 + fr, col0 = c0 + wc * 32 + 8 * fq;
#pragma unroll
    for (int ai = 0; ai < 2; ++ai)
#pragma unroll
      for (int m = 0; m < 4; ++m) { bf16_t* rowp = base + (size_t)(row0 + ai * 128 + m * 16) * ld + col0;
#pragma unroll
        for (int bj = 0; bj < 2; ++bj) { const f32x4 v0 = acc[ai][bj][m][0], v1 = acc[ai][bj][m][1];
          u32x4 o; o[0] = pk2(v0[0], v0[1]); o[1] = pk2(v0[2], v0[3]); o[2] = pk2(v1[0], v1[1]); o[3] = pk2(v1[2], v1[3]);
          *(u32x4*)(rowp + bj * 128) = o; } }
  }
};
template <int SECOND> struct EpiG23 {
  static constexpr bool PERM = true, AFTER_DRAIN = false;
  unsigned char* ws;
  DI void operator()(const f32x4 (&acc)[2][2][4][2], const pg8::Unit& u, int wr, int wc, int fr, int fq) const {
    bf16_t* T1 = (bf16_t*)(ws + OFF_T1); const bf16_t* MG = (const bf16_t*)(ws + OFF_PMG) + (SECOND ? 2048 : 0);
    const int row0 = u.pm * 256 + wr * 64 + fr, col0 = u.pn * 256 + wc * 32 + 8 * fq;
#pragma unroll
    for (int ai = 0; ai < 2; ++ai)
#pragma unroll
      for (int m = 0; m < 4; ++m) { const size_t row = (size_t)(row0 + ai * 128 + m * 16);
#pragma unroll
        for (int bj = 0; bj < 2; ++bj) { const int col = col0 + bj * 128;
          const u32x4 g = *(const u32x4*)(MG + row * 4096 + col);
          const f32x4 v0 = acc[ai][bj][m][0], v1 = acc[ai][bj][m][1];
          float r[8];
          r[0] = sigmoidf_(lo2f(g[0])) * v0[0]; r[1] = sigmoidf_(hi2f(g[0])) * v0[1]; r[2] = sigmoidf_(lo2f(g[1])) * v0[2]; r[3] = sigmoidf_(hi2f(g[1])) * v0[3];
          r[4] = sigmoidf_(lo2f(g[2])) * v1[0]; r[5] = sigmoidf_(hi2f(g[2])) * v1[1]; r[6] = sigmoidf_(lo2f(g[3])) * v1[2]; r[7] = sigmoidf_(hi2f(g[3])) * v1[3];
          if (SECOND) { const u32x4 t = *(const u32x4*)(T1 + row * 2048 + col);
            r[0] += lo2f(t[0]); r[1] += hi2f(t[0]); r[2] += lo2f(t[1]); r[3] += hi2f(t[1]); r[4] += lo2f(t[2]); r[5] += hi2f(t[2]); r[6] += lo2f(t[3]); r[7] += hi2f(t[3]); }
          u32x4 o; o[0] = pk2(r[0], r[1]); o[1] = pk2(r[2], r[3]); o[2] = pk2(r[4], r[5]); o[3] = pk2(r[6], r[7]);
          *(u32x4*)(T1 + row * 2048 + col) = o; } }
  }
};
struct EpiG4 {
  static constexpr bool PERM = false, AFTER_DRAIN = false;
  const float* xin; const float* cin; float* xout; float* cout; const float* mod;
  DI void operator()(const f32x4 (&acc)[2][2][4][2], const pg8::Unit& u, int wr, int wc, int fr, int fq) const {
    const int row0 = u.pm * 256 + wr * 64 + fr, col0 = u.pn * 256 + wc * 32 + 4 * fq;
#pragma unroll
    for (int ai = 0; ai < 2; ++ai)
#pragma unroll
      for (int m = 0; m < 4; ++m) { const int row = row0 + ai * 128 + m * 16;
        const float* src; float* dst; const float* gate;
        if (row < NLAT) { src = xin + (size_t)row * 2048; dst = xout + (size_t)row * 2048; gate = mod + (row >> 12) * 6144 + 4096; }
        else { src = cin + (size_t)(row - NLAT) * 2048; dst = cout + (size_t)(row - NLAT) * 2048; gate = mod + 4 * 6144 + 4096; }
#pragma unroll
        for (int bj = 0; bj < 2; ++bj)
#pragma unroll
          for (int n = 0; n < 2; ++n) { const int col = col0 + bj * 128 + n * 16;
            const f32x4 xv = *(const f32x4*)(src + col), gv = *(const f32x4*)(gate + col);
            *(f32x4*)(dst + col) = xv + gv * acc[ai][bj][m][n]; } }
  }
};

__device__ void phase_mod(const Params& p, unsigned char* shm) {
  float* sc = (float*)shm; float* red = sc + 5 * 2048;
  const int tid = otid(p.wid);
  for (int i = tid; i < 5 * 2048; i += 512) { const int j = i >> 11, k = i & 2047; const float v = (j < 4) ? p.c[j * 2048 + k] : p.c_ctx[k]; sc[i] = v / (1.f + expf(-v)); }
  __syncthreads();
  float* mod = (float*)(p.ws + OFF_MOD);
  const int cq = tid & 7, ks = tid >> 3;
  for (int it = blockIdx.x; it < 384; it += gridDim.x) {
    const int l = it / 192, nb = (it % 192) * 32;
    const float* W = p.ada_w + (size_t)l * 2048 * 6144 + nb + cq * 4;
    float acc[5][4];
#pragma unroll
    for (int j = 0; j < 5; ++j) { acc[j][0] = 0.f; acc[j][1] = 0.f; acc[j][2] = 0.f; acc[j][3] = 0.f; }
#pragma unroll 4
    for (int kk = 0; kk < 32; ++kk) { const int k = ks * 32 + kk; const float4 w = *(const float4*)(W + (size_t)k * 6144);
#pragma unroll
      for (int j = 0; j < 5; ++j) { const float s = sc[j * 2048 + k]; acc[j][0] += s * w.x; acc[j][1] += s * w.y; acc[j][2] += s * w.z; acc[j][3] += s * w.w; } }
#pragma unroll
    for (int j = 0; j < 5; ++j)
#pragma unroll
      for (int e = 0; e < 4; ++e) red[ks * 160 + j * 32 + cq * 4 + e] = acc[j][e];
    __syncthreads();
    if (tid < 160) { float s = 0.f; for (int q = 0; q < 64; ++q) s += red[q * 160 + tid]; const int j = tid >> 5, n = nb + (tid & 31); mod[(l * 5 + j) * 6144 + n] = s + p.ada_b[l * 6144 + n]; }
    __syncthreads();
  }
}

__device__ void cvt_group(int wid, const float* W, bf16_t* Wt, int K, int N, int k0, int n0, float scale, float* tile) {
  const int tid = otid(wid);
  float4 v[8];
#pragma unroll
  for (int q = 0; q < 4; ++q)
#pragma unroll
    for (int rr = 0; rr < 2; ++rr) { const int k = (tid >> 4) + 32 * rr, n = (tid & 15) * 4; v[q * 2 + rr] = *(const float4*)(W + (size_t)(k0 + q * 64 + k) * N + n0 + n); }
#pragma unroll
  for (int q = 0; q < 4; ++q)
#pragma unroll
    for (int rr = 0; rr < 2; ++rr) { const int k = (tid >> 4) + 32 * rr, n = (tid & 15) * 4; float* t = tile + q * 4160 + k * 65 + n; const float4 x = v[q * 2 + rr]; t[0] = x.x; t[1] = x.y; t[2] = x.z; t[3] = x.w; }
  __syncthreads();
#pragma unroll
  for (int q = 0; q < 4; ++q) { const int n = tid >> 3, k8 = (tid & 7) * 8; const float* t = tile + q * 4160; u32x4 o;
#pragma unroll
    for (int e = 0; e < 4; ++e) o[e] = pk2(t[(k8 + 2 * e) * 65 + n] * scale, t[(k8 + 2 * e + 1) * 65 + n] * scale);
    *(u32x4*)(Wt + (size_t)(n0 + n) * K + k0 + q * 64 + k8) = o; }
  __syncthreads();
}
__device__ void phase_cvt(const Params& p, int l, unsigned char* shm) {
  float* tile = (float*)shm;
  for (int it = blockIdx.x; it < 4096; it += gridDim.x) {
    if (it < 3072) { const int kg = it & 7, n0 = (it >> 3) * 64;
      cvt_group(p.wid, p.w_in + (size_t)l * DM * INW, (bf16_t*)(p.ws + OFF_WTIN), DM, INW, kg * 256, n0, (n0 >= 2048 && n0 < 4096) ? 0.0625f : 1.f, tile); }
    else if (it < 3328) { const int e = it - 3072; cvt_group(p.wid, p.w_hy_out + (size_t)l * DM * DM, (bf16_t*)(p.ws + OFF_WTHY), DM, DM, (e & 7) * 256, (e >> 3) * 64, 1.f, tile); }
    else if (it < 3840) { const int e = it - 3328; cvt_group(p.wid, p.w_ret_out + (size_t)l * 4096 * DM, (bf16_t*)(p.ws + OFF_WTRET), 4096, DM, (e & 15) * 256, (e >> 4) * 64, 1.f, tile); }
    else { const int e = it - 3840; cvt_group(p.wid, p.w_o + (size_t)l * DM * DM, (bf16_t*)(p.ws + OFF_WTO), DM, DM, (e & 7) * 256, (e >> 3) * 64, 1.f, tile); }
  }
}

__device__ void filt_item(const Params& p, int l, int Ls, int T, bool isctx, unsigned char* shm) {
  float* z = (float*)shm; float* ha = z + 17 * 36; float* hb = ha + 17 * 64;
  const int tid = otid(p.wid);
  const float* w1 = p.fw1 + l * 33 * 64; const float* b1 = p.fb1 + l * 64; const float* w2 = p.fw2 + l * 4096; const float* b2 = p.fb2 + l * 64;
  const float* w3 = p.fw3 + l * 4096; const float* b3 = p.fb3 + l * 64; const float* fq = p.ffreq + l * 64; const float* wout = p.fwout + (size_t)l * 64 * 4096;
  for (int i = tid; i < 17 * 33; i += 512) { const int pl = i / 33, f = i % 33; int pp = T * 16 + pl; if (pp > Ls - 1) pp = Ls - 1;
    float val;
    if (f == 0) val = (float)pp / (float)(Ls - 1);
    else { const int j = (f - 1) & 15; const float fj = 1e-4f + (float)j * ((15.f - 1e-4f) / 15.f); const float ang = 6.283185307179586f * (float)pp / (float)Ls; const float a = fj * ang; val = (f <= 16) ? cosf(a) : -sinf(a); }
    z[pl * 36 + f] = val; }
  __syncthreads();
  for (int idx = tid; idx < 17 * 16; idx += 512) { const int pl = idx >> 4, j0 = (idx & 15) * 4; float a[4] = {0.f, 0.f, 0.f, 0.f};
#pragma unroll 3
    for (int k = 0; k < 33; ++k) { const float v = z[pl * 36 + k]; const float4 w = *(const float4*)(w1 + k * 64 + j0); a[0] += v * w.x; a[1] += v * w.y; a[2] += v * w.z; a[3] += v * w.w; }
#pragma unroll
    for (int e = 0; e < 4; ++e) ha[pl * 64 + j0 + e] = sinf(fq[j0 + e] * (a[e] + b1[j0 + e])); }
  __syncthreads();
  for (int idx = tid; idx < 17 * 16; idx += 512) { const int pl = idx >> 4, j0 = (idx & 15) * 4; float a[4] = {0.f, 0.f, 0.f, 0.f};
#pragma unroll 4
    for (int k = 0; k < 64; ++k) { const float v = ha[pl * 64 + k]; const float4 w = *(const float4*)(w2 + k * 64 + j0); a[0] += v * w.x; a[1] += v * w.y; a[2] += v * w.z; a[3] += v * w.w; }
#pragma unroll
    for (int e = 0; e < 4; ++e) hb[pl * 64 + j0 + e] = sinf(fq[j0 + e] * (a[e] + b2[j0 + e])); }
  __syncthreads();
  for (int idx = tid; idx < 17 * 16; idx += 512) { const int pl = idx >> 4, j0 = (idx & 15) * 4; float a[4] = {0.f, 0.f, 0.f, 0.f};
#pragma unroll 4
    for (int k = 0; k < 64; ++k) { const float v = hb[pl * 64 + k]; const float4 w = *(const float4*)(w3 + k * 64 + j0); a[0] += v * w.x; a[1] += v * w.y; a[2] += v * w.z; a[3] += v * w.w; }
#pragma unroll
    for (int e = 0; e < 4; ++e) ha[pl * 64 + j0 + e] = sinf(fq[j0 + e] * (a[e] + b3[j0 + e])); }
  __syncthreads();
  const int c2 = tid * 8; const bool isb = c2 >= 2048; const int cb = c2 & 2047;
  const float mind = logf(0.01f) / 1.5f, maxd = logf(0.01f) / 0.3f;
  bf16_t* G = (bf16_t*)(p.ws + OFF_G + (size_t)l * G_LAYER); float* GC = (float*)(p.ws + OFF_GC);
  for (int pgh = 0; pgh < 4; ++pgh) {
    const int pg = pgh >> 1, c4 = c2 + (pgh & 1) * 4;
    const int plb = pg * 8 + (isb ? 0 : 1);
    float acc[8][4];
#pragma unroll
    for (int e = 0; e < 8; ++e) { acc[e][0] = 0.f; acc[e][1] = 0.f; acc[e][2] = 0.f; acc[e][3] = 0.f; }
#pragma unroll 8
    for (int k = 0; k < 64; ++k) { const float4 wa = *(const float4*)(wout + k * 4096 + c4);
#pragma unroll
      for (int e = 0; e < 8; ++e) { const float h = ha[(plb + e) * 64 + k]; acc[e][0] += h * wa.x; acc[e][1] += h * wa.y; acc[e][2] += h * wa.z; acc[e][3] += h * wa.w; } }
    const int pp0 = T * 16 + plb;
#pragma unroll
    for (int cc = 0; cc < 4; ++cc) { const int c = (c4 & 2047) + cc; const float delta = fabsf(mind + (float)c * ((maxd - mind) / 2047.f));
      float v[8];
#pragma unroll
      for (int e = 0; e < 8; ++e) { const int pp = pp0 + e; v[e] = (pp < Ls) ? acc[e][cc] * __expf(-((float)pp / (float)(Ls - 1)) * delta) : 0.f; }
      if (!isctx) {
        bf16_t* Gc = G + (size_t)c * GLEN;
        if (isb) {
          if (pp0 == 0) { for (int e = 1; e < 8; ++e) Gc[LOFF + e] = f2bf(v[e]); }
          else { u32x4 o; o[0] = pk2(v[0], v[1]); o[1] = pk2(v[2], v[3]); o[2] = pk2(v[4], v[5]); o[3] = pk2(v[6], v[7]); *(u32x4*)(Gc + LOFF + pp0) = o; }
        } else {
          u32x4 o; o[0] = pk2(v[7], v[6]); o[1] = pk2(v[5], v[4]); o[2] = pk2(v[3], v[2]); o[3] = pk2(v[1], v[0]); *(u32x4*)(Gc + LOFF - pp0 - 7) = o;
        }
      } else {
        float* Gc = GC + (size_t)c * 512;
#pragma unroll
        for (int e = 0; e < 8; ++e) { const int pp = pp0 + e; if (isb) { if (pp >= 1 && pp < Ls) Gc[256 - pp] = v[e]; } else { if (pp < Ls) Gc[256 + pp] = v[e]; } }
      }
    }
  }
  if (T == 0 && !isb) {
#pragma unroll 1
    for (int cc = 0; cc < 8; ++cc) { float a = 0.f;
#pragma unroll 4
      for (int k = 0; k < 64; ++k) a += ha[k] * wout[k * 4096 + c2 + cc];
      if (!isctx) G[(size_t)(cb + cc) * GLEN + LOFF] = f2bf(a); else GC[(size_t)(cb + cc) * 512 + 256] = a; }
  }
  __syncthreads();
}
__device__ void phase_filters(const Params& p, unsigned char* shm) {
  for (int it = blockIdx.x; it < 528; it += gridDim.x) { if (it < 512) filt_item(p, it >> 8, SEQ, it & 255, false, shm); else filt_item(p, 0, CTXL, it - 512, true, shm); }
}

__device__ void phase_norm(const Params& p, int l) {
  const int lane = otid(p.wid) & 63, gw = blockIdx.x * 8 + (otid(p.wid) >> 6), nw = gridDim.x * 8;
  const float* mod = (const float*)(p.ws + OFF_MOD) + (size_t)l * 5 * 6144; const float* lng = p.ln_g + l * 2048;
  bf16_t* H = (bf16_t*)(p.ws + OFF_H);
  for (int r = gw; r < MT; r += nw) {
    const float* src; int j;
    if (r < NLAT) { src = (l == 0 ? p.x : p.out) + (size_t)r * 2048; j = r >> 12; }
    else { src = (l == 0 ? p.ctx : (const float*)(p.ws + OFF_CTXR)) + (size_t)(r - NLAT) * 2048; j = 4; }
    const float* sh = mod + j * 6144; const float* sc = sh + 2048;
    float4 v[8]; float ss = 0.f;
#pragma unroll
    for (int i = 0; i < 8; ++i) { v[i] = *(const float4*)(src + i * 256 + lane * 4); ss += v[i].x * v[i].x + v[i].y * v[i].y + v[i].z * v[i].z + v[i].w * v[i].w; }
    ss = wsum(ss, lane);
    const float rs = rsqrtf(ss * (1.f / 2048.f) + 1e-6f);
#pragma unroll
    for (int i = 0; i < 8; ++i) { const int col = i * 256 + lane * 4; const float4 g = *(const float4*)(lng + col), a = *(const float4*)(sc + col), b = *(const float4*)(sh + col);
      u32x2 o; o[0] = pk2(v[i].x * rs * g.x * (1.f + a.x) + b.x, v[i].y * rs * g.y * (1.f + a.y) + b.y); o[1] = pk2(v[i].z * rs * g.z * (1.f + a.z) + b.z, v[i].w * rs * g.w * (1.f + a.w) + b.w);
      *(u32x2*)(H + (size_t)r * 2048 + col) = o; }
  }
}
__device__ void phase_final(const Params& p) {
  const int lane = otid(p.wid) & 63, gw = blockIdx.x * 8 + (otid(p.wid) >> 6), nw = gridDim.x * 8;
  for (int r = gw; r < NLAT; r += nw) {
    float* src = p.out + (size_t)r * 2048; float4 v[8]; float ss = 0.f;
#pragma unroll
    for (int i = 0; i < 8; ++i) { v[i] = *(const float4*)(src + i * 256 + lane * 4); ss += v[i].x * v[i].x + v[i].y * v[i].y + v[i].z * v[i].z + v[i].w * v[i].w; }
    ss = wsum(ss, lane);
    const float rs = rsqrtf(ss * (1.f / 2048.f) + 1e-6f);
#pragma unroll
    for (int i = 0; i < 8; ++i) { const int col = i * 256 + lane * 4; const float4 g = *(const float4*)(p.final_g + col); float4 o; o.x = v[i].x * rs * g.x; o.y = v[i].y * rs * g.y; o.z = v[i].z * rs * g.z; o.w = v[i].w * rs * g.w; *(float4*)(src + col) = o; }
  }
}

DI void tok_tile(int tk, int& b, int& t0, bool& isctx) { if (tk < 256) { b = tk >> 6; t0 = (tk & 63) * 64; isctx = false; } else { b = (tk - 256) >> 2; t0 = ((tk - 256) & 3) * 64; isctx = true; } }
DI int tok_row(int b, int t, bool isctx) { return isctx ? NLAT + b * CTXL + t : b * SEQ + t; }

__device__ void phase_prep(const Params& p, int l, unsigned char* shm, int mask) {
  const int tid = otid(p.wid), lane = tid & 63;
  float2* cs = (float2*)shm;
  unsigned char* reg2 = shm + 32768;
  for (int i = tid; i < 4096; i += 512) { const int pos = i >> 6, j = i & 63; const float inv = 1.f / powf(10000.f, (float)j / 64.f); float s, c; sincosf((float)pos * inv, &s, &c); cs[i] = make_float2(c, s); }
  __syncthreads();
  if (mask & 1) { bf16_t* PQ = (bf16_t*)(p.ws + OFF_PQ); const int gw = blockIdx.x * 8 + (tid >> 6), nw = gridDim.x * 8;
#pragma unroll 2
    for (int r = gw; r < NLAT; r += nw) { const int t = r & 4095, rp = t >> 6, cp = t & 63; bf16_t* row = PQ + (size_t)r * 2048;
#pragma unroll
      for (int e = 0; e < 2; ++e) { const int cmb = lane + 64 * e, hh = cmb >> 4, hf = (cmb >> 3) & 1, j8 = (cmb & 7) * 8; bf16_t* q = row + hh * 256 + hf * 128 + j8;
        const u32x4 a = *(const u32x4*)q, bq = *(const u32x4*)(q + 64); const float2* cp2 = cs + (hf ? cp : rp) * 64 + j8; u32x4 oa, ob;
#pragma unroll
        for (int w = 0; w < 4; ++w) { const float2 v0 = cp2[2 * w], v1 = cp2[2 * w + 1]; const float p10 = lo2f(a[w]), p11 = hi2f(a[w]), p20 = lo2f(bq[w]), p21 = hi2f(bq[w]);
          oa[w] = pk2(p10 * v0.x - p20 * v0.y, p11 * v1.x - p21 * v1.y); ob[w] = pk2(p10 * v0.y + p20 * v0.x, p11 * v1.y + p21 * v1.x); }
        *(u32x4*)q = oa; *(u32x4*)(q + 64) = ob; } } }
  if (mask & 2) { unsigned* tl = (unsigned*)reg2;
    bf16_t* tls = (bf16_t*)reg2;
    u32x4 pre[4];
#define PB_DECODE(it_) const int tk = (it_) / 24, sub = (it_) % 24; int b, t0; bool isctx; tok_tile(tk, b, t0, isctx); \
      bf16_t* src; int ld, co; bf16_t* dst; const bool isk = sub < 8; \
      if (isk) { src = (bf16_t*)(p.ws + OFF_PK); ld = 2048; co = sub * 256; dst = (bf16_t*)(p.ws + OFF_KT) + (size_t)((b * 8 + sub) * 256) * TT; } \
      else { const int hh = (sub - 8) >> 1, hf = (sub - 8) & 1; src = (bf16_t*)(p.ws + OFF_PV); ld = 4096; co = hh * 512 + hf * 256; dst = (bf16_t*)(p.ws + OFF_VT) + (size_t)((b * 8 + hh) * 512 + hf * 256) * TT; } \
      const int row0 = tok_row(b, t0, isctx), tt0 = isctx ? t0 : CTXL + t0;
#define PB_LOAD(it_) do { PB_DECODE(it_) (void)dst; (void)tt0; _Pragma("unroll") for (int e = 0; e < 4; ++e) { const int id = tid + 512 * e, row = id >> 5, pc = id & 31; pre[e] = *(const u32x4*)(src + (size_t)(row0 + row) * ld + co + pc * 8); } } while (0)
    const int nit = 272 * 24;
    if ((int)blockIdx.x < nit) PB_LOAD((int)blockIdx.x);
    for (int it = blockIdx.x; it < nit; it += gridDim.x) {
      PB_DECODE(it)
#pragma unroll
      for (int e = 0; e < 4; ++e) { const int id = tid + 512 * e, row = id >> 5, pc = id & 31; unsigned* d = tl + row * 129 + pc * 4; d[0] = pre[e][0]; d[1] = pre[e][1]; d[2] = pre[e][2]; d[3] = pre[e][3]; }
      if (it + (int)gridDim.x < nit) PB_LOAD(it + (int)gridDim.x);
      __syncthreads();
      if (isk && !isctx) {
#pragma unroll 4
        for (int e = 0; e < 16; ++e) { const int id = tid + 512 * e, tok = id >> 7, pr = id & 127, hf = pr >> 6, j = pr & 63; const int t = t0 + tok;
          const float2 v = cs[(hf ? (t & 63) : (t >> 6)) * 64 + j]; bf16_t* q = tls + tok * 258 + hf * 128 + j;
          const float p1 = bf2f(q[0]), p2 = bf2f(q[64]); q[0] = f2bf(p1 * v.x - p2 * v.y); q[64] = f2bf(p1 * v.y + p2 * v.x); }
        __syncthreads();
#pragma unroll
        for (int e = 0; e < 4; ++e) { const int id = tid + 512 * e, row = id >> 5, pc = id & 31; const unsigned* d = tl + row * 129 + pc * 4; u32x4 v; v[0] = d[0]; v[1] = d[1]; v[2] = d[2]; v[3] = d[3];
          *(u32x4*)(src + (size_t)(row0 + row) * ld + co + pc * 8) = v; }
      }
      { const int d2 = tid & 127, tg = (tid >> 7) * 16; unsigned w[16];
#pragma unroll
        for (int e = 0; e < 16; ++e) w[e] = tl[(tg + e) * 129 + d2];
#pragma unroll
        for (int q = 0; q < 2; ++q) { u32x4 o0, o1;
#pragma unroll
          for (int e = 0; e < 4; ++e) { const unsigned x = w[q * 8 + 2 * e], y = w[q * 8 + 2 * e + 1]; o0[e] = (x & 0xffffu) | (y << 16); o1[e] = (x >> 16) | (y & 0xffff0000u); }
          *(u32x4*)(dst + (size_t)(2 * d2) * TT + tt0 + tg + q * 8) = o0; *(u32x4*)(dst + (size_t)(2 * d2 + 1) * TT + tt0 + tg + q * 8) = o1; } }
      __syncthreads();
    }
#undef PB_DECODE
#undef PB_LOAD
  }
  if (mask & 4) { float* in = (float*)reg2;
    bf16_t* ut = (bf16_t*)(reg2 + 3 * 66 * 64 * 4);
    const bf16_t* PHY = (const bf16_t*)(p.ws + OFF_PHY); bf16_t* HV = (bf16_t*)(p.ws + OFF_HV); bf16_t* HX0 = (bf16_t*)(p.ws + OFF_HX0);
    const float* cw = p.conv_w + (size_t)l * 3 * 6144; const float* cb = p.conv_b + (size_t)l * 6144;
    const int nit = ((l == 0) ? 272 : 256) * 32;
    u32x4 pre[4];
#define PC_DECODE(it_) const int tk = (it_) >> 5, c0 = ((it_) & 31) * 64; int b, t0; bool isctx; tok_tile(tk, b, t0, isctx); const int Ls = isctx ? CTXL : SEQ; const int row0 = tok_row(b, t0, isctx);
#define PC_LOAD(it_) do { PC_DECODE(it_) _Pragma("unroll") for (int e = 0; e < 4; ++e) { const int id = tid + 512 * e; const int pi = id / 528, rem = id % 528, rr = rem >> 3, pc = rem & 7; const int t = t0 - 1 + rr; \
        u32x4 v; v[0] = 0u; v[1] = 0u; v[2] = 0u; v[3] = 0u; if (id < 1584 && t >= 0 && t < Ls) v = *(const u32x4*)(PHY + (size_t)(row0 - 1 + rr) * 6144 + pi * 2048 + c0 + pc * 8); pre[e] = v; } } while (0)
    if ((int)blockIdx.x < nit) PC_LOAD((int)blockIdx.x);
    for (int it = blockIdx.x; it < nit; it += gridDim.x) {
      PC_DECODE(it) (void)Ls;
#pragma unroll
      for (int e = 0; e < 4; ++e) { const int id = tid + 512 * e; if (id < 1584) { const int pi = id / 528, rem = id % 528, rr = rem >> 3, pc = rem & 7; const u32x4 v = pre[e];
        float* d = in + (pi * 66 + rr) * 64 + pc * 8;
        *(float4*)d = make_float4(lo2f(v[0]), hi2f(v[0]), lo2f(v[1]), hi2f(v[1])); *(float4*)(d + 4) = make_float4(lo2f(v[2]), hi2f(v[2]), lo2f(v[3]), hi2f(v[3])); } }
      if (it + (int)gridDim.x < nit) PC_LOAD(it + (int)gridDim.x);
      __syncthreads();
      { const int cg8 = (tid & 7) * 8, tok = tid >> 3;
        float cv[3][8];
#pragma unroll
        for (int pi = 0; pi < 3; ++pi) { const float* wp = cw + pi * 2048 + c0 + cg8;
          const float4 ba = *(const float4*)(cb + pi * 2048 + c0 + cg8), bb = *(const float4*)(cb + pi * 2048 + c0 + cg8 + 4);
          cv[pi][0] = ba.x; cv[pi][1] = ba.y; cv[pi][2] = ba.z; cv[pi][3] = ba.w; cv[pi][4] = bb.x; cv[pi][5] = bb.y; cv[pi][6] = bb.z; cv[pi][7] = bb.w;
#pragma unroll
          for (int k = 0; k < 3; ++k) { const float4 wa = *(const float4*)(wp + k * 6144), wb = *(const float4*)(wp + k * 6144 + 4);
            const float* ip = in + (pi * 66 + tok + k) * 64 + cg8; const float4 xa = *(const float4*)ip, xb = *(const float4*)(ip + 4);
            cv[pi][0] += xa.x * wa.x; cv[pi][1] += xa.y * wa.y; cv[pi][2] += xa.z * wa.z; cv[pi][3] += xa.w * wa.w; cv[pi][4] += xb.x * wb.x; cv[pi][5] += xb.y * wb.y; cv[pi][6] += xb.z * wb.z; cv[pi][7] += xb.w * wb.w; } }
        u32x4 hvp, hxp;
#pragma unroll
        for (int e = 0; e < 4; ++e) { hvp[e] = pk2(cv[0][2 * e] * cv[2][2 * e], cv[0][2 * e + 1] * cv[2][2 * e + 1]); hxp[e] = pk2(cv[1][2 * e], cv[1][2 * e + 1]); }
        *(u32x4*)(HV + (size_t)(row0 + tok) * 2048 + c0 + cg8) = hvp; *(u32x4*)(HX0 + (size_t)(row0 + tok) * 2048 + c0 + cg8) = hxp;
#pragma unroll
        for (int e = 0; e < 4; ++e) { ut[(cg8 + 2 * e) * 66 + tok] = (bf16_t)(hvp[e] & 0xffffu); ut[(cg8 + 2 * e + 1) * 66 + tok] = (bf16_t)(hvp[e] >> 16); } }
      __syncthreads();
      { const int c = tid >> 3, pc = tid & 7; u32x4 o;
#pragma unroll
        for (int e = 0; e < 4; ++e) o[e] = (unsigned)ut[c * 66 + pc * 8 + 2 * e] | ((unsigned)ut[c * 66 + pc * 8 + 2 * e + 1] << 16);
        bf16_t* dst = isctx ? (bf16_t*)(p.ws + OFF_UTC) + ((size_t)(c0 + c) * NB + b) * CTXL + t0 + pc * 8 : (bf16_t*)(p.ws + OFF_UT) + ((size_t)(c0 + c) * NB + b) * SEQ + t0 + pc * 8;
        *(u32x4*)dst = o; }
    }
    __syncthreads();
#undef PC_DECODE
#undef PC_LOAD
  }
}

__device__ void phase_post(const Params& p, int l, unsigned char* shm, int mask) {
  const int tid = otid(p.wid), lane = tid & 63;
  const bf16_t* HV = (const bf16_t*)(p.ws + OFF_HV); const bf16_t* HX0 = (const bf16_t*)(p.ws + OFF_HX0); const bf16_t* PHG = (const bf16_t*)(p.ws + OFF_PHG);
  bf16_t* AH = (bf16_t*)(p.ws + OFF_H); const float* hbias = p.hy_bias + l * 2048;
  if (mask & 1) { float* yt = (float*)shm;
    const bf16_t* UT = (const bf16_t*)(p.ws + OFF_UT);
    const int nit = 256 * 32; u32x4 pre;
#define PA_LOAD(it_) do { const int tk_ = (it_) >> 5, c0_ = ((it_) & 31) * 64, b_ = tk_ >> 6, t0_ = (tk_ & 63) * 64; pre = *(const u32x4*)(UT + ((size_t)(c0_ + (tid >> 3)) * NB + b_) * SEQ + t0_ + (tid & 7) * 8); } while (0)
    if ((int)blockIdx.x < nit) PA_LOAD((int)blockIdx.x);
    for (int it = blockIdx.x; it < nit; it += gridDim.x) {
      const int tk = it >> 5, c0 = (it & 31) * 64, b = tk >> 6, t0 = (tk & 63) * 64, row0 = b * SEQ + t0;
      { const int c = tid >> 3, pc = tid & 7; const u32x4 v = pre; float* d = yt + (pc * 8) * 65 + c;
        d[0] = lo2f(v[0]); d[65] = hi2f(v[0]); d[130] = lo2f(v[1]); d[195] = hi2f(v[1]); d[260] = lo2f(v[2]); d[325] = hi2f(v[2]); d[390] = lo2f(v[3]); d[455] = hi2f(v[3]); }
      if (it + (int)gridDim.x < nit) PA_LOAD(it + (int)gridDim.x);
      __syncthreads();
      { const int cg8 = (tid & 7) * 8, tok = tid >> 3; const size_t o = (size_t)(row0 + tok) * 2048 + c0 + cg8;
        const u32x4 hv = *(const u32x4*)(HV + o), hx = *(const u32x4*)(HX0 + o), hg = *(const u32x4*)(PHG + o);
        const float4 ba = *(const float4*)(hbias + c0 + cg8), bb = *(const float4*)(hbias + c0 + cg8 + 4);
        const float hb[8] = {ba.x, ba.y, ba.z, ba.w, bb.x, bb.y, bb.z, bb.w}; const float* yp = yt + tok * 65 + cg8; u32x4 r;
#pragma unroll
        for (int e = 0; e < 4; ++e) { const float a0 = (yp[2 * e] + hb[2 * e] * lo2f(hv[e])) * lo2f(hx[e]) * siluf_(lo2f(hg[e])), a1 = (yp[2 * e + 1] + hb[2 * e + 1] * hi2f(hv[e])) * hi2f(hx[e]) * siluf_(hi2f(hg[e])); r[e] = pk2(a0, a1); }
        *(u32x4*)(AH + o) = r; }
      __syncthreads();
    }
#undef PA_LOAD
  }
  if (l == 0 && (mask & 2)) { float* gc = (float*)shm; float* us = gc + 32 * 512;
    const bf16_t* UTC = (const bf16_t*)(p.ws + OFF_UTC); const float* GC = (const float*)(p.ws + OFF_GC);
    for (int it = blockIdx.x; it < 16 * 64; it += gridDim.x) {
      const int tk = it >> 6, c0 = (it & 63) * 32, b = tk >> 2, t0 = (tk & 3) * 64, row0 = NLAT + b * CTXL + t0;
#pragma unroll 8
      for (int i = tid; i < 32 * 512; i += 512) gc[i] = GC[(size_t)(c0 + (i >> 9)) * 512 + (i & 511)];
#pragma unroll 8
      for (int i = tid; i < 32 * 256; i += 512) us[i] = bf2f(UTC[((size_t)(c0 + (i >> 8)) * NB + b) * CTXL + (i & 255)]);
      __syncthreads();
      { const int t = tid & 63, cg4 = tid >> 6;
#pragma unroll 1
        for (int e = 0; e < 4; ++e) { const int c = cg4 * 4 + e; const float* g = gc + c * 512 + 256 + t0 + t; const float* u = us + c * 256; float a = 0.f;
#pragma unroll 8
          for (int s = 0; s < 256; ++s) a += u[s] * g[-s];
          const size_t o = (size_t)(row0 + t) * 2048 + c0 + c; const float hv = bf2f(HV[o]);
          AH[o] = f2bf((a + hbias[c0 + c] * hv) * bf2f(HX0[o]) * siluf_(bf2f(PHG[o]))); } }
      __syncthreads();
    }
  }
  if (mask & 4) { bf16_t* OF = (bf16_t*)(p.ws + OFF_OF); const bf16_t* OB = (const bf16_t*)(p.ws + OFF_OB); const bf16_t* RG = (const bf16_t*)(p.ws + OFF_PRG);
    const int gw = blockIdx.x * 8 + (tid >> 6), nw = gridDim.x * 8; const int nrows = (l == 0) ? MT : NLAT;
#pragma unroll 2
    for (int it = gw; it < nrows * 8; it += nw) { const size_t o = (size_t)(it >> 3) * 4096 + (it & 7) * 512 + lane * 8;
      const u32x4 a = *(const u32x4*)(OF + o), bq = *(const u32x4*)(OB + o), g = *(const u32x4*)(RG + o);
      float v[8]; float ss = 0.f;
#pragma unroll
      for (int e = 0; e < 4; ++e) { v[2 * e] = lo2f(a[e]) + lo2f(bq[e]); v[2 * e + 1] = hi2f(a[e]) + hi2f(bq[e]); ss += v[2 * e] * v[2 * e] + v[2 * e + 1] * v[2 * e + 1]; }
      ss = wsum(ss, lane);
      const float rs = rsqrtf(ss * (1.f / 512.f) + 1e-6f);
      u32x4 r;
#pragma unroll
      for (int e = 0; e < 4; ++e) r[e] = pk2(v[2 * e] * rs * siluf_(lo2f(g[e])), v[2 * e + 1] * rs * siluf_(hi2f(g[e])));
      *(u32x4*)(OF + o) = r; }
  }
}

__device__ void phase_conv(const Params& p, int l, unsigned char* shm) {
  const int tid = otid(p.wid), lane = tid & 63, wid = tid >> 6;
  bf16_t* Gs = (bf16_t*)shm;
  bf16_t* Us = (bf16_t*)(shm + 2 * GLEN * 2);
  { unsigned zz = 0u; asm volatile("" : "+v"(zz)); u32x4 z; z[0] = zz; z[1] = zz; z[2] = zz; z[3] = zz; for (int i = tid; i < 2 * 4 * USTR / 8; i += 512) ((u32x4*)Us)[i] = z; }
  __syncthreads();
  const int ch = wid >> 2, q = wid & 3, i = lane & 31, g = lane >> 5, a_l = i >> 2, b = i & 3;
  const bf16_t* G = (const bf16_t*)(p.ws + OFF_G + (size_t)l * G_LAYER); bf16_t* UT = (bf16_t*)(p.ws + OFF_UT);
  const int mb = LOFF - i + 8 * g - 128 * (8 * q + 7);
  const unsigned sh = (unsigned)(mb & 1) * 16u;
  const unsigned* Gd = (const unsigned*)(Gs + ch * GLEN) + (mb >> 1);
  const bf16_t* Ub = Us + (ch * 4 + b) * USTR + 136 * (a_l + 1) + 8 * g;
#define CONV_LDFRAG(dst, n) do { const unsigned* q_ = Gd + 8 * (n); const unsigned d0 = q_[0], d1 = q_[1], d2 = q_[2], d3 = q_[3], d4 = q_[4]; u32x4 r_; \
    r_[0] = __builtin_amdgcn_alignbit(d1, d0, sh); r_[1] = __builtin_amdgcn_alignbit(d2, d1, sh); r_[2] = __builtin_amdgcn_alignbit(d3, d2, sh); r_[3] = __builtin_amdgcn_alignbit(d4, d3, sh); \
    dst = __builtin_bit_cast(bf16x8, r_); } while (0)
  for (int pr = blockIdx.x; pr < 1024; pr += gridDim.x) {
    for (int id = tid; id < 2 * (GLEN / 2); id += 512) { const int cc = id / (GLEN / 2), dw = id % (GLEN / 2);
      unsigned v = ((const unsigned*)(G + (size_t)(pr * 2 + cc) * GLEN))[dw]; const int m = dw * 2;
      if (m < 33 || m > 8223) v &= 0xffff0000u; if (m + 1 < 33 || m + 1 > 8223) v &= 0x0000ffffu;
      ((unsigned*)Gs)[cc * (GLEN / 2) + dw] = v; }
    for (int id = tid; id < 2 * 4 * 512; id += 512) { const int cc = id >> 11, bb = (id >> 9) & 3, s8 = id & 511;
      const u32x4 v = *(const u32x4*)(UT + ((size_t)(pr * 2 + cc) * 4 + bb) * SEQ + s8 * 8); const int sp = 1024 + s8 * 8;
      *(u32x4*)(Us + (cc * 4 + bb) * USTR + sp + 8 * (sp >> 7)) = v; }
    __syncthreads();
    bf16x8 W[8]; f32x16 acc[4];
#pragma unroll
    for (int h = 0; h < 4; ++h)
#pragma unroll
      for (int e = 0; e < 16; ++e) acc[h][e] = 0.f;
    CONV_LDFRAG(W[2], -6); CONV_LDFRAG(W[3], -5); CONV_LDFRAG(W[4], -4); CONV_LDFRAG(W[5], -3); CONV_LDFRAG(W[6], -2); CONV_LDFRAG(W[7], -1);
#pragma unroll 1
    for (int it = 0; it < 39; ++it) {
#pragma unroll
      for (int u = 0; u < 8; ++u) {
        CONV_LDFRAG(W[u], it * 8 + u);
        const bf16x8 bf = *(const bf16x8*)(Ub + 136 * it + 16 * u);
#pragma unroll
        for (int h = 0; h < 4; ++h) acc[h] = __builtin_amdgcn_mfma_f32_32x32x16_bf16(W[(u - 2 * h) & 7], bf, acc[h], 0, 0, 0);
      }
    }
    { bf16_t* yrow = UT + ((size_t)(pr * 2 + ch) * 4 + b) * SEQ + 128 * (8 * q + a_l) + 4 * g;
#pragma unroll
      for (int h = 0; h < 4; ++h)
#pragma unroll
        for (int rq = 0; rq < 4; ++rq) { u32x2 o; o[0] = pk2(acc[h][4 * rq], acc[h][4 * rq + 1]); o[1] = pk2(acc[h][4 * rq + 2], acc[h][4 * rq + 3]); *(u32x2*)(yrow + 32 * h + 8 * rq) = o; } }
    __syncthreads();
  }
#undef CONV_LDFRAG
}

template <int KD> DI f32x16 mma_tile(f32x16 acc, const bf16_t* A, int lda, const bf16_t* B, int ldb, int lane) {
  const int r = lane & 31, g8 = (lane >> 5) * 8; const bf16_t* ap = A + r * lda + g8; const bf16_t* bp = B + r * ldb + g8;
#pragma unroll 4
  for (int k0 = 0; k0 < KD; k0 += 16) acc = __builtin_amdgcn_mfma_f32_32x32x16_bf16(*(const bf16x8*)(ap + k0), *(const bf16x8*)(bp + k0), acc, 0, 0, 0);
  return acc;
}
__device__ void phase_ret(const Params& p, int l, unsigned char* shm) {
  constexpr int QS = 264, TS = 72;
  const int tid = otid(p.wid), lane = tid & 63, wid = tid >> 6, g = lane >> 5;
  bf16_t* Qs = (bf16_t*)shm; bf16_t* Ks = Qs + 64 * QS; bf16_t* Kts = Ks + 64 * QS; bf16_t* Vts = Kts + 256 * TS; bf16_t* Ps = Vts + 64 * TS; bf16_t* Sts = Ps + 64 * TS;
  const bf16_t* PQ = (const bf16_t*)(p.ws + OFF_PQ); const bf16_t* PK = (const bf16_t*)(p.ws + OFF_PK);
  const bf16_t* KT = (const bf16_t*)(p.ws + OFF_KT); const bf16_t* VT = (const bf16_t*)(p.ws + OFF_VT);
  for (int it0 = blockIdx.x; it0 < 512; it0 += gridDim.x) {
    int it = it0;
    if (gridDim.x == 256) { const int xcd = it0 & 7, idx = (it0 >> 3) & 31, r = it0 >> 8; it = ((xcd + 8 * ((idx >> 3) + 4 * r)) << 3) | (idx & 7); }
    const int sl = it & 7, dir = (it >> 3) & 1, h = (it >> 4) & 7, b = it >> 7;
    const float lg = -expf(p.ret_decay[(l * 2 + dir) * 8 + h]);
    bf16_t* O = (bf16_t*)(p.ws + (dir ? OFF_OB : OFF_OF));
    for (int i = tid; i < 64 * QS / 2; i += 512) ((unsigned*)Sts)[i] = 0u;
    f32x16 S[4], cross;
#pragma unroll
    for (int x = 0; x < 4; ++x)
#pragma unroll
      for (int e = 0; e < 16; ++e) S[x][e] = 0.f;
#pragma unroll
    for (int e = 0; e < 16; ++e) cross[e] = 0.f;
    const float cd = __expf(lg * 64.f);
    const int tid2 = otid(p.wid), ln2 = tid2 & 63, g2 = ln2 >> 5;
    const int pc8 = tid2 & 7;
    float dk[8], mk[16];
#pragma unroll
    for (int w = 0; w < 8; ++w) { const int tok = pc8 * 8 + w; dk[w] = __expf(lg * (float)(dir ? tok : 63 - tok)); }
    const int wq = (tid2 >> 6) & 3, t_hi = wq >> 1, t_lo = wq & 1;
    { const int i = t_lo * 32 + (ln2 & 31);
#pragma unroll
      for (int e = 0; e < 16; ++e) { const int j = t_hi * 32 + (e & 3) + 8 * (e >> 2) + 4 * g2; const int diff = dir ? (j - i) : (i - j); mk[e] = diff >= 0 ? __expf(lg * (float)diff) : 0.f; } }
    const int qi = t_hi * 32 + (ln2 & 31);
    const float qd = __expf(lg * (float)(dir ? 64 - qi : qi + 1));
    u32x4 rq[4], rk[4], rt[4], rv;
    const unsigned qo_l = (unsigned)(tid >> 5) * 2048u + (unsigned)(h * 256 + (tid & 31) * 8);
    const unsigned ko_l = (unsigned)((b * 8 + h) * 256 + (tid >> 3)) * (unsigned)TT + (unsigned)(pc8 * 8);
    const unsigned vo_l = (unsigned)((b * 8 + h) * 512 + sl * 64 + (tid >> 3)) * (unsigned)TT + (unsigned)(pc8 * 8);
#define RET_CHUNK(step_, isctx_, t0_) do { if ((step_) < 4) { isctx_ = true; t0_ = (dir ? 3 - (step_) : (step_)) * 64; } else { isctx_ = false; const int cn_ = (step_) - 4; t0_ = (dir ? 63 - cn_ : cn_) * 64; } } while (0)
#define RET_LOAD(step_) do { bool ic_; int t0n_; RET_CHUNK(step_, ic_, t0n_); const unsigned r0_ = (unsigned)tok_row(b, t0n_, ic_) * 2048u + qo_l; const unsigned tt_ = (unsigned)(ic_ ? t0n_ : CTXL + t0n_); \
      _Pragma("unroll") for (int e = 0; e < 4; ++e) { rq[e] = *(const u32x4*)(PQ + (r0_ + (unsigned)e * 32768u)); rk[e] = *(const u32x4*)(PK + (r0_ + (unsigned)e * 32768u)); rt[e] = *(const u32x4*)(KT + (ko_l + tt_ + (unsigned)e * (unsigned)(64 * TT))); } \
      rv = *(const u32x4*)(VT + (vo_l + tt_)); } while (0)
    RET_LOAD(0);
#pragma unroll 1
    for (int step = 0; step < 68; ++step) {
      bool isctx; int t0; RET_CHUNK(step, isctx, t0);
      const int row0 = tok_row(b, t0, isctx);
      __syncthreads();
#pragma unroll
      for (int e = 0; e < 4; ++e) { const int row = (tid >> 5) + 16 * e, pc = tid & 31;
        *(u32x4*)(Qs + row * QS + pc * 8) = rq[e]; *(u32x4*)(Ks + row * QS + pc * 8) = rk[e];
        u32x4 o;
#pragma unroll
        for (int w = 0; w < 4; ++w) o[w] = pk2(lo2f(rt[e][w]) * dk[2 * w], hi2f(rt[e][w]) * dk[2 * w + 1]);
        *(u32x4*)(Kts + ((tid >> 3) + 64 * e) * TS + pc8 * 8) = o; }
      *(u32x4*)(Vts + (tid >> 3) * TS + pc8 * 8) = rv;
      if (step + 1 < 68) RET_LOAD(step + 1);
      __syncthreads();
      if (wid < 4) {
        f32x16 sc;
#pragma unroll
        for (int e = 0; e < 16; ++e) sc[e] = 0.f;
        sc = mma_tile<256>(sc, Ks + t_hi * 32 * QS, QS, Qs + t_lo * 32 * QS, QS, lane);
        const int i = t_lo * 32 + (lane & 31);
#pragma unroll
        for (int r4 = 0; r4 < 4; ++r4) { u32x2 o; o[0] = pk2(sc[4 * r4] * mk[4 * r4], sc[4 * r4 + 1] * mk[4 * r4 + 1]); o[1] = pk2(sc[4 * r4 + 2] * mk[4 * r4 + 2], sc[4 * r4 + 3] * mk[4 * r4 + 3]);
          *(u32x2*)(Ps + i * TS + t_hi * 32 + 8 * r4 + 4 * g) = o; }
      } else {
#pragma unroll
        for (int e = 0; e < 16; ++e) cross[e] = 0.f;
        cross = mma_tile<256>(cross, Sts + t_lo * 32 * QS, QS, Qs + t_hi * 32 * QS, QS, lane);
      }
      __syncthreads();
      if (wid < 4) {
#pragma unroll
        for (int x = 0; x < 4; ++x) { const int td = 2 * wid + (x >> 1), tc = x & 1;
#pragma unroll
          for (int e = 0; e < 16; ++e) S[x][e] *= cd;
          S[x] = mma_tile<64>(S[x], Kts + td * 32 * TS, TS, Vts + tc * 32 * TS, TS, lane);
          const int c = tc * 32 + (lane & 31);
#pragma unroll
          for (int r4 = 0; r4 < 4; ++r4) { u32x2 o; o[0] = pk2(S[x][4 * r4], S[x][4 * r4 + 1]); o[1] = pk2(S[x][4 * r4 + 2], S[x][4 * r4 + 3]); *(u32x2*)(Sts + c * QS + td * 32 + 8 * r4 + 4 * g) = o; } }
      } else {
        f32x16 in_;
#pragma unroll
        for (int e = 0; e < 16; ++e) in_[e] = 0.f;
        in_ = mma_tile<64>(in_, Vts + t_lo * 32 * TS, TS, Ps + t_hi * 32 * TS, TS, lane);
        const unsigned ob = (unsigned)(row0 + qi) * 4096u + (unsigned)(h * 512 + sl * 64 + t_lo * 32 + 4 * g);
#pragma unroll
        for (int r4 = 0; r4 < 4; ++r4) { u32x2 o; o[0] = pk2(in_[4 * r4] + qd * cross[4 * r4], in_[4 * r4 + 1] + qd * cross[4 * r4 + 1]); o[1] = pk2(in_[4 * r4 + 2] + qd * cross[4 * r4 + 2], in_[4 * r4 + 3] + qd * cross[4 * r4 + 3]);
          *(u32x2*)(O + (ob + (unsigned)(8 * r4))) = o; }
      }
    }
    __syncthreads();
  }
#undef RET_CHUNK
#undef RET_LOAD
}

__global__ void __launch_bounds__(512, 2) mega(Params p_in) {
  Params p = p_in; p.wid = __builtin_amdgcn_readfirstlane((int)(threadIdx.x >> 6));
  extern __shared__ __attribute__((aligned(16))) unsigned char shm[];
  cg::grid_group grid = cg::this_grid();
  PG8_LAS unsigned char* lds = (PG8_LAS unsigned char*)shm;
  const bf16_t* H = (const bf16_t*)(p.ws + OFF_H);
#pragma unroll 1
  for (int rep = 0; rep < (PROBE == 1 ? 2 : 1); ++rep) { phase_filters(p, shm); phase_mod(p, shm); }
  grid.sync();
  for (int l = 0; l < 2; ++l) {
#pragma unroll 1
    for (int rep = 0; rep < (PROBE == 1 ? 2 : 1); ++rep) { phase_cvt(p, l, shm); phase_norm(p, l); }
    grid.sync();
    { pg8::Gemm g; g.wid = p.wid; g.A = H; g.Bt = (const bf16_t*)(p.ws + OFF_WTIN); g.M = MT; g.N = INW; g.K = DM;
      pg8::Order S; S.init(64, 96, (int)gridDim.x, (int)blockIdx.x, 4, l == 0 ? 96 : 24, l == 0 ? 0 : 8);
      EpiG1 E; E.ws = p.ws; pg8::gemm_phase<EpiG1, pg8::Order>(lds, g, S, E); }
    grid.sync();
#pragma unroll 1
    for (int rep = 0; rep < (PROBE == 2 ? 2 : 1); ++rep) phase_prep(p, l, shm, rep ? 4 : 7);
    grid.sync();
    phase_conv(p, l, shm); phase_ret(p, l, shm);
    grid.sync();
#pragma unroll 1
    for (int rep = 0; rep < (PROBE == 2 ? 2 : 1); ++rep) phase_post(p, l, shm, rep ? 3 : 7);
    grid.sync();
    { const int nM = (l == 0) ? 68 : 64;
      pg8::Order S; S.init(nM, 8, (int)gridDim.x, (int)blockIdx.x, 0, 0, 0);
      { pg8::Gemm g; g.wid = p.wid; g.A = H; g.Bt = (const bf16_t*)(p.ws + OFF_WTHY); g.M = nM * 256; g.N = DM; g.K = DM; EpiG23<0> E; E.ws = p.ws; pg8::gemm_phase<EpiG23<0>, pg8::Order>(lds, g, S, E); }
      { pg8::Gemm g; g.wid = p.wid; g.A = (const bf16_t*)(p.ws + OFF_OF); g.Bt = (const bf16_t*)(p.ws + OFF_WTRET); g.M = nM * 256; g.N = DM; g.K = 4096; EpiG23<1> E; E.ws = p.ws; pg8::gemm_phase<EpiG23<1>, pg8::Order>(lds, g, S, E); }
      grid.sync();
      { pg8::Gemm g; g.wid = p.wid; g.A = (const bf16_t*)(p.ws + OFF_T1); g.Bt = (const bf16_t*)(p.ws + OFF_WTO); g.M = nM * 256; g.N = DM; g.K = DM;
        EpiG4 E; E.xin = (l == 0) ? p.x : p.out; E.cin = p.ctx; E.xout = p.out; E.cout = (float*)(p.ws + OFF_CTXR); E.mod = (const float*)(p.ws + OFF_MOD) + (size_t)l * 5 * 6144;
        pg8::gemm_phase<EpiG4, pg8::Order>(lds, g, S, E); } }
    grid.sync();
  }
  phase_final(p);
}

extern "C" void kernel_launch(void* const* d_in, const int* in_sizes, int n_in, void* d_out, int out_size, void* d_ws, size_t ws_size, hipStream_t stream) {
  constexpr size_t kDynLds = 157696;
  static int grid_blocks = 0;
  if (!grid_blocks) {
    hipFuncSetAttribute((const void*)mega, hipFuncAttributeMaxDynamicSharedMemorySize, (int)kDynLds);
    int dev = 0, cus = 0, per_cu = 0;
    hipGetDevice(&dev);
    hipDeviceGetAttribute(&cus, hipDeviceAttributeMultiprocessorCount, dev);
    hipOccupancyMaxActiveBlocksPerMultiprocessor(&per_cu, (const void*)mega, 512, kDynLds);
    grid_blocks = cus * (per_cu >= 1 ? 1 : 0);
    if (ws_size < WS_NEED || grid_blocks <= 0) { fprintf(stderr, "workspace %zu < %zu or no occupancy (%d)\n", ws_size, (size_t)WS_NEED, per_cu); grid_blocks = grid_blocks > 0 ? grid_blocks : 256; }
  }
  Params p{};
  p.x = (const float*)d_in[0]; p.c = (const float*)d_in[1]; p.ctx = (const float*)d_in[2]; p.c_ctx = (const float*)d_in[3]; p.ln_g = (const float*)d_in[4];
  p.ada_w = (const float*)d_in[5]; p.ada_b = (const float*)d_in[6]; p.w_in = (const float*)d_in[7]; p.conv_w = (const float*)d_in[8]; p.conv_b = (const float*)d_in[9];
  p.fw1 = (const float*)d_in[10]; p.fb1 = (const float*)d_in[11]; p.fw2 = (const float*)d_in[12]; p.fb2 = (const float*)d_in[13]; p.fw3 = (const float*)d_in[14]; p.fb3 = (const float*)d_in[15];
  p.ffreq = (const float*)d_in[16]; p.fwout = (const float*)d_in[17]; p.hy_bias = (const float*)d_in[18]; p.ret_decay = (const float*)d_in[19];
  p.w_hy_out = (const float*)d_in[20]; p.w_ret_out = (const float*)d_in[21]; p.w_o = (const float*)d_in[22]; p.final_g = (const float*)d_in[23];
  p.out = (float*)d_out; p.ws = (unsigned char*)d_ws;
  void* args[] = {&p};
  hipError_t e = hipLaunchCooperativeKernel((void*)mega, dim3(grid_blocks), dim3(512), args, kDynLds, stream);
  if (e != hipSuccess) fprintf(stderr, "cooperative launch failed: %s (grid %d)\n", hipGetErrorString(e), grid_blocks);
}
```

```cpp
#include <hip/hip_runtime.h>
#include <hip/hip_cooperative_groups.h>
#include <cstdio>
namespace cg = cooperative_groups;
#ifndef PROBE
#define PROBE 0
#endif

typedef unsigned short bf16_t;
typedef short bf16x8 __attribute__((ext_vector_type(8)));
typedef float f32x4 __attribute__((ext_vector_type(4)));
typedef float f32x16 __attribute__((ext_vector_type(16)));
typedef unsigned u32x4 __attribute__((ext_vector_type(4)));
typedef unsigned u32x2 __attribute__((ext_vector_type(2)));
#define DI __device__ __forceinline__

DI int otid(int wid) { int t; asm volatile("v_mbcnt_lo_u32_b32 %0, -1, 0\n\tv_mbcnt_hi_u32_b32 %0, -1, %0" : "=v"(t)); return wid * 64 + t; }
DI float wsum(float v, int lane) {
#pragma unroll
  for (int o = 32; o > 0; o >>= 1) v += __int_as_float(__builtin_amdgcn_ds_bpermute((lane ^ o) << 2, __float_as_int(v)));
  return v; }
DI float bf2f(bf16_t u) { return __uint_as_float(((unsigned)u) << 16); }
typedef __bf16 bf16v2 __attribute__((ext_vector_type(2)));
typedef float f32v2 __attribute__((ext_vector_type(2)));
DI unsigned pk2(float lo, float hi) { f32v2 v = {lo, hi}; bf16v2 b = __builtin_convertvector(v, bf16v2); return __builtin_bit_cast(unsigned, b); }
DI bf16_t f2bf(float f) { return (bf16_t)(pk2(f, 0.f) & 0xffffu); }
DI float lo2f(unsigned u) { return __uint_as_float(u << 16); }
DI float hi2f(unsigned u) { return __uint_as_float(u & 0xffff0000u); }
DI float sigmoidf_(float v) { return 1.f / (1.f + __expf(-v)); }
DI float siluf_(float v) { return v / (1.f + __expf(-v)); }

constexpr int DM = 2048, NB = 4, SEQ = 4096, CTXL = 256, NLAT = NB * SEQ, NCTX = NB * CTXL, MT = NLAT + NCTX;
constexpr int INW = 24576, NH = 8, DK = 256, DV = 512, TT = SEQ + CTXL;
constexpr int LOFF = 4128, GLEN = 8320;      constexpr size_t G_LAYER = ((size_t)2048 * 8320 * 2 + 255) & ~(size_t)255;
constexpr int USTR = 6560;

constexpr size_t AL(size_t x) { return (x + 255) & ~(size_t)255; }
constexpr size_t OFF_WTIN = 0;
constexpr size_t OFF_WTHY = OFF_WTIN + AL((size_t)INW * DM * 2);
constexpr size_t OFF_WTRET = OFF_WTHY + AL((size_t)DM * DM * 2);
constexpr size_t OFF_WTO = OFF_WTRET + AL((size_t)DM * 4096 * 2);
constexpr size_t OFF_G = OFF_WTO + AL((size_t)DM * DM * 2);
constexpr size_t OFF_GC = OFF_G + 2 * AL((size_t)DM * GLEN * 2);
constexpr size_t OFF_MOD = OFF_GC + AL((size_t)DM * 512 * 4);
constexpr size_t OFF_H = OFF_MOD + AL((size_t)2 * 5 * 6144 * 4);
constexpr size_t OFF_PQ = OFF_H + AL((size_t)MT * DM * 2);
constexpr size_t OFF_PK = OFF_PQ + AL((size_t)MT * DM * 2);
constexpr size_t OFF_PV = OFF_PK + AL((size_t)MT * DM * 2);
constexpr size_t OFF_PRG = OFF_PV + AL((size_t)MT * 4096 * 2);
constexpr size_t OFF_PHY = OFF_PRG + AL((size_t)MT * 4096 * 2);
constexpr size_t OFF_PHG = OFF_PHY + AL((size_t)MT * 6144 * 2);
constexpr size_t OFF_PMG = OFF_PHG + AL((size_t)MT * DM * 2);
constexpr size_t OFF_KT = OFF_PMG + AL((size_t)MT * 4096 * 2);
constexpr size_t OFF_VT = OFF_KT + AL((size_t)NB * NH * DK * TT * 2);
constexpr size_t OFF_UT = OFF_VT + AL((size_t)NB * NH * DV * TT * 2);
constexpr size_t OFF_UTC = OFF_UT + AL((size_t)DM * NB * SEQ * 2);
constexpr size_t OFF_HV = OFF_UTC + AL((size_t)DM * NB * CTXL * 2);
constexpr size_t OFF_HX0 = OFF_HV + AL((size_t)MT * DM * 2);
constexpr size_t OFF_CTXR = OFF_HX0 + AL((size_t)MT * DM * 2);
constexpr size_t WS_NEED = OFF_CTXR + AL((size_t)NCTX * DM * 4);
constexpr size_t OFF_OF = OFF_PV, OFF_OB = OFF_PHY, OFF_T1 = OFF_PHY + AL((size_t)MT * 4096 * 2);

struct Params {
  const float *x, *c, *ctx, *c_ctx, *ln_g, *ada_w, *ada_b, *w_in, *conv_w, *conv_b, *fw1, *fb1, *fw2, *fb2, *fw3, *fb3, *ffreq, *fwout, *hy_bias, *ret_decay, *w_hy_out, *w_ret_out, *w_o, *final_g;
  float* out;
  unsigned char* ws;
  int wid, pad_;
};

namespace pg8 {
#define PG8_LAS __attribute__((address_space(3)))
constexpr int BM = 256, BK = 64, HALF = 128, HTB = HALF * BK * 2, STAGE_BYTES = 8 * HTB, NXCD = 8, WGM = 8;
__host__ __device__ __forceinline__ int lds_byte(int r, int c) { const int st = (r >> 4) * 2 + (c >> 5), rr = r & 15, cc = c & 31, ob = rr * 64 + cc * 2; return st * 1024 + (ob ^ (((ob >> 9) & 1) << 5)); }
__host__ __device__ __forceinline__ void stage_rc(int b, int& R, int& C) { const int st = b / 1024, sb = b % 1024, swz = sb ^ (((sb >> 9) & 1) << 5); R = (st >> 1) * 16 + swz / 64; C = (st & 1) * 32 + (swz % 64) / 2; }
__host__ __device__ __forceinline__ int perm32(int rho) { const int n = rho >> 4, i = rho & 15; return 8 * (i >> 2) + 4 * n + (i & 3); }
struct Unit { int pm, pn; };
struct Gemm { const bf16_t* A; const bf16_t* Bt; int M, N, K, wid; };
struct Order {
    int nM, nN, nwg, G, c, nx_m, nx_n, x_pn0;
    __device__ void init(int nM_, int nN_, int G_, int c_, int nx_m_, int nx_n_, int x_pn0_) { nM = nM_; nN = nN_; nwg = nM * nN; G = G_; c = c_; nx_m = nx_m_; nx_n = nx_n_; x_pn0 = x_pn0_; }
    __device__ bool next(int i, Unit& u) const {
        const long L = (long)i * G + c;
        if (L >= nwg) { const int e = (int)(L - nwg); if (e >= nx_m * nx_n) return false; u.pm = nM + e % nx_m; u.pn = x_pn0 + e / nx_m; return true; }
        int wgid = (int)L; { const int q = nwg / NXCD, r = nwg % NXCD, xcd = wgid % NXCD, off = wgid / NXCD; wgid = (xcd < r ? xcd * (q + 1) : r * (q + 1) + (xcd - r) * q) + off; }
        const int nig = WGM * nN, gid = wgid / nig, fm = gid * WGM, gsz = (nM - fm) < WGM ? (nM - fm) : WGM;
        u.pm = fm + ((wgid % nig) % gsz); u.pn = (wgid % nig) / gsz; return true;
    }
    __device__ __forceinline__ void a_ready(const Unit&) const {}
    __device__ __forceinline__ void done(const Unit&) const {}
};
template <class Epi, class Sched>
__device__ __forceinline__ void gemm_phase(PG8_LAS unsigned char* lds, const Gemm g, const Sched& S, const Epi& E) {
    const int tid = otid(g.wid), wid = __builtin_amdgcn_readfirstlane(tid >> 6), lane = tid & 63, wr = wid >> 2, wc = wid & 3, fr = lane & 15, fq = lane >> 4;
    const int K = g.K, nt = K / BK;
    unsigned voffA[2], voffB[2];
#pragma unroll
    for (int i = 0; i < 2; ++i) { int R, C; stage_rc(tid * 16 + i * 8192, R, C); const int Rb = Epi::PERM ? ((R & ~31) + perm32(R & 31)) : R;
        voffA[i] = (unsigned)(R * K + C) * 2u; voffB[i] = (unsigned)(Rb * K + C) * 2u; }
    const size_t kstep = (size_t)(BK * 2);
    const size_t hstep = (size_t)HALF * K * 2;
    const size_t tstep = 2 * hstep;
    const unsigned ldsw = (unsigned)wid * 1024u;
    const int aoff = lds_byte(wr * 64 + fr, fq * 8), boff = lds_byte(wc * 32 + fr, fq * 8);
#define PG8_SA(b, h) (((b) * 2 + (h)) * HTB)
#define PG8_SB(b, h) ((4 + (b) * 2 + (h)) * HTB)
#define PG8_STAGE(bufoff, gbase, voff) do { _Pragma("unroll") for (int _i = 0; _i < 2; ++_i) \
        __builtin_amdgcn_global_load_lds((const unsigned*)((const char*)(gbase) + (voff)[_i]), (PG8_LAS unsigned*)(lds + (bufoff) + ldsw + _i * 8192), 16, 0, 0); } while (0)
#define PG8_LDA(dst, b, h) do { _Pragma("unroll") for (int m = 0; m < 4; ++m) _Pragma("unroll") for (int k = 0; k < 2; ++k) dst[m][k] = *(const PG8_LAS bf16x8*)(lds + PG8_SA(b, h) + aoff + m * 2048 + k * 1024); } while (0)
#define PG8_LDB(dst, b, h) do { _Pragma("unroll") for (int n = 0; n < 2; ++n) _Pragma("unroll") for (int k = 0; k < 2; ++k) dst[n][k] = *(const PG8_LAS bf16x8*)(lds + PG8_SB(b, h) + boff + n * 2048 + k * 1024); } while (0)
#define PG8_MMA(ai, bj, At, Bt) do { __builtin_amdgcn_s_setprio(1); _Pragma("unroll") for (int m = 0; m < 4; ++m) _Pragma("unroll") for (int n = 0; n < 2; ++n) _Pragma("unroll") for (int k = 0; k < 2; ++k) \
        acc[ai][bj][m][n] = __builtin_amdgcn_mfma_f32_16x16x32_bf16(Bt[n][k], At[m][k], acc[ai][bj][m][n], 0, 0, 0); __builtin_amdgcn_s_setprio(0); } while (0)
#define PG8_WAIT_V(n) asm volatile("s_waitcnt vmcnt(" #n ")" ::: "memory")
#define PG8_WAIT_L(n) asm volatile("s_waitcnt lgkmcnt(" #n ")" ::: "memory")
#define PG8_BAR __builtin_amdgcn_s_barrier()
#define PG8_SCHED __builtin_amdgcn_sched_barrier(0)
    Unit cur, nxt; int ui = 0;
    if (!S.next(0, cur)) return;
    f32x4 acc[2][2][4][2];
#pragma unroll
    for (int a = 0; a < 2; ++a)
#pragma unroll
        for (int b = 0; b < 2; ++b)
#pragma unroll
            for (int m = 0; m < 4; ++m)
#pragma unroll
                for (int n = 0; n < 2; ++n) acc[a][b][m][n] = (f32x4){0.f, 0.f, 0.f, 0.f};
    bf16x8 At[4][2], B0[2][2], B1[2][2];
    const char* cA = (const char*)g.A + (size_t)cur.pm * tstep; const char* cB = (const char*)g.Bt + (size_t)cur.pn * tstep;
    S.a_ready(cur);
    PG8_STAGE(PG8_SB(0, 0), cB, voffB); PG8_STAGE(PG8_SA(0, 0), cA, voffA); PG8_STAGE(PG8_SB(0, 1), cB + hstep, voffB); PG8_STAGE(PG8_SA(0, 1), cA + hstep, voffA);
    if (wr == 1) PG8_BAR;
    PG8_WAIT_V(4); PG8_BAR;
    PG8_STAGE(PG8_SB(1, 0), cB + kstep, voffB); PG8_STAGE(PG8_SA(1, 0), cA + kstep, voffA); PG8_STAGE(PG8_SB(1, 1), cB + hstep + kstep, voffB);
    PG8_WAIT_V(6); PG8_BAR;
    for (;;) {
        const bool has_next = S.next(ui + 1, nxt);
        const char* nA = has_next ? (const char*)g.A + (size_t)nxt.pm * tstep : cA; const char* nB = has_next ? (const char*)g.Bt + (size_t)nxt.pn * tstep : cB;
        for (int t = 0; t < nt; t += 2) {
            const bool last = (t == nt - 2);
            const char* a1 = cA + (size_t)(t + 1) * kstep;
            const char* a2 = last ? nA : cA + (size_t)(t + 2) * kstep; const char* b2 = last ? nB : cB + (size_t)(t + 2) * kstep;
            const char* a3 = a2 + kstep; const char* b3 = b2 + kstep;
            if (last && has_next) S.a_ready(nxt);
            PG8_LDB(B0, 0, 0); PG8_SCHED; PG8_LDA(At, 0, 0); PG8_STAGE(PG8_SA(1, 1), a1 + hstep, voffA);
            PG8_WAIT_L(8); PG8_BAR; PG8_WAIT_L(0); PG8_MMA(0, 0, At, B0); PG8_BAR; PG8_SCHED;
            PG8_LDB(B1, 0, 1); PG8_STAGE(PG8_SB(0, 0), b2, voffB);
            PG8_BAR; PG8_WAIT_L(0); PG8_MMA(0, 1, At, B1); PG8_BAR;
            PG8_LDA(At, 0, 1); PG8_STAGE(PG8_SA(0, 0), a2, voffA);
            PG8_BAR; PG8_WAIT_L(0); PG8_MMA(1, 0, At, B0); PG8_BAR; PG8_SCHED;
            PG8_STAGE(PG8_SB(0, 1), b2 + hstep, voffB);
            PG8_WAIT_V(6); PG8_BAR; PG8_MMA(1, 1, At, B1); PG8_BAR;
            PG8_LDB(B0, 1, 0); PG8_SCHED; PG8_LDA(At, 1, 0); PG8_STAGE(PG8_SA(0, 1), a2 + hstep, voffA);
            PG8_WAIT_L(8); PG8_BAR; PG8_WAIT_L(0); PG8_MMA(0, 0, At, B0); PG8_BAR; PG8_SCHED;
            PG8_LDB(B1, 1, 1); PG8_STAGE(PG8_SB(1, 0), b3, voffB);
            PG8_BAR; PG8_WAIT_L(0); PG8_MMA(0, 1, At, B1); PG8_BAR;
            PG8_LDA(At, 1, 1); PG8_STAGE(PG8_SA(1, 0), a3, voffA);
            PG8_BAR; PG8_WAIT_L(0); PG8_MMA(1, 0, At, B0); PG8_BAR; PG8_SCHED;
            PG8_STAGE(PG8_SB(1, 1), b3 + hstep, voffB);
            PG8_WAIT_V(6); PG8_BAR; PG8_MMA(1, 1, At, B1); PG8_BAR;
        }
        if constexpr (!Epi::AFTER_DRAIN) { E(acc, cur, wr, wc, fr, fq); S.done(cur); }
        if (!has_next) break;
#pragma unroll
        for (int a = 0; a < 2; ++a)
#pragma unroll
            for (int b = 0; b < 2; ++b)
#pragma unroll
                for (int m = 0; m < 4; ++m)
#pragma unroll
                    for (int n = 0; n < 2; ++n) acc[a][b][m][n] = (f32x4){0.f, 0.f, 0.f, 0.f};
        cur = nxt; cA = nA; cB = nB; ++ui;
    }
    PG8_WAIT_V(0);
    if (wr == 0) PG8_BAR;
    PG8_BAR;
    if constexpr (Epi::AFTER_DRAIN) { E.fused(acc, cur, wr, wc, fr, fq, lds, wid, lane); S.done(cur); }
#undef PG8_SA
#undef PG8_SB
#undef PG8_STAGE
#undef PG8_LDA
#undef PG8_LDB
#undef PG8_MMA

#undef PG8_WAIT_V
#undef PG8_WAIT_L
#undef PG8_BAR
#undef PG8_SCHED
}
}

struct EpiG1 {
  static constexpr bool PERM = true, AFTER_DRAIN = false;
  unsigned char* ws;
  DI void operator()(const f32x4 (&acc)[2][2][4][2], const pg8::Unit& u, int wr, int wc, int fr, int fq) const {
    const int pn = u.pn; size_t off; int ld, c0;
    if (pn < 8) { off = OFF_PQ; ld = 2048; c0 = pn * 256; }
    else if (pn < 16) { off = OFF_PK; ld = 2048; c0 = (pn - 8) * 256; }
    else if (pn < 32) { off = OFF_PV; ld = 4096; c0 = (pn - 16) * 256; }
    else if (pn < 48) { off = OFF_PRG; ld = 4096; c0 = (pn - 32) * 256; }
    else if (pn < 72) { off = OFF_PHY; ld = 6144; c0 = (pn - 48) * 256; }
    else if (pn < 80) { off = OFF_PHG; ld = 2048; c0 = (pn - 72) * 256; }
    else { off = OFF_PMG; ld = 4096; c0 = (pn - 80) * 256; }
    bf16_t* base = (bf16_t*)(ws + off);
    const int row0 = u.pm * 256 + wr * 64 + fr, col0 = c0 + wc * 32 + 8 * fq;
#pragma unroll
    for (int ai = 0; ai < 2; ++ai)
#pragma unroll
      for (int m = 0; m < 4; ++m) { bf16_t* rowp = base + (size_t)(row0 + ai * 128 + m * 16) * ld + col0;
#pragma unroll
        for (int bj = 0; bj < 2; ++bj) { const f32x4 v0 = acc[ai][bj][m][0], v1 = acc[ai][bj][m][1];
          u32x4 o; o[0] = pk2(v0[0], v0[1]); o[1] = pk2(v0[2], v0[3]); o[2] = pk2(v1[0], v1[1]); o[3] = pk2(v1[2], v1[3]);
          *(u32x4*)(rowp + bj * 128) = o; } }
  }
};
template <int SECOND> struct EpiG23 {
  static constexpr bool PERM = true, AFTER_DRAIN = false;
  unsigned char* ws;
  DI void operator()(const f32x4 (&acc)[2][2][4][2], const pg8::Unit& u, int wr, int wc, int fr, int fq) const {
    bf16_t* T1 = (bf16_t*)(ws + OFF_T1); const bf16_t* MG = (const bf16_t*)(ws + OFF_PMG) + (SECOND ? 2048 : 0);
    const int row0 = u.pm * 256 + wr * 64 + fr, col0 = u.pn * 256 + wc * 32 + 8 * fq;
#pragma unroll
    for (int ai = 0; ai < 2; ++ai)
#pragma unroll
      for (int m = 0; m < 4; ++m) { const size_t row = (size_t)(row0 + ai * 128 + m * 16);
#pragma unroll
        for (int bj = 0; bj < 2; ++bj) { const int col = col0 + bj * 128;
          const u32x4 g = *(const u32x4*)(MG + row * 4096 + col);
          const f32x4 v0 = acc[ai][bj][m][0], v1 = acc[ai][bj][m][1];
          float r[8];
          r[0] = sigmoidf_(lo2f(g[0])) * v0[0]; r[1] = sigmoidf_(hi2f(g[0])) * v0[1]; r[2] = sigmoidf_(lo2f(g[1])) * v0[2]; r[3] = sigmoidf_(hi2f(g[1])) * v0[3];
          r[4] = sigmoidf_(lo2f(g[2])) * v1[0]; r[5] = sigmoidf_(hi2f(g[2])) * v1[1]; r[6] = sigmoidf_(lo2f(g[3])) * v1[2]; r[7] = sigmoidf_(hi2f(g[3])) * v1[3];
          if (SECOND) { const u32x4 t = *(const u32x4*)(T1 + row * 2048 + col);
            r[0] += lo2f(t[0]); r[1] += hi2f(t[0]); r[2] += lo2f(t[1]); r[3] += hi2f(t[1]); r[4] += lo2f(t[2]); r[5] += hi2f(t[2]); r[6] += lo2f(t[3]); r[7] += hi2f(t[3]); }
          u32x4 o; o[0] = pk2(r[0], r[1]); o[1] = pk2(r[2], r[3]); o[2] = pk2(r[4], r[5]); o[3] = pk2(r[6], r[7]);
          *(u32x4*)(T1 + row * 2048 + col) = o; } }
  }
};
struct EpiG4 {
  static constexpr bool PERM = false, AFTER_DRAIN = false;
  const float* xin; const float* cin; float* xout; float* cout; const float* mod;
  DI void operator()(const f32x4 (&acc)[2][2][4][2], const pg8::Unit& u, int wr, int wc, int fr, int fq) const {
    const int row0 = u.pm * 256 + wr * 64 + fr, col0 = u.pn * 256 + wc * 32 + 4 * fq;
#pragma unroll
    for (int ai = 0; ai < 2; ++ai)
#pragma unroll
      for (int m = 0; m < 4; ++m) { const int row = row0 + ai * 128 + m * 16;
        const float* src; float* dst; const float* gate;
        if (row < NLAT) { src = xin + (size_t)row * 2048; dst = xout + (size_t)row * 2048; gate = mod + (row >> 12) * 6144 + 4096; }
        else { src = cin + (size_t)(row - NLAT) * 2048; dst = cout + (size_t)(row - NLAT) * 2048; gate = mod + 4 * 6144 + 4096; }
#pragma unroll
        for (int bj = 0; bj < 2; ++bj)
#pragma unroll
          for (int n = 0; n < 2; ++n) { const int col = col0 + bj * 128 + n * 16;
            const f32x4 xv = *(const f32x4*)(src + col), gv = *(const f32x4*)(gate + col);
            *(f32x4*)(dst + col) = xv + gv * acc[ai][bj][m][n]; } }
  }
};

__device__ void phase_mod(const Params& p, unsigned char* shm) {
  float* sc = (float*)shm; float* red = sc + 5 * 2048;
  const int tid = otid(p.wid);
  for (int i = tid; i < 5 * 2048; i += 512) { const int j = i >> 11, k = i & 2047; const float v = (j < 4) ? p.c[j * 2048 + k] : p.c_ctx[k]; sc[i] = v / (1.f + expf(-v)); }
  __syncthreads();
  float* mod = (float*)(p.ws + OFF_MOD);
  const int cq = tid & 7, ks = tid >> 3;
  for (int it = blockIdx.x; it < 384; it += gridDim.x) {
    const int l = it / 192, nb = (it % 192) * 32;
    const float* W = p.ada_w + (size_t)l * 2048 * 6144 + nb + cq * 4;
    float acc[5][4];
#pragma unroll
    for (int j = 0; j < 5; ++j) { acc[j][0] = 0.f; acc[j][1] = 0.f; acc[j][2] = 0.f; acc[j][3] = 0.f; }
#pragma unroll 4
    for (int kk = 0; kk < 32; ++kk) { const int k = ks * 32 + kk; const float4 w = *(const float4*)(W + (size_t)k * 6144);
#pragma unroll
      for (int j = 0; j < 5; ++j) { const float s = sc[j * 2048 + k]; acc[j][0] += s * w.x; acc[j][1] += s * w.y; acc[j][2] += s * w.z; acc[j][3] += s * w.w; } }
#pragma unroll
    for (int j = 0; j < 5; ++j)
#pragma unroll
      for (int e = 0; e < 4; ++e) red[ks * 160 + j * 32 + cq * 4 + e] = acc[j][e];
    __syncthreads();
    if (tid < 160) { float s = 0.f; for (int q = 0; q < 64; ++q) s += red[q * 160 + tid]; const int j = tid >> 5, n = nb + (tid & 31); mod[(l * 5 + j) * 6144 + n] = s + p.ada_b[l * 6144 + n]; }
    __syncthreads();
  }
}

__device__ void cvt_group(int wid, const float* W, bf16_t* Wt, int K, int N, int k0, int n0, float scale, float* tile) {
  const int tid = otid(wid);
  float4 v[8];
#pragma unroll
  for (int q = 0; q < 4; ++q)
#pragma unroll
    for (int rr = 0; rr < 2; ++rr) { const int k = (tid >> 4) + 32 * rr, n = (tid & 15) * 4; v[q * 2 + rr] = *(const float4*)(W + (size_t)(k0 + q * 64 + k) * N + n0 + n); }
#pragma unroll
  for (int q = 0; q < 4; ++q)
#pragma unroll
    for (int rr = 0; rr < 2; ++rr) { const int k = (tid >> 4) + 32 * rr, n = (tid & 15) * 4; float* t = tile + q * 4160 + k * 65 + n; const float4 x = v[q * 2 + rr]; t[0] = x.x; t[1] = x.y; t[2] = x.z; t[3] = x.w; }
  __syncthreads();
#pragma unroll
  for (int q = 0; q < 4; ++q) { const int n = tid >> 3, k8 = (tid & 7) * 8; const float* t = tile + q * 4160; u32x4 o;
#pragma unroll
    for (int e = 0; e < 4; ++e) o[e] = pk2(t[(k8 + 2 * e) * 65 + n] * scale, t[(k8 + 2 * e + 1) * 65 + n] * scale);
    *(u32x4*)(Wt + (size_t)(n0 + n) * K + k0 + q * 64 + k8) = o; }
  __syncthreads();
}
__device__ void phase_cvt(const Params& p, int l, unsigned char* shm) {
  float* tile = (float*)shm;
  for (int it = blockIdx.x; it < 4096; it += gridDim.x) {
    if (it < 3072) { const int kg = it & 7, n0 = (it >> 3) * 64;
      cvt_group(p.wid, p.w_in + (size_t)l * DM * INW, (bf16_t*)(p.ws + OFF_WTIN), DM, INW, kg * 256, n0, (n0 >= 2048 && n0 < 4096) ? 0.0625f : 1.f, tile); }
    else if (it < 3328) { const int e = it - 3072; cvt_group(p.wid, p.w_hy_out + (size_t)l * DM * DM, (bf16_t*)(p.ws + OFF_WTHY), DM, DM, (e & 7) * 256, (e >> 3) * 64, 1.f, tile); }
    else if (it < 3840) { const int e = it - 3328; cvt_group(p.wid, p.w_ret_out + (size_t)l * 4096 * DM, (bf16_t*)(p.ws + OFF_WTRET), 4096, DM, (e & 15) * 256, (e >> 4) * 64, 1.f, tile); }
    else { const int e = it - 3840; cvt_group(p.wid, p.w_o + (size_t)l * DM * DM, (bf16_t*)(p.ws + OFF_WTO), DM, DM, (e & 7) * 256, (e >> 3) * 64, 1.f, tile); }
  }
}

__device__ void filt_item(const Params& p, int l, int Ls, int T, bool isctx, unsigned char* shm) {
  float* z = (float*)shm; float* ha = z + 17 * 36; float* hb = ha + 17 * 64;
  const int tid = otid(p.wid);
  const float* w1 = p.fw1 + l * 33 * 64; const float* b1 = p.fb1 + l * 64; const float* w2 = p.fw2 + l * 4096; const float* b2 = p.fb2 + l * 64;
  const float* w3 = p.fw3 + l * 4096; const float* b3 = p.fb3 + l * 64; const float* fq = p.ffreq + l * 64; const float* wout = p.fwout + (size_t)l * 64 * 4096;
  for (int i = tid; i < 17 * 33; i += 512) { const int pl = i / 33, f = i % 33; int pp = T * 16 + pl; if (pp > Ls - 1) pp = Ls - 1;
    float val;
    if (f == 0) val = (float)pp / (float)(Ls - 1);
    else { const int j = (f - 1) & 15; const float fj = 1e-4f + (float)j * ((15.f - 1e-4f) / 15.f); const float ang = 6.283185307179586f * (float)pp / (float)Ls; const float a = fj * ang; val = (f <= 16) ? cosf(a) : -sinf(a); }
    z[pl * 36 + f] = val; }
  __syncthreads();
  for (int idx = tid; idx < 17 * 16; idx += 512) { const int pl = idx >> 4, j0 = (idx & 15) * 4; float a[4] = {0.f, 0.f, 0.f, 0.f};
#pragma unroll 3
    for (int k = 0; k < 33; ++k) { const float v = z[pl * 36 + k]; const float4 w = *(const float4*)(w1 + k * 64 + j0); a[0] += v * w.x; a[1] += v * w.y; a[2] += v * w.z; a[3] += v * w.w; }
#pragma unroll
    for (int e = 0; e < 4; ++e) ha[pl * 64 + j0 + e] = sinf(fq[j0 + e] * (a[e] + b1[j0 + e])); }
  __syncthreads();
  for (int idx = tid; idx < 17 * 16; idx += 512) { const int pl = idx >> 4, j0 = (idx & 15) * 4; float a[4] = {0.f, 0.f, 0.f, 0.f};
#pragma unroll 4
    for (int k = 0; k < 64; ++k) { const float v = ha[pl * 64 + k]; const float4 w = *(const float4*)(w2 + k * 64 + j0); a[0] += v * w.x; a[1] += v * w.y; a[2] += v * w.z; a[3] += v * w.w; }
#pragma unroll
    for (int e = 0; e < 4; ++e) hb[pl * 64 + j0 + e] = sinf(fq[j0 + e] * (a[e] + b2[j0 + e])); }
  __syncthreads();
  for (int idx = tid; idx < 17 * 16; idx += 512) { const int pl = idx >> 4, j0 = (idx & 15) * 4; float a[4] = {0.f, 0.f, 0.f, 0.f};
#pragma unroll 4
    for (int k = 0; k < 64; ++k) { const float v = hb[pl * 64 + k]; const float4 w = *(const float4*)(w3 + k * 64 + j0); a[0] += v * w.x; a[1] += v * w.y; a[2] += v * w.z; a[3] += v * w.w; }
#pragma unroll
    for (int e = 0; e < 4; ++e) ha[pl * 64 + j0 + e] = sinf(fq[j0 + e] * (a[e] + b3[j0 + e])); }
  __syncthreads();
  const int c2 = tid * 8; const bool isb = c2 >= 2048; const int cb = c2 & 2047;
  const float mind = logf(0.01f) / 1.5f, maxd = logf(0.01f) / 0.3f;
  bf16_t* G = (bf16_t*)(p.ws + OFF_G + (size_t)l * G_LAYER); float* GC = (float*)(p.ws + OFF_GC);
  for (int pgh = 0; pgh < 4; ++pgh) {
    const int pg = pgh >> 1, c4 = c2 + (pgh & 1) * 4;
    const int plb = pg * 8 + (isb ? 0 : 1);
    float acc[8][4];
#pragma unroll
    for (int e = 0; e < 8; ++e) { acc[e][0] = 0.f; acc[e][1] = 0.f; acc[e][2] = 0.f; acc[e][3] = 0.f; }
#pragma unroll 8
    for (int k = 0; k < 64; ++k) { const float4 wa = *(const float4*)(wout + k * 4096 + c4);
#pragma unroll
      for (int e = 0; e < 8; ++e) { const float h = ha[(plb + e) * 64 + k]; acc[e][0] += h * wa.x; acc[e][1] += h * wa.y; acc[e][2] += h * wa.z; acc[e][3] += h * wa.w; } }
    const int pp0 = T * 16 + plb;
#pragma unroll
    for (int cc = 0; cc < 4; ++cc) { const int c = (c4 & 2047) + cc; const float delta = fabsf(mind + (float)c * ((maxd - mind) / 2047.f));
      float v[8];
#pragma unroll
      for (int e = 0; e < 8; ++e) { const int pp = pp0 + e; v[e] = (pp < Ls) ? acc[e][cc] * __expf(-((float)pp / (float)(Ls - 1)) * delta) : 0.f; }
      if (!isctx) {
        bf16_t* Gc = G + (size_t)c * GLEN;
        if (isb) {
          if (pp0 == 0) { for (int e = 1; e < 8; ++e) Gc[LOFF + e] = f2bf(v[e]); }
          else { u32x4 o; o[0] = pk2(v[0], v[1]); o[1] = pk2(v[2], v[3]); o[2] = pk2(v[4], v[5]); o[3] = pk2(v[6], v[7]); *(u32x4*)(Gc + LOFF + pp0) = o; }
        } else {
          u32x4 o; o[0] = pk2(v[7], v[6]); o[1] = pk2(v[5], v[4]); o[2] = pk2(v[3], v[2]); o[3] = pk2(v[1], v[0]); *(u32x4*)(Gc + LOFF - pp0 - 7) = o;
        }
      } else {
        float* Gc = GC + (size_t)c * 512;
#pragma unroll
        for (int e = 0; e < 8; ++e) { const int pp = pp0 + e; if (isb) { if (pp >= 1 && pp < Ls) Gc[256 - pp] = v[e]; } else { if (pp < Ls) Gc[256 + pp] = v[e]; } }
      }
    }
  }
  if (T == 0 && !isb) {
#pragma unroll 1
    for (int cc = 0; cc < 8; ++cc) { float a = 0.f;
#pragma unroll 4
      for (int k = 0; k < 64; ++k) a += ha[k] * wout[k * 4096 + c2 + cc];
      if (!isctx) G[(size_t)(cb + cc) * GLEN + LOFF] = f2bf(a); else GC[(size_t)(cb + cc) * 512 + 256] = a; }
  }
  __syncthreads();
}
__device__ void phase_filters(const Params& p, unsigned char* shm) {
  for (int it = blockIdx.x; it < 528; it += gridDim.x) { if (it < 512) filt_item(p, it >> 8, SEQ, it & 255, false, shm); else filt_item(p, 0, CTXL, it - 512, true, shm); }
}

__device__ void phase_norm(const Params& p, int l) {
  const int lane = otid(p.wid) & 63, gw = blockIdx.x * 8 + (otid(p.wid) >> 6), nw = gridDim.x * 8;
  const float* mod = (const float*)(p.ws + OFF_MOD) + (size_t)l * 5 * 6144; const float* lng = p.ln_g + l * 2048;
  bf16_t* H = (bf16_t*)(p.ws + OFF_H);
  for (int r = gw; r < MT; r += nw) {
    const float* src; int j;
    if (r < NLAT) { src = (l == 0 ? p.x : p.out) + (size_t)r * 2048; j = r >> 12; }
    else { src = (l == 0 ? p.ctx : (const float*)(p.ws + OFF_CTXR)) + (size_t)(r - NLAT) * 2048; j = 4; }
    const float* sh = mod + j * 6144; const float* sc = sh + 2048;
    float4 v[8]; float ss = 0.f;
#pragma unroll
    for (int i = 0; i < 8; ++i) { v[i] = *(const float4*)(src + i * 256 + lane * 4); ss += v[i].x * v[i].x + v[i].y * v[i].y + v[i].z * v[i].z + v[i].w * v[i].w; }
    ss = wsum(ss, lane);
    const float rs = rsqrtf(ss * (1.f / 2048.f) + 1e-6f);
#pragma unroll
    for (int i = 0; i < 8; ++i) { const int col = i * 256 + lane * 4; const float4 g = *(const float4*)(lng + col), a = *(const float4*)(sc + col), b = *(const float4*)(sh + col);
      u32x2 o; o[0] = pk2(v[i].x * rs * g.x * (1.f + a.x) + b.x, v[i].y * rs * g.y * (1.f + a.y) + b.y); o[1] = pk2(v[i].z * rs * g.z * (1.f + a.z) + b.z, v[i].w * rs * g.w * (1.f + a.w) + b.w);
      *(u32x2*)(H + (size_t)r * 2048 + col) = o; }
  }
}
__device__ void phase_final(const Params& p) {
  const int lane = otid(p.wid) & 63, gw = blockIdx.x * 8 + (otid(p.wid) >> 6), nw = gridDim.x * 8;
  for (int r = gw; r < NLAT; r += nw) {
    float* src = p.out + (size_t)r * 2048; float4 v[8]; float ss = 0.f;
#pragma unroll
    for (int i = 0; i < 8; ++i) { v[i] = *(const float4*)(src + i * 256 + lane * 4); ss += v[i].x * v[i].x + v[i].y * v[i].y + v[i].z * v[i].z + v[i].w * v[i].w; }
    ss = wsum(ss, lane);
    const float rs = rsqrtf(ss * (1.f / 2048.f) + 1e-6f);
#pragma unroll
    for (int i = 0; i < 8; ++i) { const int col = i * 256 + lane * 4; const float4 g = *(const float4*)(p.final_g + col); float4 o; o.x = v[i].x * rs * g.x; o.y = v[i].y * rs * g.y; o.z = v[i].z * rs * g.z; o.w = v[i].w * rs * g.w; *(float4*)(src + col) = o; }
  }
}

DI void tok_tile(int tk, int& b, int& t0, bool& isctx) { if (tk < 256) { b = tk >> 6; t0 = (tk & 63) * 64; isctx = false; } else { b = (tk - 256) >> 2; t0 = ((tk - 256) & 3) * 64; isctx = true; } }
DI int tok_row(int b, int t, bool isctx) { return isctx ? NLAT + b * CTXL + t : b * SEQ + t; }

__device__ void phase_prep(const Params& p, int l, unsigned char* shm, int mask) {
  const int tid = otid(p.wid), lane = tid & 63;
  float2* cs = (float2*)shm;
  unsigned char* reg2 = shm + 32768;
  for (int i = tid; i < 4096; i += 512) { const int pos = i >> 6, j = i & 63; const float inv = 1.f / powf(10000.f, (float)j / 64.f); float s, c; sincosf((float)pos * inv, &s, &c); cs[i] = make_float2(c, s); }
  __syncthreads();
  if (mask & 1) { bf16_t* PQ = (bf16_t*)(p.ws + OFF_PQ); const int gw = blockIdx.x * 8 + (tid >> 6), nw = gridDim.x * 8;
#pragma unroll 2
    for (int r = gw; r < NLAT; r += nw) { const int t = r & 4095, rp = t >> 6, cp = t & 63; bf16_t* row = PQ + (size_t)r * 2048;
#pragma unroll
      for (int e = 0; e < 2; ++e) { const int cmb = lane + 64 * e, hh = cmb >> 4, hf = (cmb >> 3) & 1, j8 = (cmb & 7) * 8; bf16_t* q = row + hh * 256 + hf * 128 + j8;
        const u32x4 a = *(const u32x4*)q, bq = *(const u32x4*)(q + 64); const float2* cp2 = cs + (hf ? cp : rp) * 64 + j8; u32x4 oa, ob;
#pragma unroll
        for (int w = 0; w < 4; ++w) { const float2 v0 = cp2[2 * w], v1 = cp2[2 * w + 1]; const float p10 = lo2f(a[w]), p11 = hi2f(a[w]), p20 = lo2f(bq[w]), p21 = hi2f(bq[w]);
          oa[w] = pk2(p10 * v0.x - p20 * v0.y, p11 * v1.x - p21 * v1.y); ob[w] = pk2(p10 * v0.y + p20 * v0.x, p11 * v1.y + p21 * v1.x); }
        *(u32x4*)q = oa; *(u32x4*)(q + 64) = ob; } } }
  if (mask & 2) { unsigned* tl = (unsigned*)reg2;
    bf16_t* tls = (bf16_t*)reg2;
    u32x4 pre[4];
#define PB_DECODE(it_) const int tk = (it_) / 24, sub = (it_) % 24; int b, t0; bool isctx; tok_tile(tk, b, t0, isctx); \
      bf16_t* src; int ld, co; bf16_t* dst; const bool isk = sub < 8; \
      if (isk) { src = (bf16_t*)(p.ws + OFF_PK); ld = 2048; co = sub * 256; dst = (bf16_t*)(p.ws + OFF_KT) + (size_t)((b * 8 + sub) * 256) * TT; } \
      else { const int hh = (sub - 8) >> 1, hf = (sub - 8) & 1; src = (bf16_t*)(p.ws + OFF_PV); ld = 4096; co = hh * 512 + hf * 256; dst = (bf16_t*)(p.ws + OFF_VT) + (size_t)((b * 8 + hh) * 512 + hf * 256) * TT; } \
      const int row0 = tok_row(b, t0, isctx), tt0 = isctx ? t0 : CTXL + t0;
#define PB_LOAD(it_) do { PB_DECODE(it_) (void)dst; (void)tt0; _Pragma("unroll") for (int e = 0; e < 4; ++e) { const int id = tid + 512 * e, row = id >> 5, pc = id & 31; pre[e] = *(const u32x4*)(src + (size_t)(row0 + row) * ld + co + pc * 8); } } while (0)
    const int nit = 272 * 24;
    if ((int)blockIdx.x < nit) PB_LOAD((int)blockIdx.x);
    for (int it = blockIdx.x; it < nit; it += gridDim.x) {
      PB_DECODE(it)
#pragma unroll
      for (int e = 0; e < 4; ++e) { const int id = tid + 512 * e, row = id >> 5, pc = id & 31; unsigned* d = tl + row * 129 + pc * 4; d[0] = pre[e][0]; d[1] = pre[e][1]; d[2] = pre[e][2]; d[3] = pre[e][3]; }
      if (it + (int)gridDim.x < nit) PB_LOAD(it + (int)gridDim.x);
      __syncthreads();
      if (isk && !isctx) {
#pragma unroll 4
        for (int e = 0; e < 16; ++e) { const int id = tid + 512 * e, tok = id >> 7, pr = id & 127, hf = pr >> 6, j = pr & 63; const int t = t0 + tok;
          const float2 v = cs[(hf ? (t & 63) : (t >> 6)) * 64 + j]; bf16_t* q = tls + tok * 258 + hf * 128 + j;
          const float p1 = bf2f(q[0]), p2 = bf2f(q[64]); q[0] = f2bf(p1 * v.x - p2 * v.y); q[64] = f2bf(p1 * v.y + p2 * v.x); }
        __syncthreads();
#pragma unroll
        for (int e = 0; e < 4; ++e) { const int id = tid + 512 * e, row = id >> 5, pc = id & 31; const unsigned* d = tl + row * 129 + pc * 4; u32x4 v; v[0] = d[0]; v[1] = d[1]; v[2] = d[2]; v[3] = d[3];
          *(u32x4*)(src + (size_t)(row0 + row) * ld + co + pc * 8) = v; }
      }
      { const int d2 = tid & 127, tg = (tid >> 7) * 16; unsigned w[16];
#pragma unroll
        for (int e = 0; e < 16; ++e) w[e] = tl[(tg + e) * 129 + d2];
#pragma unroll
        for (int q = 0; q < 2; ++q) { u32x4 o0, o1;
#pragma unroll
          for (int e = 0; e < 4; ++e) { const unsigned x = w[q * 8 + 2 * e], y = w[q * 8 + 2 * e + 1]; o0[e] = (x & 0xffffu) | (y << 16); o1[e] = (x >> 16) | (y & 0xffff0000u); }
          *(u32x4*)(dst + (size_t)(2 * d2) * TT + tt0 + tg + q * 8) = o0; *(u32x4*)(dst + (size_t)(2 * d2 + 1) * TT + tt0 + tg + q * 8) = o1; } }
      __syncthreads();
    }
#undef PB_DECODE
#undef PB_LOAD
  }
  if (mask & 4) { float* in = (float*)reg2;
    bf16_t* ut = (bf16_t*)(reg2 + 3 * 66 * 64 * 4);
    const bf16_t* PHY = (const bf16_t*)(p.ws + OFF_PHY); bf16_t* HV = (bf16_t*)(p.ws + OFF_HV); bf16_t* HX0 = (bf16_t*)(p.ws + OFF_HX0);
    const float* cw = p.conv_w + (size_t)l * 3 * 6144; const float* cb = p.conv_b + (size_t)l * 6144;
    const int nit = ((l == 0) ? 272 : 256) * 32;
    u32x4 pre[4];
#define PC_DECODE(it_) const int tk = (it_) >> 5, c0 = ((it_) & 31) * 64; int b, t0; bool isctx; tok_tile(tk, b, t0, isctx); const int Ls = isctx ? CTXL : SEQ; const int row0 = tok_row(b, t0, isctx);
#define PC_LOAD(it_) do { PC_DECODE(it_) _Pragma("unroll") for (int e = 0; e < 4; ++e) { const int id = tid + 512 * e; const int pi = id / 528, rem = id % 528, rr = rem >> 3, pc = rem & 7; const int t = t0 - 1 + rr; \
        u32x4 v; v[0] = 0u; v[1] = 0u; v[2] = 0u; v[3] = 0u; if (id < 1584 && t >= 0 && t < Ls) v = *(const u32x4*)(PHY + (size_t)(row0 - 1 + rr) * 6144 + pi * 2048 + c0 + pc * 8); pre[e] = v; } } while (0)
    if ((int)blockIdx.x < nit) PC_LOAD((int)blockIdx.x);
    for (int it = blockIdx.x; it < nit; it += gridDim.x) {
      PC_DECODE(it) (void)Ls;
#pragma unroll
      for (int e = 0; e < 4; ++e) { const int id = tid + 512 * e; if (id < 1584) { const int pi = id / 528, rem = id % 528, rr = rem >> 3, pc = rem & 7; const u32x4 v = pre[e];
        float* d = in + (pi * 66 + rr) * 64 + pc * 8;
        *(float4*)d = make_float4(lo2f(v[0]), hi2f(v[0]), lo2f(v[1]), hi2f(v[1])); *(float4*)(d + 4) = make_float4(lo2f(v[2]), hi2f(v[2]), lo2f(v[3]), hi2f(v[3])); } }
      if (it + (int)gridDim.x < nit) PC_LOAD(it + (int)gridDim.x);
      __syncthreads();
      { const int cg8 = (tid & 7) * 8, tok = tid >> 3;
        float cv[3][8];
#pragma unroll
        for (int pi = 0; pi < 3; ++pi) { const float* wp = cw + pi * 2048 + c0 + cg8;
          const float4 ba = *(const float4*)(cb + pi * 2048 + c0 + cg8), bb = *(const float4*)(cb + pi * 2048 + c0 + cg8 + 4);
          cv[pi][0] = ba.x; cv[pi][1] = ba.y; cv[pi][2] = ba.z; cv[pi][3] = ba.w; cv[pi][4] = bb.x; cv[pi][5] = bb.y; cv[pi][6] = bb.z; cv[pi][7] = bb.w;
#pragma unroll
          for (int k = 0; k < 3; ++k) { const float4 wa = *(const float4*)(wp + k * 6144), wb = *(const float4*)(wp + k * 6144 + 4);
            const float* ip = in + (pi * 66 + tok + k) * 64 + cg8; const float4 xa = *(const float4*)ip, xb = *(const float4*)(ip + 4);
            cv[pi][0] += xa.x * wa.x; cv[pi][1] += xa.y * wa.y; cv[pi][2] += xa.z * wa.z; cv[pi][3] += xa.w * wa.w; cv[pi][4] += xb.x * wb.x; cv[pi][5] += xb.y * wb.y; cv[pi][6] += xb.z * wb.z; cv[pi][7] += xb.w * wb.w; } }
        u32x4 hvp, hxp;
#pragma unroll
        for (int e = 0; e < 4; ++e) { hvp[e] = pk2(cv[0][2 * e] * cv[2][2 * e], cv[0][2 * e + 1] * cv[2][2 * e + 1]); hxp[e] = pk2(cv[1][2 * e], cv[1][2 * e + 1]); }
        *(u32x4*)(HV + (size_t)(row0 + tok) * 2048 + c0 + cg8) = hvp; *(u32x4*)(HX0 + (size_t)(row0 + tok) * 2048 + c0 + cg8) = hxp;
#pragma unroll
        for (int e = 0; e < 4; ++e) { ut[(cg8 + 2 * e) * 66 + tok] = (bf16_t)(hvp[e] & 0xffffu); ut[(cg8 + 2 * e + 1) * 66 + tok] = (bf16_t)(hvp[e] >> 16); } }
      __syncthreads();
      { const int c = tid >> 3, pc = tid & 7; u32x4 o;
#pragma unroll
        for (int e = 0; e < 4; ++e) o[e] = (unsigned)ut[c * 66 + pc * 8 + 2 * e] | ((unsigned)ut[c * 66 + pc * 8 + 2 * e + 1] << 16);
        bf16_t* dst = isctx ? (bf16_t*)(p.ws + OFF_UTC) + ((size_t)(c0 + c) * NB + b) * CTXL + t0 + pc * 8 : (bf16_t*)(p.ws + OFF_UT) + ((size_t)(c0 + c) * NB + b) * SEQ + t0 + pc * 8;
        *(u32x4*)dst = o; }
    }
    __syncthreads();
#undef PC_DECODE
#undef PC_LOAD
  }
}

__device__ void phase_post(const Params& p, int l, unsigned char* shm, int mask) {
  const int tid = otid(p.wid), lane = tid & 63;
  const bf16_t* HV = (const bf16_t*)(p.ws + OFF_HV); const bf16_t* HX0 = (const bf16_t*)(p.ws + OFF_HX0); const bf16_t* PHG = (const bf16_t*)(p.ws + OFF_PHG);
  bf16_t* AH = (bf16_t*)(p.ws + OFF_H); const float* hbias = p.hy_bias + l * 2048;
  if (mask & 1) { float* yt = (float*)shm;
    const bf16_t* UT = (const bf16_t*)(p.ws + OFF_UT);
    const int nit = 256 * 32; u32x4 pre;
#define PA_LOAD(it_) do { const int tk_ = (it_) >> 5, c0_ = ((it_) & 31) * 64, b_ = tk_ >> 6, t0_ = (tk_ & 63) * 64; pre = *(const u32x4*)(UT + ((size_t)(c0_ + (tid >> 3)) * NB + b_) * SEQ + t0_ + (tid & 7) * 8); } while (0)
    if ((int)blockIdx.x < nit) PA_LOAD((int)blockIdx.x);
    for (int it = blockIdx.x; it < nit; it += gridDim.x) {
      const int tk = it >> 5, c0 = (it & 31) * 64, b = tk >> 6, t0 = (tk & 63) * 64, row0 = b * SEQ + t0;
      { const int c = tid >> 3, pc = tid & 7; const u32x4 v = pre; float* d = yt + (pc * 8) * 65 + c;
        d[0] = lo2f(v[0]); d[65] = hi2f(v[0]); d[130] = lo2f(v[1]); d[195] = hi2f(v[1]); d[260] = lo2f(v[2]); d[325] = hi2f(v[2]); d[390] = lo2f(v[3]); d[455] = hi2f(v[3]); }
      if (it + (int)gridDim.x < nit) PA_LOAD(it + (int)gridDim.x);
      __syncthreads();
      { const int cg8 = (tid & 7) * 8, tok = tid >> 3; const size_t o = (size_t)(row0 + tok) * 2048 + c0 + cg8;
        const u32x4 hv = *(const u32x4*)(HV + o), hx = *(const u32x4*)(HX0 + o), hg = *(const u32x4*)(PHG + o);
        const float4 ba = *(const float4*)(hbias + c0 + cg8), bb = *(const float4*)(hbias + c0 + cg8 + 4);
        const float hb[8] = {ba.x, ba.y, ba.z, ba.w, bb.x, bb.y, bb.z, bb.w}; const float* yp = yt + tok * 65 + cg8; u32x4 r;
#pragma unroll
        for (int e = 0; e < 4; ++e) { const float a0 = (yp[2 * e] + hb[2 * e] * lo2f(hv[e])) * lo2f(hx[e]) * siluf_(lo2f(hg[e])), a1 = (yp[2 * e + 1] + hb[2 * e + 1] * hi2f(hv[e])) * hi2f(hx[e]) * siluf_(hi2f(hg[e])); r[e] = pk2(a0, a1); }
        *(u32x4*)(AH + o) = r; }
      __syncthreads();
    }
#undef PA_LOAD
  }
  if (l == 0 && (mask & 2)) { float* gc = (float*)shm; float* us = gc + 32 * 512;
    const bf16_t* UTC = (const bf16_t*)(p.ws + OFF_UTC); const float* GC = (const float*)(p.ws + OFF_GC);
    for (int it = blockIdx.x; it < 16 * 64; it += gridDim.x) {
      const int tk = it >> 6, c0 = (it & 63) * 32, b = tk >> 2, t0 = (tk & 3) * 64, row0 = NLAT + b * CTXL + t0;
#pragma unroll 8
      for (int i = tid; i < 32 * 512; i += 512) gc[i] = GC[(size_t)(c0 + (i >> 9)) * 512 + (i & 511)];
#pragma unroll 8
      for (int i = tid; i < 32 * 256; i += 512) us[i] = bf2f(UTC[((size_t)(c0 + (i >> 8)) * NB + b) * CTXL + (i & 255)]);
      __syncthreads();
      { const int t = tid & 63, cg4 = tid >> 6;
#pragma unroll 1
        for (int e = 0; e < 4; ++e) { const int c = cg4 * 4 + e; const float* g = gc + c * 512 + 256 + t0 + t; const float* u = us + c * 256; float a = 0.f;
#pragma unroll 8
          for (int s = 0; s < 256; ++s) a += u[s] * g[-s];
          const size_t o = (size_t)(row0 + t) * 2048 + c0 + c; const float hv = bf2f(HV[o]);
          AH[o] = f2bf((a + hbias[c0 + c] * hv) * bf2f(HX0[o]) * siluf_(bf2f(PHG[o]))); } }
      __syncthreads();
    }
  }
  if (mask & 4) { bf16_t* OF = (bf16_t*)(p.ws + OFF_OF); const bf16_t* OB = (const bf16_t*)(p.ws + OFF_OB); const bf16_t* RG = (const bf16_t*)(p.ws + OFF_PRG);
    const int gw = blockIdx.x * 8 + (tid >> 6), nw = gridDim.x * 8; const int nrows = (l == 0) ? MT : NLAT;
#pragma unroll 2
    for (int it = gw; it < nrows * 8; it += nw) { const size_t o = (size_t)(it >> 3) * 4096 + (it & 7) * 512 + lane * 8;
      const u32x4 a = *(const u32x4*)(OF + o), bq = *(const u32x4*)(OB + o), g = *(const u32x4*)(RG + o);
      float v[8]; float ss = 0.f;
#pragma unroll
      for (int e = 0; e < 4; ++e) { v[2 * e] = lo2f(a[e]) + lo2f(bq[e]); v[2 * e + 1] = hi2f(a[e]) + hi2f(bq[e]); ss += v[2 * e] * v[2 * e] + v[2 * e + 1] * v[2 * e + 1]; }
      ss = wsum(ss, lane);
      const float rs = rsqrtf(ss * (1.f / 512.f) + 1e-6f);
      u32x4 r;
#pragma unroll
      for (int e = 0; e < 4; ++e) r[e] = pk2(v[2 * e] * rs * siluf_(lo2f(g[e])), v[2 * e + 1] * rs * siluf_(hi2f(g[e])));
      *(u32x4*)(OF + o) = r; }
  }
}

__device__ void phase_conv(const Params& p, int l, unsigned char* shm) {
  const int tid = otid(p.wid), lane = tid & 63, wid = tid >> 6;
  bf16_t* Gs = (bf16_t*)shm;
  bf16_t* Us = (bf16_t*)(shm + 2 * GLEN * 2);
  { unsigned zz = 0u; asm volatile("" : "+v"(zz)); u32x4 z; z[0] = zz; z[1] = zz; z[2] = zz; z[3] = zz; for (int i = tid; i < 2 * 4 * USTR / 8; i += 512) ((u32x4*)Us)[i] = z; }
  __syncthreads();
  const int ch = wid >> 2, q = wid & 3, i = lane & 31, g = lane >> 5, a_l = i >> 2, b = i & 3;
  const bf16_t* G = (const bf16_t*)(p.ws + OFF_G + (size_t)l * G_LAYER); bf16_t* UT = (bf16_t*)(p.ws + OFF_UT);
  const int mb = LOFF - i + 8 * g - 128 * (8 * q + 7);
  const unsigned sh = (unsigned)(mb & 1) * 16u;
  const unsigned* Gd = (const unsigned*)(Gs + ch * GLEN) + (mb >> 1);
  const bf16_t* Ub = Us + (ch * 4 + b) * USTR + 136 * (a_l + 1) + 8 * g;
#define CONV_LDFRAG(dst, n) do { const unsigned* q_ = Gd + 8 * (n); const unsigned d0 = q_[0], d1 = q_[1], d2 = q_[2], d3 = q_[3], d4 = q_[4]; u32x4 r_; \
    r_[0] = __builtin_amdgcn_alignbit(d1, d0, sh); r_[1] = __builtin_amdgcn_alignbit(d2, d1, sh); r_[2] = __builtin_amdgcn_alignbit(d3, d2, sh); r_[3] = __builtin_amdgcn_alignbit(d4, d3, sh); \
    dst = __builtin_bit_cast(bf16x8, r_); } while (0)
  for (int pr = blockIdx.x; pr < 1024; pr += gridDim.x) {
    for (int id = tid; id < 2 * (GLEN / 2); id += 512) { const int cc = id / (GLEN / 2), dw = id % (GLEN / 2);
      unsigned v = ((const unsigned*)(G + (size_t)(pr * 2 + cc) * GLEN))[dw]; const int m = dw * 2;
      if (m < 33 || m > 8223) v &= 0xffff0000u; if (m + 1 < 33 || m + 1 > 8223) v &= 0x0000ffffu;
      ((unsigned*)Gs)[cc * (GLEN / 2) + dw] = v; }
    for (int id = tid; id < 2 * 4 * 512; id += 512) { const int cc = id >> 11, bb = (id >> 9) & 3, s8 = id & 511;
      const u32x4 v = *(const u32x4*)(UT + ((size_t)(pr * 2 + cc) * 4 + bb) * SEQ + s8 * 8); const int sp = 1024 + s8 * 8;
      *(u32x4*)(Us + (cc * 4 + bb) * USTR + sp + 8 * (sp >> 7)) = v; }
    __syncthreads();
    bf16x8 W[8]; f32x16 acc[4];
#pragma unroll
    for (int h = 0; h < 4; ++h)
#pragma unroll
      for (int e = 0; e < 16; ++e) acc[h][e] = 0.f;
    CONV_LDFRAG(W[2], -6); CONV_LDFRAG(W[3], -5); CONV_LDFRAG(W[4], -4); CONV_LDFRAG(W[5], -3); CONV_LDFRAG(W[6], -2); CONV_LDFRAG(W[7], -1);
#pragma unroll 1
    for (int it = 0; it < 39; ++it) {
#pragma unroll
      for (int u = 0; u < 8; ++u) {
        CONV_LDFRAG(W[u], it * 8 + u);
        const bf16x8 bf = *(const bf16x8*)(Ub + 136 * it + 16 * u);
#pragma unroll
        for (int h = 0; h < 4; ++h) acc[h] = __builtin_amdgcn_mfma_f32_32x32x16_bf16(W[(u - 2 * h) & 7], bf, acc[h], 0, 0, 0);
      }
    }
    { bf16_t* yrow = UT + ((size_t)(pr * 2 + ch) * 4 + b) * SEQ + 128 * (8 * q + a_l) + 4 * g;
#pragma unroll
      for (int h = 0; h < 4; ++h)
#pragma unroll
        for (int rq = 0; rq < 4; ++rq) { u32x2 o; o[0] = pk2(acc[h][4 * rq], acc[h][4 * rq + 1]); o[1] = pk2(acc[h][4 * rq + 2], acc[h][4 * rq + 3]); *(u32x2*)(yrow + 32 * h + 8 * rq) = o; } }
    __syncthreads();
  }
#undef CONV_LDFRAG
}

template <int KD> DI f32x16 mma_tile(f32x16 acc, const bf16_t* A, int lda, const bf16_t* B, int ldb, int lane) {
  const int r = lane & 31, g8 = (lane >> 5) * 8; const bf16_t* ap = A + r * lda + g8; const bf16_t* bp = B + r * ldb + g8;
#pragma unroll 4
  for (int k0 = 0; k0 < KD; k0 += 16) acc = __builtin_amdgcn_mfma_f32_32x32x16_bf16(*(const bf16x8*)(ap + k0), *(const bf16x8*)(bp + k0), acc, 0, 0, 0);
  return acc;
}
__device__ void phase_ret(const Params& p, int l, unsigned char* shm) {
  constexpr int QS = 264, TS = 72;
  const int tid = otid(p.wid), lane = tid & 63, wid = tid >> 6, g = lane >> 5;
  bf16_t* Qs = (bf16_t*)shm; bf16_t* Ks = Qs + 64 * QS; bf16_t* Kts = Ks + 64 * QS; bf16_t* Vts = Kts + 256 * TS; bf16_t* Ps = Vts + 64 * TS; bf16_t* Sts = Ps + 64 * TS;
  const bf16_t* PQ = (const bf16_t*)(p.ws + OFF_PQ); const bf16_t* PK = (const bf16_t*)(p.ws + OFF_PK);
  const bf16_t* KT = (const bf16_t*)(p.ws + OFF_KT); const bf16_t* VT = (const bf16_t*)(p.ws + OFF_VT);
  for (int it0 = blockIdx.x; it0 < 512; it0 += gridDim.x) {
    int it = it0;
    if (gridDim.x == 256) { const int xcd = it0 & 7, idx = (it0 >> 3) & 31, r = it0 >> 8; it = ((xcd + 8 * ((idx >> 3) + 4 * r)) << 3) | (idx & 7); }
    const int sl = it & 7, dir = (it >> 3) & 1, h = (it >> 4) & 7, b = it >> 7;
    const float lg = -expf(p.ret_decay[(l * 2 + dir) * 8 + h]);
    bf16_t* O = (bf16_t*)(p.ws + (dir ? OFF_OB : OFF_OF));
    for (int i = tid; i < 64 * QS / 2; i += 512) ((unsigned*)Sts)[i] = 0u;
    f32x16 S[4], cross;
#pragma unroll
    for (int x = 0; x < 4; ++x)
#pragma unroll
      for (int e = 0; e < 16; ++e) S[x][e] = 0.f;
#pragma unroll
    for (int e = 0; e < 16; ++e) cross[e] = 0.f;
    const float cd = __expf(lg * 64.f);
    const int tid2 = otid(p.wid), ln2 = tid2 & 63, g2 = ln2 >> 5;
    const int pc8 = tid2 & 7;
    float dk[8], mk[16];
#pragma unroll
    for (int w = 0; w < 8; ++w) { const int tok = pc8 * 8 + w; dk[w] = __expf(lg * (float)(dir ? tok : 63 - tok)); }
    const int wq = (tid2 >> 6) & 3, t_hi = wq >> 1, t_lo = wq & 1;
    { const int i = t_lo * 32 + (ln2 & 31);
#pragma unroll
      for (int e = 0; e < 16; ++e) { const int j = t_hi * 32 + (e & 3) + 8 * (e >> 2) + 4 * g2; const int diff = dir ? (j - i) : (i - j); mk[e] = diff >= 0 ? __expf(lg * (float)(dir ? -i : i - 63)) : 0.f; } }
    const int qi = t_hi * 32 + (ln2 & 31);
    const float qd = __expf(lg * (float)(dir ? 64 - qi : qi + 1));
    u32x4 rq[4], rk[4], rt[4], rv;
    const unsigned qo_l = (unsigned)(tid >> 5) * 2048u + (unsigned)(h * 256 + (tid & 31) * 8);
    const unsigned ko_l = (unsigned)((b * 8 + h) * 256 + (tid >> 3)) * (unsigned)TT + (unsigned)(pc8 * 8);
    const unsigned vo_l = (unsigned)((b * 8 + h) * 512 + sl * 64 + (tid >> 3)) * (unsigned)TT + (unsigned)(pc8 * 8);
#define RET_CHUNK(step_, isctx_, t0_) do { if ((step_) < 4) { isctx_ = true; t0_ = (dir ? 3 - (step_) : (step_)) * 64; } else { isctx_ = false; const int cn_ = (step_) - 4; t0_ = (dir ? 63 - cn_ : cn_) * 64; } } while (0)
#define RET_LOAD(step_) do { bool ic_; int t0n_; RET_CHUNK(step_, ic_, t0n_); const unsigned r0_ = (unsigned)tok_row(b, t0n_, ic_) * 2048u + qo_l; const unsigned tt_ = (unsigned)(ic_ ? t0n_ : CTXL + t0n_); \
      _Pragma("unroll") for (int e = 0; e < 4; ++e) { rq[e] = *(const u32x4*)(PQ + (r0_ + (unsigned)e * 32768u)); rk[e] = *(const u32x4*)(PK + (r0_ + (unsigned)e * 32768u)); rt[e] = *(const u32x4*)(KT + (ko_l + tt_ + (unsigned)e * (unsigned)(64 * TT))); } \
      rv = *(const u32x4*)(VT + (vo_l + tt_)); } while (0)
    RET_LOAD(0);
#pragma unroll 1
    for (int step = 0; step < 68; ++step) {
      bool isctx; int t0; RET_CHUNK(step, isctx, t0);
      const int row0 = tok_row(b, t0, isctx);
      __syncthreads();
#pragma unroll
      for (int e = 0; e < 4; ++e) { const int row = (tid >> 5) + 16 * e, pc = tid & 31;
        *(u32x4*)(Qs + row * QS + pc * 8) = rq[e]; *(u32x4*)(Ks + row * QS + pc * 8) = rk[e];
        *(u32x4*)(Kts + ((tid >> 3) + 64 * e) * TS + pc8 * 8) = rt[e]; }
      { u32x4 o;
#pragma unroll
        for (int w = 0; w < 4; ++w) o[w] = pk2(lo2f(rv[w]) * dk[2 * w], hi2f(rv[w]) * dk[2 * w + 1]);
        *(u32x4*)(Vts + (tid >> 3) * TS + pc8 * 8) = o; }
      if (step + 1 < 68) RET_LOAD(step + 1);
      __syncthreads();
      if (wid < 4) {
        f32x16 sc;
#pragma unroll
        for (int e = 0; e < 16; ++e) sc[e] = 0.f;
        sc = mma_tile<256>(sc, Ks + t_hi * 32 * QS, QS, Qs + t_lo * 32 * QS, QS, lane);
        const int i = t_lo * 32 + (lane & 31);
#pragma unroll
        for (int r4 = 0; r4 < 4; ++r4) { u32x2 o; o[0] = pk2(sc[4 * r4] * mk[4 * r4], sc[4 * r4 + 1] * mk[4 * r4 + 1]); o[1] = pk2(sc[4 * r4 + 2] * mk[4 * r4 + 2], sc[4 * r4 + 3] * mk[4 * r4 + 3]);
          *(u32x2*)(Ps + i * TS + t_hi * 32 + 8 * r4 + 4 * g) = o; }
      } else {
#pragma unroll
        for (int e = 0; e < 16; ++e) cross[e] = 0.f;
        cross = mma_tile<256>(cross, Sts + t_lo * 32 * QS, QS, Qs + t_hi * 32 * QS, QS, lane);
      }
      __syncthreads();
      if (wid < 4) {
#pragma unroll
        for (int x = 0; x < 4; ++x) { const int td = 2 * wid + (x >> 1), tc = x & 1;
#pragma unroll
          for (int e = 0; e < 16; ++e) S[x][e] *= cd;
          S[x] = mma_tile<64>(S[x], Kts + td * 32 * TS, TS, Vts + tc * 32 * TS, TS, lane);
          const int c = tc * 32 + (lane & 31);
#pragma unroll
          for (int r4 = 0; r4 < 4; ++r4) { u32x2 o; o[0] = pk2(S[x][4 * r4], S[x][4 * r4 + 1]); o[1] = pk2(S[x][4 * r4 + 2], S[x][4 * r4 + 3]); *(u32x2*)(Sts + c * QS + td * 32 + 8 * r4 + 4 * g) = o; } }
      } else {
        f32x16 in_;
#pragma unroll
        for (int e = 0; e < 16; ++e) in_[e] = 0.f;
        in_ = mma_tile<64>(in_, Vts + t_lo * 32 * TS, TS, Ps + t_hi * 32 * TS, TS, lane);
        const unsigned ob = (unsigned)(row0 + qi) * 4096u + (unsigned)(h * 512 + sl * 64 + t_lo * 32 + 4 * g);
#pragma unroll
        for (int r4 = 0; r4 < 4; ++r4) { u32x2 o; o[0] = pk2(in_[4 * r4] + qd * cross[4 * r4], in_[4 * r4 + 1] + qd * cross[4 * r4 + 1]); o[1] = pk2(in_[4 * r4 + 2] + qd * cross[4 * r4 + 2], in_[4 * r4 + 3] + qd * cross[4 * r4 + 3]);
          *(u32x2*)(O + (ob + (unsigned)(8 * r4))) = o; }
      }
    }
    __syncthreads();
  }
#undef RET_CHUNK
#undef RET_LOAD
}

__global__ void __launch_bounds__(512, 2) mega(Params p_in) {
  Params p = p_in; p.wid = __builtin_amdgcn_readfirstlane((int)(threadIdx.x >> 6));
  extern __shared__ __attribute__((aligned(16))) unsigned char shm[];
  cg::grid_group grid = cg::this_grid();
  PG8_LAS unsigned char* lds = (PG8_LAS unsigned char*)shm;
  const bf16_t* H = (const bf16_t*)(p.ws + OFF_H);
#pragma unroll 1
  for (int rep = 0; rep < (PROBE == 1 ? 2 : 1); ++rep) { phase_filters(p, shm); phase_mod(p, shm); }
  grid.sync();
  for (int l = 0; l < 2; ++l) {
#pragma unroll 1
    for (int rep = 0; rep < (PROBE == 1 ? 2 : 1); ++rep) { phase_cvt(p, l, shm); phase_norm(p, l); }
    grid.sync();
    { pg8::Gemm g; g.wid = p.wid; g.A = H; g.Bt = (const bf16_t*)(p.ws + OFF_WTIN); g.M = MT; g.N = INW; g.K = DM;
      pg8::Order S; S.init(64, 96, (int)gridDim.x, (int)blockIdx.x, 4, l == 0 ? 96 : 24, l == 0 ? 0 : 8);
      EpiG1 E; E.ws = p.ws; pg8::gemm_phase<EpiG1, pg8::Order>(lds, g, S, E); }
    grid.sync();
#pragma unroll 1
    for (int rep = 0; rep < (PROBE == 2 ? 2 : 1); ++rep) phase_prep(p, l, shm, rep ? 4 : 7);
    grid.sync();
    phase_conv(p, l, shm); phase_ret(p, l, shm);
    grid.sync();
#pragma unroll 1
    for (int rep = 0; rep < (PROBE == 2 ? 2 : 1); ++rep) phase_post(p, l, shm, rep ? 3 : 7);
    grid.sync();
    { const int nM = (l == 0) ? 68 : 64;
      pg8::Order S; S.init(nM, 8, (int)gridDim.x, (int)blockIdx.x, 0, 0, 0);
      { pg8::Gemm g; g.wid = p.wid; g.A = H; g.Bt = (const bf16_t*)(p.ws + OFF_WTHY); g.M = nM * 256; g.N = DM; g.K = DM; EpiG23<0> E; E.ws = p.ws; pg8::gemm_phase<EpiG23<0>, pg8::Order>(lds, g, S, E); }
      { pg8::Gemm g; g.wid = p.wid; g.A = (const bf16_t*)(p.ws + OFF_OF); g.Bt = (const bf16_t*)(p.ws + OFF_WTRET); g.M = nM * 256; g.N = DM; g.K = 4096; EpiG23<1> E; E.ws = p.ws; pg8::gemm_phase<EpiG23<1>, pg8::Order>(lds, g, S, E); }
      grid.sync();
      { pg8::Gemm g; g.wid = p.wid; g.A = (const bf16_t*)(p.ws + OFF_T1); g.Bt = (const bf16_t*)(p.ws + OFF_WTO); g.M = nM * 256; g.N = DM; g.K = DM;
        EpiG4 E; E.xin = (l == 0) ? p.x : p.out; E.cin = p.ctx; E.xout = p.out; E.cout = (float*)(p.ws + OFF_CTXR); E.mod = (const float*)(p.ws + OFF_MOD) + (size_t)l * 5 * 6144;
        pg8::gemm_phase<EpiG4, pg8::Order>(lds, g, S, E); } }
    grid.sync();
  }
  phase_final(p);
}

extern "C" void kernel_launch(void* const* d_in, const int* in_sizes, int n_in, void* d_out, int out_size, void* d_ws, size_t ws_size, hipStream_t stream) {
  constexpr size_t kDynLds = 157696;
  static int grid_blocks = 0;
  if (!grid_blocks) {
    hipFuncSetAttribute((const void*)mega, hipFuncAttributeMaxDynamicSharedMemorySize, (int)kDynLds);
    int dev = 0, cus = 0, per_cu = 0;
    hipGetDevice(&dev);
    hipDeviceGetAttribute(&cus, hipDeviceAttributeMultiprocessorCount, dev);
    hipOccupancyMaxActiveBlocksPerMultiprocessor(&per_cu, (const void*)mega, 512, kDynLds);
    grid_blocks = cus * (per_cu >= 1 ? 1 : 0);
    if (ws_size < WS_NEED || grid_blocks <= 0) { fprintf(stderr, "workspace %zu < %zu or no occupancy (%d)\n", ws_size, (size_t)WS_NEED, per_cu); grid_blocks = grid_blocks > 0 ? grid_blocks : 256; }
  }
  Params p{};
  p.x = (const float*)d_in[0]; p.c = (const float*)d_in[1]; p.ctx = (const float*)d_in[2]; p.c_ctx = (const float*)d_in[3]; p.ln_g = (const float*)d_in[4];
  p.ada_w = (const float*)d_in[5]; p.ada_b = (const float*)d_in[6]; p.w_in = (const float*)d_in[7]; p.conv_w = (const float*)d_in[8]; p.conv_b = (const float*)d_in[9];
  p.fw1 = (const float*)d_in[10]; p.fb1 = (const float*)d_in[11]; p.fw2 = (const float*)d_in[12]; p.fb2 = (const float*)d_in[13]; p.fw3 = (const float*)d_in[14]; p.fb3 = (const float*)d_in[15];
  p.ffreq = (const float*)d_in[16]; p.fwout = (const float*)d_in[17]; p.hy_bias = (const float*)d_in[18]; p.ret_decay = (const float*)d_in[19];
  p.w_hy_out = (const float*)d_in[20]; p.w_ret_out = (const float*)d_in[21]; p.w_o = (const float*)d_in[22]; p.final_g = (const float*)d_in[23];
  p.out = (float*)d_out; p.ws = (unsigned char*)d_ws;
  void* args[] = {&p};
  hipError_t e = hipLaunchCooperativeKernel((void*)mega, dim3(grid_blocks), dim3(512), args, kDynLds, stream);
  if (e != hipSuccess) fprintf(stderr, "cooperative launch failed: %s (grid %d)\n", hipGetErrorString(e), grid_blocks);
}
```

```cpp
#include <hip/hip_runtime.h>
#include <hip/hip_cooperative_groups.h>
#include <cstdio>
namespace cg = cooperative_groups;
#ifndef PROBE
#define PROBE 0
#endif

typedef unsigned short bf16_t;
typedef short bf16x8 __attribute__((ext_vector_type(8)));
typedef float f32x4 __attribute__((ext_vector_type(4)));
typedef float f32x16 __attribute__((ext_vector_type(16)));
typedef unsigned u32x4 __attribute__((ext_vector_type(4)));
typedef unsigned u32x2 __attribute__((ext_vector_type(2)));
typedef short s16x4 __attribute__((ext_vector_type(4)));
#define DI __device__ __forceinline__

DI int otid(int wid) { int t; asm volatile("v_mbcnt_lo_u32_b32 %0, -1, 0\n\tv_mbcnt_hi_u32_b32 %0, -1, %0" : "=v"(t)); return wid * 64 + t; }
DI float wsum(float v, int lane) {
#pragma unroll
  for (int o = 32; o > 0; o >>= 1) v += __int_as_float(__builtin_amdgcn_ds_bpermute((lane ^ o) << 2, __float_as_int(v)));
  return v; }
DI float bf2f(bf16_t u) { return __uint_as_float(((unsigned)u) << 16); }
typedef __bf16 bf16v2 __attribute__((ext_vector_type(2)));
typedef float f32v2 __attribute__((ext_vector_type(2)));
DI unsigned pk2(float lo, float hi) { f32v2 v = {lo, hi}; bf16v2 b = __builtin_convertvector(v, bf16v2); return __builtin_bit_cast(unsigned, b); }
DI bf16_t f2bf(float f) { return (bf16_t)(pk2(f, 0.f) & 0xffffu); }
DI float lo2f(unsigned u) { return __uint_as_float(u << 16); }
DI float hi2f(unsigned u) { return __uint_as_float(u & 0xffff0000u); }
DI float sigmoidf_(float v) { return 1.f / (1.f + __expf(-v)); }
DI float siluf_(float v) { return v / (1.f + __expf(-v)); }

constexpr int DM = 2048, NB = 4, SEQ = 4096, CTXL = 256, NLAT = NB * SEQ, NCTX = NB * CTXL, MT = NLAT + NCTX;
constexpr int INW = 24576, NH = 8, DK = 256, DV = 512, TT = SEQ + CTXL;
constexpr int LOFF = 4128, GLEN = 8320;      constexpr size_t G_LAYER = ((size_t)2048 * 8320 * 2 + 255) & ~(size_t)255;
constexpr int USTR = 6560;

constexpr size_t AL(size_t x) { return (x + 255) & ~(size_t)255; }
constexpr size_t OFF_WTIN = 0;
constexpr size_t OFF_WTHY = OFF_WTIN + AL((size_t)INW * DM * 2);
constexpr size_t OFF_WTRET = OFF_WTHY + AL((size_t)DM * DM * 2);
constexpr size_t OFF_WTO = OFF_WTRET + AL((size_t)DM * 4096 * 2);
constexpr size_t OFF_G = OFF_WTO + AL((size_t)DM * DM * 2);
constexpr size_t OFF_GC = OFF_G + 2 * AL((size_t)DM * GLEN * 2);
constexpr size_t OFF_MOD = OFF_GC + AL((size_t)DM * 512 * 4);
constexpr size_t OFF_H = OFF_MOD + AL((size_t)2 * 5 * 6144 * 4);
constexpr size_t OFF_PQ = OFF_H + AL((size_t)MT * DM * 2);
constexpr size_t OFF_PK = OFF_PQ + AL((size_t)MT * DM * 2);
constexpr size_t OFF_PV = OFF_PK + AL((size_t)MT * DM * 2);
constexpr size_t OFF_PRG = OFF_PV + AL((size_t)MT * 4096 * 2);
constexpr size_t OFF_PHY = OFF_PRG + AL((size_t)MT * 4096 * 2);
constexpr size_t OFF_PHG = OFF_PHY + AL((size_t)MT * 6144 * 2);
constexpr size_t OFF_PMG = OFF_PHG + AL((size_t)MT * DM * 2);
constexpr size_t OFF_KT = OFF_PMG + AL((size_t)MT * 4096 * 2);
constexpr size_t OFF_VT = OFF_KT + AL((size_t)NB * NH * DK * TT * 2);
constexpr size_t OFF_UT = OFF_VT + AL((size_t)NB * NH * DV * TT * 2);
constexpr size_t OFF_UTC = OFF_UT + AL((size_t)DM * NB * SEQ * 2);
constexpr size_t OFF_HV = OFF_UTC + AL((size_t)DM * NB * CTXL * 2);
constexpr size_t OFF_HX0 = OFF_HV + AL((size_t)MT * DM * 2);
constexpr size_t OFF_CTXR = OFF_HX0 + AL((size_t)MT * DM * 2);
constexpr size_t WS_NEED = OFF_CTXR + AL((size_t)NCTX * DM * 4);
constexpr size_t OFF_OF = OFF_KT, OFF_OB = OFF_PHY, OFF_T1 = OFF_PHY + AL((size_t)MT * 4096 * 2);

struct Params {
  const float *x, *c, *ctx, *c_ctx, *ln_g, *ada_w, *ada_b, *w_in, *conv_w, *conv_b, *fw1, *fb1, *fw2, *fb2, *fw3, *fb3, *ffreq, *fwout, *hy_bias, *ret_decay, *w_hy_out, *w_ret_out, *w_o, *final_g;
  float* out;
  unsigned char* ws;
  int wid, pad_;
};

namespace pg8 {
#define PG8_LAS __attribute__((address_space(3)))
constexpr int BM = 256, BK = 64, HALF = 128, HTB = HALF * BK * 2, STAGE_BYTES = 8 * HTB, NXCD = 8, WGM = 8;
__host__ __device__ __forceinline__ int lds_byte(int r, int c) { const int st = (r >> 4) * 2 + (c >> 5), rr = r & 15, cc = c & 31, ob = rr * 64 + cc * 2; return st * 1024 + (ob ^ (((ob >> 9) & 1) << 5)); }
__host__ __device__ __forceinline__ void stage_rc(int b, int& R, int& C) { const int st = b / 1024, sb = b % 1024, swz = sb ^ (((sb >> 9) & 1) << 5); R = (st >> 1) * 16 + swz / 64; C = (st & 1) * 32 + (swz % 64) / 2; }
__host__ __device__ __forceinline__ int perm32(int rho) { const int n = rho >> 4, i = rho & 15; return 8 * (i >> 2) + 4 * n + (i & 3); }
struct Unit { int pm, pn; };
struct Gemm { const bf16_t* A; const bf16_t* Bt; int M, N, K, wid; };
struct Order {
    int nM, nN, nwg, G, c, nx_m, nx_n, x_pn0;
    __device__ void init(int nM_, int nN_, int G_, int c_, int nx_m_, int nx_n_, int x_pn0_) { nM = nM_; nN = nN_; nwg = nM * nN; G = G_; c = c_; nx_m = nx_m_; nx_n = nx_n_; x_pn0 = x_pn0_; }
    __device__ bool next(int i, Unit& u) const {
        const long L = (long)i * G + c;
        if (L >= nwg) { const int e = (int)(L - nwg); if (e >= nx_m * nx_n) return false; u.pm = nM + e % nx_m; u.pn = x_pn0 + e / nx_m; return true; }
        int wgid = (int)L; { const int q = nwg / NXCD, r = nwg % NXCD, xcd = wgid % NXCD, off = wgid / NXCD; wgid = (xcd < r ? xcd * (q + 1) : r * (q + 1) + (xcd - r) * q) + off; }
        const int nig = WGM * nN, gid = wgid / nig, fm = gid * WGM, gsz = (nM - fm) < WGM ? (nM - fm) : WGM;
        u.pm = fm + ((wgid % nig) % gsz); u.pn = (wgid % nig) / gsz; return true;
    }
    __device__ __forceinline__ void a_ready(const Unit&) const {}
    __device__ __forceinline__ void done(const Unit&) const {}
};
template <class Epi, class Sched>
__device__ __forceinline__ void gemm_phase(PG8_LAS unsigned char* lds, const Gemm g, const Sched& S, const Epi& E) {
    const int tid = otid(g.wid), wid = __builtin_amdgcn_readfirstlane(tid >> 6), lane = tid & 63, wr = wid >> 2, wc = wid & 3, fr = lane & 15, fq = lane >> 4;
    const int K = g.K, nt = K / BK;
    unsigned voffA[2], voffB[2];
#pragma unroll
    for (int i = 0; i < 2; ++i) { int R, C; stage_rc(tid * 16 + i * 8192, R, C); const int Rb = Epi::PERM ? ((R & ~31) + perm32(R & 31)) : R;
        voffA[i] = (unsigned)(R * K + C) * 2u; voffB[i] = (unsigned)(Rb * K + C) * 2u; }
    const size_t kstep = (size_t)(BK * 2);
    const size_t hstep = (size_t)HALF * K * 2;
    const size_t tstep = 2 * hstep;
    const unsigned ldsw = (unsigned)wid * 1024u;
    const int aoff = lds_byte(wr * 64 + fr, fq * 8), boff = lds_byte(wc * 32 + fr, fq * 8);
#define PG8_SA(b, h) (((b) * 2 + (h)) * HTB)
#define PG8_SB(b, h) ((4 + (b) * 2 + (h)) * HTB)
#define PG8_STAGE(bufoff, gbase, voff) do { _Pragma("unroll") for (int _i = 0; _i < 2; ++_i) \
        __builtin_amdgcn_global_load_lds((const unsigned*)((const char*)(gbase) + (voff)[_i]), (PG8_LAS unsigned*)(lds + (bufoff) + ldsw + _i * 8192), 16, 0, 0); } while (0)
#define PG8_LDA(dst, b, h) do { _Pragma("unroll") for (int m = 0; m < 4; ++m) _Pragma("unroll") for (int k = 0; k < 2; ++k) dst[m][k] = *(const PG8_LAS bf16x8*)(lds + PG8_SA(b, h) + aoff + m * 2048 + k * 1024); } while (0)
#define PG8_LDB(dst, b, h) do { _Pragma("unroll") for (int n = 0; n < 2; ++n) _Pragma("unroll") for (int k = 0; k < 2; ++k) dst[n][k] = *(const PG8_LAS bf16x8*)(lds + PG8_SB(b, h) + boff + n * 2048 + k * 1024); } while (0)
#define PG8_MMA(ai, bj, At, Bt) do { __builtin_amdgcn_s_setprio(1); _Pragma("unroll") for (int m = 0; m < 4; ++m) _Pragma("unroll") for (int n = 0; n < 2; ++n) _Pragma("unroll") for (int k = 0; k < 2; ++k) \
        acc[ai][bj][m][n] = __builtin_amdgcn_mfma_f32_16x16x32_bf16(Bt[n][k], At[m][k], acc[ai][bj][m][n], 0, 0, 0); __builtin_amdgcn_s_setprio(0); } while (0)
#define PG8_WAIT_V(n) asm volatile("s_waitcnt vmcnt(" #n ")" ::: "memory")
#define PG8_WAIT_L(n) asm volatile("s_waitcnt lgkmcnt(" #n ")" ::: "memory")
#define PG8_BAR __builtin_amdgcn_s_barrier()
#define PG8_SCHED __builtin_amdgcn_sched_barrier(0)
    Unit cur, nxt; int ui = 0;
    if (!S.next(0, cur)) return;
    f32x4 acc[2][2][4][2];
#pragma unroll
    for (int a = 0; a < 2; ++a)
#pragma unroll
        for (int b = 0; b < 2; ++b)
#pragma unroll
            for (int m = 0; m < 4; ++m)
#pragma unroll
                for (int n = 0; n < 2; ++n) acc[a][b][m][n] = (f32x4){0.f, 0.f, 0.f, 0.f};
    bf16x8 At[4][2], B0[2][2], B1[2][2];
    const char* cA = (const char*)g.A + (size_t)cur.pm * tstep; const char* cB = (const char*)g.Bt + (size_t)cur.pn * tstep;
    S.a_ready(cur);
    PG8_STAGE(PG8_SB(0, 0), cB, voffB); PG8_STAGE(PG8_SA(0, 0), cA, voffA); PG8_STAGE(PG8_SB(0, 1), cB + hstep, voffB); PG8_STAGE(PG8_SA(0, 1), cA + hstep, voffA);
    if (wr == 1) PG8_BAR;
    PG8_WAIT_V(4); PG8_BAR;
    PG8_STAGE(PG8_SB(1, 0), cB + kstep, voffB); PG8_STAGE(PG8_SA(1, 0), cA + kstep, voffA); PG8_STAGE(PG8_SB(1, 1), cB + hstep + kstep, voffB);
    PG8_WAIT_V(6); PG8_BAR;
    for (;;) {
        const bool has_next = S.next(ui + 1, nxt);
        const char* nA = has_next ? (const char*)g.A + (size_t)nxt.pm * tstep : cA; const char* nB = has_next ? (const char*)g.Bt + (size_t)nxt.pn * tstep : cB;
        for (int t = 0; t < nt; t += 2) {
            const bool last = (t == nt - 2);
            const char* a1 = cA + (size_t)(t + 1) * kstep;
            const char* a2 = last ? nA : cA + (size_t)(t + 2) * kstep; const char* b2 = last ? nB : cB + (size_t)(t + 2) * kstep;
            const char* a3 = a2 + kstep; const char* b3 = b2 + kstep;
            if (last && has_next) S.a_ready(nxt);
            PG8_LDB(B0, 0, 0); PG8_SCHED; PG8_LDA(At, 0, 0); PG8_STAGE(PG8_SA(1, 1), a1 + hstep, voffA);
            PG8_WAIT_L(8); PG8_BAR; PG8_WAIT_L(0); PG8_MMA(0, 0, At, B0); PG8_BAR; PG8_SCHED;
            PG8_LDB(B1, 0, 1); PG8_STAGE(PG8_SB(0, 0), b2, voffB);
            PG8_BAR; PG8_WAIT_L(0); PG8_MMA(0, 1, At, B1); PG8_BAR;
            PG8_LDA(At, 0, 1); PG8_STAGE(PG8_SA(0, 0), a2, voffA);
            PG8_BAR; PG8_WAIT_L(0); PG8_MMA(1, 0, At, B0); PG8_BAR; PG8_SCHED;
            PG8_STAGE(PG8_SB(0, 1), b2 + hstep, voffB);
            PG8_WAIT_V(6); PG8_BAR; PG8_MMA(1, 1, At, B1); PG8_BAR;
            PG8_LDB(B0, 1, 0); PG8_SCHED; PG8_LDA(At, 1, 0); PG8_STAGE(PG8_SA(0, 1), a2 + hstep, voffA);
            PG8_WAIT_L(8); PG8_BAR; PG8_WAIT_L(0); PG8_MMA(0, 0, At, B0); PG8_BAR; PG8_SCHED;
            PG8_LDB(B1, 1, 1); PG8_STAGE(PG8_SB(1, 0), b3, voffB);
            PG8_BAR; PG8_WAIT_L(0); PG8_MMA(0, 1, At, B1); PG8_BAR;
            PG8_LDA(At, 1, 1); PG8_STAGE(PG8_SA(1, 0), a3, voffA);
            PG8_BAR; PG8_WAIT_L(0); PG8_MMA(1, 0, At, B0); PG8_BAR; PG8_SCHED;
            PG8_STAGE(PG8_SB(1, 1), b3 + hstep, voffB);
            PG8_WAIT_V(6); PG8_BAR; PG8_MMA(1, 1, At, B1); PG8_BAR;
        }
        if constexpr (!Epi::AFTER_DRAIN) { E(acc, cur, wr, wc, fr, fq); S.done(cur); }
        if (!has_next) break;
#pragma unroll
        for (int a = 0; a < 2; ++a)
#pragma unroll
            for (int b = 0; b < 2; ++b)
#pragma unroll
                for (int m = 0; m < 4; ++m)
#pragma unroll
                    for (int n = 0; n < 2; ++n) acc[a][b][m][n] = (f32x4){0.f, 0.f, 0.f, 0.f};
        cur = nxt; cA = nA; cB = nB; ++ui;
    }
    PG8_WAIT_V(0);
    if (wr == 0) PG8_BAR;
    PG8_BAR;
    if constexpr (Epi::AFTER_DRAIN) { E.fused(acc, cur, wr, wc, fr, fq, lds, wid, lane); S.done(cur); }
#undef PG8_SA
#undef PG8_SB
#undef PG8_STAGE
#undef PG8_LDA
#undef PG8_LDB
#undef PG8_MMA

#undef PG8_WAIT_V
#undef PG8_WAIT_L
#undef PG8_BAR
#undef PG8_SCHED
}
}

struct EpiG1 {
  static constexpr bool PERM = true, AFTER_DRAIN = false;
  unsigned char* ws;
  DI void operator()(const f32x4 (&acc)[2][2][4][2], const pg8::Unit& u, int wr, int wc, int fr, int fq) const {
    const int pn = u.pn; size_t off; int ld, c0;
    if (pn < 8) { off = OFF_PQ; ld = 2048; c0 = pn * 256; }
    else if (pn < 16) { off = OFF_PK; ld = 2048; c0 = (pn - 8) * 256; }
    else if (pn < 32) { off = OFF_PV; ld = 4096; c0 = (pn - 16) * 256; }
    else if (pn < 48) { off = OFF_PRG; ld = 4096; c0 = (pn - 32) * 256; }
    else if (pn < 72) { off = OFF_PHY; ld = 6144; c0 = (pn - 48) * 256; }
    else if (pn < 80) { off = OFF_PHG; ld = 2048; c0 = (pn - 72) * 256; }
    else { off = OFF_PMG; ld = 4096; c0 = (pn - 80) * 256; }
    bf16_t* base = (bf16_t*)(ws + off);
    const int row0 = u.pm * 256 + wr * 64 + fr, col0 = c0 + wc * 32 + 8 * fq;
#pragma unroll
    for (int ai = 0; ai < 2; ++ai)
#pragma unroll
      for (int m = 0; m < 4; ++m) { bf16_t* rowp = base + (size_t)(row0 + ai * 128 + m * 16) * ld + col0;
#pragma unroll
        for (int bj = 0; bj < 2; ++bj) { const f32x4 v0 = acc[ai][bj][m][0], v1 = acc[ai][bj][m][1];
          u32x4 o; o[0] = pk2(v0[0], v0[1]); o[1] = pk2(v0[2], v0[3]); o[2] = pk2(v1[0], v1[1]); o[3] = pk2(v1[2], v1[3]);
          *(u32x4*)(rowp + bj * 128) = o; } }
  }
};
template <int SECOND> struct EpiG23 {
  static constexpr bool PERM = true, AFTER_DRAIN = false;
  unsigned char* ws;
  DI void operator()(const f32x4 (&acc)[2][2][4][2], const pg8::Unit& u, int wr, int wc, int fr, int fq) const {
    bf16_t* T1 = (bf16_t*)(ws + OFF_T1); const bf16_t* MG = (const bf16_t*)(ws + OFF_PMG) + (SECOND ? 2048 : 0);
    const int row0 = u.pm * 256 + wr * 64 + fr, col0 = u.pn * 256 + wc * 32 + 8 * fq;
#pragma unroll
    for (int ai = 0; ai < 2; ++ai)
#pragma unroll
      for (int m = 0; m < 4; ++m) { const size_t row = (size_t)(row0 + ai * 128 + m * 16);
#pragma unroll
        for (int bj = 0; bj < 2; ++bj) { const int col = col0 + bj * 128;
          const u32x4 g = *(const u32x4*)(MG + row * 4096 + col);
          const f32x4 v0 = acc[ai][bj][m][0], v1 = acc[ai][bj][m][1];
          float r[8];
          r[0] = sigmoidf_(lo2f(g[0])) * v0[0]; r[1] = sigmoidf_(hi2f(g[0])) * v0[1]; r[2] = sigmoidf_(lo2f(g[1])) * v0[2]; r[3] = sigmoidf_(hi2f(g[1])) * v0[3];
          r[4] = sigmoidf_(lo2f(g[2])) * v1[0]; r[5] = sigmoidf_(hi2f(g[2])) * v1[1]; r[6] = sigmoidf_(lo2f(g[3])) * v1[2]; r[7] = sigmoidf_(hi2f(g[3])) * v1[3];
          if (SECOND) { const u32x4 t = *(const u32x4*)(T1 + row * 2048 + col);
            r[0] += lo2f(t[0]); r[1] += hi2f(t[0]); r[2] += lo2f(t[1]); r[3] += hi2f(t[1]); r[4] += lo2f(t[2]); r[5] += hi2f(t[2]); r[6] += lo2f(t[3]); r[7] += hi2f(t[3]); }
          u32x4 o; o[0] = pk2(r[0], r[1]); o[1] = pk2(r[2], r[3]); o[2] = pk2(r[4], r[5]); o[3] = pk2(r[6], r[7]);
          *(u32x4*)(T1 + row * 2048 + col) = o; } }
  }
};
struct EpiG4 {
  static constexpr bool PERM = false, AFTER_DRAIN = false;
  const float* xin; const float* cin; float* xout; float* cout; const float* mod;
  DI void operator()(const f32x4 (&acc)[2][2][4][2], const pg8::Unit& u, int wr, int wc, int fr, int fq) const {
    const int row0 = u.pm * 256 + wr * 64 + fr, col0 = u.pn * 256 + wc * 32 + 4 * fq;
#pragma unroll
    for (int ai = 0; ai < 2; ++ai)
#pragma unroll
      for (int m = 0; m < 4; ++m) { const int row = row0 + ai * 128 + m * 16;
        const float* src; float* dst; const float* gate;
        if (row < NLAT) { src = xin + (size_t)row * 2048; dst = xout + (size_t)row * 2048; gate = mod + (row >> 12) * 6144 + 4096; }
        else { src = cin + (size_t)(row - NLAT) * 2048; dst = cout + (size_t)(row - NLAT) * 2048; gate = mod + 4 * 6144 + 4096; }
#pragma unroll
        for (int bj = 0; bj < 2; ++bj)
#pragma unroll
          for (int n = 0; n < 2; ++n) { const int col = col0 + bj * 128 + n * 16;
            const f32x4 xv = *(const f32x4*)(src + col), gv = *(const f32x4*)(gate + col);
            *(f32x4*)(dst + col) = xv + gv * acc[ai][bj][m][n]; } }
  }
};

__device__ void phase_mod(const Params& p, unsigned char* shm) {
  float* sc = (float*)shm; float* red = sc + 5 * 2048;
  const int tid = otid(p.wid);
  for (int i = tid; i < 5 * 2048; i += 512) { const int j = i >> 11, k = i & 2047; const float v = (j < 4) ? p.c[j * 2048 + k] : p.c_ctx[k]; sc[i] = v / (1.f + expf(-v)); }
  __syncthreads();
  float* mod = (float*)(p.ws + OFF_MOD);
  const int cq = tid & 7, ks = tid >> 3;
  for (int it = blockIdx.x; it < 384; it += gridDim.x) {
    const int l = it / 192, nb = (it % 192) * 32;
    const float* W = p.ada_w + (size_t)l * 2048 * 6144 + nb + cq * 4;
    float acc[5][4];
#pragma unroll
    for (int j = 0; j < 5; ++j) { acc[j][0] = 0.f; acc[j][1] = 0.f; acc[j][2] = 0.f; acc[j][3] = 0.f; }
#pragma unroll 4
    for (int kk = 0; kk < 32; ++kk) { const int k = ks * 32 + kk; const float4 w = *(const float4*)(W + (size_t)k * 6144);
#pragma unroll
      for (int j = 0; j < 5; ++j) { const float s = sc[j * 2048 + k]; acc[j][0] += s * w.x; acc[j][1] += s * w.y; acc[j][2] += s * w.z; acc[j][3] += s * w.w; } }
#pragma unroll
    for (int j = 0; j < 5; ++j)
#pragma unroll
      for (int e = 0; e < 4; ++e) red[ks * 160 + j * 32 + cq * 4 + e] = acc[j][e];
    __syncthreads();
    if (tid < 160) { float s = 0.f; for (int q = 0; q < 64; ++q) s += red[q * 160 + tid]; const int j = tid >> 5, n = nb + (tid & 31); mod[(l * 5 + j) * 6144 + n] = s + p.ada_b[l * 6144 + n]; }
    __syncthreads();
  }
}

__device__ void cvt_group(int wid, const float* W, bf16_t* Wt, int K, int N, int k0, int n0, float scale, float* tile) {
  const int tid = otid(wid);
  float4 v[8];
#pragma unroll
  for (int q = 0; q < 4; ++q)
#pragma unroll
    for (int rr = 0; rr < 2; ++rr) { const int k = (tid >> 4) + 32 * rr, n = (tid & 15) * 4; v[q * 2 + rr] = *(const float4*)(W + (size_t)(k0 + q * 64 + k) * N + n0 + n); }
#pragma unroll
  for (int q = 0; q < 4; ++q)
#pragma unroll
    for (int rr = 0; rr < 2; ++rr) { const int k = (tid >> 4) + 32 * rr, n = (tid & 15) * 4; float* t = tile + q * 4160 + k * 65 + n; const float4 x = v[q * 2 + rr]; t[0] = x.x; t[1] = x.y; t[2] = x.z; t[3] = x.w; }
  __syncthreads();
#pragma unroll
  for (int q = 0; q < 4; ++q) { const int n = tid >> 3, k8 = (tid & 7) * 8; const float* t = tile + q * 4160; u32x4 o;
#pragma unroll
    for (int e = 0; e < 4; ++e) o[e] = pk2(t[(k8 + 2 * e) * 65 + n] * scale, t[(k8 + 2 * e + 1) * 65 + n] * scale);
    *(u32x4*)(Wt + (size_t)(n0 + n) * K + k0 + q * 64 + k8) = o; }
  __syncthreads();
}
__device__ void phase_cvt(const Params& p, int l, unsigned char* shm) {
  float* tile = (float*)shm;
  for (int it = blockIdx.x; it < 4096; it += gridDim.x) {
    if (it < 3072) { const int kg = it & 7, n0 = (it >> 3) * 64;
      cvt_group(p.wid, p.w_in + (size_t)l * DM * INW, (bf16_t*)(p.ws + OFF_WTIN), DM, INW, kg * 256, n0, (n0 >= 2048 && n0 < 4096) ? 0.0625f : 1.f, tile); }
    else if (it < 3328) { const int e = it - 3072; cvt_group(p.wid, p.w_hy_out + (size_t)l * DM * DM, (bf16_t*)(p.ws + OFF_WTHY), DM, DM, (e & 7) * 256, (e >> 3) * 64, 1.f, tile); }
    else if (it < 3840) { const int e = it - 3328; cvt_group(p.wid, p.w_ret_out + (size_t)l * 4096 * DM, (bf16_t*)(p.ws + OFF_WTRET), 4096, DM, (e & 15) * 256, (e >> 4) * 64, 1.f, tile); }
    else { const int e = it - 3840; cvt_group(p.wid, p.w_o + (size_t)l * DM * DM, (bf16_t*)(p.ws + OFF_WTO), DM, DM, (e & 7) * 256, (e >> 3) * 64, 1.f, tile); }
  }
}

__device__ void filt_item(const Params& p, int l, int Ls, int T, bool isctx, unsigned char* shm) {
  float* z = (float*)shm; float* ha = z + 17 * 36; float* hb = ha + 17 * 64;
  const int tid = otid(p.wid);
  const float* w1 = p.fw1 + l * 33 * 64; const float* b1 = p.fb1 + l * 64; const float* w2 = p.fw2 + l * 4096; const float* b2 = p.fb2 + l * 64;
  const float* w3 = p.fw3 + l * 4096; const float* b3 = p.fb3 + l * 64; const float* fq = p.ffreq + l * 64; const float* wout = p.fwout + (size_t)l * 64 * 4096;
  for (int i = tid; i < 17 * 33; i += 512) { const int pl = i / 33, f = i % 33; int pp = T * 16 + pl; if (pp > Ls - 1) pp = Ls - 1;
    float val;
    if (f == 0) val = (float)pp / (float)(Ls - 1);
    else { const int j = (f - 1) & 15; const float fj = 1e-4f + (float)j * ((15.f - 1e-4f) / 15.f); const float ang = 6.283185307179586f * (float)pp / (float)Ls; const float a = fj * ang; val = (f <= 16) ? cosf(a) : -sinf(a); }
    z[pl * 36 + f] = val; }
  __syncthreads();
  for (int idx = tid; idx < 17 * 16; idx += 512) { const int pl = idx >> 4, j0 = (idx & 15) * 4; float a[4] = {0.f, 0.f, 0.f, 0.f};
#pragma unroll 3
    for (int k = 0; k < 33; ++k) { const float v = z[pl * 36 + k]; const float4 w = *(const float4*)(w1 + k * 64 + j0); a[0] += v * w.x; a[1] += v * w.y; a[2] += v * w.z; a[3] += v * w.w; }
#pragma unroll
    for (int e = 0; e < 4; ++e) ha[pl * 64 + j0 + e] = sinf(fq[j0 + e] * (a[e] + b1[j0 + e])); }
  __syncthreads();
  for (int idx = tid; idx < 17 * 16; idx += 512) { const int pl = idx >> 4, j0 = (idx & 15) * 4; float a[4] = {0.f, 0.f, 0.f, 0.f};
#pragma unroll 4
    for (int k = 0; k < 64; ++k) { const float v = ha[pl * 64 + k]; const float4 w = *(const float4*)(w2 + k * 64 + j0); a[0] += v * w.x; a[1] += v * w.y; a[2] += v * w.z; a[3] += v * w.w; }
#pragma unroll
    for (int e = 0; e < 4; ++e) hb[pl * 64 + j0 + e] = sinf(fq[j0 + e] * (a[e] + b2[j0 + e])); }
  __syncthreads();
  for (int idx = tid; idx < 17 * 16; idx += 512) { const int pl = idx >> 4, j0 = (idx & 15) * 4; float a[4] = {0.f, 0.f, 0.f, 0.f};
#pragma unroll 4
    for (int k = 0; k < 64; ++k) { const float v = hb[pl * 64 + k]; const float4 w = *(const float4*)(w3 + k * 64 + j0); a[0] += v * w.x; a[1] += v * w.y; a[2] += v * w.z; a[3] += v * w.w; }
#pragma unroll
    for (int e = 0; e < 4; ++e) ha[pl * 64 + j0 + e] = sinf(fq[j0 + e] * (a[e] + b3[j0 + e])); }
  __syncthreads();
  const int c2 = tid * 8; const bool isb = c2 >= 2048; const int cb = c2 & 2047;
  const float mind = logf(0.01f) / 1.5f, maxd = logf(0.01f) / 0.3f;
  bf16_t* G = (bf16_t*)(p.ws + OFF_G + (size_t)l * G_LAYER); float* GC = (float*)(p.ws + OFF_GC);
  for (int pgh = 0; pgh < 4; ++pgh) {
    const int pg = pgh >> 1, c4 = c2 + (pgh & 1) * 4;
    const int plb = pg * 8 + (isb ? 0 : 1);
    float acc[8][4];
#pragma unroll
    for (int e = 0; e < 8; ++e) { acc[e][0] = 0.f; acc[e][1] = 0.f; acc[e][2] = 0.f; acc[e][3] = 0.f; }
#pragma unroll 8
    for (int k = 0; k < 64; ++k) { const float4 wa = *(const float4*)(wout + k * 4096 + c4);
#pragma unroll
      for (int e = 0; e < 8; ++e) { const float h = ha[(plb + e) * 64 + k]; acc[e][0] += h * wa.x; acc[e][1] += h * wa.y; acc[e][2] += h * wa.z; acc[e][3] += h * wa.w; } }
    const int pp0 = T * 16 + plb;
#pragma unroll
    for (int cc = 0; cc < 4; ++cc) { const int c = (c4 & 2047) + cc; const float delta = fabsf(mind + (float)c * ((maxd - mind) / 2047.f));
      float v[8];
#pragma unroll
      for (int e = 0; e < 8; ++e) { const int pp = pp0 + e; v[e] = (pp < Ls) ? acc[e][cc] * __expf(-((float)pp / (float)(Ls - 1)) * delta) : 0.f; }
      if (!isctx) {
        bf16_t* Gc = G + (size_t)c * GLEN;
        if (isb) {
          if (pp0 == 0) { for (int e = 1; e < 8; ++e) Gc[LOFF + e] = f2bf(v[e]); }
          else { u32x4 o; o[0] = pk2(v[0], v[1]); o[1] = pk2(v[2], v[3]); o[2] = pk2(v[4], v[5]); o[3] = pk2(v[6], v[7]); *(u32x4*)(Gc + LOFF + pp0) = o; }
        } else {
          u32x4 o; o[0] = pk2(v[7], v[6]); o[1] = pk2(v[5], v[4]); o[2] = pk2(v[3], v[2]); o[3] = pk2(v[1], v[0]); *(u32x4*)(Gc + LOFF - pp0 - 7) = o;
        }
      } else {
        float* Gc = GC + (size_t)c * 512;
#pragma unroll
        for (int e = 0; e < 8; ++e) { const int pp = pp0 + e; if (isb) { if (pp >= 1 && pp < Ls) Gc[256 - pp] = v[e]; } else { if (pp < Ls) Gc[256 + pp] = v[e]; } }
      }
    }
  }
  if (T == 0 && !isb) {
#pragma unroll 1
    for (int cc = 0; cc < 8; ++cc) { float a = 0.f;
#pragma unroll 4
      for (int k = 0; k < 64; ++k) a += ha[k] * wout[k * 4096 + c2 + cc];
      if (!isctx) G[(size_t)(cb + cc) * GLEN + LOFF] = f2bf(a); else GC[(size_t)(cb + cc) * 512 + 256] = a; }
  }
  __syncthreads();
}
__device__ void phase_filters(const Params& p, unsigned char* shm) {
  for (int it = blockIdx.x; it < 528; it += gridDim.x) { if (it < 512) filt_item(p, it >> 8, SEQ, it & 255, false, shm); else filt_item(p, 0, CTXL, it - 512, true, shm); }
}

__device__ void phase_norm(const Params& p, int l) {
  const int lane = otid(p.wid) & 63, gw = blockIdx.x * 8 + (otid(p.wid) >> 6), nw = gridDim.x * 8;
  const float* mod = (const float*)(p.ws + OFF_MOD) + (size_t)l * 5 * 6144; const float* lng = p.ln_g + l * 2048;
  bf16_t* H = (bf16_t*)(p.ws + OFF_H);
  for (int r = gw; r < MT; r += nw) {
    const float* src; int j;
    if (r < NLAT) { src = (l == 0 ? p.x : p.out) + (size_t)r * 2048; j = r >> 12; }
    else { src = (l == 0 ? p.ctx : (const float*)(p.ws + OFF_CTXR)) + (size_t)(r - NLAT) * 2048; j = 4; }
    const float* sh = mod + j * 6144; const float* sc = sh + 2048;
    float4 v[8]; float ss = 0.f;
#pragma unroll
    for (int i = 0; i < 8; ++i) { v[i] = *(const float4*)(src + i * 256 + lane * 4); ss += v[i].x * v[i].x + v[i].y * v[i].y + v[i].z * v[i].z + v[i].w * v[i].w; }
    ss = wsum(ss, lane);
    const float rs = rsqrtf(ss * (1.f / 2048.f) + 1e-6f);
#pragma unroll
    for (int i = 0; i < 8; ++i) { const int col = i * 256 + lane * 4; const float4 g = *(const float4*)(lng + col), a = *(const float4*)(sc + col), b = *(const float4*)(sh + col);
      u32x2 o; o[0] = pk2(v[i].x * rs * g.x * (1.f + a.x) + b.x, v[i].y * rs * g.y * (1.f + a.y) + b.y); o[1] = pk2(v[i].z * rs * g.z * (1.f + a.z) + b.z, v[i].w * rs * g.w * (1.f + a.w) + b.w);
      *(u32x2*)(H + (size_t)r * 2048 + col) = o; }
  }
}
__device__ void phase_final(const Params& p) {
  const int lane = otid(p.wid) & 63, gw = blockIdx.x * 8 + (otid(p.wid) >> 6), nw = gridDim.x * 8;
  for (int r = gw; r < NLAT; r += nw) {
    float* src = p.out + (size_t)r * 2048; float4 v[8]; float ss = 0.f;
#pragma unroll
    for (int i = 0; i < 8; ++i) { v[i] = *(const float4*)(src + i * 256 + lane * 4); ss += v[i].x * v[i].x + v[i].y * v[i].y + v[i].z * v[i].z + v[i].w * v[i].w; }
    ss = wsum(ss, lane);
    const float rs = rsqrtf(ss * (1.f / 2048.f) + 1e-6f);
#pragma unroll
    for (int i = 0; i < 8; ++i) { const int col = i * 256 + lane * 4; const float4 g = *(const float4*)(p.final_g + col); float4 o; o.x = v[i].x * rs * g.x; o.y = v[i].y * rs * g.y; o.z = v[i].z * rs * g.z; o.w = v[i].w * rs * g.w; *(float4*)(src + col) = o; }
  }
}

DI void tok_tile(int tk, int& b, int& t0, bool& isctx) { if (tk < 256) { b = tk >> 6; t0 = (tk & 63) * 64; isctx = false; } else { b = (tk - 256) >> 2; t0 = ((tk - 256) & 3) * 64; isctx = true; } }
DI int tok_row(int b, int t, bool isctx) { return isctx ? NLAT + b * CTXL + t : b * SEQ + t; }

__device__ void phase_prep(const Params& p, int l, unsigned char* shm, int mask) {
  const int tid = otid(p.wid), lane = tid & 63;
  float2* cs = (float2*)shm;
  unsigned char* reg2 = shm + 32768;
  for (int i = tid; i < 4096; i += 512) { const int pos = i >> 6, j = i & 63; const float inv = 1.f / powf(10000.f, (float)j / 64.f); float s, c; sincosf((float)pos * inv, &s, &c); cs[i] = make_float2(c, s); }
  __syncthreads();
  if (mask & 1) { const int gw = blockIdx.x * 8 + (tid >> 6), nw = gridDim.x * 8;
#pragma unroll 1
    for (int r = gw; r < 2 * NLAT; r += nw) { const int rr = r >> 1; const int t = rr & 4095, rp = t >> 6, cp = t & 63;
      bf16_t* row = (bf16_t*)(p.ws + ((r & 1) ? OFF_PK : OFF_PQ)) + (size_t)rr * 2048;
#pragma unroll
      for (int e = 0; e < 2; ++e) { const int cmb = lane + 64 * e, hh = cmb >> 4, hf = (cmb >> 3) & 1, j8 = (cmb & 7) * 8; bf16_t* q = row + hh * 256 + hf * 128 + j8;
        const u32x4 a = *(const u32x4*)q, bq = *(const u32x4*)(q + 64); const float2* cp2 = cs + (hf ? cp : rp) * 64 + j8; u32x4 oa, ob;
#pragma unroll
        for (int w = 0; w < 4; ++w) { const float2 v0 = cp2[2 * w], v1 = cp2[2 * w + 1]; const float p10 = lo2f(a[w]), p11 = hi2f(a[w]), p20 = lo2f(bq[w]), p21 = hi2f(bq[w]);
          oa[w] = pk2(p10 * v0.x - p20 * v0.y, p11 * v1.x - p21 * v1.y); ob[w] = pk2(p10 * v0.y + p20 * v0.x, p11 * v1.y + p21 * v1.x); }
        *(u32x4*)q = oa; *(u32x4*)(q + 64) = ob; } } }
  if (mask & 4) { float* in = (float*)reg2;
    bf16_t* ut = (bf16_t*)(reg2 + 3 * 66 * 64 * 4);
    const bf16_t* PHY = (const bf16_t*)(p.ws + OFF_PHY); bf16_t* HV = (bf16_t*)(p.ws + OFF_HV); bf16_t* HX0 = (bf16_t*)(p.ws + OFF_HX0);
    const float* cw = p.conv_w + (size_t)l * 3 * 6144; const float* cb = p.conv_b + (size_t)l * 6144;
    const int nit = ((l == 0) ? 272 : 256) * 32;
    u32x4 pre[4];
#define PC_DECODE(it_) const int tk = (it_) >> 5, c0 = ((it_) & 31) * 64; int b, t0; bool isctx; tok_tile(tk, b, t0, isctx); const int Ls = isctx ? CTXL : SEQ; const int row0 = tok_row(b, t0, isctx);
#define PC_LOAD(it_) do { PC_DECODE(it_) _Pragma("unroll") for (int e = 0; e < 4; ++e) { const int id = tid + 512 * e; const int pi = id / 528, rem = id % 528, rr = rem >> 3, pc = rem & 7; const int t = t0 - 1 + rr; \
        u32x4 v; v[0] = 0u; v[1] = 0u; v[2] = 0u; v[3] = 0u; if (id < 1584 && t >= 0 && t < Ls) v = *(const u32x4*)(PHY + (size_t)(row0 - 1 + rr) * 6144 + pi * 2048 + c0 + pc * 8); pre[e] = v; } } while (0)
    if ((int)blockIdx.x < nit) PC_LOAD((int)blockIdx.x);
    for (int it = blockIdx.x; it < nit; it += gridDim.x) {
      PC_DECODE(it) (void)Ls;
#pragma unroll
      for (int e = 0; e < 4; ++e) { const int id = tid + 512 * e; if (id < 1584) { const int pi = id / 528, rem = id % 528, rr = rem >> 3, pc = rem & 7; const u32x4 v = pre[e];
        float* d = in + (pi * 66 + rr) * 64 + pc * 8;
        *(float4*)d = make_float4(lo2f(v[0]), hi2f(v[0]), lo2f(v[1]), hi2f(v[1])); *(float4*)(d + 4) = make_float4(lo2f(v[2]), hi2f(v[2]), lo2f(v[3]), hi2f(v[3])); } }
      if (it + (int)gridDim.x < nit) PC_LOAD(it + (int)gridDim.x);
      __syncthreads();
      { const int cg8 = (tid & 7) * 8, tok = tid >> 3;
        float cv[3][8];
#pragma unroll
        for (int pi = 0; pi < 3; ++pi) { const float* wp = cw + pi * 2048 + c0 + cg8;
          const float4 ba = *(const float4*)(cb + pi * 2048 + c0 + cg8), bb = *(const float4*)(cb + pi * 2048 + c0 + cg8 + 4);
          cv[pi][0] = ba.x; cv[pi][1] = ba.y; cv[pi][2] = ba.z; cv[pi][3] = ba.w; cv[pi][4] = bb.x; cv[pi][5] = bb.y; cv[pi][6] = bb.z; cv[pi][7] = bb.w;
#pragma unroll
          for (int k = 0; k < 3; ++k) { const float4 wa = *(const float4*)(wp + k * 6144), wb = *(const float4*)(wp + k * 6144 + 4);
            const float* ip = in + (pi * 66 + tok + k) * 64 + cg8; const float4 xa = *(const float4*)ip, xb = *(const float4*)(ip + 4);
            cv[pi][0] += xa.x * wa.x; cv[pi][1] += xa.y * wa.y; cv[pi][2] += xa.z * wa.z; cv[pi][3] += xa.w * wa.w; cv[pi][4] += xb.x * wb.x; cv[pi][5] += xb.y * wb.y; cv[pi][6] += xb.z * wb.z; cv[pi][7] += xb.w * wb.w; } }
        u32x4 hvp, hxp;
#pragma unroll
        for (int e = 0; e < 4; ++e) { hvp[e] = pk2(cv[0][2 * e] * cv[2][2 * e], cv[0][2 * e + 1] * cv[2][2 * e + 1]); hxp[e] = pk2(cv[1][2 * e], cv[1][2 * e + 1]); }
        *(u32x4*)(HV + (size_t)(row0 + tok) * 2048 + c0 + cg8) = hvp; *(u32x4*)(HX0 + (size_t)(row0 + tok) * 2048 + c0 + cg8) = hxp;
#pragma unroll
        for (int e = 0; e < 4; ++e) { ut[(cg8 + 2 * e) * 66 + tok] = (bf16_t)(hvp[e] & 0xffffu); ut[(cg8 + 2 * e + 1) * 66 + tok] = (bf16_t)(hvp[e] >> 16); } }
      __syncthreads();
      { const int c = tid >> 3, pc = tid & 7; u32x4 o;
#pragma unroll
        for (int e = 0; e < 4; ++e) o[e] = (unsigned)ut[c * 66 + pc * 8 + 2 * e] | ((unsigned)ut[c * 66 + pc * 8 + 2 * e + 1] << 16);
        bf16_t* dst = isctx ? (bf16_t*)(p.ws + OFF_UTC) + ((size_t)(c0 + c) * NB + b) * CTXL + t0 + pc * 8 : (bf16_t*)(p.ws + OFF_UT) + ((size_t)(c0 + c) * NB + b) * SEQ + t0 + pc * 8;
        *(u32x4*)dst = o; }
    }
    __syncthreads();
#undef PC_DECODE
#undef PC_LOAD
  }
}

__device__ void phase_post(const Params& p, int l, unsigned char* shm, int mask) {
  const int tid = otid(p.wid), lane = tid & 63;
  const bf16_t* HV = (const bf16_t*)(p.ws + OFF_HV); const bf16_t* HX0 = (const bf16_t*)(p.ws + OFF_HX0); const bf16_t* PHG = (const bf16_t*)(p.ws + OFF_PHG);
  bf16_t* AH = (bf16_t*)(p.ws + OFF_H); const float* hbias = p.hy_bias + l * 2048;
  if (mask & 1) { float* yt = (float*)shm;
    const bf16_t* UT = (const bf16_t*)(p.ws + OFF_UT);
    const int nit = 256 * 32; u32x4 pre;
#define PA_LOAD(it_) do { const int tk_ = (it_) >> 5, c0_ = ((it_) & 31) * 64, b_ = tk_ >> 6, t0_ = (tk_ & 63) * 64; pre = *(const u32x4*)(UT + ((size_t)(c0_ + (tid >> 3)) * NB + b_) * SEQ + t0_ + (tid & 7) * 8); } while (0)
    if ((int)blockIdx.x < nit) PA_LOAD((int)blockIdx.x);
    for (int it = blockIdx.x; it < nit; it += gridDim.x) {
      const int tk = it >> 5, c0 = (it & 31) * 64, b = tk >> 6, t0 = (tk & 63) * 64, row0 = b * SEQ + t0;
      { const int c = tid >> 3, pc = tid & 7; const u32x4 v = pre; float* d = yt + (pc * 8) * 65 + c;
        d[0] = lo2f(v[0]); d[65] = hi2f(v[0]); d[130] = lo2f(v[1]); d[195] = hi2f(v[1]); d[260] = lo2f(v[2]); d[325] = hi2f(v[2]); d[390] = lo2f(v[3]); d[455] = hi2f(v[3]); }
      if (it + (int)gridDim.x < nit) PA_LOAD(it + (int)gridDim.x);
      __syncthreads();
      { const int cg8 = (tid & 7) * 8, tok = tid >> 3; const size_t o = (size_t)(row0 + tok) * 2048 + c0 + cg8;
        const u32x4 hv = *(const u32x4*)(HV + o), hx = *(const u32x4*)(HX0 + o), hg = *(const u32x4*)(PHG + o);
        const float4 ba = *(const float4*)(hbias + c0 + cg8), bb = *(const float4*)(hbias + c0 + cg8 + 4);
        const float hb[8] = {ba.x, ba.y, ba.z, ba.w, bb.x, bb.y, bb.z, bb.w}; const float* yp = yt + tok * 65 + cg8; u32x4 r;
#pragma unroll
        for (int e = 0; e < 4; ++e) { const float a0 = (yp[2 * e] + hb[2 * e] * lo2f(hv[e])) * lo2f(hx[e]) * siluf_(lo2f(hg[e])), a1 = (yp[2 * e + 1] + hb[2 * e + 1] * hi2f(hv[e])) * hi2f(hx[e]) * siluf_(hi2f(hg[e])); r[e] = pk2(a0, a1); }
        *(u32x4*)(AH + o) = r; }
      __syncthreads();
    }
#undef PA_LOAD
  }
  if (l == 0 && (mask & 2)) { float* gc = (float*)shm; float* us = gc + 32 * 512;
    const bf16_t* UTC = (const bf16_t*)(p.ws + OFF_UTC); const float* GC = (const float*)(p.ws + OFF_GC);
    for (int it = blockIdx.x; it < 16 * 64; it += gridDim.x) {
      const int tk = it >> 6, c0 = (it & 63) * 32, b = tk >> 2, t0 = (tk & 3) * 64, row0 = NLAT + b * CTXL + t0;
#pragma unroll 8
      for (int i = tid; i < 32 * 512; i += 512) gc[i] = GC[(size_t)(c0 + (i >> 9)) * 512 + (i & 511)];
#pragma unroll 8
      for (int i = tid; i < 32 * 256; i += 512) us[i] = bf2f(UTC[((size_t)(c0 + (i >> 8)) * NB + b) * CTXL + (i & 255)]);
      __syncthreads();
      { const int t = tid & 63, cg4 = tid >> 6;
#pragma unroll 1
        for (int e = 0; e < 4; ++e) { const int c = cg4 * 4 + e; const float* g = gc + c * 512 + 256 + t0 + t; const float* u = us + c * 256; float a = 0.f;
#pragma unroll 8
          for (int s = 0; s < 256; ++s) a += u[s] * g[-s];
          const size_t o = (size_t)(row0 + t) * 2048 + c0 + c; const float hv = bf2f(HV[o]);
          AH[o] = f2bf((a + hbias[c0 + c] * hv) * bf2f(HX0[o]) * siluf_(bf2f(PHG[o]))); } }
      __syncthreads();
    }
  }
  if (mask & 4) { bf16_t* OF = (bf16_t*)(p.ws + OFF_OF); const bf16_t* OB = (const bf16_t*)(p.ws + OFF_OB); const bf16_t* RG = (const bf16_t*)(p.ws + OFF_PRG);
    const int gw = blockIdx.x * 8 + (tid >> 6), nw = gridDim.x * 8; const int nrows = (l == 0) ? MT : NLAT;
#pragma unroll 2
    for (int it = gw; it < nrows * 8; it += nw) { const size_t o = (size_t)(it >> 3) * 4096 + (it & 7) * 512 + lane * 8;
      const u32x4 a = *(const u32x4*)(OF + o), bq = *(const u32x4*)(OB + o), g = *(const u32x4*)(RG + o);
      float v[8]; float ss = 0.f;
#pragma unroll
      for (int e = 0; e < 4; ++e) { v[2 * e] = lo2f(a[e]) + lo2f(bq[e]); v[2 * e + 1] = hi2f(a[e]) + hi2f(bq[e]); ss += v[2 * e] * v[2 * e] + v[2 * e + 1] * v[2 * e + 1]; }
      ss = wsum(ss, lane);
      const float rs = rsqrtf(ss * (1.f / 512.f) + 1e-6f);
      u32x4 r;
#pragma unroll
      for (int e = 0; e < 4; ++e) r[e] = pk2(v[2 * e] * rs * siluf_(lo2f(g[e])), v[2 * e + 1] * rs * siluf_(hi2f(g[e])));
      *(u32x4*)(OF + o) = r; }
  }
}

__device__ void phase_conv(const Params& p, int l, unsigned char* shm) {
  const int tid = otid(p.wid), lane = tid & 63, wid = tid >> 6;
  bf16_t* Gs = (bf16_t*)shm;
  bf16_t* Us = (bf16_t*)(shm + 2 * GLEN * 2);
  { unsigned zz = 0u; asm volatile("" : "+v"(zz)); u32x4 z; z[0] = zz; z[1] = zz; z[2] = zz; z[3] = zz; for (int i = tid; i < 2 * 4 * USTR / 8; i += 512) ((u32x4*)Us)[i] = z; }
  __syncthreads();
  const int ch = wid >> 2, q = wid & 3, i = lane & 31, g = lane >> 5, a_l = i >> 2, b = i & 3;
  const bf16_t* G = (const bf16_t*)(p.ws + OFF_G + (size_t)l * G_LAYER); bf16_t* UT = (bf16_t*)(p.ws + OFF_UT);
  const int mb = LOFF - i + 8 * g - 128 * (8 * q + 7);
  const unsigned sh = (unsigned)(mb & 1) * 16u;
  const unsigned* Gd = (const unsigned*)(Gs + ch * GLEN) + (mb >> 1);
  const bf16_t* Ub = Us + (ch * 4 + b) * USTR + 136 * (a_l + 1) + 8 * g;
#define CONV_LDFRAG(dst, n) do { const unsigned* q_ = Gd + 8 * (n); const unsigned d0 = q_[0], d1 = q_[1], d2 = q_[2], d3 = q_[3], d4 = q_[4]; u32x4 r_; \
    r_[0] = __builtin_amdgcn_alignbit(d1, d0, sh); r_[1] = __builtin_amdgcn_alignbit(d2, d1, sh); r_[2] = __builtin_amdgcn_alignbit(d3, d2, sh); r_[3] = __builtin_amdgcn_alignbit(d4, d3, sh); \
    dst = __builtin_bit_cast(bf16x8, r_); } while (0)
  for (int pr = blockIdx.x; pr < 1024; pr += gridDim.x) {
    for (int id = tid; id < 2 * (GLEN / 2); id += 512) { const int cc = id / (GLEN / 2), dw = id % (GLEN / 2);
      unsigned v = ((const unsigned*)(G + (size_t)(pr * 2 + cc) * GLEN))[dw]; const int m = dw * 2;
      if (m < 33 || m > 8223) v &= 0xffff0000u; if (m + 1 < 33 || m + 1 > 8223) v &= 0x0000ffffu;
      ((unsigned*)Gs)[cc * (GLEN / 2) + dw] = v; }
    for (int id = tid; id < 2 * 4 * 512; id += 512) { const int cc = id >> 11, bb = (id >> 9) & 3, s8 = id & 511;
      const u32x4 v = *(const u32x4*)(UT + ((size_t)(pr * 2 + cc) * 4 + bb) * SEQ + s8 * 8); const int sp = 1024 + s8 * 8;
      *(u32x4*)(Us + (cc * 4 + bb) * USTR + sp + 8 * (sp >> 7)) = v; }
    __syncthreads();
    bf16x8 W[8]; f32x16 acc[4];
#pragma unroll
    for (int h = 0; h < 4; ++h)
#pragma unroll
      for (int e = 0; e < 16; ++e) acc[h][e] = 0.f;
    CONV_LDFRAG(W[2], -6); CONV_LDFRAG(W[3], -5); CONV_LDFRAG(W[4], -4); CONV_LDFRAG(W[5], -3); CONV_LDFRAG(W[6], -2); CONV_LDFRAG(W[7], -1);
#pragma unroll 1
    for (int it = 0; it < 39; ++it) {
#pragma unroll
      for (int u = 0; u < 8; ++u) {
        CONV_LDFRAG(W[u], it * 8 + u);
        const bf16x8 bf = *(const bf16x8*)(Ub + 136 * it + 16 * u);
#pragma unroll
        for (int h = 0; h < 4; ++h) acc[h] = __builtin_amdgcn_mfma_f32_32x32x16_bf16(W[(u - 2 * h) & 7], bf, acc[h], 0, 0, 0);
      }
    }
    { bf16_t* yrow = UT + ((size_t)(pr * 2 + ch) * 4 + b) * SEQ + 128 * (8 * q + a_l) + 4 * g;
#pragma unroll
      for (int h = 0; h < 4; ++h)
#pragma unroll
        for (int rq = 0; rq < 4; ++rq) { u32x2 o; o[0] = pk2(acc[h][4 * rq], acc[h][4 * rq + 1]); o[1] = pk2(acc[h][4 * rq + 2], acc[h][4 * rq + 3]); *(u32x2*)(yrow + 32 * h + 8 * rq) = o; } }
    __syncthreads();
  }
#undef CONV_LDFRAG
}

template <int KD> DI f32x16 mma_tile(f32x16 acc, const bf16_t* A, int lda, const bf16_t* B, int ldb, int lane) {
  const int r = lane & 31, g8 = (lane >> 5) * 8; const bf16_t* ap = A + r * lda + g8; const bf16_t* bp = B + r * ldb + g8;
#pragma unroll 4
  for (int k0 = 0; k0 < KD; k0 += 16) acc = __builtin_amdgcn_mfma_f32_32x32x16_bf16(*(const bf16x8*)(ap + k0), *(const bf16x8*)(bp + k0), acc, 0, 0, 0);
  return acc;
}
DI bf16x8 tr_frag(const bf16_t* img, int ld, int lane) {
  const int h = lane >> 5, blk = (lane >> 4) & 1, q = (lane & 15) >> 2, pp = lane & 3;
  const bf16_t* a = img + (8 * h + q) * ld + 16 * blk + 4 * pp;
  const s16x4 r0 = __builtin_amdgcn_ds_read_tr16_b64_v4i16((__attribute__((address_space(3))) s16x4*)a);
  const s16x4 r1 = __builtin_amdgcn_ds_read_tr16_b64_v4i16((__attribute__((address_space(3))) s16x4*)(a + 4 * ld));
  bf16x8 f; f[0] = r0[0]; f[1] = r0[1]; f[2] = r0[2]; f[3] = r0[3]; f[4] = r1[0]; f[5] = r1[1]; f[6] = r1[2]; f[7] = r1[3]; return f;
}
__device__ void phase_ret(const Params& p, int l, unsigned char* shm) {
  constexpr int QS = 264, VS = 144, TS = 72;
  const int tid = otid(p.wid), lane = tid & 63, wid = tid >> 6, g = lane >> 5;
  bf16_t* Qs = (bf16_t*)shm; bf16_t* Ks = Qs + 64 * QS; bf16_t* Vs = Ks + 64 * QS; bf16_t* Ps = Vs + 64 * VS; bf16_t* Sts = Ps + 64 * TS;
  const bf16_t* PQ = (const bf16_t*)(p.ws + OFF_PQ); const bf16_t* PK = (const bf16_t*)(p.ws + OFF_PK); const bf16_t* PV = (const bf16_t*)(p.ws + OFF_PV);
  for (int it0 = blockIdx.x; it0 < 256; it0 += gridDim.x) {
    int it = it0;
    if (gridDim.x == 256) { const int xcd = it0 & 7, idx = it0 >> 3; it = ((xcd + 8 * (idx >> 2)) << 2) | (idx & 3); }
    const int sl = it & 3, dir = (it >> 2) & 1, h = (it >> 3) & 7, b = it >> 6;
    const float lg = -expf(p.ret_decay[(l * 2 + dir) * 8 + h]);
    bf16_t* O = (bf16_t*)(p.ws + (dir ? OFF_OB : OFF_OF));
    for (int i = tid; i < 128 * QS / 2; i += 512) ((unsigned*)Sts)[i] = 0u;
    f32x16 S[4], cross;
#pragma unroll
    for (int x = 0; x < 4; ++x)
#pragma unroll
      for (int e = 0; e < 16; ++e) S[x][e] = 0.f;
#pragma unroll
    for (int e = 0; e < 16; ++e) cross[e] = 0.f;
    const float cd = __expf(lg * 64.f);
    const int tid2 = otid(p.wid), ln2 = tid2 & 63, g2 = ln2 >> 5, w2 = tid2 >> 6;
    float mk[16], dkv[2];
#pragma unroll
    for (int e = 0; e < 2; ++e) { const int tok = (tid2 >> 4) + 32 * e; dkv[e] = __expf(lg * (float)(dir ? tok : 63 - tok)); }
    const int wq = w2 & 3, s_tj = wq >> 1, s_ti = wq & 1;
    const int o_tc = w2 >> 1, o_ti = w2 & 1;
    { const int i = s_ti * 32 + (ln2 & 31);
#pragma unroll
      for (int e = 0; e < 16; ++e) { const int j = s_tj * 32 + (e & 3) + 8 * (e >> 2) + 4 * g2; const int diff = dir ? (j - i) : (i - j); mk[e] = diff >= 0 ? __expf(lg * (float)(dir ? -i : i - 63)) : 0.f; } }
    const int qi = o_ti * 32 + (ln2 & 31);
    const float qd = __expf(lg * (float)(dir ? 64 - qi : qi + 1));
    u32x4 rq[4], rk[4], rv[2];
    const unsigned qo_l = (unsigned)(tid >> 5) * 2048u + (unsigned)(h * 256 + (tid & 31) * 8);
    const unsigned vo_l = (unsigned)(tid >> 4) * 4096u + (unsigned)(h * 512 + sl * 128 + (tid & 15) * 8);
#define RET_CHUNK(step_, isctx_, t0_) do { if ((step_) < 4) { isctx_ = true; t0_ = (dir ? 3 - (step_) : (step_)) * 64; } else { isctx_ = false; const int cn_ = (step_) - 4; t0_ = (dir ? 63 - cn_ : cn_) * 64; } } while (0)
#define RET_LOAD(step_) do { bool ic_; int t0n_; RET_CHUNK(step_, ic_, t0n_); const unsigned rw_ = (unsigned)tok_row(b, t0n_, ic_); \
      _Pragma("unroll") for (int e = 0; e < 4; ++e) { rq[e] = *(const u32x4*)(PQ + (rw_ * 2048u + qo_l + (unsigned)e * 32768u)); rk[e] = *(const u32x4*)(PK + (rw_ * 2048u + qo_l + (unsigned)e * 32768u)); } \
      _Pragma("unroll") for (int e = 0; e < 2; ++e) rv[e] = *(const u32x4*)(PV + (rw_ * 4096u + vo_l + (unsigned)e * 131072u)); } while (0)
    RET_LOAD(0);
#pragma unroll 1
    for (int step = 0; step < 68; ++step) {
      bool isctx; int t0; RET_CHUNK(step, isctx, t0);
      const int row0 = tok_row(b, t0, isctx);
      __syncthreads();
#pragma unroll
      for (int e = 0; e < 4; ++e) { const int row = (tid >> 5) + 16 * e, pc = tid & 31; *(u32x4*)(Qs + row * QS + pc * 8) = rq[e]; *(u32x4*)(Ks + row * QS + pc * 8) = rk[e]; }
#pragma unroll
      for (int e = 0; e < 2; ++e) { u32x4 o;
#pragma unroll
        for (int w = 0; w < 4; ++w) o[w] = pk2(lo2f(rv[e][w]) * dkv[e], hi2f(rv[e][w]) * dkv[e]);
        *(u32x4*)(Vs + ((tid >> 4) + 32 * e) * VS + (tid & 15) * 8) = o; }
      if (step + 1 < 68) RET_LOAD(step + 1);
      __syncthreads();
      if (wid < 4) {
        f32x16 sc;
#pragma unroll
        for (int e = 0; e < 16; ++e) sc[e] = 0.f;
        sc = mma_tile<256>(sc, Ks + s_tj * 32 * QS, QS, Qs + s_ti * 32 * QS, QS, lane);
        const int i = s_ti * 32 + (lane & 31);
#pragma unroll
        for (int r4 = 0; r4 < 4; ++r4) { u32x2 o; o[0] = pk2(sc[4 * r4] * mk[4 * r4], sc[4 * r4 + 1] * mk[4 * r4 + 1]); o[1] = pk2(sc[4 * r4 + 2] * mk[4 * r4 + 2], sc[4 * r4 + 3] * mk[4 * r4 + 3]);
          *(u32x2*)(Ps + i * TS + s_tj * 32 + 8 * r4 + 4 * g) = o; }
      }
#pragma unroll
      for (int e = 0; e < 16; ++e) cross[e] = 0.f;
      cross = mma_tile<256>(cross, Sts + o_tc * 32 * QS, QS, Qs + o_ti * 32 * QS, QS, lane);
      __syncthreads();
      { f32x16 in_;
#pragma unroll
        for (int e = 0; e < 16; ++e) in_[e] = 0.f;
        const bf16_t* pb = Ps + (o_ti * 32 + (lane & 31)) * TS + 8 * g;
#pragma unroll
        for (int ks = 0; ks < 4; ++ks) in_ = __builtin_amdgcn_mfma_f32_32x32x16_bf16(tr_frag(Vs + 16 * ks * VS + 32 * o_tc, VS, lane), *(const bf16x8*)(pb + 16 * ks), in_, 0, 0, 0);
        const unsigned ob = (unsigned)(row0 + qi) * 4096u + (unsigned)(h * 512 + sl * 128 + o_tc * 32 + 4 * g);
#pragma unroll
        for (int r4 = 0; r4 < 4; ++r4) { u32x2 o; o[0] = pk2(in_[4 * r4] + qd * cross[4 * r4], in_[4 * r4 + 1] + qd * cross[4 * r4 + 1]); o[1] = pk2(in_[4 * r4 + 2] + qd * cross[4 * r4 + 2], in_[4 * r4 + 3] + qd * cross[4 * r4 + 3]);
          *(u32x2*)(O + (ob + (unsigned)(8 * r4))) = o; } }
      { bf16x8 ka[4];
#pragma unroll
        for (int ks = 0; ks < 4; ++ks) ka[ks] = tr_frag(Ks + 16 * ks * QS + 32 * wid, QS, lane);
#pragma unroll
        for (int x = 0; x < 4; ++x) {
#pragma unroll
          for (int e = 0; e < 16; ++e) S[x][e] *= cd;
#pragma unroll
          for (int ks = 0; ks < 4; ++ks) S[x] = __builtin_amdgcn_mfma_f32_32x32x16_bf16(ka[ks], tr_frag(Vs + 16 * ks * VS + 32 * x, VS, lane), S[x], 0, 0, 0);
          const int c = x * 32 + (lane & 31);
#pragma unroll
          for (int r4 = 0; r4 < 4; ++r4) { u32x2 o; o[0] = pk2(S[x][4 * r4], S[x][4 * r4 + 1]); o[1] = pk2(S[x][4 * r4 + 2], S[x][4 * r4 + 3]); *(u32x2*)(Sts + c * QS + wid * 32 + 8 * r4 + 4 * g) = o; } } }
    }
    __syncthreads();
  }
#undef RET_CHUNK
#undef RET_LOAD
}

__global__ void __launch_bounds__(512, 2) mega(Params p_in) {
  Params p = p_in; p.wid = __builtin_amdgcn_readfirstlane((int)(threadIdx.x >> 6));
  extern __shared__ __attribute__((aligned(16))) unsigned char shm[];
  cg::grid_group grid = cg::this_grid();
  PG8_LAS unsigned char* lds = (PG8_LAS unsigned char*)shm;
  const bf16_t* H = (const bf16_t*)(p.ws + OFF_H);
#pragma unroll 1
  for (int rep = 0; rep < (PROBE == 1 ? 2 : 1); ++rep) { phase_filters(p, shm); phase_mod(p, shm); }
  grid.sync();
  for (int l = 0; l < 2; ++l) {
#pragma unroll 1
    for (int rep = 0; rep < (PROBE == 1 ? 2 : 1); ++rep) { phase_cvt(p, l, shm); phase_norm(p, l); }
    grid.sync();
    { pg8::Gemm g; g.wid = p.wid; g.A = H; g.Bt = (const bf16_t*)(p.ws + OFF_WTIN); g.M = MT; g.N = INW; g.K = DM;
      pg8::Order S; S.init(64, 96, (int)gridDim.x, (int)blockIdx.x, 4, l == 0 ? 96 : 24, l == 0 ? 0 : 8);
      EpiG1 E; E.ws = p.ws; pg8::gemm_phase<EpiG1, pg8::Order>(lds, g, S, E); }
    grid.sync();
#pragma unroll 1
    for (int rep = 0; rep < (PROBE == 2 ? 2 : 1); ++rep) phase_prep(p, l, shm, rep ? 4 : 7);
    grid.sync();
    phase_conv(p, l, shm); phase_ret(p, l, shm);
    grid.sync();
#pragma unroll 1
    for (int rep = 0; rep < (PROBE == 2 ? 2 : 1); ++rep) phase_post(p, l, shm, rep ? 3 : 7);
    grid.sync();
    { const int nM = (l == 0) ? 68 : 64;
      pg8::Order S; S.init(nM, 8, (int)gridDim.x, (int)blockIdx.x, 0, 0, 0);
      { pg8::Gemm g; g.wid = p.wid; g.A = H; g.Bt = (const bf16_t*)(p.ws + OFF_WTHY); g.M = nM * 256; g.N = DM; g.K = DM; EpiG23<0> E; E.ws = p.ws; pg8::gemm_phase<EpiG23<0>, pg8::Order>(lds, g, S, E); }
      { pg8::Gemm g; g.wid = p.wid; g.A = (const bf16_t*)(p.ws + OFF_OF); g.Bt = (const bf16_t*)(p.ws + OFF_WTRET); g.M = nM * 256; g.N = DM; g.K = 4096; EpiG23<1> E; E.ws = p.ws; pg8::gemm_phase<EpiG23<1>, pg8::Order>(lds, g, S, E); }
      grid.sync();
      { pg8::Gemm g; g.wid = p.wid; g.A = (const bf16_t*)(p.ws + OFF_T1); g.Bt = (const bf16_t*)(p.ws + OFF_WTO); g.M = nM * 256; g.N = DM; g.K = DM;
        EpiG4 E; E.xin = (l == 0) ? p.x : p.out; E.cin = p.ctx; E.xout = p.out; E.cout = (float*)(p.ws + OFF_CTXR); E.mod = (const float*)(p.ws + OFF_MOD) + (size_t)l * 5 * 6144;
        pg8::gemm_phase<EpiG4, pg8::Order>(lds, g, S, E); } }
    grid.sync();
  }
  phase_final(p);
}

extern "C" void kernel_launch(void* const* d_in, const int* in_sizes, int n_in, void* d_out, int out_size, void* d_ws, size_t ws_size, hipStream_t stream) {
  constexpr size_t kDynLds = 162816;
  static int grid_blocks = 0;
  if (!grid_blocks) {
    hipFuncSetAttribute((const void*)mega, hipFuncAttributeMaxDynamicSharedMemorySize, (int)kDynLds);
    int dev = 0, cus = 0, per_cu = 0;
    hipGetDevice(&dev);
    hipDeviceGetAttribute(&cus, hipDeviceAttributeMultiprocessorCount, dev);
    hipOccupancyMaxActiveBlocksPerMultiprocessor(&per_cu, (const void*)mega, 512, kDynLds);
    grid_blocks = cus * (per_cu >= 1 ? 1 : 0);
    if (ws_size < WS_NEED || grid_blocks <= 0) { fprintf(stderr, "workspace %zu < %zu or no occupancy (%d)\n", ws_size, (size_t)WS_NEED, per_cu); grid_blocks = grid_blocks > 0 ? grid_blocks : 256; }
  }
  Params p{};
  p.x = (const float*)d_in[0]; p.c = (const float*)d_in[1]; p.ctx = (const float*)d_in[2]; p.c_ctx = (const float*)d_in[3]; p.ln_g = (const float*)d_in[4];
  p.ada_w = (const float*)d_in[5]; p.ada_b = (const float*)d_in[6]; p.w_in = (const float*)d_in[7]; p.conv_w = (const float*)d_in[8]; p.conv_b = (const float*)d_in[9];
  p.fw1 = (const float*)d_in[10]; p.fb1 = (const float*)d_in[11]; p.fw2 = (const float*)d_in[12]; p.fb2 = (const float*)d_in[13]; p.fw3 = (const float*)d_in[14]; p.fb3 = (const float*)d_in[15];
  p.ffreq = (const float*)d_in[16]; p.fwout = (const float*)d_in[17]; p.hy_bias = (const float*)d_in[18]; p.ret_decay = (const float*)d_in[19];
  p.w_hy_out = (const float*)d_in[20]; p.w_ret_out = (const float*)d_in[21]; p.w_o = (const float*)d_in[22]; p.final_g = (const float*)d_in[23];
  p.out = (float*)d_out; p.ws = (unsigned char*)d_ws;
  void* args[] = {&p};
  hipError_t e = hipLaunchCooperativeKernel((void*)mega, dim3(grid_blocks), dim3(512), args, kDynLds, stream);
  if (e != hipSuccess) fprintf(stderr, "cooperative launch failed: %s (grid %d)\n", hipGetErrorString(e), grid_blocks);
}
```

```cpp
#include <hip/hip_runtime.h>
#include <hip/hip_cooperative_groups.h>
#include <cstdio>
namespace cg = cooperative_groups;
#ifndef PROBE
#define PROBE 0
#endif

typedef unsigned short bf16_t;
typedef short bf16x8 __attribute__((ext_vector_type(8)));
typedef float f32x4 __attribute__((ext_vector_type(4)));
typedef float f32x16 __attribute__((ext_vector_type(16)));
typedef unsigned u32x4 __attribute__((ext_vector_type(4)));
typedef unsigned u32x2 __attribute__((ext_vector_type(2)));
typedef short s16x4 __attribute__((ext_vector_type(4)));
#define DI __device__ __forceinline__

DI int otid(int wid) { int t; asm volatile("v_mbcnt_lo_u32_b32 %0, -1, 0\n\tv_mbcnt_hi_u32_b32 %0, -1, %0" : "=v"(t)); return wid * 64 + t; }
DI float wsum(float v, int lane) {
#pragma unroll
  for (int o = 32; o > 0; o >>= 1) v += __int_as_float(__builtin_amdgcn_ds_bpermute((lane ^ o) << 2, __float_as_int(v)));
  return v; }
DI float bf2f(bf16_t u) { return __uint_as_float(((unsigned)u) << 16); }
typedef __bf16 bf16v2 __attribute__((ext_vector_type(2)));
typedef float f32v2 __attribute__((ext_vector_type(2)));
DI unsigned pk2(float lo, float hi) { f32v2 v = {lo, hi}; bf16v2 b = __builtin_convertvector(v, bf16v2); return __builtin_bit_cast(unsigned, b); }
DI bf16_t f2bf(float f) { return (bf16_t)(pk2(f, 0.f) & 0xffffu); }
DI float lo2f(unsigned u) { return __uint_as_float(u << 16); }
DI float hi2f(unsigned u) { return __uint_as_float(u & 0xffff0000u); }
DI float sigmoidf_(float v) { return 1.f / (1.f + __expf(-v)); }
DI float siluf_(float v) { return v / (1.f + __expf(-v)); }

constexpr int DM = 2048, NB = 4, SEQ = 4096, CTXL = 256, NLAT = NB * SEQ, NCTX = NB * CTXL, MT = NLAT + NCTX;
constexpr int INW = 24576, NH = 8, DK = 256, DV = 512, TT = SEQ + CTXL;
constexpr int LOFF = 4128, GLEN = 8320;      constexpr size_t G_LAYER = ((size_t)2048 * 8320 * 2 + 255) & ~(size_t)255;
constexpr int USTR = 6560;

constexpr size_t AL(size_t x) { return (x + 255) & ~(size_t)255; }
constexpr size_t OFF_WTIN = 0;
constexpr size_t OFF_WTHY = OFF_WTIN + AL((size_t)INW * DM * 2);
constexpr size_t OFF_WTRET = OFF_WTHY + AL((size_t)DM * DM * 2);
constexpr size_t OFF_WTO = OFF_WTRET + AL((size_t)DM * 4096 * 2);
constexpr size_t OFF_G = OFF_WTO + AL((size_t)DM * DM * 2);
constexpr size_t OFF_GC = OFF_G + 2 * AL((size_t)DM * GLEN * 2);
constexpr size_t OFF_MOD = OFF_GC + AL((size_t)DM * 512 * 4);
constexpr size_t OFF_H = OFF_MOD + AL((size_t)2 * 5 * 6144 * 4);
constexpr size_t OFF_PQ = OFF_H + AL((size_t)MT * DM * 2);
constexpr size_t OFF_PK = OFF_PQ + AL((size_t)MT * DM * 2);
constexpr size_t OFF_PV = OFF_PK + AL((size_t)MT * DM * 2);
constexpr size_t OFF_PRG = OFF_PV + AL((size_t)MT * 4096 * 2);
constexpr size_t OFF_PHY = OFF_PRG + AL((size_t)MT * 4096 * 2);
constexpr size_t OFF_PHG = OFF_PHY + AL((size_t)MT * 6144 * 2);
constexpr size_t OFF_PMG = OFF_PHG + AL((size_t)MT * DM * 2);
constexpr size_t OFF_KT = OFF_PMG + AL((size_t)MT * 4096 * 2);
constexpr size_t OFF_VT = OFF_KT + AL((size_t)NB * NH * DK * TT * 2);
constexpr size_t OFF_UT = OFF_VT + AL((size_t)NB * NH * DV * TT * 2);
constexpr size_t OFF_UTC = OFF_UT + AL((size_t)DM * NB * SEQ * 2);
constexpr size_t OFF_HV = OFF_UTC + AL((size_t)DM * NB * CTXL * 2);
constexpr size_t OFF_HX0 = OFF_HV + AL((size_t)MT * DM * 2);
constexpr size_t OFF_CTXR = OFF_HX0 + AL((size_t)MT * DM * 2);
constexpr size_t OFF_BAR = OFF_CTXR + AL((size_t)NCTX * DM * 4);
constexpr size_t WS_NEED = OFF_BAR + AL((size_t)3456 * 4);
constexpr size_t OFF_OF = OFF_KT, OFF_OB = OFF_PHY, OFF_T1 = OFF_PHY + AL((size_t)MT * 4096 * 2);

struct Params {
  const float *x, *c, *ctx, *c_ctx, *ln_g, *ada_w, *ada_b, *w_in, *conv_w, *conv_b, *fw1, *fb1, *fw2, *fb2, *fw3, *fb3, *ffreq, *fwout, *hy_bias, *ret_decay, *w_hy_out, *w_ret_out, *w_o, *final_g;
  float* out;
  unsigned char* ws;
  int wid, pad_;
};


#define XB_TMO      128
#define XB_XCNT(j)  (256  + 64 * (j))
#define XB_XSUB(j)  (1280 + 64 * (j))
#define XB_XGEN(j)  (2304 + 64 * (j))
#define XB_TOP      3328
#define XB_TOPGEN   3392
#define XCD_BAR_WORDS 3456
#define XB_SPIN_CAP (1u << 18)
#define XLAS __attribute__((address_space(3)))
DI unsigned xb_ld(unsigned* p)              { return __hip_atomic_load(p, __ATOMIC_RELAXED, __HIP_MEMORY_SCOPE_AGENT); }
DI unsigned xb_add(unsigned* p, unsigned v) { return __hip_atomic_fetch_add(p, v, __ATOMIC_RELAXED, __HIP_MEMORY_SCOPE_AGENT); }
DI unsigned xb_xcc_id() { return (unsigned)__builtin_amdgcn_s_getreg((3 << 11) | 20) & 0xFu; }
#define XB_SPIN(cond, bar) do { unsigned _sp = 0; while (cond) { __builtin_amdgcn_s_sleep(1); \
    if ((++_sp & 255u) == 0u) { if (xb_ld(&(bar)[XB_TMO])) break; if (_sp > XB_SPIN_CAP) { atomicAdd(&(bar)[XB_TMO], 1u); break; } } } } while (0)
struct XcdBarrier { unsigned* bar; unsigned x; volatile XLAS unsigned* st; };
DI XcdBarrier xcd_barrier_post(unsigned* bar, volatile XLAS unsigned* st, bool leader) {
    XcdBarrier b; b.bar = bar; b.x = xb_xcc_id(); b.st = st;
    if (leader) (void)xb_add(&bar[XB_XCNT(b.x)], 1u);
    return b;
}
DI void xcd_barrier_complete(unsigned* bar, unsigned x, unsigned& nloc, unsigned& nx) {
    const unsigned G = gridDim.x * gridDim.y * gridDim.z;
    unsigned sum, cnt, mine, sp = 0u;
    for (;;) {
        sum = 0u; cnt = 0u; mine = 0u;
#pragma unroll
        for (unsigned j = 0; j < 16; ++j) { const unsigned c = xb_ld(&bar[XB_XCNT(j)]); sum += c; cnt += (c > 0u) ? 1u : 0u; mine = (j == x) ? c : mine; }
        if (sum == G) break;
        __builtin_amdgcn_s_sleep(1);
        if ((++sp & 255u) == 0u) { if (xb_ld(&bar[XB_TMO])) break; if (sp > XB_SPIN_CAP) { atomicAdd(&bar[XB_TMO], 1u); break; } }
    }
    nloc = mine > 0u ? mine : 1u; nx = cnt > 0u ? cnt : 1u;
}
DI void xcd_barrier(const XcdBarrier& b, bool leader) {
    asm volatile("s_waitcnt vmcnt(0)" ::: "memory");
    __syncthreads();
    if (leader) {
        unsigned* bar = b.bar;
        __builtin_amdgcn_s_waitcnt(0);
        unsigned nloc = b.st[0], nx = b.st[1];
        if (nloc == 0u) { xcd_barrier_complete(bar, b.x, nloc, nx); b.st[0] = nloc; b.st[1] = nx; }
        const unsigned old = xb_add(&bar[XB_XSUB(b.x)], 1u);
        const unsigned gen = old / nloc;
        if (old + 1u == (gen + 1u) * nloc) {
            __builtin_amdgcn_fence(__ATOMIC_RELEASE, "agent");
            asm volatile("s_waitcnt vmcnt(0)" ::: "memory");
            const unsigned og = xb_add(&bar[XB_TOP], 1u);
            const unsigned tg = og / nx;
            if (og + 1u == (tg + 1u) * nx) xb_add(&bar[XB_TOPGEN], 1u);
            else XB_SPIN(xb_ld(&bar[XB_TOPGEN]) == tg, bar);
            __builtin_amdgcn_fence(__ATOMIC_ACQUIRE, "agent");
            xb_add(&bar[XB_XGEN(b.x)], 1u);
            asm volatile("s_waitcnt vmcnt(0)" ::: "memory");
        } else {
            XB_SPIN(xb_ld(&bar[XB_XGEN(b.x)]) == gen, bar);
            __builtin_amdgcn_fence(__ATOMIC_ACQUIRE, "agent");
            asm volatile("s_waitcnt vmcnt(0)" ::: "memory");
        }
    }
    __syncthreads();
}

namespace pg8 {
#define PG8_LAS __attribute__((address_space(3)))
constexpr int BM = 256, BK = 64, HALF = 128, HTB = HALF * BK * 2, STAGE_BYTES = 8 * HTB, NXCD = 8, WGM = 8;
__host__ __device__ __forceinline__ int lds_byte(int r, int c) { const int st = (r >> 4) * 2 + (c >> 5), rr = r & 15, cc = c & 31, ob = rr * 64 + cc * 2; return st * 1024 + (ob ^ (((ob >> 9) & 1) << 5)); }
__host__ __device__ __forceinline__ void stage_rc(int b, int& R, int& C) { const int st = b / 1024, sb = b % 1024, swz = sb ^ (((sb >> 9) & 1) << 5); R = (st >> 1) * 16 + swz / 64; C = (st & 1) * 32 + (swz % 64) / 2; }
__host__ __device__ __forceinline__ int perm32(int rho) { const int n = rho >> 4, i = rho & 15; return 8 * (i >> 2) + 4 * n + (i & 3); }
struct Unit { int pm, pn; };
struct Gemm { const bf16_t* A; const bf16_t* Bt; int M, N, K, wid; };
struct Order {
    int nM, nN, nwg, G, c, nx_m, nx_n, x_pn0;
    __device__ void init(int nM_, int nN_, int G_, int c_, int nx_m_, int nx_n_, int x_pn0_) { nM = nM_; nN = nN_; nwg = nM * nN; G = G_; c = c_; nx_m = nx_m_; nx_n = nx_n_; x_pn0 = x_pn0_; }
    __device__ bool next(int i, Unit& u) const {
        const long L = (long)i * G + c;
        if (L >= nwg) { const int e = (int)(L - nwg); if (e >= nx_m * nx_n) return false; u.pm = nM + e % nx_m; u.pn = x_pn0 + e / nx_m; return true; }
        int wgid = (int)L; { const int q = nwg / NXCD, r = nwg % NXCD, xcd = wgid % NXCD, off = wgid / NXCD; wgid = (xcd < r ? xcd * (q + 1) : r * (q + 1) + (xcd - r) * q) + off; }
        const int nig = WGM * nN, gid = wgid / nig, fm = gid * WGM, gsz = (nM - fm) < WGM ? (nM - fm) : WGM;
        u.pm = fm + ((wgid % nig) % gsz); u.pn = (wgid % nig) / gsz; return true;
    }
    __device__ __forceinline__ void a_ready(const Unit&) const {}
    __device__ __forceinline__ void done(const Unit&) const {}
};
template <class Epi, class Sched>
__device__ __forceinline__ void gemm_phase(PG8_LAS unsigned char* lds, const Gemm g, const Sched& S, const Epi& E) {
    const int tid = otid(g.wid), wid = __builtin_amdgcn_readfirstlane(tid >> 6), lane = tid & 63, wr = wid >> 2, wc = wid & 3, fr = lane & 15, fq = lane >> 4;
    const int K = g.K, nt = K / BK;
    unsigned voffA[2], voffB[2];
#pragma unroll
    for (int i = 0; i < 2; ++i) { int R, C; stage_rc(tid * 16 + i * 8192, R, C); const int Rb = Epi::PERM ? ((R & ~31) + perm32(R & 31)) : R;
        voffA[i] = (unsigned)(R * K + C) * 2u; voffB[i] = (unsigned)(Rb * K + C) * 2u; }
    const size_t kstep = (size_t)(BK * 2);
    const size_t hstep = (size_t)HALF * K * 2;
    const size_t tstep = 2 * hstep;
    const unsigned ldsw = (unsigned)wid * 1024u;
    const int aoff = lds_byte(wr * 64 + fr, fq * 8), boff = lds_byte(wc * 32 + fr, fq * 8);
#define PG8_SA(b, h) (((b) * 2 + (h)) * HTB)
#define PG8_SB(b, h) ((4 + (b) * 2 + (h)) * HTB)
#define PG8_STAGE(bufoff, gbase, voff) do { _Pragma("unroll") for (int _i = 0; _i < 2; ++_i) \
        __builtin_amdgcn_global_load_lds((const unsigned*)((const char*)(gbase) + (voff)[_i]), (PG8_LAS unsigned*)(lds + (bufoff) + ldsw + _i * 8192), 16, 0, 0); } while (0)
#define PG8_LDA(dst, b, h) do { _Pragma("unroll") for (int m = 0; m < 4; ++m) _Pragma("unroll") for (int k = 0; k < 2; ++k) dst[m][k] = *(const PG8_LAS bf16x8*)(lds + PG8_SA(b, h) + aoff + m * 2048 + k * 1024); } while (0)
#define PG8_LDB(dst, b, h) do { _Pragma("unroll") for (int n = 0; n < 2; ++n) _Pragma("unroll") for (int k = 0; k < 2; ++k) dst[n][k] = *(const PG8_LAS bf16x8*)(lds + PG8_SB(b, h) + boff + n * 2048 + k * 1024); } while (0)
#define PG8_MMA(ai, bj, At, Bt) do { __builtin_amdgcn_s_setprio(1); _Pragma("unroll") for (int m = 0; m < 4; ++m) _Pragma("unroll") for (int n = 0; n < 2; ++n) _Pragma("unroll") for (int k = 0; k < 2; ++k) \
        acc[ai][bj][m][n] = __builtin_amdgcn_mfma_f32_16x16x32_bf16(Bt[n][k], At[m][k], acc[ai][bj][m][n], 0, 0, 0); __builtin_amdgcn_s_setprio(0); } while (0)
#define PG8_WAIT_V(n) asm volatile("s_waitcnt vmcnt(" #n ")" ::: "memory")
#define PG8_WAIT_L(n) asm volatile("s_waitcnt lgkmcnt(" #n ")" ::: "memory")
#define PG8_BAR __builtin_amdgcn_s_barrier()
#define PG8_SCHED __builtin_amdgcn_sched_barrier(0)
    Unit cur, nxt; int ui = 0;
    if (!S.next(0, cur)) return;
    f32x4 acc[2][2][4][2];
#pragma unroll
    for (int a = 0; a < 2; ++a)
#pragma unroll
        for (int b = 0; b < 2; ++b)
#pragma unroll
            for (int m = 0; m < 4; ++m)
#pragma unroll
                for (int n = 0; n < 2; ++n) acc[a][b][m][n] = (f32x4){0.f, 0.f, 0.f, 0.f};
    bf16x8 At[4][2], B0[2][2], B1[2][2];
    const char* cA = (const char*)g.A + (size_t)cur.pm * tstep; const char* cB = (const char*)g.Bt + (size_t)cur.pn * tstep;
    S.a_ready(cur);
    PG8_STAGE(PG8_SB(0, 0), cB, voffB); PG8_STAGE(PG8_SA(0, 0), cA, voffA); PG8_STAGE(PG8_SB(0, 1), cB + hstep, voffB); PG8_STAGE(PG8_SA(0, 1), cA + hstep, voffA);
    if (wr == 1) PG8_BAR;
    PG8_WAIT_V(4); PG8_BAR;
    PG8_STAGE(PG8_SB(1, 0), cB + kstep, voffB); PG8_STAGE(PG8_SA(1, 0), cA + kstep, voffA); PG8_STAGE(PG8_SB(1, 1), cB + hstep + kstep, voffB);
    PG8_WAIT_V(6); PG8_BAR;
    for (;;) {
        const bool has_next = S.next(ui + 1, nxt);
        const char* nA = has_next ? (const char*)g.A + (size_t)nxt.pm * tstep : cA; const char* nB = has_next ? (const char*)g.Bt + (size_t)nxt.pn * tstep : cB;
        for (int t = 0; t < nt; t += 2) {
            const bool last = (t == nt - 2);
            const char* a1 = cA + (size_t)(t + 1) * kstep;
            const char* a2 = last ? nA : cA + (size_t)(t + 2) * kstep; const char* b2 = last ? nB : cB + (size_t)(t + 2) * kstep;
            const char* a3 = a2 + kstep; const char* b3 = b2 + kstep;
            if (last && has_next) S.a_ready(nxt);
            PG8_LDB(B0, 0, 0); PG8_SCHED; PG8_LDA(At, 0, 0); PG8_STAGE(PG8_SA(1, 1), a1 + hstep, voffA);
            PG8_WAIT_L(8); PG8_BAR; PG8_WAIT_L(0); PG8_MMA(0, 0, At, B0); PG8_BAR; PG8_SCHED;
            PG8_LDB(B1, 0, 1); PG8_STAGE(PG8_SB(0, 0), b2, voffB);
            PG8_BAR; PG8_WAIT_L(0); PG8_MMA(0, 1, At, B1); PG8_BAR;
            PG8_LDA(At, 0, 1); PG8_STAGE(PG8_SA(0, 0), a2, voffA);
            PG8_BAR; PG8_WAIT_L(0); PG8_MMA(1, 0, At, B0); PG8_BAR; PG8_SCHED;
            PG8_STAGE(PG8_SB(0, 1), b2 + hstep, voffB);
            PG8_WAIT_V(6); PG8_BAR; PG8_MMA(1, 1, At, B1); PG8_BAR;
            PG8_LDB(B0, 1, 0); PG8_SCHED; PG8_LDA(At, 1, 0); PG8_STAGE(PG8_SA(0, 1), a2 + hstep, voffA);
            PG8_WAIT_L(8); PG8_BAR; PG8_WAIT_L(0); PG8_MMA(0, 0, At, B0); PG8_BAR; PG8_SCHED;
            PG8_LDB(B1, 1, 1); PG8_STAGE(PG8_SB(1, 0), b3, voffB);
            PG8_BAR; PG8_WAIT_L(0); PG8_MMA(0, 1, At, B1); PG8_BAR;
            PG8_LDA(At, 1, 1); PG8_STAGE(PG8_SA(1, 0), a3, voffA);
            PG8_BAR; PG8_WAIT_L(0); PG8_MMA(1, 0, At, B0); PG8_BAR; PG8_SCHED;
            PG8_STAGE(PG8_SB(1, 1), b3 + hstep, voffB);
            PG8_WAIT_V(6); PG8_BAR; PG8_MMA(1, 1, At, B1); PG8_BAR;
        }
        if constexpr (!Epi::AFTER_DRAIN) { E(acc, cur, wr, wc, fr, fq); S.done(cur); }
        if (!has_next) break;
#pragma unroll
        for (int a = 0; a < 2; ++a)
#pragma unroll
            for (int b = 0; b < 2; ++b)
#pragma unroll
                for (int m = 0; m < 4; ++m)
#pragma unroll
                    for (int n = 0; n < 2; ++n) acc[a][b][m][n] = (f32x4){0.f, 0.f, 0.f, 0.f};
        cur = nxt; cA = nA; cB = nB; ++ui;
    }
    PG8_WAIT_V(0);
    if (wr == 0) PG8_BAR;
    PG8_BAR;
    if constexpr (Epi::AFTER_DRAIN) { E.fused(acc, cur, wr, wc, fr, fq, lds, wid, lane); S.done(cur); }
#undef PG8_SA
#undef PG8_SB
#undef PG8_STAGE
#undef PG8_LDA
#undef PG8_LDB
#undef PG8_MMA

#undef PG8_WAIT_V
#undef PG8_WAIT_L
#undef PG8_BAR
#undef PG8_SCHED
}
}

struct EpiG1 {
  static constexpr bool PERM = true, AFTER_DRAIN = false;
  unsigned char* ws;
  DI void operator()(const f32x4 (&acc)[2][2][4][2], const pg8::Unit& u, int wr, int wc, int fr, int fq) const {
    const int pn = u.pn; size_t off; int ld, c0;
    if (pn < 8) { off = OFF_PQ; ld = 2048; c0 = pn * 256; }
    else if (pn < 16) { off = OFF_PK; ld = 2048; c0 = (pn - 8) * 256; }
    else if (pn < 32) { off = OFF_PV; ld = 4096; c0 = (pn - 16) * 256; }
    else if (pn < 48) { off = OFF_PRG; ld = 4096; c0 = (pn - 32) * 256; }
    else if (pn < 72) { off = OFF_PHY; ld = 6144; c0 = (pn - 48) * 256; }
    else if (pn < 80) { off = OFF_PHG; ld = 2048; c0 = (pn - 72) * 256; }
    else { off = OFF_PMG; ld = 4096; c0 = (pn - 80) * 256; }
    bf16_t* base = (bf16_t*)(ws + off);
    const int row0 = u.pm * 256 + wr * 64 + fr, col0 = c0 + wc * 32 + 8 * fq;
#pragma unroll
    for (int ai = 0; ai < 2; ++ai)
#pragma unroll
      for (int m = 0; m < 4; ++m) { bf16_t* rowp = base + (size_t)(row0 + ai * 128 + m * 16) * ld + col0;
#pragma unroll
        for (int bj = 0; bj < 2; ++bj) { const f32x4 v0 = acc[ai][bj][m][0], v1 = acc[ai][bj][m][1];
          u32x4 o; o[0] = pk2(v0[0], v0[1]); o[1] = pk2(v0[2], v0[3]); o[2] = pk2(v1[0], v1[1]); o[3] = pk2(v1[2], v1[3]);
          *(u32x4*)(rowp + bj * 128) = o; } }
  }
};
template <int SECOND> struct EpiG23 {
  static constexpr bool PERM = true, AFTER_DRAIN = false;
  unsigned char* ws;
  DI void operator()(const f32x4 (&acc)[2][2][4][2], const pg8::Unit& u, int wr, int wc, int fr, int fq) const {
    bf16_t* T1 = (bf16_t*)(ws + OFF_T1); const bf16_t* MG = (const bf16_t*)(ws + OFF_PMG) + (SECOND ? 2048 : 0);
    const int row0 = u.pm * 256 + wr * 64 + fr, col0 = u.pn * 256 + wc * 32 + 8 * fq;
#pragma unroll
    for (int ai = 0; ai < 2; ++ai)
#pragma unroll
      for (int m = 0; m < 4; ++m) { const size_t row = (size_t)(row0 + ai * 128 + m * 16);
#pragma unroll
        for (int bj = 0; bj < 2; ++bj) { const int col = col0 + bj * 128;
          const u32x4 g = *(const u32x4*)(MG + row * 4096 + col);
          const f32x4 v0 = acc[ai][bj][m][0], v1 = acc[ai][bj][m][1];
          float r[8];
          r[0] = sigmoidf_(lo2f(g[0])) * v0[0]; r[1] = sigmoidf_(hi2f(g[0])) * v0[1]; r[2] = sigmoidf_(lo2f(g[1])) * v0[2]; r[3] = sigmoidf_(hi2f(g[1])) * v0[3];
          r[4] = sigmoidf_(lo2f(g[2])) * v1[0]; r[5] = sigmoidf_(hi2f(g[2])) * v1[1]; r[6] = sigmoidf_(lo2f(g[3])) * v1[2]; r[7] = sigmoidf_(hi2f(g[3])) * v1[3];
          if (SECOND) { const u32x4 t = *(const u32x4*)(T1 + row * 2048 + col);
            r[0] += lo2f(t[0]); r[1] += hi2f(t[0]); r[2] += lo2f(t[1]); r[3] += hi2f(t[1]); r[4] += lo2f(t[2]); r[5] += hi2f(t[2]); r[6] += lo2f(t[3]); r[7] += hi2f(t[3]); }
          u32x4 o; o[0] = pk2(r[0], r[1]); o[1] = pk2(r[2], r[3]); o[2] = pk2(r[4], r[5]); o[3] = pk2(r[6], r[7]);
          *(u32x4*)(T1 + row * 2048 + col) = o; } }
  }
};
struct EpiG4 {
  static constexpr bool PERM = false, AFTER_DRAIN = false;
  const float* xin; const float* cin; float* xout; float* cout; const float* mod;
  DI void operator()(const f32x4 (&acc)[2][2][4][2], const pg8::Unit& u, int wr, int wc, int fr, int fq) const {
    const int row0 = u.pm * 256 + wr * 64 + fr, col0 = u.pn * 256 + wc * 32 + 4 * fq;
#pragma unroll
    for (int ai = 0; ai < 2; ++ai)
#pragma unroll
      for (int m = 0; m < 4; ++m) { const int row = row0 + ai * 128 + m * 16;
        const float* src; float* dst; const float* gate;
        if (row < NLAT) { src = xin + (size_t)row * 2048; dst = xout + (size_t)row * 2048; gate = mod + (row >> 12) * 6144 + 4096; }
        else { src = cin + (size_t)(row - NLAT) * 2048; dst = cout + (size_t)(row - NLAT) * 2048; gate = mod + 4 * 6144 + 4096; }
#pragma unroll
        for (int bj = 0; bj < 2; ++bj)
#pragma unroll
          for (int n = 0; n < 2; ++n) { const int col = col0 + bj * 128 + n * 16;
            const f32x4 xv = *(const f32x4*)(src + col), gv = *(const f32x4*)(gate + col);
            *(f32x4*)(dst + col) = xv + gv * acc[ai][bj][m][n]; } }
  }
};

__device__ void phase_mod(const Params& p, unsigned char* shm) {
  float* sc = (float*)shm; float* red = sc + 5 * 2048;
  const int tid = otid(p.wid);
  for (int i = tid; i < 5 * 2048; i += 512) { const int j = i >> 11, k = i & 2047; const float v = (j < 4) ? p.c[j * 2048 + k] : p.c_ctx[k]; sc[i] = v / (1.f + expf(-v)); }
  __syncthreads();
  float* mod = (float*)(p.ws + OFF_MOD);
  const int cq = tid & 7, ks = tid >> 3;
  for (int it = blockIdx.x; it < 384; it += gridDim.x) {
    const int l = it / 192, nb = (it % 192) * 32;
    const float* W = p.ada_w + (size_t)l * 2048 * 6144 + nb + cq * 4;
    float acc[5][4];
#pragma unroll
    for (int j = 0; j < 5; ++j) { acc[j][0] = 0.f; acc[j][1] = 0.f; acc[j][2] = 0.f; acc[j][3] = 0.f; }
#pragma unroll 4
    for (int kk = 0; kk < 32; ++kk) { const int k = ks * 32 + kk; const float4 w = *(const float4*)(W + (size_t)k * 6144);
#pragma unroll
      for (int j = 0; j < 5; ++j) { const float s = sc[j * 2048 + k]; acc[j][0] += s * w.x; acc[j][1] += s * w.y; acc[j][2] += s * w.z; acc[j][3] += s * w.w; } }
#pragma unroll
    for (int j = 0; j < 5; ++j)
#pragma unroll
      for (int e = 0; e < 4; ++e) red[ks * 160 + j * 32 + cq * 4 + e] = acc[j][e];
    __syncthreads();
    if (tid < 160) { float s = 0.f; for (int q = 0; q < 64; ++q) s += red[q * 160 + tid]; const int j = tid >> 5, n = nb + (tid & 31); mod[(l * 5 + j) * 6144 + n] = s + p.ada_b[l * 6144 + n]; }
    __syncthreads();
  }
}

__device__ void cvt_group(int wid, const float* W, bf16_t* Wt, int K, int N, int k0, int n0, float scale, float* tile) {
  const int tid = otid(wid);
  float4 v[8];
#pragma unroll
  for (int q = 0; q < 4; ++q)
#pragma unroll
    for (int rr = 0; rr < 2; ++rr) { const int k = (tid >> 4) + 32 * rr, n = (tid & 15) * 4; v[q * 2 + rr] = *(const float4*)(W + (size_t)(k0 + q * 64 + k) * N + n0 + n); }
#pragma unroll
  for (int q = 0; q < 4; ++q)
#pragma unroll
    for (int rr = 0; rr < 2; ++rr) { const int k = (tid >> 4) + 32 * rr, n = (tid & 15) * 4; float* t = tile + q * 4160 + k * 65 + n; const float4 x = v[q * 2 + rr]; t[0] = x.x; t[1] = x.y; t[2] = x.z; t[3] = x.w; }
  __syncthreads();
#pragma unroll
  for (int q = 0; q < 4; ++q) { const int n = tid >> 3, k8 = (tid & 7) * 8; const float* t = tile + q * 4160; u32x4 o;
#pragma unroll
    for (int e = 0; e < 4; ++e) o[e] = pk2(t[(k8 + 2 * e) * 65 + n] * scale, t[(k8 + 2 * e + 1) * 65 + n] * scale);
    *(u32x4*)(Wt + (size_t)(n0 + n) * K + k0 + q * 64 + k8) = o; }
  __syncthreads();
}
__device__ void phase_cvt(const Params& p, int l, unsigned char* shm) {
  float* tile = (float*)shm;
  for (int it = blockIdx.x; it < 4096; it += gridDim.x) {
    if (it < 3072) { const int kg = it & 7, n0 = (it >> 3) * 64;
      cvt_group(p.wid, p.w_in + (size_t)l * DM * INW, (bf16_t*)(p.ws + OFF_WTIN), DM, INW, kg * 256, n0, (n0 >= 2048 && n0 < 4096) ? 0.0625f : 1.f, tile); }
    else if (it < 3328) { const int e = it - 3072; cvt_group(p.wid, p.w_hy_out + (size_t)l * DM * DM, (bf16_t*)(p.ws + OFF_WTHY), DM, DM, (e & 7) * 256, (e >> 3) * 64, 1.f, tile); }
    else if (it < 3840) { const int e = it - 3328; cvt_group(p.wid, p.w_ret_out + (size_t)l * 4096 * DM, (bf16_t*)(p.ws + OFF_WTRET), 4096, DM, (e & 15) * 256, (e >> 4) * 64, 1.f, tile); }
    else { const int e = it - 3840; cvt_group(p.wid, p.w_o + (size_t)l * DM * DM, (bf16_t*)(p.ws + OFF_WTO), DM, DM, (e & 7) * 256, (e >> 3) * 64, 1.f, tile); }
  }
}

__device__ void filt_item(const Params& p, int l, int Ls, int T, bool isctx, unsigned char* shm) {
  float* z = (float*)shm; float* ha = z + 17 * 36; float* hb = ha + 17 * 64;
  const int tid = otid(p.wid);
  const float* w1 = p.fw1 + l * 33 * 64; const float* b1 = p.fb1 + l * 64; const float* w2 = p.fw2 + l * 4096; const float* b2 = p.fb2 + l * 64;
  const float* w3 = p.fw3 + l * 4096; const float* b3 = p.fb3 + l * 64; const float* fq = p.ffreq + l * 64; const float* wout = p.fwout + (size_t)l * 64 * 4096;
  for (int i = tid; i < 17 * 33; i += 512) { const int pl = i / 33, f = i % 33; int pp = T * 16 + pl; if (pp > Ls - 1) pp = Ls - 1;
    float val;
    if (f == 0) val = (float)pp / (float)(Ls - 1);
    else { const int j = (f - 1) & 15; const float fj = 1e-4f + (float)j * ((15.f - 1e-4f) / 15.f); const float ang = 6.283185307179586f * (float)pp / (float)Ls; const float a = fj * ang; val = (f <= 16) ? cosf(a) : -sinf(a); }
    z[pl * 36 + f] = val; }
  __syncthreads();
  for (int idx = tid; idx < 17 * 16; idx += 512) { const int pl = idx >> 4, j0 = (idx & 15) * 4; float a[4] = {0.f, 0.f, 0.f, 0.f};
#pragma unroll 3
    for (int k = 0; k < 33; ++k) { const float v = z[pl * 36 + k]; const float4 w = *(const float4*)(w1 + k * 64 + j0); a[0] += v * w.x; a[1] += v * w.y; a[2] += v * w.z; a[3] += v * w.w; }
#pragma unroll
    for (int e = 0; e < 4; ++e) ha[pl * 64 + j0 + e] = sinf(fq[j0 + e] * (a[e] + b1[j0 + e])); }
  __syncthreads();
  for (int idx = tid; idx < 17 * 16; idx += 512) { const int pl = idx >> 4, j0 = (idx & 15) * 4; float a[4] = {0.f, 0.f, 0.f, 0.f};
#pragma unroll 4
    for (int k = 0; k < 64; ++k) { const float v = ha[pl * 64 + k]; const float4 w = *(const float4*)(w2 + k * 64 + j0); a[0] += v * w.x; a[1] += v * w.y; a[2] += v * w.z; a[3] += v * w.w; }
#pragma unroll
    for (int e = 0; e < 4; ++e) hb[pl * 64 + j0 + e] = sinf(fq[j0 + e] * (a[e] + b2[j0 + e])); }
  __syncthreads();
  for (int idx = tid; idx < 17 * 16; idx += 512) { const int pl = idx >> 4, j0 = (idx & 15) * 4; float a[4] = {0.f, 0.f, 0.f, 0.f};
#pragma unroll 4
    for (int k = 0; k < 64; ++k) { const float v = hb[pl * 64 + k]; const float4 w = *(const float4*)(w3 + k * 64 + j0); a[0] += v * w.x; a[1] += v * w.y; a[2] += v * w.z; a[3] += v * w.w; }
#pragma unroll
    for (int e = 0; e < 4; ++e) ha[pl * 64 + j0 + e] = sinf(fq[j0 + e] * (a[e] + b3[j0 + e])); }
  __syncthreads();
  const int c2 = tid * 8; const bool isb = c2 >= 2048; const int cb = c2 & 2047;
  const float mind = logf(0.01f) / 1.5f, maxd = logf(0.01f) / 0.3f;
  bf16_t* G = (bf16_t*)(p.ws + OFF_G + (size_t)l * G_LAYER); float* GC = (float*)(p.ws + OFF_GC);
  for (int pgh = 0; pgh < 4; ++pgh) {
    const int pg = pgh >> 1, c4 = c2 + (pgh & 1) * 4;
    const int plb = pg * 8 + (isb ? 0 : 1);
    float acc[8][4];
#pragma unroll
    for (int e = 0; e < 8; ++e) { acc[e][0] = 0.f; acc[e][1] = 0.f; acc[e][2] = 0.f; acc[e][3] = 0.f; }
#pragma unroll 8
    for (int k = 0; k < 64; ++k) { const float4 wa = *(const float4*)(wout + k * 4096 + c4);
#pragma unroll
      for (int e = 0; e < 8; ++e) { const float h = ha[(plb + e) * 64 + k]; acc[e][0] += h * wa.x; acc[e][1] += h * wa.y; acc[e][2] += h * wa.z; acc[e][3] += h * wa.w; } }
    const int pp0 = T * 16 + plb;
#pragma unroll
    for (int cc = 0; cc < 4; ++cc) { const int c = (c4 & 2047) + cc; const float delta = fabsf(mind + (float)c * ((maxd - mind) / 2047.f));
      float v[8];
#pragma unroll
      for (int e = 0; e < 8; ++e) { const int pp = pp0 + e; v[e] = (pp < Ls) ? acc[e][cc] * __expf(-((float)pp / (float)(Ls - 1)) * delta) : 0.f; }
      if (!isctx) {
        bf16_t* Gc = G + (size_t)c * GLEN;
        if (isb) {
          if (pp0 == 0) { for (int e = 1; e < 8; ++e) Gc[LOFF + e] = f2bf(v[e]); }
          else { u32x4 o; o[0] = pk2(v[0], v[1]); o[1] = pk2(v[2], v[3]); o[2] = pk2(v[4], v[5]); o[3] = pk2(v[6], v[7]); *(u32x4*)(Gc + LOFF + pp0) = o; }
        } else {
          u32x4 o; o[0] = pk2(v[7], v[6]); o[1] = pk2(v[5], v[4]); o[2] = pk2(v[3], v[2]); o[3] = pk2(v[1], v[0]); *(u32x4*)(Gc + LOFF - pp0 - 7) = o;
        }
      } else {
        float* Gc = GC + (size_t)c * 512;
#pragma unroll
        for (int e = 0; e < 8; ++e) { const int pp = pp0 + e; if (isb) { if (pp >= 1 && pp < Ls) Gc[256 - pp] = v[e]; } else { if (pp < Ls) Gc[256 + pp] = v[e]; } }
      }
    }
  }
  if (T == 0 && !isb) {
#pragma unroll 1
    for (int cc = 0; cc < 8; ++cc) { float a = 0.f;
#pragma unroll 4
      for (int k = 0; k < 64; ++k) a += ha[k] * wout[k * 4096 + c2 + cc];
      if (!isctx) G[(size_t)(cb + cc) * GLEN + LOFF] = f2bf(a); else GC[(size_t)(cb + cc) * 512 + 256] = a; }
  }
  __syncthreads();
}
__device__ void phase_filters(const Params& p, unsigned char* shm) {
  for (int it = blockIdx.x; it < 528; it += gridDim.x) { if (it < 512) filt_item(p, it >> 8, SEQ, it & 255, false, shm); else filt_item(p, 0, CTXL, it - 512, true, shm); }
}

__device__ void phase_norm(const Params& p, int l) {
  const int lane = otid(p.wid) & 63, gw = blockIdx.x * 8 + (otid(p.wid) >> 6), nw = gridDim.x * 8;
  const float* mod = (const float*)(p.ws + OFF_MOD) + (size_t)l * 5 * 6144; const float* lng = p.ln_g + l * 2048;
  bf16_t* H = (bf16_t*)(p.ws + OFF_H);
  for (int r = gw; r < MT; r += nw) {
    const float* src; int j;
    if (r < NLAT) { src = (l == 0 ? p.x : p.out) + (size_t)r * 2048; j = r >> 12; }
    else { src = (l == 0 ? p.ctx : (const float*)(p.ws + OFF_CTXR)) + (size_t)(r - NLAT) * 2048; j = 4; }
    const float* sh = mod + j * 6144; const float* sc = sh + 2048;
    float4 v[8]; float ss = 0.f;
#pragma unroll
    for (int i = 0; i < 8; ++i) { v[i] = *(const float4*)(src + i * 256 + lane * 4); ss += v[i].x * v[i].x + v[i].y * v[i].y + v[i].z * v[i].z + v[i].w * v[i].w; }
    ss = wsum(ss, lane);
    const float rs = rsqrtf(ss * (1.f / 2048.f) + 1e-6f);
#pragma unroll
    for (int i = 0; i < 8; ++i) { const int col = i * 256 + lane * 4; const float4 g = *(const float4*)(lng + col), a = *(const float4*)(sc + col), b = *(const float4*)(sh + col);
      u32x2 o; o[0] = pk2(v[i].x * rs * g.x * (1.f + a.x) + b.x, v[i].y * rs * g.y * (1.f + a.y) + b.y); o[1] = pk2(v[i].z * rs * g.z * (1.f + a.z) + b.z, v[i].w * rs * g.w * (1.f + a.w) + b.w);
      *(u32x2*)(H + (size_t)r * 2048 + col) = o; }
  }
}
__device__ void phase_final(const Params& p) {
  const int lane = otid(p.wid) & 63, gw = blockIdx.x * 8 + (otid(p.wid) >> 6), nw = gridDim.x * 8;
  for (int r = gw; r < NLAT; r += nw) {
    float* src = p.out + (size_t)r * 2048; float4 v[8]; float ss = 0.f;
#pragma unroll
    for (int i = 0; i < 8; ++i) { v[i] = *(const float4*)(src + i * 256 + lane * 4); ss += v[i].x * v[i].x + v[i].y * v[i].y + v[i].z * v[i].z + v[i].w * v[i].w; }
    ss = wsum(ss, lane);
    const float rs = rsqrtf(ss * (1.f / 2048.f) + 1e-6f);
#pragma unroll
    for (int i = 0; i < 8; ++i) { const int col = i * 256 + lane * 4; const float4 g = *(const float4*)(p.final_g + col); float4 o; o.x = v[i].x * rs * g.x; o.y = v[i].y * rs * g.y; o.z = v[i].z * rs * g.z; o.w = v[i].w * rs * g.w; *(float4*)(src + col) = o; }
  }
}

DI void tok_tile(int tk, int& b, int& t0, bool& isctx) { if (tk < 256) { b = tk >> 6; t0 = (tk & 63) * 64; isctx = false; } else { b = (tk - 256) >> 2; t0 = ((tk - 256) & 3) * 64; isctx = true; } }
DI int tok_row(int b, int t, bool isctx) { return isctx ? NLAT + b * CTXL + t : b * SEQ + t; }

__device__ void phase_prep(const Params& p, int l, unsigned char* shm, int mask) {
  const int tid = otid(p.wid), lane = tid & 63;
  float2* cs = (float2*)shm;
  unsigned char* reg2 = shm + 32768;
  for (int i = tid; i < 4096; i += 512) { const int pos = i >> 6, j = i & 63; const float inv = 1.f / powf(10000.f, (float)j / 64.f); float s, c; sincosf((float)pos * inv, &s, &c); cs[i] = make_float2(c, s); }
  __syncthreads();
  if (mask & 1) { const int gw = blockIdx.x * 8 + (tid >> 6), nw = gridDim.x * 8;
#pragma unroll 1
    for (int r = gw; r < 2 * NLAT; r += nw) { const int rr = r >> 1; const int t = rr & 4095, rp = t >> 6, cp = t & 63;
      bf16_t* row = (bf16_t*)(p.ws + ((r & 1) ? OFF_PK : OFF_PQ)) + (size_t)rr * 2048;
#pragma unroll
      for (int e = 0; e < 2; ++e) { const int cmb = lane + 64 * e, hh = cmb >> 4, hf = (cmb >> 3) & 1, j8 = (cmb & 7) * 8; bf16_t* q = row + hh * 256 + hf * 128 + j8;
        const u32x4 a = *(const u32x4*)q, bq = *(const u32x4*)(q + 64); const float2* cp2 = cs + (hf ? cp : rp) * 64 + j8; u32x4 oa, ob;
#pragma unroll
        for (int w = 0; w < 4; ++w) { const float2 v0 = cp2[2 * w], v1 = cp2[2 * w + 1]; const float p10 = lo2f(a[w]), p11 = hi2f(a[w]), p20 = lo2f(bq[w]), p21 = hi2f(bq[w]);
          oa[w] = pk2(p10 * v0.x - p20 * v0.y, p11 * v1.x - p21 * v1.y); ob[w] = pk2(p10 * v0.y + p20 * v0.x, p11 * v1.y + p21 * v1.x); }
        *(u32x4*)q = oa; *(u32x4*)(q + 64) = ob; } } }
  if (mask & 4) { float* in = (float*)reg2;
    bf16_t* ut = (bf16_t*)(reg2 + 3 * 66 * 64 * 4);
    const bf16_t* PHY = (const bf16_t*)(p.ws + OFF_PHY); bf16_t* HV = (bf16_t*)(p.ws + OFF_HV); bf16_t* HX0 = (bf16_t*)(p.ws + OFF_HX0);
    const float* cw = p.conv_w + (size_t)l * 3 * 6144; const float* cb = p.conv_b + (size_t)l * 6144;
    const int nit = ((l == 0) ? 272 : 256) * 32;
    u32x4 pre[4];
#define PC_DECODE(it_) const int tk = (it_) >> 5, c0 = ((it_) & 31) * 64; int b, t0; bool isctx; tok_tile(tk, b, t0, isctx); const int Ls = isctx ? CTXL : SEQ; const int row0 = tok_row(b, t0, isctx);
#define PC_LOAD(it_) do { PC_DECODE(it_) _Pragma("unroll") for (int e = 0; e < 4; ++e) { const int id = tid + 512 * e; const int pi = id / 528, rem = id % 528, rr = rem >> 3, pc = rem & 7; const int t = t0 - 1 + rr; \
        u32x4 v; v[0] = 0u; v[1] = 0u; v[2] = 0u; v[3] = 0u; if (id < 1584 && t >= 0 && t < Ls) v = *(const u32x4*)(PHY + (size_t)(row0 - 1 + rr) * 6144 + pi * 2048 + c0 + pc * 8); pre[e] = v; } } while (0)
    if ((int)blockIdx.x < nit) PC_LOAD((int)blockIdx.x);
    for (int it = blockIdx.x; it < nit; it += gridDim.x) {
      PC_DECODE(it) (void)Ls;
#pragma unroll
      for (int e = 0; e < 4; ++e) { const int id = tid + 512 * e; if (id < 1584) { const int pi = id / 528, rem = id % 528, rr = rem >> 3, pc = rem & 7; const u32x4 v = pre[e];
        float* d = in + (pi * 66 + rr) * 64 + pc * 8;
        *(float4*)d = make_float4(lo2f(v[0]), hi2f(v[0]), lo2f(v[1]), hi2f(v[1])); *(float4*)(d + 4) = make_float4(lo2f(v[2]), hi2f(v[2]), lo2f(v[3]), hi2f(v[3])); } }
      if (it + (int)gridDim.x < nit) PC_LOAD(it + (int)gridDim.x);
      __syncthreads();
      { const int cg8 = (tid & 7) * 8, tok = tid >> 3;
        float cv[3][8];
#pragma unroll
        for (int pi = 0; pi < 3; ++pi) { const float* wp = cw + pi * 2048 + c0 + cg8;
          const float4 ba = *(const float4*)(cb + pi * 2048 + c0 + cg8), bb = *(const float4*)(cb + pi * 2048 + c0 + cg8 + 4);
          cv[pi][0] = ba.x; cv[pi][1] = ba.y; cv[pi][2] = ba.z; cv[pi][3] = ba.w; cv[pi][4] = bb.x; cv[pi][5] = bb.y; cv[pi][6] = bb.z; cv[pi][7] = bb.w;
#pragma unroll
          for (int k = 0; k < 3; ++k) { const float4 wa = *(const float4*)(wp + k * 6144), wb = *(const float4*)(wp + k * 6144 + 4);
            const float* ip = in + (pi * 66 + tok + k) * 64 + cg8; const float4 xa = *(const float4*)ip, xb = *(const float4*)(ip + 4);
            cv[pi][0] += xa.x * wa.x; cv[pi][1] += xa.y * wa.y; cv[pi][2] += xa.z * wa.z; cv[pi][3] += xa.w * wa.w; cv[pi][4] += xb.x * wb.x; cv[pi][5] += xb.y * wb.y; cv[pi][6] += xb.z * wb.z; cv[pi][7] += xb.w * wb.w; } }
        u32x4 hvp, hxp;
#pragma unroll
        for (int e = 0; e < 4; ++e) { hvp[e] = pk2(cv[0][2 * e] * cv[2][2 * e], cv[0][2 * e + 1] * cv[2][2 * e + 1]); hxp[e] = pk2(cv[1][2 * e], cv[1][2 * e + 1]); }
        *(u32x4*)(HV + (size_t)(row0 + tok) * 2048 + c0 + cg8) = hvp; *(u32x4*)(HX0 + (size_t)(row0 + tok) * 2048 + c0 + cg8) = hxp;
#pragma unroll
        for (int e = 0; e < 4; ++e) { ut[(cg8 + 2 * e) * 66 + tok] = (bf16_t)(hvp[e] & 0xffffu); ut[(cg8 + 2 * e + 1) * 66 + tok] = (bf16_t)(hvp[e] >> 16); } }
      __syncthreads();
      { const int c = tid >> 3, pc = tid & 7; u32x4 o;
#pragma unroll
        for (int e = 0; e < 4; ++e) o[e] = (unsigned)ut[c * 66 + pc * 8 + 2 * e] | ((unsigned)ut[c * 66 + pc * 8 + 2 * e + 1] << 16);
        bf16_t* dst = isctx ? (bf16_t*)(p.ws + OFF_UTC) + ((size_t)(c0 + c) * NB + b) * CTXL + t0 + pc * 8 : (bf16_t*)(p.ws + OFF_UT) + ((size_t)(c0 + c) * NB + b) * SEQ + t0 + pc * 8;
        *(u32x4*)dst = o; }
    }
    __syncthreads();
#undef PC_DECODE
#undef PC_LOAD
  }
}

__device__ void phase_post(const Params& p, int l, unsigned char* shm, int mask) {
  const int tid = otid(p.wid), lane = tid & 63;
  const bf16_t* HV = (const bf16_t*)(p.ws + OFF_HV); const bf16_t* HX0 = (const bf16_t*)(p.ws + OFF_HX0); const bf16_t* PHG = (const bf16_t*)(p.ws + OFF_PHG);
  bf16_t* AH = (bf16_t*)(p.ws + OFF_H); const float* hbias = p.hy_bias + l * 2048;
  if (mask & 1) { float* yt = (float*)shm;
    const bf16_t* UT = (const bf16_t*)(p.ws + OFF_UT);
    const int nit = 256 * 32; u32x4 pre;
#define PA_LOAD(it_) do { const int tk_ = (it_) >> 5, c0_ = ((it_) & 31) * 64, b_ = tk_ >> 6, t0_ = (tk_ & 63) * 64; pre = *(const u32x4*)(UT + ((size_t)(c0_ + (tid >> 3)) * NB + b_) * SEQ + t0_ + (tid & 7) * 8); } while (0)
    if ((int)blockIdx.x < nit) PA_LOAD((int)blockIdx.x);
    for (int it = blockIdx.x; it < nit; it += gridDim.x) {
      const int tk = it >> 5, c0 = (it & 31) * 64, b = tk >> 6, t0 = (tk & 63) * 64, row0 = b * SEQ + t0;
      { const int c = tid >> 3, pc = tid & 7; const u32x4 v = pre; float* d = yt + (pc * 8) * 65 + c;
        d[0] = lo2f(v[0]); d[65] = hi2f(v[0]); d[130] = lo2f(v[1]); d[195] = hi2f(v[1]); d[260] = lo2f(v[2]); d[325] = hi2f(v[2]); d[390] = lo2f(v[3]); d[455] = hi2f(v[3]); }
      if (it + (int)gridDim.x < nit) PA_LOAD(it + (int)gridDim.x);
      __syncthreads();
      { const int cg8 = (tid & 7) * 8, tok = tid >> 3; const size_t o = (size_t)(row0 + tok) * 2048 + c0 + cg8;
        const u32x4 hv = *(const u32x4*)(HV + o), hx = *(const u32x4*)(HX0 + o), hg = *(const u32x4*)(PHG + o);
        const float4 ba = *(const float4*)(hbias + c0 + cg8), bb = *(const float4*)(hbias + c0 + cg8 + 4);
        const float hb[8] = {ba.x, ba.y, ba.z, ba.w, bb.x, bb.y, bb.z, bb.w}; const float* yp = yt + tok * 65 + cg8; u32x4 r;
#pragma unroll
        for (int e = 0; e < 4; ++e) { const float a0 = (yp[2 * e] + hb[2 * e] * lo2f(hv[e])) * lo2f(hx[e]) * siluf_(lo2f(hg[e])), a1 = (yp[2 * e + 1] + hb[2 * e + 1] * hi2f(hv[e])) * hi2f(hx[e]) * siluf_(hi2f(hg[e])); r[e] = pk2(a0, a1); }
        *(u32x4*)(AH + o) = r; }
      __syncthreads();
    }
#undef PA_LOAD
  }
  if (l == 0 && (mask & 2)) { float* gc = (float*)shm; float* us = gc + 32 * 512;
    const bf16_t* UTC = (const bf16_t*)(p.ws + OFF_UTC); const float* GC = (const float*)(p.ws + OFF_GC);
    for (int it = blockIdx.x; it < 16 * 64; it += gridDim.x) {
      const int tk = it >> 6, c0 = (it & 63) * 32, b = tk >> 2, t0 = (tk & 3) * 64, row0 = NLAT + b * CTXL + t0;
#pragma unroll 8
      for (int i = tid; i < 32 * 512; i += 512) gc[i] = GC[(size_t)(c0 + (i >> 9)) * 512 + (i & 511)];
#pragma unroll 8
      for (int i = tid; i < 32 * 256; i += 512) us[i] = bf2f(UTC[((size_t)(c0 + (i >> 8)) * NB + b) * CTXL + (i & 255)]);
      __syncthreads();
      { const int t = tid & 63, cg4 = tid >> 6;
#pragma unroll 1
        for (int e = 0; e < 4; ++e) { const int c = cg4 * 4 + e; const float* g = gc + c * 512 + 256 + t0 + t; const float* u = us + c * 256; float a = 0.f;
#pragma unroll 8
          for (int s = 0; s < 256; ++s) a += u[s] * g[-s];
          const size_t o = (size_t)(row0 + t) * 2048 + c0 + c; const float hv = bf2f(HV[o]);
          AH[o] = f2bf((a + hbias[c0 + c] * hv) * bf2f(HX0[o]) * siluf_(bf2f(PHG[o]))); } }
      __syncthreads();
    }
  }
  if (mask & 4) { bf16_t* OF = (bf16_t*)(p.ws + OFF_OF); const bf16_t* OB = (const bf16_t*)(p.ws + OFF_OB); const bf16_t* RG = (const bf16_t*)(p.ws + OFF_PRG);
    const int gw = blockIdx.x * 8 + (tid >> 6), nw = gridDim.x * 8; const int nrows = (l == 0) ? MT : NLAT;
#pragma unroll 2
    for (int it = gw; it < nrows * 8; it += nw) { const size_t o = (size_t)(it >> 3) * 4096 + (it & 7) * 512 + lane * 8;
      const u32x4 a = *(const u32x4*)(OF + o), bq = *(const u32x4*)(OB + o), g = *(const u32x4*)(RG + o);
      float v[8]; float ss = 0.f;
#pragma unroll
      for (int e = 0; e < 4; ++e) { v[2 * e] = lo2f(a[e]) + lo2f(bq[e]); v[2 * e + 1] = hi2f(a[e]) + hi2f(bq[e]); ss += v[2 * e] * v[2 * e] + v[2 * e + 1] * v[2 * e + 1]; }
      ss = wsum(ss, lane);
      const float rs = rsqrtf(ss * (1.f / 512.f) + 1e-6f);
      u32x4 r;
#pragma unroll
      for (int e = 0; e < 4; ++e) r[e] = pk2(v[2 * e] * rs * siluf_(lo2f(g[e])), v[2 * e + 1] * rs * siluf_(hi2f(g[e])));
      *(u32x4*)(OF + o) = r; }
  }
}

__device__ void phase_conv(const Params& p, int l, unsigned char* shm) {
  const int tid = otid(p.wid), lane = tid & 63, wid = tid >> 6;
  bf16_t* Gs = (bf16_t*)shm;
  bf16_t* Us = (bf16_t*)(shm + 2 * GLEN * 2);
  { unsigned zz = 0u; asm volatile("" : "+v"(zz)); u32x4 z; z[0] = zz; z[1] = zz; z[2] = zz; z[3] = zz; for (int i = tid; i < 2 * 4 * USTR / 8; i += 512) ((u32x4*)Us)[i] = z; }
  __syncthreads();
  const int ch = wid >> 2, q = wid & 3, i = lane & 31, g = lane >> 5, a_l = i >> 2, b = i & 3;
  const bf16_t* G = (const bf16_t*)(p.ws + OFF_G + (size_t)l * G_LAYER); bf16_t* UT = (bf16_t*)(p.ws + OFF_UT);
  const int mb = LOFF - i + 8 * g - 128 * (8 * q + 7);
  const unsigned sh = (unsigned)(mb & 1) * 16u;
  const unsigned* Gd = (const unsigned*)(Gs + ch * GLEN) + (mb >> 1);
  const bf16_t* Ub = Us + (ch * 4 + b) * USTR + 136 * (a_l + 1) + 8 * g;
#define CONV_LDFRAG(dst, n) do { const unsigned* q_ = Gd + 8 * (n); const unsigned d0 = q_[0], d1 = q_[1], d2 = q_[2], d3 = q_[3], d4 = q_[4]; u32x4 r_; \
    r_[0] = __builtin_amdgcn_alignbit(d1, d0, sh); r_[1] = __builtin_amdgcn_alignbit(d2, d1, sh); r_[2] = __builtin_amdgcn_alignbit(d3, d2, sh); r_[3] = __builtin_amdgcn_alignbit(d4, d3, sh); \
    dst = __builtin_bit_cast(bf16x8, r_); } while (0)
  for (int pr = blockIdx.x; pr < 1024; pr += gridDim.x) {
    for (int id = tid; id < 2 * (GLEN / 2); id += 512) { const int cc = id / (GLEN / 2), dw = id % (GLEN / 2);
      unsigned v = ((const unsigned*)(G + (size_t)(pr * 2 + cc) * GLEN))[dw]; const int m = dw * 2;
      if (m < 33 || m > 8223) v &= 0xffff0000u; if (m + 1 < 33 || m + 1 > 8223) v &= 0x0000ffffu;
      ((unsigned*)Gs)[cc * (GLEN / 2) + dw] = v; }
    for (int id = tid; id < 2 * 4 * 512; id += 512) { const int cc = id >> 11, bb = (id >> 9) & 3, s8 = id & 511;
      const u32x4 v = *(const u32x4*)(UT + ((size_t)(pr * 2 + cc) * 4 + bb) * SEQ + s8 * 8); const int sp = 1024 + s8 * 8;
      *(u32x4*)(Us + (cc * 4 + bb) * USTR + sp + 8 * (sp >> 7)) = v; }
    __syncthreads();
    bf16x8 W[8]; f32x16 acc[4];
#pragma unroll
    for (int h = 0; h < 4; ++h)
#pragma unroll
      for (int e = 0; e < 16; ++e) acc[h][e] = 0.f;
    CONV_LDFRAG(W[2], -6); CONV_LDFRAG(W[3], -5); CONV_LDFRAG(W[4], -4); CONV_LDFRAG(W[5], -3); CONV_LDFRAG(W[6], -2); CONV_LDFRAG(W[7], -1);
#pragma unroll 1
    for (int it = 0; it < 39; ++it) {
#pragma unroll
      for (int u = 0; u < 8; ++u) {
        CONV_LDFRAG(W[u], it * 8 + u);
        const bf16x8 bf = *(const bf16x8*)(Ub + 136 * it + 16 * u);
#pragma unroll
        for (int h = 0; h < 4; ++h) acc[h] = __builtin_amdgcn_mfma_f32_32x32x16_bf16(W[(u - 2 * h) & 7], bf, acc[h], 0, 0, 0);
      }
    }
    { bf16_t* yrow = UT + ((size_t)(pr * 2 + ch) * 4 + b) * SEQ + 128 * (8 * q + a_l) + 4 * g;
#pragma unroll
      for (int h = 0; h < 4; ++h)
#pragma unroll
        for (int rq = 0; rq < 4; ++rq) { u32x2 o; o[0] = pk2(acc[h][4 * rq], acc[h][4 * rq + 1]); o[1] = pk2(acc[h][4 * rq + 2], acc[h][4 * rq + 3]); *(u32x2*)(yrow + 32 * h + 8 * rq) = o; } }
    __syncthreads();
  }
#undef CONV_LDFRAG
}

template <int KD> DI f32x16 mma_tile(f32x16 acc, const bf16_t* A, int lda, const bf16_t* B, int ldb, int lane) {
  const int r = lane & 31, g8 = (lane >> 5) * 8; const bf16_t* ap = A + r * lda + g8; const bf16_t* bp = B + r * ldb + g8;
#pragma unroll 4
  for (int k0 = 0; k0 < KD; k0 += 16) acc = __builtin_amdgcn_mfma_f32_32x32x16_bf16(*(const bf16x8*)(ap + k0), *(const bf16x8*)(bp + k0), acc, 0, 0, 0);
  return acc;
}
DI bf16x8 tr_frag(const bf16_t* img, int ld, int lane) {
  const int h = lane >> 5, blk = (lane >> 4) & 1, q = (lane & 15) >> 2, pp = lane & 3;
  const bf16_t* a = img + (8 * h + q) * ld + 16 * blk + 4 * pp;
  const s16x4 r0 = __builtin_amdgcn_ds_read_tr16_b64_v4i16((__attribute__((address_space(3))) s16x4*)a);
  const s16x4 r1 = __builtin_amdgcn_ds_read_tr16_b64_v4i16((__attribute__((address_space(3))) s16x4*)(a + 4 * ld));
  bf16x8 f; f[0] = r0[0]; f[1] = r0[1]; f[2] = r0[2]; f[3] = r0[3]; f[4] = r1[0]; f[5] = r1[1]; f[6] = r1[2]; f[7] = r1[3]; return f;
}
__device__ void phase_ret(const Params& p, int l, unsigned char* shm) {
  constexpr int QS = 264, VS = 144, TS = 72;
  const int tid = otid(p.wid), lane = tid & 63, wid = tid >> 6, g = lane >> 5;
  bf16_t* Qs = (bf16_t*)shm; bf16_t* Ks = Qs + 64 * QS; bf16_t* Vs = Ks + 64 * QS; bf16_t* Ps = Vs + 64 * VS; bf16_t* Sts = Ps + 64 * TS;
  const bf16_t* PQ = (const bf16_t*)(p.ws + OFF_PQ); const bf16_t* PK = (const bf16_t*)(p.ws + OFF_PK); const bf16_t* PV = (const bf16_t*)(p.ws + OFF_PV);
  for (int it0 = blockIdx.x; it0 < 256; it0 += gridDim.x) {
    int it = it0;
    if (gridDim.x == 256) { const int xcd = it0 & 7, idx = it0 >> 3; it = ((xcd + 8 * (idx >> 2)) << 2) | (idx & 3); }
    const int sl = it & 3, dir = (it >> 2) & 1, h = (it >> 3) & 7, b = it >> 6;
    const float lg = -expf(p.ret_decay[(l * 2 + dir) * 8 + h]);
    bf16_t* O = (bf16_t*)(p.ws + (dir ? OFF_OB : OFF_OF));
    for (int i = tid; i < 128 * QS / 2; i += 512) ((unsigned*)Sts)[i] = 0u;
    f32x16 S[4], cross;
#pragma unroll
    for (int x = 0; x < 4; ++x)
#pragma unroll
      for (int e = 0; e < 16; ++e) S[x][e] = 0.f;
#pragma unroll
    for (int e = 0; e < 16; ++e) cross[e] = 0.f;
    const float cd = __expf(lg * 64.f);
    const int tid2 = otid(p.wid), ln2 = tid2 & 63, g2 = ln2 >> 5, w2 = tid2 >> 6;
    float mk[16], dkv[2];
#pragma unroll
    for (int e = 0; e < 2; ++e) { const int tok = (tid2 >> 4) + 32 * e; dkv[e] = __expf(lg * (float)(dir ? tok : 63 - tok)); }
    const int wq = w2 & 3, s_tj = wq >> 1, s_ti = wq & 1;
    const int o_tc = w2 >> 1, o_ti = w2 & 1;
    { const int i = s_ti * 32 + (ln2 & 31);
#pragma unroll
      for (int e = 0; e < 16; ++e) { const int j = s_tj * 32 + (e & 3) + 8 * (e >> 2) + 4 * g2; const int diff = dir ? (j - i) : (i - j); mk[e] = diff >= 0 ? __expf(lg * (float)(dir ? -i : i - 63)) : 0.f; } }
    const int qi = o_ti * 32 + (ln2 & 31);
    const float qd = __expf(lg * (float)(dir ? 64 - qi : qi + 1));
    u32x4 rq[4], rk[4], rv[2];
    const unsigned qo_l = (unsigned)(tid >> 5) * 2048u + (unsigned)(h * 256 + (tid & 31) * 8);
    const unsigned vo_l = (unsigned)(tid >> 4) * 4096u + (unsigned)(h * 512 + sl * 128 + (tid & 15) * 8);
#define RET_CHUNK(step_, isctx_, t0_) do { if ((step_) < 4) { isctx_ = true; t0_ = (dir ? 3 - (step_) : (step_)) * 64; } else { isctx_ = false; const int cn_ = (step_) - 4; t0_ = (dir ? 63 - cn_ : cn_) * 64; } } while (0)
#define RET_LOAD(step_) do { bool ic_; int t0n_; RET_CHUNK(step_, ic_, t0n_); const unsigned rw_ = (unsigned)tok_row(b, t0n_, ic_); \
      _Pragma("unroll") for (int e = 0; e < 4; ++e) { rq[e] = *(const u32x4*)(PQ + (rw_ * 2048u + qo_l + (unsigned)e * 32768u)); rk[e] = *(const u32x4*)(PK + (rw_ * 2048u + qo_l + (unsigned)e * 32768u)); } \
      _Pragma("unroll") for (int e = 0; e < 2; ++e) rv[e] = *(const u32x4*)(PV + (rw_ * 4096u + vo_l + (unsigned)e * 131072u)); } while (0)
    RET_LOAD(0);
#pragma unroll 1
    for (int step = 0; step < 68; ++step) {
      bool isctx; int t0; RET_CHUNK(step, isctx, t0);
      const int row0 = tok_row(b, t0, isctx);
      __syncthreads();
#pragma unroll
      for (int e = 0; e < 4; ++e) { const int row = (tid >> 5) + 16 * e, pc = tid & 31; *(u32x4*)(Qs + row * QS + pc * 8) = rq[e]; *(u32x4*)(Ks + row * QS + pc * 8) = rk[e]; }
#pragma unroll
      for (int e = 0; e < 2; ++e) { u32x4 o;
#pragma unroll
        for (int w = 0; w < 4; ++w) o[w] = pk2(lo2f(rv[e][w]) * dkv[e], hi2f(rv[e][w]) * dkv[e]);
        *(u32x4*)(Vs + ((tid >> 4) + 32 * e) * VS + (tid & 15) * 8) = o; }
      if (step + 1 < 68) RET_LOAD(step + 1);
      __syncthreads();
      if (wid < 4) {
        f32x16 sc;
#pragma unroll
        for (int e = 0; e < 16; ++e) sc[e] = 0.f;
        sc = mma_tile<256>(sc, Ks + s_tj * 32 * QS, QS, Qs + s_ti * 32 * QS, QS, lane);
        const int i = s_ti * 32 + (lane & 31);
#pragma unroll
        for (int r4 = 0; r4 < 4; ++r4) { u32x2 o; o[0] = pk2(sc[4 * r4] * mk[4 * r4], sc[4 * r4 + 1] * mk[4 * r4 + 1]); o[1] = pk2(sc[4 * r4 + 2] * mk[4 * r4 + 2], sc[4 * r4 + 3] * mk[4 * r4 + 3]);
          *(u32x2*)(Ps + i * TS + s_tj * 32 + 8 * r4 + 4 * g) = o; }
      }
#pragma unroll
      for (int e = 0; e < 16; ++e) cross[e] = 0.f;
      cross = mma_tile<256>(cross, Sts + o_tc * 32 * QS, QS, Qs + o_ti * 32 * QS, QS, lane);
      __syncthreads();
      { f32x16 in_;
#pragma unroll
        for (int e = 0; e < 16; ++e) in_[e] = 0.f;
        const bf16_t* pb = Ps + (o_ti * 32 + (lane & 31)) * TS + 8 * g;
#pragma unroll
        for (int ks = 0; ks < 4; ++ks) in_ = __builtin_amdgcn_mfma_f32_32x32x16_bf16(tr_frag(Vs + 16 * ks * VS + 32 * o_tc, VS, lane), *(const bf16x8*)(pb + 16 * ks), in_, 0, 0, 0);
        const unsigned ob = (unsigned)(row0 + qi) * 4096u + (unsigned)(h * 512 + sl * 128 + o_tc * 32 + 4 * g);
#pragma unroll
        for (int r4 = 0; r4 < 4; ++r4) { u32x2 o; o[0] = pk2(in_[4 * r4] + qd * cross[4 * r4], in_[4 * r4 + 1] + qd * cross[4 * r4 + 1]); o[1] = pk2(in_[4 * r4 + 2] + qd * cross[4 * r4 + 2], in_[4 * r4 + 3] + qd * cross[4 * r4 + 3]);
          *(u32x2*)(O + (ob + (unsigned)(8 * r4))) = o; } }
      { bf16x8 ka[4];
#pragma unroll
        for (int ks = 0; ks < 4; ++ks) ka[ks] = tr_frag(Ks + 16 * ks * QS + 32 * wid, QS, lane);
#pragma unroll
        for (int x = 0; x < 4; ++x) {
#pragma unroll
          for (int e = 0; e < 16; ++e) S[x][e] *= cd;
#pragma unroll
          for (int ks = 0; ks < 4; ++ks) S[x] = __builtin_amdgcn_mfma_f32_32x32x16_bf16(ka[ks], tr_frag(Vs + 16 * ks * VS + 32 * x, VS, lane), S[x], 0, 0, 0);
          const int c = x * 32 + (lane & 31);
#pragma unroll
          for (int r4 = 0; r4 < 4; ++r4) { u32x2 o; o[0] = pk2(S[x][4 * r4], S[x][4 * r4 + 1]); o[1] = pk2(S[x][4 * r4 + 2], S[x][4 * r4 + 3]); *(u32x2*)(Sts + c * QS + wid * 32 + 8 * r4 + 4 * g) = o; } } }
    }
    __syncthreads();
  }
#undef RET_CHUNK
#undef RET_LOAD
}

__global__ void __launch_bounds__(512, 2) mega(Params p_in) {
  Params p = p_in; p.wid = __builtin_amdgcn_readfirstlane((int)(threadIdx.x >> 6));
  extern __shared__ __attribute__((aligned(16))) unsigned char shm[];
  cg::grid_group grid = cg::this_grid();
  PG8_LAS unsigned char* lds = (PG8_LAS unsigned char*)shm;
  volatile XLAS unsigned* xst = (volatile XLAS unsigned*)(lds + 163824);
  if (otid(p.wid) == 0) { xst[0] = 0u; xst[1] = 0u; }
  __syncthreads();
  const XcdBarrier xb = xcd_barrier_post((unsigned*)(p.ws + OFF_BAR), xst, otid(p.wid) == 0);
  const bf16_t* H = (const bf16_t*)(p.ws + OFF_H);
#pragma unroll 1
  for (int rep = 0; rep < (PROBE == 1 ? 2 : 1); ++rep) { phase_filters(p, shm); phase_mod(p, shm); }
  grid.sync();
  for (int l = 0; l < 2; ++l) {
#pragma unroll 1
    for (int rep = 0; rep < (PROBE == 1 ? 2 : 1); ++rep) { phase_cvt(p, l, shm); phase_norm(p, l); }
    xcd_barrier(xb, otid(p.wid) == 0);
    { pg8::Gemm g; g.wid = p.wid; g.A = H; g.Bt = (const bf16_t*)(p.ws + OFF_WTIN); g.M = MT; g.N = INW; g.K = DM;
      pg8::Order S; S.init(64, 96, (int)gridDim.x, (int)blockIdx.x, 4, l == 0 ? 96 : 24, l == 0 ? 0 : 8);
      EpiG1 E; E.ws = p.ws; pg8::gemm_phase<EpiG1, pg8::Order>(lds, g, S, E); }
    xcd_barrier(xb, otid(p.wid) == 0);
#pragma unroll 1
    for (int rep = 0; rep < (PROBE == 2 ? 2 : 1); ++rep) phase_prep(p, l, shm, rep ? 4 : 7);
    xcd_barrier(xb, otid(p.wid) == 0);
    phase_conv(p, l, shm);
#pragma unroll 1
    for (int rep = 0; rep < (PROBE == 3 ? 2 : 1); ++rep) phase_ret(p, l, shm);
    xcd_barrier(xb, otid(p.wid) == 0);
#pragma unroll 1
    for (int rep = 0; rep < (PROBE == 2 ? 2 : 1); ++rep) phase_post(p, l, shm, rep ? 3 : 7);
    xcd_barrier(xb, otid(p.wid) == 0);
    { const int nM = (l == 0) ? 68 : 64;
      pg8::Order S; S.init(nM, 8, (int)gridDim.x, (int)blockIdx.x, 0, 0, 0);
#pragma unroll 1
      for (int rep = 0; rep < (PROBE == 4 ? 2 : 1); ++rep) {
      { pg8::Gemm g; g.wid = p.wid; g.A = H; g.Bt = (const bf16_t*)(p.ws + OFF_WTHY); g.M = nM * 256; g.N = DM; g.K = DM; EpiG23<0> E; E.ws = p.ws; pg8::gemm_phase<EpiG23<0>, pg8::Order>(lds, g, S, E); }
      { pg8::Gemm g; g.wid = p.wid; g.A = (const bf16_t*)(p.ws + OFF_OF); g.Bt = (const bf16_t*)(p.ws + OFF_WTRET); g.M = nM * 256; g.N = DM; g.K = 4096; EpiG23<1> E; E.ws = p.ws; pg8::gemm_phase<EpiG23<1>, pg8::Order>(lds, g, S, E); }
      }
      xcd_barrier(xb, otid(p.wid) == 0);
      { pg8::Gemm g; g.wid = p.wid; g.A = (const bf16_t*)(p.ws + OFF_T1); g.Bt = (const bf16_t*)(p.ws + OFF_WTO); g.M = nM * 256; g.N = DM; g.K = DM;
        EpiG4 E; E.xin = (l == 0) ? p.x : p.out; E.cin = p.ctx; E.xout = p.out; E.cout = (float*)(p.ws + OFF_CTXR); E.mod = (const float*)(p.ws + OFF_MOD) + (size_t)l * 5 * 6144;
        pg8::gemm_phase<EpiG4, pg8::Order>(lds, g, S, E); } }
    xcd_barrier(xb, otid(p.wid) == 0);
  }
  phase_final(p);
}

extern "C" void kernel_launch(void* const* d_in, const int* in_sizes, int n_in, void* d_out, int out_size, void* d_ws, size_t ws_size, hipStream_t stream) {
  constexpr size_t kDynLds = 163840;
  static int grid_blocks = 0;
  if (!grid_blocks) {
    hipFuncSetAttribute((const void*)mega, hipFuncAttributeMaxDynamicSharedMemorySize, (int)kDynLds);
    int dev = 0, cus = 0, per_cu = 0;
    hipGetDevice(&dev);
    hipDeviceGetAttribute(&cus, hipDeviceAttributeMultiprocessorCount, dev);
    hipOccupancyMaxActiveBlocksPerMultiprocessor(&per_cu, (const void*)mega, 512, kDynLds);
    grid_blocks = cus * (per_cu >= 1 ? 1 : 0);
    if (ws_size < WS_NEED || grid_blocks <= 0) { fprintf(stderr, "workspace %zu < %zu or no occupancy (%d)\n", ws_size, (size_t)WS_NEED, per_cu); grid_blocks = grid_blocks > 0 ? grid_blocks : 256; }
  }
  Params p{};
  p.x = (const float*)d_in[0]; p.c = (const float*)d_in[1]; p.ctx = (const float*)d_in[2]; p.c_ctx = (const float*)d_in[3]; p.ln_g = (const float*)d_in[4];
  p.ada_w = (const float*)d_in[5]; p.ada_b = (const float*)d_in[6]; p.w_in = (const float*)d_in[7]; p.conv_w = (const float*)d_in[8]; p.conv_b = (const float*)d_in[9];
  p.fw1 = (const float*)d_in[10]; p.fb1 = (const float*)d_in[11]; p.fw2 = (const float*)d_in[12]; p.fb2 = (const float*)d_in[13]; p.fw3 = (const float*)d_in[14]; p.fb3 = (const float*)d_in[15];
  p.ffreq = (const float*)d_in[16]; p.fwout = (const float*)d_in[17]; p.hy_bias = (const float*)d_in[18]; p.ret_decay = (const float*)d_in[19];
  p.w_hy_out = (const float*)d_in[20]; p.w_ret_out = (const float*)d_in[21]; p.w_o = (const float*)d_in[22]; p.final_g = (const float*)d_in[23];
  p.out = (float*)d_out; p.ws = (unsigned char*)d_ws;
  void* args[] = {&p};
  (void)hipMemsetAsync((unsigned char*)d_ws + OFF_BAR, 0, (size_t)XCD_BAR_WORDS * 4, stream);
  hipError_t e = hipLaunchCooperativeKernel((void*)mega, dim3(grid_blocks), dim3(512), args, kDynLds, stream);
  if (e != hipSuccess) fprintf(stderr, "cooperative launch failed: %s (grid %d)\n", hipGetErrorString(e), grid_blocks);
}
```

```cpp
#include <hip/hip_runtime.h>
#include <hip/hip_cooperative_groups.h>
#include <cstdio>
namespace cg = cooperative_groups;
#ifndef PROBE
#define PROBE 0
#endif

typedef unsigned short bf16_t;
typedef short bf16x8 __attribute__((ext_vector_type(8)));
typedef float f32x4 __attribute__((ext_vector_type(4)));
typedef float f32x16 __attribute__((ext_vector_type(16)));
typedef unsigned u32x4 __attribute__((ext_vector_type(4)));
typedef unsigned u32x2 __attribute__((ext_vector_type(2)));
typedef short s16x4 __attribute__((ext_vector_type(4)));
#define DI __device__ __forceinline__

DI int otid(int wid) { int t; asm volatile("v_mbcnt_lo_u32_b32 %0, -1, 0\n\tv_mbcnt_hi_u32_b32 %0, -1, %0" : "=v"(t)); return wid * 64 + t; }
DI float wsum(float v, int lane) {
#pragma unroll
  for (int o = 32; o > 0; o >>= 1) v += __int_as_float(__builtin_amdgcn_ds_bpermute((lane ^ o) << 2, __float_as_int(v)));
  return v; }
DI float bf2f(bf16_t u) { return __uint_as_float(((unsigned)u) << 16); }
typedef __bf16 bf16v2 __attribute__((ext_vector_type(2)));
typedef float f32v2 __attribute__((ext_vector_type(2)));
DI unsigned pk2(float lo, float hi) { f32v2 v = {lo, hi}; bf16v2 b = __builtin_convertvector(v, bf16v2); return __builtin_bit_cast(unsigned, b); }
DI bf16_t f2bf(float f) { return (bf16_t)(pk2(f, 0.f) & 0xffffu); }
DI float lo2f(unsigned u) { return __uint_as_float(u << 16); }
DI float hi2f(unsigned u) { return __uint_as_float(u & 0xffff0000u); }
DI float sigmoidf_(float v) { return 1.f / (1.f + __expf(-v)); }
DI float siluf_(float v) { return v / (1.f + __expf(-v)); }

constexpr int DM = 2048, NB = 4, SEQ = 4096, CTXL = 256, NLAT = NB * SEQ, NCTX = NB * CTXL, MT = NLAT + NCTX;
constexpr int INW = 24576, NH = 8, DK = 256, DV = 512, TT = SEQ + CTXL;
constexpr int LOFF = 4128, GLEN = 8320;      constexpr size_t G_LAYER = ((size_t)2048 * 8320 * 2 + 255) & ~(size_t)255;
constexpr int USTR = 6560;

constexpr size_t AL(size_t x) { return (x + 255) & ~(size_t)255; }
constexpr size_t OFF_WTIN = 0;
constexpr size_t OFF_WTHY = OFF_WTIN + AL((size_t)INW * DM * 2);
constexpr size_t OFF_WTRET = OFF_WTHY + AL((size_t)DM * DM * 2);
constexpr size_t OFF_WTO = OFF_WTRET + AL((size_t)DM * 4096 * 2);
constexpr size_t OFF_G = OFF_WTO + AL((size_t)DM * DM * 2);
constexpr size_t OFF_GC = OFF_G + 2 * AL((size_t)DM * GLEN * 2);
constexpr size_t OFF_MOD = OFF_GC + AL((size_t)DM * 512 * 4);
constexpr size_t OFF_H = OFF_MOD + AL((size_t)2 * 5 * 6144 * 4);
constexpr size_t OFF_PQ = OFF_H + AL((size_t)MT * DM * 2);
constexpr size_t OFF_PK = OFF_PQ + AL((size_t)MT * DM * 2);
constexpr size_t OFF_PV = OFF_PK + AL((size_t)MT * DM * 2);
constexpr size_t OFF_PRG = OFF_PV + AL((size_t)MT * 4096 * 2);
constexpr size_t OFF_PHY = OFF_PRG + AL((size_t)MT * 4096 * 2);
constexpr size_t OFF_PHG = OFF_PHY + AL((size_t)MT * 6144 * 2);
constexpr size_t OFF_PMG = OFF_PHG + AL((size_t)MT * DM * 2);
constexpr size_t OFF_KT = OFF_PMG + AL((size_t)MT * 4096 * 2);
constexpr size_t OFF_VT = OFF_KT + AL((size_t)NB * NH * DK * TT * 2);
constexpr size_t OFF_UT = OFF_VT + AL((size_t)NB * NH * DV * TT * 2);
constexpr size_t OFF_UTC = OFF_UT + AL((size_t)DM * NB * SEQ * 2);
constexpr size_t OFF_HV = OFF_UTC + AL((size_t)DM * NB * CTXL * 2);
constexpr size_t OFF_HX0 = OFF_HV + AL((size_t)MT * DM * 2);
constexpr size_t OFF_CTXR = OFF_HX0 + AL((size_t)MT * DM * 2);
constexpr size_t OFF_BAR = OFF_CTXR + AL((size_t)NCTX * DM * 4);
constexpr size_t OFF_CS = OFF_BAR + AL((size_t)3456 * 4);
constexpr size_t WS_NEED = OFF_CS + AL((size_t)4096 * 8);
constexpr size_t OFF_OF = OFF_KT, OFF_OB = OFF_PHY, OFF_T1 = OFF_PHY + AL((size_t)MT * 4096 * 2);

struct Params {
  const float *x, *c, *ctx, *c_ctx, *ln_g, *ada_w, *ada_b, *w_in, *conv_w, *conv_b, *fw1, *fb1, *fw2, *fb2, *fw3, *fb3, *ffreq, *fwout, *hy_bias, *ret_decay, *w_hy_out, *w_ret_out, *w_o, *final_g;
  float* out;
  unsigned char* ws;
  int wid, pad_;
};


#define XB_TMO      128
#define XB_XCNT(j)  (256  + 64 * (j))
#define XB_XSUB(j)  (1280 + 64 * (j))
#define XB_XGEN(j)  (2304 + 64 * (j))
#define XB_TOP      3328
#define XB_TOPGEN   3392
#define XCD_BAR_WORDS 3456
#define XB_SPIN_CAP (1u << 18)
#define XLAS __attribute__((address_space(3)))
DI unsigned xb_ld(unsigned* p)              { return __hip_atomic_load(p, __ATOMIC_RELAXED, __HIP_MEMORY_SCOPE_AGENT); }
DI unsigned xb_add(unsigned* p, unsigned v) { return __hip_atomic_fetch_add(p, v, __ATOMIC_RELAXED, __HIP_MEMORY_SCOPE_AGENT); }
DI unsigned xb_xcc_id() { return (unsigned)__builtin_amdgcn_s_getreg((3 << 11) | 20) & 0xFu; }
#define XB_SPIN(cond, bar) do { unsigned _sp = 0; while (cond) { __builtin_amdgcn_s_sleep(1); \
    if ((++_sp & 255u) == 0u) { if (xb_ld(&(bar)[XB_TMO])) break; if (_sp > XB_SPIN_CAP) { atomicAdd(&(bar)[XB_TMO], 1u); break; } } } } while (0)
struct XcdBarrier { unsigned* bar; unsigned x; volatile XLAS unsigned* st; };
DI XcdBarrier xcd_barrier_post(unsigned* bar, volatile XLAS unsigned* st, bool leader) {
    XcdBarrier b; b.bar = bar; b.x = xb_xcc_id(); b.st = st;
    if (leader) (void)xb_add(&bar[XB_XCNT(b.x)], 1u);
    return b;
}
DI void xcd_barrier_complete(unsigned* bar, unsigned x, unsigned& nloc, unsigned& nx) {
    const unsigned G = gridDim.x * gridDim.y * gridDim.z;
    unsigned sum, cnt, mine, sp = 0u;
    for (;;) {
        sum = 0u; cnt = 0u; mine = 0u;
#pragma unroll
        for (unsigned j = 0; j < 16; ++j) { const unsigned c = xb_ld(&bar[XB_XCNT(j)]); sum += c; cnt += (c > 0u) ? 1u : 0u; mine = (j == x) ? c : mine; }
        if (sum == G) break;
        __builtin_amdgcn_s_sleep(1);
        if ((++sp & 255u) == 0u) { if (xb_ld(&bar[XB_TMO])) break; if (sp > XB_SPIN_CAP) { atomicAdd(&bar[XB_TMO], 1u); break; } }
    }
    nloc = mine > 0u ? mine : 1u; nx = cnt > 0u ? cnt : 1u;
}
DI void xcd_barrier(const XcdBarrier& b, bool leader) {
    asm volatile("s_waitcnt vmcnt(0)" ::: "memory");
    __syncthreads();
    if (leader) {
        unsigned* bar = b.bar;
        __builtin_amdgcn_s_waitcnt(0);
        unsigned nloc = b.st[0], nx = b.st[1];
        if (nloc == 0u) { xcd_barrier_complete(bar, b.x, nloc, nx); b.st[0] = nloc; b.st[1] = nx; }
        const unsigned old = xb_add(&bar[XB_XSUB(b.x)], 1u);
        const unsigned gen = old / nloc;
        if (old + 1u == (gen + 1u) * nloc) {
            __builtin_amdgcn_fence(__ATOMIC_RELEASE, "agent");
            asm volatile("s_waitcnt vmcnt(0)" ::: "memory");
            const unsigned og = xb_add(&bar[XB_TOP], 1u);
            const unsigned tg = og / nx;
            if (og + 1u == (tg + 1u) * nx) xb_add(&bar[XB_TOPGEN], 1u);
            else XB_SPIN(xb_ld(&bar[XB_TOPGEN]) == tg, bar);
            __builtin_amdgcn_fence(__ATOMIC_ACQUIRE, "agent");
            xb_add(&bar[XB_XGEN(b.x)], 1u);
            asm volatile("s_waitcnt vmcnt(0)" ::: "memory");
        } else {
            XB_SPIN(xb_ld(&bar[XB_XGEN(b.x)]) == gen, bar);
            __builtin_amdgcn_fence(__ATOMIC_ACQUIRE, "agent");
            asm volatile("s_waitcnt vmcnt(0)" ::: "memory");
        }
    }
    __syncthreads();
}

namespace pg8 {
#define PG8_LAS __attribute__((address_space(3)))
constexpr int BM = 256, BK = 64, HALF = 128, HTB = HALF * BK * 2, STAGE_BYTES = 8 * HTB, NXCD = 8, WGM = 8;
__host__ __device__ __forceinline__ int lds_byte(int r, int c) { const int st = (r >> 4) * 2 + (c >> 5), rr = r & 15, cc = c & 31, ob = rr * 64 + cc * 2; return st * 1024 + (ob ^ (((ob >> 9) & 1) << 5)); }
__host__ __device__ __forceinline__ void stage_rc(int b, int& R, int& C) { const int st = b / 1024, sb = b % 1024, swz = sb ^ (((sb >> 9) & 1) << 5); R = (st >> 1) * 16 + swz / 64; C = (st & 1) * 32 + (swz % 64) / 2; }
__host__ __device__ __forceinline__ int perm32(int rho) { const int n = rho >> 4, i = rho & 15; return 8 * (i >> 2) + 4 * n + (i & 3); }
struct Unit { int pm, pn; };
struct Gemm { const bf16_t* A; const bf16_t* Bt; int M, N, K, wid; };
struct Order {
    int nM, nN, nwg, G, c, nx_m, nx_n, x_pn0;
    __device__ void init(int nM_, int nN_, int G_, int c_, int nx_m_, int nx_n_, int x_pn0_) { nM = nM_; nN = nN_; nwg = nM * nN; G = G_; c = c_; nx_m = nx_m_; nx_n = nx_n_; x_pn0 = x_pn0_; }
    __device__ bool next(int i, Unit& u) const {
        const long L = (long)i * G + c;
        if (L >= nwg) { const int e = (int)(L - nwg); if (e >= nx_m * nx_n) return false; u.pm = nM + e % nx_m; u.pn = x_pn0 + e / nx_m; return true; }
        int wgid = (int)L; { const int q = nwg / NXCD, r = nwg % NXCD, xcd = wgid % NXCD, off = wgid / NXCD; wgid = (xcd < r ? xcd * (q + 1) : r * (q + 1) + (xcd - r) * q) + off; }
        const int nig = WGM * nN, gid = wgid / nig, fm = gid * WGM, gsz = (nM - fm) < WGM ? (nM - fm) : WGM;
        u.pm = fm + ((wgid % nig) % gsz); u.pn = (wgid % nig) / gsz; return true;
    }
    __device__ __forceinline__ void a_ready(const Unit&) const {}
    __device__ __forceinline__ void done(const Unit&) const {}
};
template <class Epi, class Sched>
__device__ __forceinline__ void gemm_phase(PG8_LAS unsigned char* lds, const Gemm g, const Sched& S, const Epi& E) {
    const int tid = otid(g.wid), wid = __builtin_amdgcn_readfirstlane(tid >> 6), lane = tid & 63, wr = wid >> 2, wc = wid & 3, fr = lane & 15, fq = lane >> 4;
    const int K = g.K, nt = K / BK;
    unsigned voffA[2], voffB[2];
#pragma unroll
    for (int i = 0; i < 2; ++i) { int R, C; stage_rc(tid * 16 + i * 8192, R, C); const int Rb = Epi::PERM ? ((R & ~31) + perm32(R & 31)) : R;
        voffA[i] = (unsigned)(R * K + C) * 2u; voffB[i] = (unsigned)(Rb * K + C) * 2u; }
    const size_t kstep = (size_t)(BK * 2);
    const size_t hstep = (size_t)HALF * K * 2;
    const size_t tstep = 2 * hstep;
    const unsigned ldsw = (unsigned)wid * 1024u;
    const int aoff = lds_byte(wr * 64 + fr, fq * 8), boff = lds_byte(wc * 32 + fr, fq * 8);
#define PG8_SA(b, h) (((b) * 2 + (h)) * HTB)
#define PG8_SB(b, h) ((4 + (b) * 2 + (h)) * HTB)
#define PG8_STAGE(bufoff, gbase, voff) do { _Pragma("unroll") for (int _i = 0; _i < 2; ++_i) \
        __builtin_amdgcn_global_load_lds((const unsigned*)((const char*)(gbase) + (voff)[_i]), (PG8_LAS unsigned*)(lds + (bufoff) + ldsw + _i * 8192), 16, 0, 0); } while (0)
#define PG8_LDA(dst, b, h) do { _Pragma("unroll") for (int m = 0; m < 4; ++m) _Pragma("unroll") for (int k = 0; k < 2; ++k) dst[m][k] = *(const PG8_LAS bf16x8*)(lds + PG8_SA(b, h) + aoff + m * 2048 + k * 1024); } while (0)
#define PG8_LDB(dst, b, h) do { _Pragma("unroll") for (int n = 0; n < 2; ++n) _Pragma("unroll") for (int k = 0; k < 2; ++k) dst[n][k] = *(const PG8_LAS bf16x8*)(lds + PG8_SB(b, h) + boff + n * 2048 + k * 1024); } while (0)
#define PG8_MMA(ai, bj, At, Bt) do { __builtin_amdgcn_s_setprio(1); _Pragma("unroll") for (int m = 0; m < 4; ++m) _Pragma("unroll") for (int n = 0; n < 2; ++n) _Pragma("unroll") for (int k = 0; k < 2; ++k) \
        acc[ai][bj][m][n] = __builtin_amdgcn_mfma_f32_16x16x32_bf16(Bt[n][k], At[m][k], acc[ai][bj][m][n], 0, 0, 0); __builtin_amdgcn_s_setprio(0); } while (0)
#define PG8_WAIT_V(n) asm volatile("s_waitcnt vmcnt(" #n ")" ::: "memory")
#define PG8_WAIT_L(n) asm volatile("s_waitcnt lgkmcnt(" #n ")" ::: "memory")
#define PG8_BAR __builtin_amdgcn_s_barrier()
#define PG8_SCHED __builtin_amdgcn_sched_barrier(0)
    Unit cur, nxt; int ui = 0;
    if (!S.next(0, cur)) return;
    f32x4 acc[2][2][4][2];
#pragma unroll
    for (int a = 0; a < 2; ++a)
#pragma unroll
        for (int b = 0; b < 2; ++b)
#pragma unroll
            for (int m = 0; m < 4; ++m)
#pragma unroll
                for (int n = 0; n < 2; ++n) acc[a][b][m][n] = (f32x4){0.f, 0.f, 0.f, 0.f};
    bf16x8 At[4][2], B0[2][2], B1[2][2];
    const char* cA = (const char*)g.A + (size_t)cur.pm * tstep; const char* cB = (const char*)g.Bt + (size_t)cur.pn * tstep;
    S.a_ready(cur);
    PG8_STAGE(PG8_SB(0, 0), cB, voffB); PG8_STAGE(PG8_SA(0, 0), cA, voffA); PG8_STAGE(PG8_SB(0, 1), cB + hstep, voffB); PG8_STAGE(PG8_SA(0, 1), cA + hstep, voffA);
    if (wr == 1) PG8_BAR;
    PG8_WAIT_V(4); PG8_BAR;
    PG8_STAGE(PG8_SB(1, 0), cB + kstep, voffB); PG8_STAGE(PG8_SA(1, 0), cA + kstep, voffA); PG8_STAGE(PG8_SB(1, 1), cB + hstep + kstep, voffB);
    PG8_WAIT_V(6); PG8_BAR;
    for (;;) {
        const bool has_next = S.next(ui + 1, nxt);
        const char* nA = has_next ? (const char*)g.A + (size_t)nxt.pm * tstep : cA; const char* nB = has_next ? (const char*)g.Bt + (size_t)nxt.pn * tstep : cB;
        for (int t = 0; t < nt; t += 2) {
            const bool last = (t == nt - 2);
            const char* a1 = cA + (size_t)(t + 1) * kstep;
            const char* a2 = last ? nA : cA + (size_t)(t + 2) * kstep; const char* b2 = last ? nB : cB + (size_t)(t + 2) * kstep;
            const char* a3 = a2 + kstep; const char* b3 = b2 + kstep;
            if (last && has_next) S.a_ready(nxt);
            PG8_LDB(B0, 0, 0); PG8_SCHED; PG8_LDA(At, 0, 0); PG8_STAGE(PG8_SA(1, 1), a1 + hstep, voffA);
            PG8_WAIT_L(8); PG8_BAR; PG8_WAIT_L(0); PG8_MMA(0, 0, At, B0); PG8_BAR; PG8_SCHED;
            PG8_LDB(B1, 0, 1); PG8_STAGE(PG8_SB(0, 0), b2, voffB);
            PG8_BAR; PG8_WAIT_L(0); PG8_MMA(0, 1, At, B1); PG8_BAR;
            PG8_LDA(At, 0, 1); PG8_STAGE(PG8_SA(0, 0), a2, voffA);
            PG8_BAR; PG8_WAIT_L(0); PG8_MMA(1, 0, At, B0); PG8_BAR; PG8_SCHED;
            PG8_STAGE(PG8_SB(0, 1), b2 + hstep, voffB);
            PG8_WAIT_V(6); PG8_BAR; PG8_MMA(1, 1, At, B1); PG8_BAR;
            PG8_LDB(B0, 1, 0); PG8_SCHED; PG8_LDA(At, 1, 0); PG8_STAGE(PG8_SA(0, 1), a2 + hstep, voffA);
            PG8_WAIT_L(8); PG8_BAR; PG8_WAIT_L(0); PG8_MMA(0, 0, At, B0); PG8_BAR; PG8_SCHED;
            PG8_LDB(B1, 1, 1); PG8_STAGE(PG8_SB(1, 0), b3, voffB);
            PG8_BAR; PG8_WAIT_L(0); PG8_MMA(0, 1, At, B1); PG8_BAR;
            PG8_LDA(At, 1, 1); PG8_STAGE(PG8_SA(1, 0), a3, voffA);
            PG8_BAR; PG8_WAIT_L(0); PG8_MMA(1, 0, At, B0); PG8_BAR; PG8_SCHED;
            PG8_STAGE(PG8_SB(1, 1), b3 + hstep, voffB);
            PG8_WAIT_V(6); PG8_BAR; PG8_MMA(1, 1, At, B1); PG8_BAR;
        }
        if constexpr (!Epi::AFTER_DRAIN) { E(acc, cur, wr, wc, fr, fq); S.done(cur); }
        if (!has_next) break;
#pragma unroll
        for (int a = 0; a < 2; ++a)
#pragma unroll
            for (int b = 0; b < 2; ++b)
#pragma unroll
                for (int m = 0; m < 4; ++m)
#pragma unroll
                    for (int n = 0; n < 2; ++n) acc[a][b][m][n] = (f32x4){0.f, 0.f, 0.f, 0.f};
        cur = nxt; cA = nA; cB = nB; ++ui;
    }
    PG8_WAIT_V(0);
    if (wr == 0) PG8_BAR;
    PG8_BAR;
    if constexpr (Epi::AFTER_DRAIN) { E.fused(acc, cur, wr, wc, fr, fq, lds, wid, lane); S.done(cur); }
#undef PG8_SA
#undef PG8_SB
#undef PG8_STAGE
#undef PG8_LDA
#undef PG8_LDB
#undef PG8_MMA

#undef PG8_WAIT_V
#undef PG8_WAIT_L
#undef PG8_BAR
#undef PG8_SCHED
}
}

struct EpiG1 {
  static constexpr bool PERM = true, AFTER_DRAIN = false;
  unsigned char* ws;
  DI void operator()(const f32x4 (&acc)[2][2][4][2], const pg8::Unit& u, int wr, int wc, int fr, int fq) const {
    const int pn = u.pn; size_t off; int ld, c0;
    if (pn < 8) { off = OFF_PQ; ld = 2048; c0 = pn * 256; }
    else if (pn < 16) { off = OFF_PK; ld = 2048; c0 = (pn - 8) * 256; }
    else if (pn < 32) { off = OFF_PV; ld = 4096; c0 = (pn - 16) * 256; }
    else if (pn < 48) { off = OFF_PRG; ld = 4096; c0 = (pn - 32) * 256; }
    else if (pn < 72) { off = OFF_PHY; ld = 6144; c0 = (pn - 48) * 256; }
    else if (pn < 80) { off = OFF_PHG; ld = 2048; c0 = (pn - 72) * 256; }
    else { off = OFF_PMG; ld = 4096; c0 = (pn - 80) * 256; }
    bf16_t* base = (bf16_t*)(ws + off);
    const int row0 = u.pm * 256 + wr * 64 + fr, col0 = c0 + wc * 32 + 8 * fq;
    const bool rope = (pn < 16) && (u.pm < 64);
    const float4* CS = (const float4*)(ws + OFF_CS) + (wc * 4 + fq) * 2;
#pragma unroll
    for (int ai = 0; ai < 2; ++ai)
#pragma unroll
      for (int m = 0; m < 4; ++m) { const int row = row0 + ai * 128 + m * 16; bf16_t* rowp = base + (size_t)row * ld + col0;
#pragma unroll
        for (int bj = 0; bj < 2; ++bj) { f32x4 v0 = acc[ai][bj][m][0], v1 = acc[ai][bj][m][1];
          if (rope) { const int t = row & 4095, pos = bj ? (t & 63) : (t >> 6); const float4 ca = CS[pos * 32], cb = CS[pos * 32 + 1];
            const f32x4 a = v0, b = v1;
            v0[0] = a[0] * ca.x - b[0] * ca.y; v1[0] = a[0] * ca.y + b[0] * ca.x; v0[1] = a[1] * ca.z - b[1] * ca.w; v1[1] = a[1] * ca.w + b[1] * ca.z;
            v0[2] = a[2] * cb.x - b[2] * cb.y; v1[2] = a[2] * cb.y + b[2] * cb.x; v0[3] = a[3] * cb.z - b[3] * cb.w; v1[3] = a[3] * cb.w + b[3] * cb.z; }
          u32x4 o; o[0] = pk2(v0[0], v0[1]); o[1] = pk2(v0[2], v0[3]); o[2] = pk2(v1[0], v1[1]); o[3] = pk2(v1[2], v1[3]);
          *(u32x4*)(rowp + bj * 128) = o; } }
  }
};
template <int SECOND> struct EpiG23 {
  static constexpr bool PERM = true, AFTER_DRAIN = false;
  unsigned char* ws;
  DI void operator()(const f32x4 (&acc)[2][2][4][2], const pg8::Unit& u, int wr, int wc, int fr, int fq) const {
    bf16_t* T1 = (bf16_t*)(ws + OFF_T1); const bf16_t* MG = (const bf16_t*)(ws + OFF_PMG) + (SECOND ? 2048 : 0);
    const int row0 = u.pm * 256 + wr * 64 + fr, col0 = u.pn * 256 + wc * 32 + 8 * fq;
#pragma unroll
    for (int ai = 0; ai < 2; ++ai)
#pragma unroll
      for (int m = 0; m < 4; ++m) { const size_t row = (size_t)(row0 + ai * 128 + m * 16);
#pragma unroll
        for (int bj = 0; bj < 2; ++bj) { const int col = col0 + bj * 128;
          const u32x4 g = *(const u32x4*)(MG + row * 4096 + col);
          const f32x4 v0 = acc[ai][bj][m][0], v1 = acc[ai][bj][m][1];
          float r[8];
          r[0] = sigmoidf_(lo2f(g[0])) * v0[0]; r[1] = sigmoidf_(hi2f(g[0])) * v0[1]; r[2] = sigmoidf_(lo2f(g[1])) * v0[2]; r[3] = sigmoidf_(hi2f(g[1])) * v0[3];
          r[4] = sigmoidf_(lo2f(g[2])) * v1[0]; r[5] = sigmoidf_(hi2f(g[2])) * v1[1]; r[6] = sigmoidf_(lo2f(g[3])) * v1[2]; r[7] = sigmoidf_(hi2f(g[3])) * v1[3];
          if (SECOND) { const u32x4 t = *(const u32x4*)(T1 + row * 2048 + col);
            r[0] += lo2f(t[0]); r[1] += hi2f(t[0]); r[2] += lo2f(t[1]); r[3] += hi2f(t[1]); r[4] += lo2f(t[2]); r[5] += hi2f(t[2]); r[6] += lo2f(t[3]); r[7] += hi2f(t[3]); }
          u32x4 o; o[0] = pk2(r[0], r[1]); o[1] = pk2(r[2], r[3]); o[2] = pk2(r[4], r[5]); o[3] = pk2(r[6], r[7]);
          *(u32x4*)(T1 + row * 2048 + col) = o; } }
  }
};
struct EpiG4 {
  static constexpr bool PERM = false, AFTER_DRAIN = false;
  const float* xin; const float* cin; float* xout; float* cout; const float* mod;
  DI void operator()(const f32x4 (&acc)[2][2][4][2], const pg8::Unit& u, int wr, int wc, int fr, int fq) const {
    const int row0 = u.pm * 256 + wr * 64 + fr, col0 = u.pn * 256 + wc * 32 + 4 * fq;
#pragma unroll
    for (int ai = 0; ai < 2; ++ai)
#pragma unroll
      for (int m = 0; m < 4; ++m) { const int row = row0 + ai * 128 + m * 16;
        const float* src; float* dst; const float* gate;
        if (row < NLAT) { src = xin + (size_t)row * 2048; dst = xout + (size_t)row * 2048; gate = mod + (row >> 12) * 6144 + 4096; }
        else { src = cin + (size_t)(row - NLAT) * 2048; dst = cout + (size_t)(row - NLAT) * 2048; gate = mod + 4 * 6144 + 4096; }
#pragma unroll
        for (int bj = 0; bj < 2; ++bj)
#pragma unroll
          for (int n = 0; n < 2; ++n) { const int col = col0 + bj * 128 + n * 16;
            const f32x4 xv = *(const f32x4*)(src + col), gv = *(const f32x4*)(gate + col);
            *(f32x4*)(dst + col) = xv + gv * acc[ai][bj][m][n]; } }
  }
};

__device__ void phase_mod(const Params& p, unsigned char* shm) {
  float* sc = (float*)shm; float* red = sc + 5 * 2048;
  const int tid = otid(p.wid);
  for (int i = tid; i < 5 * 2048; i += 512) { const int j = i >> 11, k = i & 2047; const float v = (j < 4) ? p.c[j * 2048 + k] : p.c_ctx[k]; sc[i] = v / (1.f + expf(-v)); }
  __syncthreads();
  { const int i = blockIdx.x * 512 + tid; if (i < 4096) { const int pos = i >> 6, j = i & 63; const float inv = 1.f / powf(10000.f, (float)j / 64.f); float sn, cn; sincosf((float)pos * inv, &sn, &cn); ((float2*)(p.ws + OFF_CS))[i] = make_float2(cn, sn); } }
  float* mod = (float*)(p.ws + OFF_MOD);
  const int cq = tid & 7, ks = tid >> 3;
  for (int it = blockIdx.x; it < 384; it += gridDim.x) {
    const int l = it / 192, nb = (it % 192) * 32;
    const float* W = p.ada_w + (size_t)l * 2048 * 6144 + nb + cq * 4;
    float acc[5][4];
#pragma unroll
    for (int j = 0; j < 5; ++j) { acc[j][0] = 0.f; acc[j][1] = 0.f; acc[j][2] = 0.f; acc[j][3] = 0.f; }
#pragma unroll 4
    for (int kk = 0; kk < 32; ++kk) { const int k = ks * 32 + kk; const float4 w = *(const float4*)(W + (size_t)k * 6144);
#pragma unroll
      for (int j = 0; j < 5; ++j) { const float s = sc[j * 2048 + k]; acc[j][0] += s * w.x; acc[j][1] += s * w.y; acc[j][2] += s * w.z; acc[j][3] += s * w.w; } }
#pragma unroll
    for (int j = 0; j < 5; ++j)
#pragma unroll
      for (int e = 0; e < 4; ++e) red[ks * 160 + j * 32 + cq * 4 + e] = acc[j][e];
    __syncthreads();
    if (tid < 160) { float s = 0.f; for (int q = 0; q < 64; ++q) s += red[q * 160 + tid]; const int j = tid >> 5, n = nb + (tid & 31); mod[(l * 5 + j) * 6144 + n] = s + p.ada_b[l * 6144 + n]; }
    __syncthreads();
  }
}

__device__ void cvt_group(int wid, const float* W, bf16_t* Wt, int K, int N, int k0, int n0, float scale, float* tile, bool perm) {
  const int tid = otid(wid);
  float4 v[8];
  int nsrc = n0 + (tid & 15) * 4;
  if (perm) { const int pc = (n0 & 255) + (tid & 15) * 4, r = pc & 127; nsrc = (n0 & ~255) + (pc & 128) + (r >> 3) * 4 + 64 * ((r >> 2) & 1); }
#pragma unroll
  for (int q = 0; q < 4; ++q)
#pragma unroll
    for (int rr = 0; rr < 2; ++rr) { const int k = (tid >> 4) + 32 * rr; v[q * 2 + rr] = *(const float4*)(W + (size_t)(k0 + q * 64 + k) * N + nsrc); }
#pragma unroll
  for (int q = 0; q < 4; ++q)
#pragma unroll
    for (int rr = 0; rr < 2; ++rr) { const int k = (tid >> 4) + 32 * rr, n = (tid & 15) * 4; float* t = tile + q * 4160 + k * 65 + n; const float4 x = v[q * 2 + rr]; t[0] = x.x; t[1] = x.y; t[2] = x.z; t[3] = x.w; }
  __syncthreads();
#pragma unroll
  for (int q = 0; q < 4; ++q) { const int n = tid >> 3, k8 = (tid & 7) * 8; const float* t = tile + q * 4160; u32x4 o;
#pragma unroll
    for (int e = 0; e < 4; ++e) o[e] = pk2(t[(k8 + 2 * e) * 65 + n] * scale, t[(k8 + 2 * e + 1) * 65 + n] * scale);
    *(u32x4*)(Wt + (size_t)(n0 + n) * K + k0 + q * 64 + k8) = o; }
  __syncthreads();
}
__device__ void phase_cvt(const Params& p, int l, unsigned char* shm) {
  float* tile = (float*)shm;
  for (int it = blockIdx.x; it < 4096; it += gridDim.x) {
    if (it < 3072) { const int kg = it & 7, n0 = (it >> 3) * 64;
      cvt_group(p.wid, p.w_in + (size_t)l * DM * INW, (bf16_t*)(p.ws + OFF_WTIN), DM, INW, kg * 256, n0, (n0 >= 2048 && n0 < 4096) ? 0.0625f : 1.f, tile, n0 < 4096); }
    else if (it < 3328) { const int e = it - 3072; cvt_group(p.wid, p.w_hy_out + (size_t)l * DM * DM, (bf16_t*)(p.ws + OFF_WTHY), DM, DM, (e & 7) * 256, (e >> 3) * 64, 1.f, tile, false); }
    else if (it < 3840) { const int e = it - 3328; cvt_group(p.wid, p.w_ret_out + (size_t)l * 4096 * DM, (bf16_t*)(p.ws + OFF_WTRET), 4096, DM, (e & 15) * 256, (e >> 4) * 64, 1.f, tile, false); }
    else { const int e = it - 3840; cvt_group(p.wid, p.w_o + (size_t)l * DM * DM, (bf16_t*)(p.ws + OFF_WTO), DM, DM, (e & 7) * 256, (e >> 3) * 64, 1.f, tile, false); }
  }
}

DI void filt_item(const Params& p, int l, int Ls, int T, bool isctx, unsigned char* shm) {
  float* z = (float*)shm; float* ha = z + 17 * 36; float* hb = ha + 17 * 64;
  const int tid = otid(p.wid);
  const float* w1 = p.fw1 + l * 33 * 64; const float* b1 = p.fb1 + l * 64; const float* w2 = p.fw2 + l * 4096; const float* b2 = p.fb2 + l * 64;
  const float* w3 = p.fw3 + l * 4096; const float* b3 = p.fb3 + l * 64; const float* fq = p.ffreq + l * 64; const float* wout = p.fwout + (size_t)l * 64 * 4096;
  float* w1s = z + 2816; float* w2s = w1s + 2112; float* w3s = w2s + 4096;
  { const float4 a0 = ((const float4*)w2)[tid], a1 = ((const float4*)w2)[tid + 512], b0 = ((const float4*)w3)[tid], b1 = ((const float4*)w3)[tid + 512];
    const float4 c0 = ((const float4*)w1)[tid]; float4 c1 = c0; if (tid < 16) c1 = ((const float4*)w1)[tid + 512];
    ((float4*)w2s)[tid] = a0; ((float4*)w2s)[tid + 512] = a1; ((float4*)w3s)[tid] = b0; ((float4*)w3s)[tid + 512] = b1; ((float4*)w1s)[tid] = c0; if (tid < 16) ((float4*)w1s)[tid + 512] = c1; }
  for (int i = tid; i < 17 * 33; i += 512) { const int pl = i / 33, f = i % 33; int pp = T * 16 + pl; if (pp > Ls - 1) pp = Ls - 1;
    float val;
    if (f == 0) val = (float)pp / (float)(Ls - 1);
    else { const int j = (f - 1) & 15; const float fj = 1e-4f + (float)j * ((15.f - 1e-4f) / 15.f); const float ang = 6.283185307179586f * (float)pp / (float)Ls; const float a = fj * ang; val = (f <= 16) ? cosf(a) : -sinf(a); }
    z[pl * 36 + f] = val; }
  __syncthreads();
  for (int idx = tid; idx < 17 * 16; idx += 512) { const int pl = idx >> 4, j0 = (idx & 15) * 4; float a[4] = {0.f, 0.f, 0.f, 0.f};
#pragma unroll 3
    for (int k = 0; k < 33; ++k) { const float v = z[pl * 36 + k]; const float4 w = *(const float4*)(w1s + k * 64 + j0); a[0] += v * w.x; a[1] += v * w.y; a[2] += v * w.z; a[3] += v * w.w; }
#pragma unroll
    for (int e = 0; e < 4; ++e) ha[pl * 64 + j0 + e] = sinf(fq[j0 + e] * (a[e] + b1[j0 + e])); }
  __syncthreads();
  for (int idx = tid; idx < 17 * 16; idx += 512) { const int pl = idx >> 4, j0 = (idx & 15) * 4; float a[4] = {0.f, 0.f, 0.f, 0.f};
#pragma unroll 4
    for (int k = 0; k < 64; ++k) { const float v = ha[pl * 64 + k]; const float4 w = *(const float4*)(w2s + k * 64 + j0); a[0] += v * w.x; a[1] += v * w.y; a[2] += v * w.z; a[3] += v * w.w; }
#pragma unroll
    for (int e = 0; e < 4; ++e) hb[pl * 64 + j0 + e] = sinf(fq[j0 + e] * (a[e] + b2[j0 + e])); }
  __syncthreads();
  for (int idx = tid; idx < 17 * 16; idx += 512) { const int pl = idx >> 4, j0 = (idx & 15) * 4; float a[4] = {0.f, 0.f, 0.f, 0.f};
#pragma unroll 4
    for (int k = 0; k < 64; ++k) { const float v = hb[pl * 64 + k]; const float4 w = *(const float4*)(w3s + k * 64 + j0); a[0] += v * w.x; a[1] += v * w.y; a[2] += v * w.z; a[3] += v * w.w; }
#pragma unroll
    for (int e = 0; e < 4; ++e) ha[pl * 64 + j0 + e] = sinf(fq[j0 + e] * (a[e] + b3[j0 + e])); }
  __syncthreads();
  const int c2 = tid * 8; const bool isb = c2 >= 2048; const int cb = c2 & 2047;
  const float mind = logf(0.01f) / 1.5f, maxd = logf(0.01f) / 0.3f;
  bf16_t* G = (bf16_t*)(p.ws + OFF_G + (size_t)l * G_LAYER); float* GC = (float*)(p.ws + OFF_GC);
  for (int pgh = 0; pgh < 4; ++pgh) {
    const int pg = pgh >> 1, c4 = c2 + (pgh & 1) * 4;
    const int plb = pg * 8 + (isb ? 0 : 1);
    float acc[8][4];
#pragma unroll
    for (int e = 0; e < 8; ++e) { acc[e][0] = 0.f; acc[e][1] = 0.f; acc[e][2] = 0.f; acc[e][3] = 0.f; }
#pragma unroll 8
    for (int k = 0; k < 64; ++k) { const float4 wa = *(const float4*)(wout + k * 4096 + c4);
#pragma unroll
      for (int e = 0; e < 8; ++e) { const float h = ha[(plb + e) * 64 + k]; acc[e][0] += h * wa.x; acc[e][1] += h * wa.y; acc[e][2] += h * wa.z; acc[e][3] += h * wa.w; } }
    const int pp0 = T * 16 + plb;
#pragma unroll
    for (int cc = 0; cc < 4; ++cc) { const int c = (c4 & 2047) + cc; const float delta = fabsf(mind + (float)c * ((maxd - mind) / 2047.f));
      float v[8];
#pragma unroll
      for (int e = 0; e < 8; ++e) { const int pp = pp0 + e; v[e] = (pp < Ls) ? acc[e][cc] * __expf(-((float)pp / (float)(Ls - 1)) * delta) : 0.f; }
      if (!isctx) {
        bf16_t* Gc = G + (size_t)c * GLEN;
        if (isb) {
          if (pp0 == 0) { for (int e = 1; e < 8; ++e) Gc[LOFF + e] = f2bf(v[e]); }
          else { u32x4 o; o[0] = pk2(v[0], v[1]); o[1] = pk2(v[2], v[3]); o[2] = pk2(v[4], v[5]); o[3] = pk2(v[6], v[7]); *(u32x4*)(Gc + LOFF + pp0) = o; }
        } else {
          u32x4 o; o[0] = pk2(v[7], v[6]); o[1] = pk2(v[5], v[4]); o[2] = pk2(v[3], v[2]); o[3] = pk2(v[1], v[0]); *(u32x4*)(Gc + LOFF - pp0 - 7) = o;
        }
      } else {
        float* Gc = GC + (size_t)c * 512;
#pragma unroll
        for (int e = 0; e < 8; ++e) { const int pp = pp0 + e; if (isb) { if (pp >= 1 && pp < Ls) Gc[256 - pp] = v[e]; } else { if (pp < Ls) Gc[256 + pp] = v[e]; } }
      }
    }
  }
  if (T == 0 && !isb) {
#pragma unroll 1
    for (int cc = 0; cc < 8; ++cc) { float a = 0.f;
#pragma unroll 4
      for (int k = 0; k < 64; ++k) a += ha[k] * wout[k * 4096 + c2 + cc];
      if (!isctx) G[(size_t)(cb + cc) * GLEN + LOFF] = f2bf(a); else GC[(size_t)(cb + cc) * 512 + 256] = a; }
  }
  __syncthreads();
}
__device__ void phase_filters(const Params& p, unsigned char* shm) {
  for (int it = blockIdx.x; it < 528; it += gridDim.x) { const bool ic = it >= 512; filt_item(p, ic ? 0 : (it >> 8), ic ? CTXL : SEQ, ic ? it - 512 : (it & 255), ic, shm); }
}

__device__ void phase_norm(const Params& p, int l) {
  const int lane = otid(p.wid) & 63, gw = blockIdx.x * 8 + (otid(p.wid) >> 6), nw = gridDim.x * 8;
  const float* mod = (const float*)(p.ws + OFF_MOD) + (size_t)l * 5 * 6144; const float* lng = p.ln_g + l * 2048;
  bf16_t* H = (bf16_t*)(p.ws + OFF_H);
  for (int r = gw; r < MT; r += nw) {
    const float* src; int j;
    if (r < NLAT) { src = (l == 0 ? p.x : p.out) + (size_t)r * 2048; j = r >> 12; }
    else { src = (l == 0 ? p.ctx : (const float*)(p.ws + OFF_CTXR)) + (size_t)(r - NLAT) * 2048; j = 4; }
    const float* sh = mod + j * 6144; const float* sc = sh + 2048;
    float4 v[8]; float ss = 0.f;
#pragma unroll
    for (int i = 0; i < 8; ++i) { v[i] = *(const float4*)(src + i * 256 + lane * 4); ss += v[i].x * v[i].x + v[i].y * v[i].y + v[i].z * v[i].z + v[i].w * v[i].w; }
    ss = wsum(ss, lane);
    const float rs = rsqrtf(ss * (1.f / 2048.f) + 1e-6f);
#pragma unroll
    for (int i = 0; i < 8; ++i) { const int col = i * 256 + lane * 4; const float4 g = *(const float4*)(lng + col), a = *(const float4*)(sc + col), b = *(const float4*)(sh + col);
      u32x2 o; o[0] = pk2(v[i].x * rs * g.x * (1.f + a.x) + b.x, v[i].y * rs * g.y * (1.f + a.y) + b.y); o[1] = pk2(v[i].z * rs * g.z * (1.f + a.z) + b.z, v[i].w * rs * g.w * (1.f + a.w) + b.w);
      *(u32x2*)(H + (size_t)r * 2048 + col) = o; }
  }
}
__device__ void phase_final(const Params& p) {
  const int lane = otid(p.wid) & 63, gw = blockIdx.x * 8 + (otid(p.wid) >> 6), nw = gridDim.x * 8;
  for (int r = gw; r < NLAT; r += nw) {
    float* src = p.out + (size_t)r * 2048; float4 v[8]; float ss = 0.f;
#pragma unroll
    for (int i = 0; i < 8; ++i) { v[i] = *(const float4*)(src + i * 256 + lane * 4); ss += v[i].x * v[i].x + v[i].y * v[i].y + v[i].z * v[i].z + v[i].w * v[i].w; }
    ss = wsum(ss, lane);
    const float rs = rsqrtf(ss * (1.f / 2048.f) + 1e-6f);
#pragma unroll
    for (int i = 0; i < 8; ++i) { const int col = i * 256 + lane * 4; const float4 g = *(const float4*)(p.final_g + col); float4 o; o.x = v[i].x * rs * g.x; o.y = v[i].y * rs * g.y; o.z = v[i].z * rs * g.z; o.w = v[i].w * rs * g.w; *(float4*)(src + col) = o; }
  }
}

DI void tok_tile(int tk, int& b, int& t0, bool& isctx) { if (tk < 256) { b = tk >> 6; t0 = (tk & 63) * 64; isctx = false; } else { b = (tk - 256) >> 2; t0 = ((tk - 256) & 3) * 64; isctx = true; } }
DI int tok_row(int b, int t, bool isctx) { return isctx ? NLAT + b * CTXL + t : b * SEQ + t; }

__device__ void phase_prep(const Params& p, int l, unsigned char* shm, int mask) {
  const int tid = otid(p.wid), lane = tid & 63;
  unsigned char* reg2 = shm + 32768;
  (void)lane;
  if (mask & 4) { float* in = (float*)reg2;
    bf16_t* ut = (bf16_t*)(reg2 + 3 * 66 * 64 * 4);
    const bf16_t* PHY = (const bf16_t*)(p.ws + OFF_PHY); bf16_t* HV = (bf16_t*)(p.ws + OFF_HV); bf16_t* HX0 = (bf16_t*)(p.ws + OFF_HX0);
    const float* cw = p.conv_w + (size_t)l * 3 * 6144; const float* cb = p.conv_b + (size_t)l * 6144;
    const int nit = ((l == 0) ? 272 : 256) * 32;
    u32x4 pre[4];
#define PC_DECODE(it_) const int tk = (it_) >> 5, c0 = ((it_) & 31) * 64; int b, t0; bool isctx; tok_tile(tk, b, t0, isctx); const int Ls = isctx ? CTXL : SEQ; const int row0 = tok_row(b, t0, isctx);
#define PC_LOAD(it_) do { PC_DECODE(it_) _Pragma("unroll") for (int e = 0; e < 4; ++e) { const int id = tid + 512 * e; const int pi = id / 528, rem = id % 528, rr = rem >> 3, pc = rem & 7; const int t = t0 - 1 + rr; \
        u32x4 v; v[0] = 0u; v[1] = 0u; v[2] = 0u; v[3] = 0u; if (id < 1584 && t >= 0 && t < Ls) v = *(const u32x4*)(PHY + (size_t)(row0 - 1 + rr) * 6144 + pi * 2048 + c0 + pc * 8); pre[e] = v; } } while (0)
    if ((int)blockIdx.x < nit) PC_LOAD((int)blockIdx.x);
    for (int it = blockIdx.x; it < nit; it += gridDim.x) {
      PC_DECODE(it) (void)Ls;
#pragma unroll
      for (int e = 0; e < 4; ++e) { const int id = tid + 512 * e; if (id < 1584) { const int pi = id / 528, rem = id % 528, rr = rem >> 3, pc = rem & 7; const u32x4 v = pre[e];
        float* d = in + (pi * 66 + rr) * 64 + pc * 8;
        *(float4*)d = make_float4(lo2f(v[0]), hi2f(v[0]), lo2f(v[1]), hi2f(v[1])); *(float4*)(d + 4) = make_float4(lo2f(v[2]), hi2f(v[2]), lo2f(v[3]), hi2f(v[3])); } }
      if (it + (int)gridDim.x < nit) PC_LOAD(it + (int)gridDim.x);
      __syncthreads();
      { const int cg8 = (tid & 7) * 8, tok = tid >> 3;
        float cv[3][8];
#pragma unroll
        for (int pi = 0; pi < 3; ++pi) { const float* wp = cw + pi * 2048 + c0 + cg8;
          const float4 ba = *(const float4*)(cb + pi * 2048 + c0 + cg8), bb = *(const float4*)(cb + pi * 2048 + c0 + cg8 + 4);
          cv[pi][0] = ba.x; cv[pi][1] = ba.y; cv[pi][2] = ba.z; cv[pi][3] = ba.w; cv[pi][4] = bb.x; cv[pi][5] = bb.y; cv[pi][6] = bb.z; cv[pi][7] = bb.w;
#pragma unroll
          for (int k = 0; k < 3; ++k) { const float4 wa = *(const float4*)(wp + k * 6144), wb = *(const float4*)(wp + k * 6144 + 4);
            const float* ip = in + (pi * 66 + tok + k) * 64 + cg8; const float4 xa = *(const float4*)ip, xb = *(const float4*)(ip + 4);
            cv[pi][0] += xa.x * wa.x; cv[pi][1] += xa.y * wa.y; cv[pi][2] += xa.z * wa.z; cv[pi][3] += xa.w * wa.w; cv[pi][4] += xb.x * wb.x; cv[pi][5] += xb.y * wb.y; cv[pi][6] += xb.z * wb.z; cv[pi][7] += xb.w * wb.w; } }
        u32x4 hvp, hxp;
#pragma unroll
        for (int e = 0; e < 4; ++e) { hvp[e] = pk2(cv[0][2 * e] * cv[2][2 * e], cv[0][2 * e + 1] * cv[2][2 * e + 1]); hxp[e] = pk2(cv[1][2 * e], cv[1][2 * e + 1]); }
        *(u32x4*)(HV + (size_t)(row0 + tok) * 2048 + c0 + cg8) = hvp; *(u32x4*)(HX0 + (size_t)(row0 + tok) * 2048 + c0 + cg8) = hxp;
#pragma unroll
        for (int e = 0; e < 4; ++e) { ut[(cg8 + 2 * e) * 66 + tok] = (bf16_t)(hvp[e] & 0xffffu); ut[(cg8 + 2 * e + 1) * 66 + tok] = (bf16_t)(hvp[e] >> 16); } }
      __syncthreads();
      { const int c = tid >> 3, pc = tid & 7; u32x4 o;
#pragma unroll
        for (int e = 0; e < 4; ++e) o[e] = (unsigned)ut[c * 66 + pc * 8 + 2 * e] | ((unsigned)ut[c * 66 + pc * 8 + 2 * e + 1] << 16);
        bf16_t* dst = isctx ? (bf16_t*)(p.ws + OFF_UTC) + ((size_t)(c0 + c) * NB + b) * CTXL + t0 + pc * 8 : (bf16_t*)(p.ws + OFF_UT) + ((size_t)(c0 + c) * NB + b) * SEQ + t0 + pc * 8;
        *(u32x4*)dst = o; }
    }
    __syncthreads();
#undef PC_DECODE
#undef PC_LOAD
  }
}

__device__ void phase_post(const Params& p, int l, unsigned char* shm, int mask) {
  const int tid = otid(p.wid), lane = tid & 63;
  const bf16_t* HV = (const bf16_t*)(p.ws + OFF_HV); const bf16_t* HX0 = (const bf16_t*)(p.ws + OFF_HX0); const bf16_t* PHG = (const bf16_t*)(p.ws + OFF_PHG);
  bf16_t* AH = (bf16_t*)(p.ws + OFF_H); const float* hbias = p.hy_bias + l * 2048;
  if (mask & 1) { float* yt = (float*)shm;
    const bf16_t* UT = (const bf16_t*)(p.ws + OFF_UT);
    const int nit = 256 * 32; u32x4 pre;
#define PA_LOAD(it_) do { const int tk_ = (it_) >> 5, c0_ = ((it_) & 31) * 64, b_ = tk_ >> 6, t0_ = (tk_ & 63) * 64; pre = *(const u32x4*)(UT + ((size_t)(c0_ + (tid >> 3)) * NB + b_) * SEQ + t0_ + (tid & 7) * 8); } while (0)
    if ((int)blockIdx.x < nit) PA_LOAD((int)blockIdx.x);
    for (int it = blockIdx.x; it < nit; it += gridDim.x) {
      const int tk = it >> 5, c0 = (it & 31) * 64, b = tk >> 6, t0 = (tk & 63) * 64, row0 = b * SEQ + t0;
      { const int c = tid >> 3, pc = tid & 7; const u32x4 v = pre; float* d = yt + (pc * 8) * 65 + c;
        d[0] = lo2f(v[0]); d[65] = hi2f(v[0]); d[130] = lo2f(v[1]); d[195] = hi2f(v[1]); d[260] = lo2f(v[2]); d[325] = hi2f(v[2]); d[390] = lo2f(v[3]); d[455] = hi2f(v[3]); }
      if (it + (int)gridDim.x < nit) PA_LOAD(it + (int)gridDim.x);
      __syncthreads();
      { const int cg8 = (tid & 7) * 8, tok = tid >> 3; const size_t o = (size_t)(row0 + tok) * 2048 + c0 + cg8;
        const u32x4 hv = *(const u32x4*)(HV + o), hx = *(const u32x4*)(HX0 + o), hg = *(const u32x4*)(PHG + o);
        const float4 ba = *(const float4*)(hbias + c0 + cg8), bb = *(const float4*)(hbias + c0 + cg8 + 4);
        const float hb[8] = {ba.x, ba.y, ba.z, ba.w, bb.x, bb.y, bb.z, bb.w}; const float* yp = yt + tok * 65 + cg8; u32x4 r;
#pragma unroll
        for (int e = 0; e < 4; ++e) { const float a0 = (yp[2 * e] + hb[2 * e] * lo2f(hv[e])) * lo2f(hx[e]) * siluf_(lo2f(hg[e])), a1 = (yp[2 * e + 1] + hb[2 * e + 1] * hi2f(hv[e])) * hi2f(hx[e]) * siluf_(hi2f(hg[e])); r[e] = pk2(a0, a1); }
        *(u32x4*)(AH + o) = r; }
      __syncthreads();
    }
#undef PA_LOAD
  }
  if (l == 0 && (mask & 2)) { float* gc = (float*)shm; float* us = gc + 32 * 512;
    const bf16_t* UTC = (const bf16_t*)(p.ws + OFF_UTC); const float* GC = (const float*)(p.ws + OFF_GC);
    for (int it = blockIdx.x; it < 16 * 64; it += gridDim.x) {
      const int tk = it >> 6, c0 = (it & 63) * 32, b = tk >> 2, t0 = (tk & 3) * 64, row0 = NLAT + b * CTXL + t0;
#pragma unroll 8
      for (int i = tid; i < 32 * 512; i += 512) gc[i] = GC[(size_t)(c0 + (i >> 9)) * 512 + (i & 511)];
#pragma unroll 8
      for (int i = tid; i < 32 * 256; i += 512) us[i] = bf2f(UTC[((size_t)(c0 + (i >> 8)) * NB + b) * CTXL + (i & 255)]);
      __syncthreads();
      { const int t = tid & 63, cg4 = tid >> 6;
#pragma unroll 1
        for (int e = 0; e < 4; ++e) { const int c = cg4 * 4 + e; const float* g = gc + c * 512 + 256 + t0 + t; const float* u = us + c * 256; float a = 0.f;
#pragma unroll 8
          for (int s = 0; s < 256; ++s) a += u[s] * g[-s];
          const size_t o = (size_t)(row0 + t) * 2048 + c0 + c; const float hv = bf2f(HV[o]);
          AH[o] = f2bf((a + hbias[c0 + c] * hv) * bf2f(HX0[o]) * siluf_(bf2f(PHG[o]))); } }
      __syncthreads();
    }
  }
  if (mask & 4) { bf16_t* OF = (bf16_t*)(p.ws + OFF_OF); const bf16_t* OB = (const bf16_t*)(p.ws + OFF_OB); const bf16_t* RG = (const bf16_t*)(p.ws + OFF_PRG);
    const int gw = blockIdx.x * 8 + (tid >> 6), nw = gridDim.x * 8; const int nrows = (l == 0) ? MT : NLAT;
#pragma unroll 2
    for (int it = gw; it < nrows * 8; it += nw) { const size_t o = (size_t)(it >> 3) * 4096 + (it & 7) * 512 + lane * 8;
      const u32x4 a = *(const u32x4*)(OF + o), bq = *(const u32x4*)(OB + o), g = *(const u32x4*)(RG + o);
      float v[8]; float ss = 0.f;
#pragma unroll
      for (int e = 0; e < 4; ++e) { v[2 * e] = lo2f(a[e]) + lo2f(bq[e]); v[2 * e + 1] = hi2f(a[e]) + hi2f(bq[e]); ss += v[2 * e] * v[2 * e] + v[2 * e + 1] * v[2 * e + 1]; }
      ss = wsum(ss, lane);
      const float rs = rsqrtf(ss * (1.f / 512.f) + 1e-6f);
      u32x4 r;
#pragma unroll
      for (int e = 0; e < 4; ++e) r[e] = pk2(v[2 * e] * rs * siluf_(lo2f(g[e])), v[2 * e + 1] * rs * siluf_(hi2f(g[e])));
      *(u32x4*)(OF + o) = r; }
  }
}

__device__ void phase_conv(const Params& p, int l, unsigned char* shm) {
  const int tid = otid(p.wid), lane = tid & 63, wid = tid >> 6;
  bf16_t* Gs = (bf16_t*)shm;
  bf16_t* Us = (bf16_t*)(shm + 2 * GLEN * 2);
  { unsigned zz = 0u; asm volatile("" : "+v"(zz)); u32x4 z; z[0] = zz; z[1] = zz; z[2] = zz; z[3] = zz; for (int i = tid; i < 2 * 4 * USTR / 8; i += 512) ((u32x4*)Us)[i] = z; }
  __syncthreads();
  const int ch = wid >> 2, q = wid & 3, i = lane & 31, g = lane >> 5, a_l = i >> 2, b = i & 3;
  const bf16_t* G = (const bf16_t*)(p.ws + OFF_G + (size_t)l * G_LAYER); bf16_t* UT = (bf16_t*)(p.ws + OFF_UT);
  const int mb = LOFF - i + 8 * g - 128 * (8 * q + 7);
  const unsigned sh = (unsigned)(mb & 1) * 16u;
  const unsigned* Gd = (const unsigned*)(Gs + ch * GLEN) + (mb >> 1);
  const bf16_t* Ub = Us + (ch * 4 + b) * USTR + 136 * (a_l + 1) + 8 * g;
#define CONV_LDFRAG(dst, n) do { const unsigned* q_ = Gd + 8 * (n); const unsigned d0 = q_[0], d1 = q_[1], d2 = q_[2], d3 = q_[3], d4 = q_[4]; u32x4 r_; \
    r_[0] = __builtin_amdgcn_alignbit(d1, d0, sh); r_[1] = __builtin_amdgcn_alignbit(d2, d1, sh); r_[2] = __builtin_amdgcn_alignbit(d3, d2, sh); r_[3] = __builtin_amdgcn_alignbit(d4, d3, sh); \
    dst = __builtin_bit_cast(bf16x8, r_); } while (0)
  for (int pr = blockIdx.x; pr < 1024; pr += gridDim.x) {
    for (int id = tid; id < 2 * (GLEN / 2); id += 512) { const int cc = id / (GLEN / 2), dw = id % (GLEN / 2);
      unsigned v = ((const unsigned*)(G + (size_t)(pr * 2 + cc) * GLEN))[dw]; const int m = dw * 2;
      if (m < 33 || m > 8223) v &= 0xffff0000u; if (m + 1 < 33 || m + 1 > 8223) v &= 0x0000ffffu;
      ((unsigned*)Gs)[cc * (GLEN / 2) + dw] = v; }
    for (int id = tid; id < 2 * 4 * 512; id += 512) { const int cc = id >> 11, bb = (id >> 9) & 3, s8 = id & 511;
      const u32x4 v = *(const u32x4*)(UT + ((size_t)(pr * 2 + cc) * 4 + bb) * SEQ + s8 * 8); const int sp = 1024 + s8 * 8;
      *(u32x4*)(Us + (cc * 4 + bb) * USTR + sp + 8 * (sp >> 7)) = v; }
    __syncthreads();
    bf16x8 W[8]; f32x16 acc[4];
#pragma unroll
    for (int h = 0; h < 4; ++h)
#pragma unroll
      for (int e = 0; e < 16; ++e) acc[h][e] = 0.f;
    CONV_LDFRAG(W[2], -6); CONV_LDFRAG(W[3], -5); CONV_LDFRAG(W[4], -4); CONV_LDFRAG(W[5], -3); CONV_LDFRAG(W[6], -2); CONV_LDFRAG(W[7], -1);
#pragma unroll 1
    for (int it = 0; it < 39; ++it) {
#pragma unroll
      for (int u = 0; u < 8; ++u) {
        CONV_LDFRAG(W[u], it * 8 + u);
        const bf16x8 bf = *(const bf16x8*)(Ub + 136 * it + 16 * u);
#pragma unroll
        for (int h = 0; h < 4; ++h) acc[h] = __builtin_amdgcn_mfma_f32_32x32x16_bf16(W[(u - 2 * h) & 7], bf, acc[h], 0, 0, 0);
      }
    }
    { bf16_t* yrow = UT + ((size_t)(pr * 2 + ch) * 4 + b) * SEQ + 128 * (8 * q + a_l) + 4 * g;
#pragma unroll
      for (int h = 0; h < 4; ++h)
#pragma unroll
        for (int rq = 0; rq < 4; ++rq) { u32x2 o; o[0] = pk2(acc[h][4 * rq], acc[h][4 * rq + 1]); o[1] = pk2(acc[h][4 * rq + 2], acc[h][4 * rq + 3]); *(u32x2*)(yrow + 32 * h + 8 * rq) = o; } }
    __syncthreads();
  }
#undef CONV_LDFRAG
}

template <int KD> DI f32x16 mma_tile(f32x16 acc, const bf16_t* A, int lda, const bf16_t* B, int ldb, int lane) {
  const int r = lane & 31, g8 = (lane >> 5) * 8; const bf16_t* ap = A + r * lda + g8; const bf16_t* bp = B + r * ldb + g8;
#pragma unroll 4
  for (int k0 = 0; k0 < KD; k0 += 16) acc = __builtin_amdgcn_mfma_f32_32x32x16_bf16(*(const bf16x8*)(ap + k0), *(const bf16x8*)(bp + k0), acc, 0, 0, 0);
  return acc;
}
DI bf16x8 tr_frag(const bf16_t* img, int ld, int lane) {
  const int h = lane >> 5, blk = (lane >> 4) & 1, q = (lane & 15) >> 2, pp = lane & 3;
  const bf16_t* a = img + (8 * h + q) * ld + 16 * blk + 4 * pp;
  const s16x4 r0 = __builtin_amdgcn_ds_read_tr16_b64_v4i16((__attribute__((address_space(3))) s16x4*)a);
  const s16x4 r1 = __builtin_amdgcn_ds_read_tr16_b64_v4i16((__attribute__((address_space(3))) s16x4*)(a + 4 * ld));
  bf16x8 f; f[0] = r0[0]; f[1] = r0[1]; f[2] = r0[2]; f[3] = r0[3]; f[4] = r1[0]; f[5] = r1[1]; f[6] = r1[2]; f[7] = r1[3]; return f;
}
__device__ void phase_ret(const Params& p, int l, unsigned char* shm) {
  constexpr int QS = 264, VS = 144, TS = 72;
  const int tid = otid(p.wid), lane = tid & 63, wid = tid >> 6, g = lane >> 5;
  bf16_t* Qs = (bf16_t*)shm; bf16_t* Ks = Qs + 64 * QS; bf16_t* Vs = Ks + 64 * QS; bf16_t* Ps = Vs + 64 * VS; bf16_t* Sts = Ps + 64 * TS;
  const bf16_t* PQ = (const bf16_t*)(p.ws + OFF_PQ); const bf16_t* PK = (const bf16_t*)(p.ws + OFF_PK); const bf16_t* PV = (const bf16_t*)(p.ws + OFF_PV);
  for (int it0 = blockIdx.x; it0 < 256; it0 += gridDim.x) {
    int it = it0;
    if (gridDim.x == 256) { const int xcd = it0 & 7, idx = it0 >> 3; it = ((xcd + 8 * (idx >> 2)) << 2) | (idx & 3); }
    const int sl = it & 3, dir = (it >> 2) & 1, h = (it >> 3) & 7, b = it >> 6;
    const float lg = -expf(p.ret_decay[(l * 2 + dir) * 8 + h]);
    bf16_t* O = (bf16_t*)(p.ws + (dir ? OFF_OB : OFF_OF));
    for (int i = tid; i < 128 * QS / 2; i += 512) ((unsigned*)Sts)[i] = 0u;
    f32x16 S[4], cross;
#pragma unroll
    for (int x = 0; x < 4; ++x)
#pragma unroll
      for (int e = 0; e < 16; ++e) S[x][e] = 0.f;
#pragma unroll
    for (int e = 0; e < 16; ++e) cross[e] = 0.f;
    const float cd = __expf(lg * 64.f);
    const int tid2 = otid(p.wid), ln2 = tid2 & 63, g2 = ln2 >> 5, w2 = tid2 >> 6;
    float mk[16], dkv[2];
#pragma unroll
    for (int e = 0; e < 2; ++e) { const int tok = (tid2 >> 4) + 32 * e; dkv[e] = __expf(lg * (float)(dir ? tok : 63 - tok)); }
    const int wq = w2 & 3, s_tj = wq >> 1, s_ti = wq & 1;
    const int o_tc = w2 >> 1, o_ti = w2 & 1;
    { const int i = s_ti * 32 + (ln2 & 31);
#pragma unroll
      for (int e = 0; e < 16; ++e) { const int j = s_tj * 32 + (e & 3) + 8 * (e >> 2) + 4 * g2; const int diff = dir ? (j - i) : (i - j); mk[e] = diff >= 0 ? __expf(lg * (float)(dir ? -i : i - 63)) : 0.f; } }
    const int qi = o_ti * 32 + (ln2 & 31);
    const float qd = __expf(lg * (float)(dir ? 64 - qi : qi + 1));
    u32x4 rq[4], rk[4], rv[2];
    const unsigned qo_l = (unsigned)(tid >> 5) * 2048u + (unsigned)(h * 256 + (tid & 31) * 8);
    const unsigned vo_l = (unsigned)(tid >> 4) * 4096u + (unsigned)(h * 512 + sl * 128 + (tid & 15) * 8);
#define RET_CHUNK(step_, isctx_, t0_) do { if ((step_) < 4) { isctx_ = true; t0_ = (dir ? 3 - (step_) : (step_)) * 64; } else { isctx_ = false; const int cn_ = (step_) - 4; t0_ = (dir ? 63 - cn_ : cn_) * 64; } } while (0)
#define RET_LOAD(step_) do { bool ic_; int t0n_; RET_CHUNK(step_, ic_, t0n_); const unsigned rw_ = (unsigned)tok_row(b, t0n_, ic_); \
      _Pragma("unroll") for (int e = 0; e < 4; ++e) { rq[e] = *(const u32x4*)(PQ + (rw_ * 2048u + qo_l + (unsigned)e * 32768u)); rk[e] = *(const u32x4*)(PK + (rw_ * 2048u + qo_l + (unsigned)e * 32768u)); } \
      _Pragma("unroll") for (int e = 0; e < 2; ++e) rv[e] = *(const u32x4*)(PV + (rw_ * 4096u + vo_l + (unsigned)e * 131072u)); } while (0)
    RET_LOAD(0);
#pragma unroll 1
    for (int step = 0; step < 68; ++step) {
      bool isctx; int t0; RET_CHUNK(step, isctx, t0);
      const int row0 = tok_row(b, t0, isctx);
      __syncthreads();
#pragma unroll
      for (int e = 0; e < 4; ++e) { const int row = (tid >> 5) + 16 * e, pc = tid & 31; *(u32x4*)(Qs + row * QS + pc * 8) = rq[e]; *(u32x4*)(Ks + row * QS + pc * 8) = rk[e]; }
#pragma unroll
      for (int e = 0; e < 2; ++e) { u32x4 o;
#pragma unroll
        for (int w = 0; w < 4; ++w) o[w] = pk2(lo2f(rv[e][w]) * dkv[e], hi2f(rv[e][w]) * dkv[e]);
        *(u32x4*)(Vs + ((tid >> 4) + 32 * e) * VS + (tid & 15) * 8) = o; }
      if (step + 1 < 68) RET_LOAD(step + 1);
      __syncthreads();
      if (wid < 4) {
        f32x16 sc;
#pragma unroll
        for (int e = 0; e < 16; ++e) sc[e] = 0.f;
        sc = mma_tile<256>(sc, Ks + s_tj * 32 * QS, QS, Qs + s_ti * 32 * QS, QS, lane);
        const int i = s_ti * 32 + (lane & 31);
#pragma unroll
        for (int r4 = 0; r4 < 4; ++r4) { u32x2 o; o[0] = pk2(sc[4 * r4] * mk[4 * r4], sc[4 * r4 + 1] * mk[4 * r4 + 1]); o[1] = pk2(sc[4 * r4 + 2] * mk[4 * r4 + 2], sc[4 * r4 + 3] * mk[4 * r4 + 3]);
          *(u32x2*)(Ps + i * TS + s_tj * 32 + 8 * r4 + 4 * g) = o; }
      }
#pragma unroll
      for (int e = 0; e < 16; ++e) cross[e] = 0.f;
      cross = mma_tile<256>(cross, Sts + o_tc * 32 * QS, QS, Qs + o_ti * 32 * QS, QS, lane);
      __syncthreads();
      { f32x16 in_;
#pragma unroll
        for (int e = 0; e < 16; ++e) in_[e] = 0.f;
        const bf16_t* pb = Ps + (o_ti * 32 + (lane & 31)) * TS + 8 * g;
#pragma unroll
        for (int ks = 0; ks < 4; ++ks) in_ = __builtin_amdgcn_mfma_f32_32x32x16_bf16(tr_frag(Vs + 16 * ks * VS + 32 * o_tc, VS, lane), *(const bf16x8*)(pb + 16 * ks), in_, 0, 0, 0);
        const unsigned ob = (unsigned)(row0 + qi) * 4096u + (unsigned)(h * 512 + sl * 128 + o_tc * 32 + 4 * g);
#pragma unroll
        for (int r4 = 0; r4 < 4; ++r4) { u32x2 o; o[0] = pk2(in_[4 * r4] + qd * cross[4 * r4], in_[4 * r4 + 1] + qd * cross[4 * r4 + 1]); o[1] = pk2(in_[4 * r4 + 2] + qd * cross[4 * r4 + 2], in_[4 * r4 + 3] + qd * cross[4 * r4 + 3]);
          *(u32x2*)(O + (ob + (unsigned)(8 * r4))) = o; } }
      { bf16x8 ka[4];
#pragma unroll
        for (int ks = 0; ks < 4; ++ks) ka[ks] = tr_frag(Ks + 16 * ks * QS + 32 * wid, QS, lane);
#pragma unroll
        for (int x = 0; x < 4; ++x) {
#pragma unroll
          for (int e = 0; e < 16; ++e) S[x][e] *= cd;
#pragma unroll
          for (int ks = 0; ks < 4; ++ks) S[x] = __builtin_amdgcn_mfma_f32_32x32x16_bf16(ka[ks], tr_frag(Vs + 16 * ks * VS + 32 * x, VS, lane), S[x], 0, 0, 0);
          const int c = x * 32 + (lane & 31);
#pragma unroll
          for (int r4 = 0; r4 < 4; ++r4) { u32x2 o; o[0] = pk2(S[x][4 * r4], S[x][4 * r4 + 1]); o[1] = pk2(S[x][4 * r4 + 2], S[x][4 * r4 + 3]); *(u32x2*)(Sts + c * QS + wid * 32 + 8 * r4 + 4 * g) = o; } } }
    }
    __syncthreads();
  }
#undef RET_CHUNK
#undef RET_LOAD
}

__global__ void __launch_bounds__(512, 2) mega(Params p_in) {
  Params p = p_in; p.wid = __builtin_amdgcn_readfirstlane((int)(threadIdx.x >> 6));
  extern __shared__ __attribute__((aligned(16))) unsigned char shm[];
  cg::grid_group grid = cg::this_grid();
  PG8_LAS unsigned char* lds = (PG8_LAS unsigned char*)shm;
  volatile XLAS unsigned* xst = (volatile XLAS unsigned*)(lds + 163824);
  if (otid(p.wid) == 0) { xst[0] = 0u; xst[1] = 0u; }
  __syncthreads();
  const XcdBarrier xb = xcd_barrier_post((unsigned*)(p.ws + OFF_BAR), xst, otid(p.wid) == 0);
  const bf16_t* H = (const bf16_t*)(p.ws + OFF_H);
#pragma unroll 1
  for (int rep = 0; rep < (PROBE == 1 ? 2 : 1); ++rep) { phase_filters(p, shm); phase_mod(p, shm); }
  grid.sync();
  for (int l = 0; l < 2; ++l) {
#pragma unroll 1
    for (int rep = 0; rep < (PROBE == 1 ? 2 : 1); ++rep) { phase_cvt(p, l, shm); phase_norm(p, l); }
    xcd_barrier(xb, otid(p.wid) == 0);
    { pg8::Gemm g; g.wid = p.wid; g.A = H; g.Bt = (const bf16_t*)(p.ws + OFF_WTIN); g.M = MT; g.N = INW; g.K = DM;
      pg8::Order S; S.init(64, 96, (int)gridDim.x, (int)blockIdx.x, 4, l == 0 ? 96 : 24, l == 0 ? 0 : 8);
      EpiG1 E; E.ws = p.ws; pg8::gemm_phase<EpiG1, pg8::Order>(lds, g, S, E); }
    xcd_barrier(xb, otid(p.wid) == 0);
#pragma unroll 1
    for (int rep = 0; rep < (PROBE == 2 ? 2 : 1); ++rep) phase_prep(p, l, shm, rep ? 4 : 7);
    xcd_barrier(xb, otid(p.wid) == 0);
    phase_conv(p, l, shm);
#pragma unroll 1
    for (int rep = 0; rep < (PROBE == 3 ? 2 : 1); ++rep) phase_ret(p, l, shm);
    xcd_barrier(xb, otid(p.wid) == 0);
#pragma unroll 1
    for (int rep = 0; rep < (PROBE == 2 ? 2 : 1); ++rep) phase_post(p, l, shm, rep ? 3 : 7);
    xcd_barrier(xb, otid(p.wid) == 0);
    { const int nM = (l == 0) ? 68 : 64;
      pg8::Order S; S.init(nM, 8, (int)gridDim.x, (int)blockIdx.x, 0, 0, 0);
#pragma unroll 1
      for (int rep = 0; rep < (PROBE == 4 ? 2 : 1); ++rep) {
      { pg8::Gemm g; g.wid = p.wid; g.A = H; g.Bt = (const bf16_t*)(p.ws + OFF_WTHY); g.M = nM * 256; g.N = DM; g.K = DM; EpiG23<0> E; E.ws = p.ws; pg8::gemm_phase<EpiG23<0>, pg8::Order>(lds, g, S, E); }
      { pg8::Gemm g; g.wid = p.wid; g.A = (const bf16_t*)(p.ws + OFF_OF); g.Bt = (const bf16_t*)(p.ws + OFF_WTRET); g.M = nM * 256; g.N = DM; g.K = 4096; EpiG23<1> E; E.ws = p.ws; pg8::gemm_phase<EpiG23<1>, pg8::Order>(lds, g, S, E); }
      }
      xcd_barrier(xb, otid(p.wid) == 0);
      { pg8::Gemm g; g.wid = p.wid; g.A = (const bf16_t*)(p.ws + OFF_T1); g.Bt = (const bf16_t*)(p.ws + OFF_WTO); g.M = nM * 256; g.N = DM; g.K = DM;
        EpiG4 E; E.xin = (l == 0) ? p.x : p.out; E.cin = p.ctx; E.xout = p.out; E.cout = (float*)(p.ws + OFF_CTXR); E.mod = (const float*)(p.ws + OFF_MOD) + (size_t)l * 5 * 6144;
        pg8::gemm_phase<EpiG4, pg8::Order>(lds, g, S, E); } }
    xcd_barrier(xb, otid(p.wid) == 0);
  }
  phase_final(p);
}

extern "C" void kernel_launch(void* const* d_in, const int* in_sizes, int n_in, void* d_out, int out_size, void* d_ws, size_t ws_size, hipStream_t stream) {
  constexpr size_t kDynLds = 163840;
  static int grid_blocks = 0;
  if (!grid_blocks) {
    hipFuncSetAttribute((const void*)mega, hipFuncAttributeMaxDynamicSharedMemorySize, (int)kDynLds);
    int dev = 0, cus = 0, per_cu = 0;
    hipGetDevice(&dev);
    hipDeviceGetAttribute(&cus, hipDeviceAttributeMultiprocessorCount, dev);
    hipOccupancyMaxActiveBlocksPerMultiprocessor(&per_cu, (const void*)mega, 512, kDynLds);
    grid_blocks = cus * (per_cu >= 1 ? 1 : 0);
    if (ws_size < WS_NEED || grid_blocks <= 0) { fprintf(stderr, "workspace %zu < %zu or no occupancy (%d)\n", ws_size, (size_t)WS_NEED, per_cu); grid_blocks = grid_blocks > 0 ? grid_blocks : 256; }
  }
  Params p{};
  p.x = (const float*)d_in[0]; p.c = (const float*)d_in[1]; p.ctx = (const float*)d_in[2]; p.c_ctx = (const float*)d_in[3]; p.ln_g = (const float*)d_in[4];
  p.ada_w = (const float*)d_in[5]; p.ada_b = (const float*)d_in[6]; p.w_in = (const float*)d_in[7]; p.conv_w = (const float*)d_in[8]; p.conv_b = (const float*)d_in[9];
  p.fw1 = (const float*)d_in[10]; p.fb1 = (const float*)d_in[11]; p.fw2 = (const float*)d_in[12]; p.fb2 = (const float*)d_in[13]; p.fw3 = (const float*)d_in[14]; p.fb3 = (const float*)d_in[15];
  p.ffreq = (const float*)d_in[16]; p.fwout = (const float*)d_in[17]; p.hy_bias = (const float*)d_in[18]; p.ret_decay = (const float*)d_in[19];
  p.w_hy_out = (const float*)d_in[20]; p.w_ret_out = (const float*)d_in[21]; p.w_o = (const float*)d_in[22]; p.final_g = (const float*)d_in[23];
  p.out = (float*)d_out; p.ws = (unsigned char*)d_ws;
  void* args[] = {&p};
  (void)hipMemsetAsync((unsigned char*)d_ws + OFF_BAR, 0, (size_t)XCD_BAR_WORDS * 4, stream);
  hipError_t e = hipLaunchCooperativeKernel((void*)mega, dim3(grid_blocks), dim3(512), args, kDynLds, stream);
  if (e != hipSuccess) fprintf(stderr, "cooperative launch failed: %s (grid %d)\n", hipGetErrorString(e), grid_blocks);
}
```

```cpp
#include <hip/hip_runtime.h>
#include <hip/hip_cooperative_groups.h>
#include <cstdio>
namespace cg = cooperative_groups;
#ifndef PROBE
#define PROBE 0
#endif

typedef unsigned short bf16_t;
typedef short bf16x8 __attribute__((ext_vector_type(8)));
typedef float f32x4 __attribute__((ext_vector_type(4)));
typedef float f32x16 __attribute__((ext_vector_type(16)));
typedef unsigned u32x4 __attribute__((ext_vector_type(4)));
typedef unsigned u32x2 __attribute__((ext_vector_type(2)));
typedef short s16x4 __attribute__((ext_vector_type(4)));
#define DI __device__ __forceinline__

DI int otid(int wid) { int t; asm volatile("v_mbcnt_lo_u32_b32 %0, -1, 0\n\tv_mbcnt_hi_u32_b32 %0, -1, %0" : "=v"(t)); return wid * 64 + t; }
DI float wsum(float v, int lane) {
#pragma unroll
  for (int o = 32; o > 0; o >>= 1) v += __int_as_float(__builtin_amdgcn_ds_bpermute((lane ^ o) << 2, __float_as_int(v)));
  return v; }
DI float bf2f(bf16_t u) { return __uint_as_float(((unsigned)u) << 16); }
typedef __bf16 bf16v2 __attribute__((ext_vector_type(2)));
typedef float f32v2 __attribute__((ext_vector_type(2)));
DI unsigned pk2(float lo, float hi) { f32v2 v = {lo, hi}; bf16v2 b = __builtin_convertvector(v, bf16v2); return __builtin_bit_cast(unsigned, b); }
DI bf16_t f2bf(float f) { return (bf16_t)(pk2(f, 0.f) & 0xffffu); }
DI float lo2f(unsigned u) { return __uint_as_float(u << 16); }
DI float hi2f(unsigned u) { return __uint_as_float(u & 0xffff0000u); }
DI float sigmoidf_(float v) { return 1.f / (1.f + __expf(-v)); }
DI float siluf_(float v) { return v / (1.f + __expf(-v)); }

constexpr int DM = 2048, NB = 4, SEQ = 4096, CTXL = 256, NLAT = NB * SEQ, NCTX = NB * CTXL, MT = NLAT + NCTX;
constexpr int INW = 24576, NH = 8, DK = 256, DV = 512, TT = SEQ + CTXL;
constexpr int LOFF = 4128, GLEN = 8320;      constexpr size_t G_LAYER = ((size_t)2048 * 8320 * 2 + 255) & ~(size_t)255;
constexpr int USTR = 6560;

constexpr size_t AL(size_t x) { return (x + 255) & ~(size_t)255; }
constexpr size_t OFF_WTIN = 0;
constexpr size_t OFF_WTHY = OFF_WTIN + AL((size_t)INW * DM * 2);
constexpr size_t OFF_WTRET = OFF_WTHY + AL((size_t)DM * DM * 2);
constexpr size_t OFF_WTO = OFF_WTRET + AL((size_t)DM * 4096 * 2);
constexpr size_t OFF_G = OFF_WTO + AL((size_t)DM * DM * 2);
constexpr size_t OFF_GC = OFF_G + 2 * AL((size_t)DM * GLEN * 2);
constexpr size_t OFF_MOD = OFF_GC + AL((size_t)DM * 512 * 4);
constexpr size_t OFF_H = OFF_MOD + AL((size_t)2 * 5 * 6144 * 4);
constexpr size_t OFF_PQ = OFF_H + AL((size_t)MT * DM * 2);
constexpr size_t OFF_PK = OFF_PQ + AL((size_t)MT * DM * 2);
constexpr size_t OFF_PV = OFF_PK + AL((size_t)MT * DM * 2);
constexpr size_t OFF_PRG = OFF_PV + AL((size_t)MT * 4096 * 2);
constexpr size_t OFF_PHY = OFF_PRG + AL((size_t)MT * 4096 * 2);
constexpr size_t OFF_PHG = OFF_PHY + AL((size_t)MT * 6144 * 2);
constexpr size_t OFF_PMG = OFF_PHG + AL((size_t)MT * DM * 2);
constexpr size_t OFF_KT = OFF_PMG + AL((size_t)MT * 4096 * 2);
constexpr size_t OFF_VT = OFF_KT + AL((size_t)NB * NH * DK * TT * 2);
constexpr size_t OFF_UT = OFF_VT + AL((size_t)NB * NH * DV * TT * 2);
constexpr size_t OFF_UTC = OFF_UT + AL((size_t)DM * NB * SEQ * 2);
constexpr size_t OFF_HV = OFF_UTC + AL((size_t)DM * NB * CTXL * 2);
constexpr size_t OFF_HX0 = OFF_HV + AL((size_t)MT * DM * 2);
constexpr size_t OFF_CTXR = OFF_HX0 + AL((size_t)MT * DM * 2);
constexpr size_t OFF_BAR = OFF_CTXR + AL((size_t)NCTX * DM * 4);
constexpr size_t OFF_CS = OFF_BAR + AL((size_t)3456 * 4);
constexpr size_t WS_NEED = OFF_CS + AL((size_t)4096 * 8);
constexpr size_t OFF_OF = OFF_KT, OFF_OB = OFF_PHY, OFF_T1 = OFF_PHY + AL((size_t)MT * 4096 * 2);

struct Params {
  const float *x, *c, *ctx, *c_ctx, *ln_g, *ada_w, *ada_b, *w_in, *conv_w, *conv_b, *fw1, *fb1, *fw2, *fb2, *fw3, *fb3, *ffreq, *fwout, *hy_bias, *ret_decay, *w_hy_out, *w_ret_out, *w_o, *final_g;
  float* out;
  unsigned char* ws;
  int wid, pad_;
};


#define XB_TMO      128
#define XB_XCNT(j)  (256  + 64 * (j))
#define XB_XSUB(j)  (1280 + 64 * (j))
#define XB_XGEN(j)  (2304 + 64 * (j))
#define XB_TOP      3328
#define XB_TOPGEN   3392
#define XCD_BAR_WORDS 3456
#define XB_SPIN_CAP (1u << 18)
#define XLAS __attribute__((address_space(3)))
DI unsigned xb_ld(unsigned* p)              { return __hip_atomic_load(p, __ATOMIC_RELAXED, __HIP_MEMORY_SCOPE_AGENT); }
DI unsigned xb_add(unsigned* p, unsigned v) { return __hip_atomic_fetch_add(p, v, __ATOMIC_RELAXED, __HIP_MEMORY_SCOPE_AGENT); }
DI unsigned xb_xcc_id() { return (unsigned)__builtin_amdgcn_s_getreg((3 << 11) | 20) & 0xFu; }
#define XB_SPIN(cond, bar) do { unsigned _sp = 0; while (cond) { __builtin_amdgcn_s_sleep(1); \
    if ((++_sp & 255u) == 0u) { if (xb_ld(&(bar)[XB_TMO])) break; if (_sp > XB_SPIN_CAP) { atomicAdd(&(bar)[XB_TMO], 1u); break; } } } } while (0)
struct XcdBarrier { unsigned* bar; unsigned x; volatile XLAS unsigned* st; };
DI XcdBarrier xcd_barrier_post(unsigned* bar, volatile XLAS unsigned* st, bool leader) {
    XcdBarrier b; b.bar = bar; b.x = xb_xcc_id(); b.st = st;
    if (leader) (void)xb_add(&bar[XB_XCNT(b.x)], 1u);
    return b;
}
DI void xcd_barrier_complete(unsigned* bar, unsigned x, unsigned& nloc, unsigned& nx) {
    const unsigned G = gridDim.x * gridDim.y * gridDim.z;
    unsigned sum, cnt, mine, sp = 0u;
    for (;;) {
        sum = 0u; cnt = 0u; mine = 0u;
#pragma unroll
        for (unsigned j = 0; j < 16; ++j) { const unsigned c = xb_ld(&bar[XB_XCNT(j)]); sum += c; cnt += (c > 0u) ? 1u : 0u; mine = (j == x) ? c : mine; }
        if (sum == G) break;
        __builtin_amdgcn_s_sleep(1);
        if ((++sp & 255u) == 0u) { if (xb_ld(&bar[XB_TMO])) break; if (sp > XB_SPIN_CAP) { atomicAdd(&bar[XB_TMO], 1u); break; } }
    }
    nloc = mine > 0u ? mine : 1u; nx = cnt > 0u ? cnt : 1u;
}
DI void xcd_barrier(const XcdBarrier& b, bool leader) {
    asm volatile("s_waitcnt vmcnt(0)" ::: "memory");
    __syncthreads();
    if (leader) {
        unsigned* bar = b.bar;
        __builtin_amdgcn_s_waitcnt(0);
        unsigned nloc = b.st[0], nx = b.st[1];
        if (nloc == 0u) { xcd_barrier_complete(bar, b.x, nloc, nx); b.st[0] = nloc; b.st[1] = nx; }
        const unsigned old = xb_add(&bar[XB_XSUB(b.x)], 1u);
        const unsigned gen = old / nloc;
        if (old + 1u == (gen + 1u) * nloc) {
            __builtin_amdgcn_fence(__ATOMIC_RELEASE, "agent");
            asm volatile("s_waitcnt vmcnt(0)" ::: "memory");
            const unsigned og = xb_add(&bar[XB_TOP], 1u);
            const unsigned tg = og / nx;
            if (og + 1u == (tg + 1u) * nx) xb_add(&bar[XB_TOPGEN], 1u);
            else XB_SPIN(xb_ld(&bar[XB_TOPGEN]) == tg, bar);
            __builtin_amdgcn_fence(__ATOMIC_ACQUIRE, "agent");
            xb_add(&bar[XB_XGEN(b.x)], 1u);
            asm volatile("s_waitcnt vmcnt(0)" ::: "memory");
        } else {
            XB_SPIN(xb_ld(&bar[XB_XGEN(b.x)]) == gen, bar);
            __builtin_amdgcn_fence(__ATOMIC_ACQUIRE, "agent");
            asm volatile("s_waitcnt vmcnt(0)" ::: "memory");
        }
    }
    __syncthreads();
}

namespace pg8 {
#define PG8_LAS __attribute__((address_space(3)))
constexpr int BM = 256, BK = 64, HALF = 128, HTB = HALF * BK * 2, STAGE_BYTES = 8 * HTB, NXCD = 8, WGM = 8;
__host__ __device__ __forceinline__ int lds_byte(int r, int c) { const int st = (r >> 4) * 2 + (c >> 5), rr = r & 15, cc = c & 31, ob = rr * 64 + cc * 2; return st * 1024 + (ob ^ (((ob >> 9) & 1) << 5)); }
__host__ __device__ __forceinline__ void stage_rc(int b, int& R, int& C) { const int st = b / 1024, sb = b % 1024, swz = sb ^ (((sb >> 9) & 1) << 5); R = (st >> 1) * 16 + swz / 64; C = (st & 1) * 32 + (swz % 64) / 2; }
__host__ __device__ __forceinline__ int perm32(int rho) { const int n = rho >> 4, i = rho & 15; return 8 * (i >> 2) + 4 * n + (i & 3); }
struct Unit { int pm, pn; };
struct Gemm { const bf16_t* A; const bf16_t* Bt; int M, N, K, wid; };
struct Order {
    int nM, nN, nwg, G, c, nx_m, nx_n, x_pn0;
    __device__ void init(int nM_, int nN_, int G_, int c_, int nx_m_, int nx_n_, int x_pn0_) { nM = nM_; nN = nN_; nwg = nM * nN; G = G_; c = c_; nx_m = nx_m_; nx_n = nx_n_; x_pn0 = x_pn0_; }
    __device__ bool next(int i, Unit& u) const {
        const long L = (long)i * G + c;
        if (L >= nwg) { const int e = (int)(L - nwg); if (e >= nx_m * nx_n) return false; u.pm = nM + e % nx_m; u.pn = x_pn0 + e / nx_m; return true; }
        int wgid = (int)L; { const int q = nwg / NXCD, r = nwg % NXCD, xcd = wgid % NXCD, off = wgid / NXCD; wgid = (xcd < r ? xcd * (q + 1) : r * (q + 1) + (xcd - r) * q) + off; }
        const int nig = WGM * nN, gid = wgid / nig, fm = gid * WGM, gsz = (nM - fm) < WGM ? (nM - fm) : WGM;
        u.pm = fm + ((wgid % nig) % gsz); u.pn = (wgid % nig) / gsz; return true;
    }
    __device__ __forceinline__ void a_ready(const Unit&) const {}
    __device__ __forceinline__ void done(const Unit&) const {}
};
template <class Epi, class Sched>
__device__ __forceinline__ void gemm_phase(PG8_LAS unsigned char* lds, const Gemm g, const Sched& S, const Epi& E) {
    const int tid = otid(g.wid), wid = __builtin_amdgcn_readfirstlane(tid >> 6), lane = tid & 63, wr = wid >> 2, wc = wid & 3, fr = lane & 15, fq = lane >> 4;
    const int K = g.K, nt = K / BK;
    unsigned voffA[2], voffB[2];
#pragma unroll
    for (int i = 0; i < 2; ++i) { int R, C; stage_rc(tid * 16 + i * 8192, R, C); const int Rb = Epi::PERM ? ((R & ~31) + perm32(R & 31)) : R;
        voffA[i] = (unsigned)(R * K + C) * 2u; voffB[i] = (unsigned)(Rb * K + C) * 2u; }
    const size_t kstep = (size_t)(BK * 2);
    const size_t hstep = (size_t)HALF * K * 2;
    const size_t tstep = 2 * hstep;
    const unsigned ldsw = (unsigned)wid * 1024u;
    const int aoff = lds_byte(wr * 64 + fr, fq * 8), boff = lds_byte(wc * 32 + fr, fq * 8);
#define PG8_SA(b, h) (((b) * 2 + (h)) * HTB)
#define PG8_SB(b, h) ((4 + (b) * 2 + (h)) * HTB)
#define PG8_STAGE(bufoff, gbase, voff) do { _Pragma("unroll") for (int _i = 0; _i < 2; ++_i) \
        __builtin_amdgcn_global_load_lds((const unsigned*)((const char*)(gbase) + (voff)[_i]), (PG8_LAS unsigned*)(lds + (bufoff) + ldsw + _i * 8192), 16, 0, 0); } while (0)
#define PG8_LDA(dst, b, h) do { _Pragma("unroll") for (int m = 0; m < 4; ++m) _Pragma("unroll") for (int k = 0; k < 2; ++k) dst[m][k] = *(const PG8_LAS bf16x8*)(lds + PG8_SA(b, h) + aoff + m * 2048 + k * 1024); } while (0)
#define PG8_LDB(dst, b, h) do { _Pragma("unroll") for (int n = 0; n < 2; ++n) _Pragma("unroll") for (int k = 0; k < 2; ++k) dst[n][k] = *(const PG8_LAS bf16x8*)(lds + PG8_SB(b, h) + boff + n * 2048 + k * 1024); } while (0)
#define PG8_MMA(ai, bj, At, Bt) do { __builtin_amdgcn_s_setprio(1); _Pragma("unroll") for (int m = 0; m < 4; ++m) _Pragma("unroll") for (int n = 0; n < 2; ++n) _Pragma("unroll") for (int k = 0; k < 2; ++k) \
        acc[ai][bj][m][n] = __builtin_amdgcn_mfma_f32_16x16x32_bf16(Bt[n][k], At[m][k], acc[ai][bj][m][n], 0, 0, 0); __builtin_amdgcn_s_setprio(0); } while (0)
#define PG8_WAIT_V(n) asm volatile("s_waitcnt vmcnt(" #n ")" ::: "memory")
#define PG8_WAIT_L(n) asm volatile("s_waitcnt lgkmcnt(" #n ")" ::: "memory")
#define PG8_BAR __builtin_amdgcn_s_barrier()
#define PG8_SCHED __builtin_amdgcn_sched_barrier(0)
    Unit cur, nxt; int ui = 0;
    if (!S.next(0, cur)) return;
    f32x4 acc[2][2][4][2];
#pragma unroll
    for (int a = 0; a < 2; ++a)
#pragma unroll
        for (int b = 0; b < 2; ++b)
#pragma unroll
            for (int m = 0; m < 4; ++m)
#pragma unroll
                for (int n = 0; n < 2; ++n) acc[a][b][m][n] = (f32x4){0.f, 0.f, 0.f, 0.f};
    bf16x8 At[4][2], B0[2][2], B1[2][2];
    const char* cA = (const char*)g.A + (size_t)cur.pm * tstep; const char* cB = (const char*)g.Bt + (size_t)cur.pn * tstep;
    S.a_ready(cur);
    PG8_STAGE(PG8_SB(0, 0), cB, voffB); PG8_STAGE(PG8_SA(0, 0), cA, voffA); PG8_STAGE(PG8_SB(0, 1), cB + hstep, voffB); PG8_STAGE(PG8_SA(0, 1), cA + hstep, voffA);
    if (wr == 1) PG8_BAR;
    PG8_WAIT_V(4); PG8_BAR;
    PG8_STAGE(PG8_SB(1, 0), cB + kstep, voffB); PG8_STAGE(PG8_SA(1, 0), cA + kstep, voffA); PG8_STAGE(PG8_SB(1, 1), cB + hstep + kstep, voffB);
    PG8_WAIT_V(6); PG8_BAR;
    for (;;) {
        const bool has_next = S.next(ui + 1, nxt);
        const char* nA = has_next ? (const char*)g.A + (size_t)nxt.pm * tstep : cA; const char* nB = has_next ? (const char*)g.Bt + (size_t)nxt.pn * tstep : cB;
        for (int t = 0; t < nt; t += 2) {
            const bool last = (t == nt - 2);
            const char* a1 = cA + (size_t)(t + 1) * kstep;
            const char* a2 = last ? nA : cA + (size_t)(t + 2) * kstep; const char* b2 = last ? nB : cB + (size_t)(t + 2) * kstep;
            const char* a3 = a2 + kstep; const char* b3 = b2 + kstep;
            if (last && has_next) S.a_ready(nxt);
            PG8_LDB(B0, 0, 0); PG8_SCHED; PG8_LDA(At, 0, 0); PG8_STAGE(PG8_SA(1, 1), a1 + hstep, voffA);
            PG8_WAIT_L(8); PG8_BAR; PG8_WAIT_L(0); PG8_MMA(0, 0, At, B0); PG8_BAR; PG8_SCHED;
            PG8_LDB(B1, 0, 1); PG8_STAGE(PG8_SB(0, 0), b2, voffB);
            PG8_BAR; PG8_WAIT_L(0); PG8_MMA(0, 1, At, B1); PG8_BAR;
            PG8_LDA(At, 0, 1); PG8_STAGE(PG8_SA(0, 0), a2, voffA);
            PG8_BAR; PG8_WAIT_L(0); PG8_MMA(1, 0, At, B0); PG8_BAR; PG8_SCHED;
            PG8_STAGE(PG8_SB(0, 1), b2 + hstep, voffB);
            PG8_WAIT_V(6); PG8_BAR; PG8_MMA(1, 1, At, B1); PG8_BAR;
            PG8_LDB(B0, 1, 0); PG8_SCHED; PG8_LDA(At, 1, 0); PG8_STAGE(PG8_SA(0, 1), a2 + hstep, voffA);
            PG8_WAIT_L(8); PG8_BAR; PG8_WAIT_L(0); PG8_MMA(0, 0, At, B0); PG8_BAR; PG8_SCHED;
            PG8_LDB(B1, 1, 1); PG8_STAGE(PG8_SB(1, 0), b3, voffB);
            PG8_BAR; PG8_WAIT_L(0); PG8_MMA(0, 1, At, B1); PG8_BAR;
            PG8_LDA(At, 1, 1); PG8_STAGE(PG8_SA(1, 0), a3, voffA);
            PG8_BAR; PG8_WAIT_L(0); PG8_MMA(1, 0, At, B0); PG8_BAR; PG8_SCHED;
            PG8_STAGE(PG8_SB(1, 1), b3 + hstep, voffB);
            PG8_WAIT_V(6); PG8_BAR; PG8_MMA(1, 1, At, B1); PG8_BAR;
        }
        if constexpr (!Epi::AFTER_DRAIN) { E(acc, cur, wr, wc, fr, fq); S.done(cur); }
        if (!has_next) break;
#pragma unroll
        for (int a = 0; a < 2; ++a)
#pragma unroll
            for (int b = 0; b < 2; ++b)
#pragma unroll
                for (int m = 0; m < 4; ++m)
#pragma unroll
                    for (int n = 0; n < 2; ++n) acc[a][b][m][n] = (f32x4){0.f, 0.f, 0.f, 0.f};
        cur = nxt; cA = nA; cB = nB; ++ui;
    }
    PG8_WAIT_V(0);
    if (wr == 0) PG8_BAR;
    PG8_BAR;
    if constexpr (Epi::AFTER_DRAIN) { E.fused(acc, cur, wr, wc, fr, fq, lds, wid, lane); S.done(cur); }
#undef PG8_SA
#undef PG8_SB
#undef PG8_STAGE
#undef PG8_LDA
#undef PG8_LDB
#undef PG8_MMA

#undef PG8_WAIT_V
#undef PG8_WAIT_L
#undef PG8_BAR
#undef PG8_SCHED
}
}

struct EpiG1 {
  static constexpr bool PERM = true, AFTER_DRAIN = false;
  unsigned char* ws;
  DI void operator()(const f32x4 (&acc)[2][2][4][2], const pg8::Unit& u, int wr, int wc, int fr, int fq) const {
    const int pn = u.pn; size_t off; int ld, c0;
    if (pn < 8) { off = OFF_PQ; ld = 2048; c0 = pn * 256; }
    else if (pn < 16) { off = OFF_PK; ld = 2048; c0 = (pn - 8) * 256; }
    else if (pn < 32) { off = OFF_PV; ld = 4096; c0 = (pn - 16) * 256; }
    else if (pn < 48) { off = OFF_PRG; ld = 4096; c0 = (pn - 32) * 256; }
    else if (pn < 72) { off = OFF_PHY; ld = 6144; c0 = (pn - 48) * 256; }
    else if (pn < 80) { off = OFF_PHG; ld = 2048; c0 = (pn - 72) * 256; }
    else { off = OFF_PMG; ld = 4096; c0 = (pn - 80) * 256; }
    bf16_t* base = (bf16_t*)(ws + off);
    const int row0 = u.pm * 256 + wr * 64 + fr, col0 = c0 + wc * 32 + 8 * fq;
    const bool rope = (pn < 16) && (u.pm < 64);
    const float4* CS = (const float4*)(ws + OFF_CS) + (wc * 4 + fq) * 2;
#pragma unroll
    for (int ai = 0; ai < 2; ++ai)
#pragma unroll
      for (int m = 0; m < 4; ++m) { const int row = row0 + ai * 128 + m * 16; bf16_t* rowp = base + (size_t)row * ld + col0;
#pragma unroll
        for (int bj = 0; bj < 2; ++bj) { f32x4 v0 = acc[ai][bj][m][0], v1 = acc[ai][bj][m][1];
          if (rope) { const int t = row & 4095, pos = bj ? (t & 63) : (t >> 6); const float4 ca = CS[pos * 32], cb = CS[pos * 32 + 1];
            const f32x4 a = v0, b = v1;
            v0[0] = a[0] * ca.x - b[0] * ca.y; v1[0] = a[0] * ca.y + b[0] * ca.x; v0[1] = a[1] * ca.z - b[1] * ca.w; v1[1] = a[1] * ca.w + b[1] * ca.z;
            v0[2] = a[2] * cb.x - b[2] * cb.y; v1[2] = a[2] * cb.y + b[2] * cb.x; v0[3] = a[3] * cb.z - b[3] * cb.w; v1[3] = a[3] * cb.w + b[3] * cb.z; }
          u32x4 o; o[0] = pk2(v0[0], v0[1]); o[1] = pk2(v0[2], v0[3]); o[2] = pk2(v1[0], v1[1]); o[3] = pk2(v1[2], v1[3]);
          *(u32x4*)(rowp + bj * 128) = o; } }
  }
};
template <int SECOND> struct EpiG23 {
  static constexpr bool PERM = true, AFTER_DRAIN = false;
  unsigned char* ws;
  DI void operator()(const f32x4 (&acc)[2][2][4][2], const pg8::Unit& u, int wr, int wc, int fr, int fq) const {
    bf16_t* T1 = (bf16_t*)(ws + OFF_T1); const bf16_t* MG = (const bf16_t*)(ws + OFF_PMG) + (SECOND ? 2048 : 0);
    const int row0 = u.pm * 256 + wr * 64 + fr, col0 = u.pn * 256 + wc * 32 + 8 * fq;
#pragma unroll
    for (int ai = 0; ai < 2; ++ai)
#pragma unroll
      for (int m = 0; m < 4; ++m) { const size_t row = (size_t)(row0 + ai * 128 + m * 16);
#pragma unroll
        for (int bj = 0; bj < 2; ++bj) { const int col = col0 + bj * 128;
          const u32x4 g = *(const u32x4*)(MG + row * 4096 + col);
          const f32x4 v0 = acc[ai][bj][m][0], v1 = acc[ai][bj][m][1];
          float r[8];
          r[0] = sigmoidf_(lo2f(g[0])) * v0[0]; r[1] = sigmoidf_(hi2f(g[0])) * v0[1]; r[2] = sigmoidf_(lo2f(g[1])) * v0[2]; r[3] = sigmoidf_(hi2f(g[1])) * v0[3];
          r[4] = sigmoidf_(lo2f(g[2])) * v1[0]; r[5] = sigmoidf_(hi2f(g[2])) * v1[1]; r[6] = sigmoidf_(lo2f(g[3])) * v1[2]; r[7] = sigmoidf_(hi2f(g[3])) * v1[3];
          if (SECOND) { const u32x4 t = *(const u32x4*)(T1 + row * 2048 + col);
            r[0] += lo2f(t[0]); r[1] += hi2f(t[0]); r[2] += lo2f(t[1]); r[3] += hi2f(t[1]); r[4] += lo2f(t[2]); r[5] += hi2f(t[2]); r[6] += lo2f(t[3]); r[7] += hi2f(t[3]); }
          u32x4 o; o[0] = pk2(r[0], r[1]); o[1] = pk2(r[2], r[3]); o[2] = pk2(r[4], r[5]); o[3] = pk2(r[6], r[7]);
          *(u32x4*)(T1 + row * 2048 + col) = o; } }
  }
};
struct EpiG4 {
  static constexpr bool PERM = false, AFTER_DRAIN = false;
  const float* xin; const float* cin; float* xout; float* cout; const float* mod;
  DI void operator()(const f32x4 (&acc)[2][2][4][2], const pg8::Unit& u, int wr, int wc, int fr, int fq) const {
    const int row0 = u.pm * 256 + wr * 64 + fr, col0 = u.pn * 256 + wc * 32 + 4 * fq;
#pragma unroll
    for (int ai = 0; ai < 2; ++ai)
#pragma unroll
      for (int m = 0; m < 4; ++m) { const int row = row0 + ai * 128 + m * 16;
        const float* src; float* dst; const float* gate;
        if (row < NLAT) { src = xin + (size_t)row * 2048; dst = xout + (size_t)row * 2048; gate = mod + (row >> 12) * 6144 + 4096; }
        else { src = cin + (size_t)(row - NLAT) * 2048; dst = cout + (size_t)(row - NLAT) * 2048; gate = mod + 4 * 6144 + 4096; }
#pragma unroll
        for (int bj = 0; bj < 2; ++bj)
#pragma unroll
          for (int n = 0; n < 2; ++n) { const int col = col0 + bj * 128 + n * 16;
            const f32x4 xv = *(const f32x4*)(src + col), gv = *(const f32x4*)(gate + col);
            *(f32x4*)(dst + col) = xv + gv * acc[ai][bj][m][n]; } }
  }
};

__device__ void phase_mod(const Params& p, unsigned char* shm) {
  float* sc = (float*)shm; float* red = sc + 5 * 2048;
  const int tid = otid(p.wid);
  for (int i = tid; i < 5 * 2048; i += 512) { const int j = i >> 11, k = i & 2047; const float v = (j < 4) ? p.c[j * 2048 + k] : p.c_ctx[k]; sc[i] = v / (1.f + expf(-v)); }
  __syncthreads();
  { const int i = blockIdx.x * 512 + tid; if (i < 4096) { const int pos = i >> 6, j = i & 63; const float inv = 1.f / powf(10000.f, (float)j / 64.f); float sn, cn; sincosf((float)pos * inv, &sn, &cn); ((float2*)(p.ws + OFF_CS))[i] = make_float2(cn, sn); } }
  float* mod = (float*)(p.ws + OFF_MOD);
  const int cq = tid & 7, ks = tid >> 3;
  for (int it = blockIdx.x; it < 384; it += gridDim.x) {
    const int l = it / 192, nb = (it % 192) * 32;
    const float* W = p.ada_w + (size_t)l * 2048 * 6144 + nb + cq * 4;
    float acc[5][4];
#pragma unroll
    for (int j = 0; j < 5; ++j) { acc[j][0] = 0.f; acc[j][1] = 0.f; acc[j][2] = 0.f; acc[j][3] = 0.f; }
#pragma unroll 4
    for (int kk = 0; kk < 32; ++kk) { const int k = ks * 32 + kk; const float4 w = *(const float4*)(W + (size_t)k * 6144);
#pragma unroll
      for (int j = 0; j < 5; ++j) { const float s = sc[j * 2048 + k]; acc[j][0] += s * w.x; acc[j][1] += s * w.y; acc[j][2] += s * w.z; acc[j][3] += s * w.w; } }
#pragma unroll
    for (int j = 0; j < 5; ++j)
#pragma unroll
      for (int e = 0; e < 4; ++e) red[ks * 160 + j * 32 + cq * 4 + e] = acc[j][e];
    __syncthreads();
    if (tid < 160) { float s = 0.f; for (int q = 0; q < 64; ++q) s += red[q * 160 + tid]; const int j = tid >> 5, n = nb + (tid & 31); mod[(l * 5 + j) * 6144 + n] = s + p.ada_b[l * 6144 + n]; }
    __syncthreads();
  }
}

__device__ void cvt_group(int wid, const float* W, bf16_t* Wt, int K, int N, int k0, int n0, float scale, float* tile, bool perm) {
  const int tid = otid(wid);
  float4 v[8];
  int nsrc = n0 + (tid & 15) * 4;
  if (perm) { const int pc = (n0 & 255) + (tid & 15) * 4, r = pc & 127; nsrc = (n0 & ~255) + (pc & 128) + (r >> 3) * 4 + 64 * ((r >> 2) & 1); }
#pragma unroll
  for (int q = 0; q < 4; ++q)
#pragma unroll
    for (int rr = 0; rr < 2; ++rr) { const int k = (tid >> 4) + 32 * rr; v[q * 2 + rr] = *(const float4*)(W + (size_t)(k0 + q * 64 + k) * N + nsrc); }
#pragma unroll
  for (int q = 0; q < 4; ++q)
#pragma unroll
    for (int rr = 0; rr < 2; ++rr) { const int k = (tid >> 4) + 32 * rr, n = (tid & 15) * 4; float* t = tile + q * 4160 + k * 65 + n; const float4 x = v[q * 2 + rr]; t[0] = x.x; t[1] = x.y; t[2] = x.z; t[3] = x.w; }
  __syncthreads();
#pragma unroll
  for (int q = 0; q < 4; ++q) { const int n = tid >> 3, k8 = (tid & 7) * 8; const float* t = tile + q * 4160; u32x4 o;
#pragma unroll
    for (int e = 0; e < 4; ++e) o[e] = pk2(t[(k8 + 2 * e) * 65 + n] * scale, t[(k8 + 2 * e + 1) * 65 + n] * scale);
    *(u32x4*)(Wt + (size_t)(n0 + n) * K + k0 + q * 64 + k8) = o; }
  __syncthreads();
}
__device__ void phase_cvt(const Params& p, int l, unsigned char* shm) {
  float* tile = (float*)shm;
  for (int it = blockIdx.x; it < 4096; it += gridDim.x) {
    if (it < 3072) { const int kg = it & 7, n0 = (it >> 3) * 64;
      cvt_group(p.wid, p.w_in + (size_t)l * DM * INW, (bf16_t*)(p.ws + OFF_WTIN), DM, INW, kg * 256, n0, (n0 >= 2048 && n0 < 4096) ? 0.0625f : 1.f, tile, n0 < 4096); }
    else if (it < 3328) { const int e = it - 3072; cvt_group(p.wid, p.w_hy_out + (size_t)l * DM * DM, (bf16_t*)(p.ws + OFF_WTHY), DM, DM, (e & 7) * 256, (e >> 3) * 64, 1.f, tile, false); }
    else if (it < 3840) { const int e = it - 3328; cvt_group(p.wid, p.w_ret_out + (size_t)l * 4096 * DM, (bf16_t*)(p.ws + OFF_WTRET), 4096, DM, (e & 15) * 256, (e >> 4) * 64, 1.f, tile, false); }
    else { const int e = it - 3840; cvt_group(p.wid, p.w_o + (size_t)l * DM * DM, (bf16_t*)(p.ws + OFF_WTO), DM, DM, (e & 7) * 256, (e >> 3) * 64, 1.f, tile, false); }
  }
}

DI void filt_item(const Params& p, int l, int Ls, int T, bool isctx, unsigned char* shm) {
  float* z = (float*)shm; float* ha = z + 17 * 36; float* hb = ha + 17 * 64;
  const int tid = otid(p.wid);
  const float* w1 = p.fw1 + l * 33 * 64; const float* b1 = p.fb1 + l * 64; const float* w2 = p.fw2 + l * 4096; const float* b2 = p.fb2 + l * 64;
  const float* w3 = p.fw3 + l * 4096; const float* b3 = p.fb3 + l * 64; const float* fq = p.ffreq + l * 64; const float* wout = p.fwout + (size_t)l * 64 * 4096;
  float* w1s = z + 2816; float* w2s = w1s + 2112; float* w3s = w2s + 4096;
  { const float4 a0 = ((const float4*)w2)[tid], a1 = ((const float4*)w2)[tid + 512], b0 = ((const float4*)w3)[tid], b1 = ((const float4*)w3)[tid + 512];
    const float4 c0 = ((const float4*)w1)[tid]; float4 c1 = c0; if (tid < 16) c1 = ((const float4*)w1)[tid + 512];
    ((float4*)w2s)[tid] = a0; ((float4*)w2s)[tid + 512] = a1; ((float4*)w3s)[tid] = b0; ((float4*)w3s)[tid + 512] = b1; ((float4*)w1s)[tid] = c0; if (tid < 16) ((float4*)w1s)[tid + 512] = c1; }
  for (int i = tid; i < 17 * 33; i += 512) { const int pl = i / 33, f = i % 33; int pp = T * 16 + pl; if (pp > Ls - 1) pp = Ls - 1;
    float val;
    if (f == 0) val = (float)pp / (float)(Ls - 1);
    else { const int j = (f - 1) & 15; const float fj = 1e-4f + (float)j * ((15.f - 1e-4f) / 15.f); const float ang = 6.283185307179586f * (float)pp / (float)Ls; const float a = fj * ang; val = (f <= 16) ? cosf(a) : -sinf(a); }
    z[pl * 36 + f] = val; }
  __syncthreads();
  for (int idx = tid; idx < 17 * 16; idx += 512) { const int pl = idx >> 4, j0 = (idx & 15) * 4; float a[4] = {0.f, 0.f, 0.f, 0.f};
#pragma unroll 3
    for (int k = 0; k < 33; ++k) { const float v = z[pl * 36 + k]; const float4 w = *(const float4*)(w1s + k * 64 + j0); a[0] += v * w.x; a[1] += v * w.y; a[2] += v * w.z; a[3] += v * w.w; }
#pragma unroll
    for (int e = 0; e < 4; ++e) ha[pl * 64 + j0 + e] = sinf(fq[j0 + e] * (a[e] + b1[j0 + e])); }
  __syncthreads();
  for (int idx = tid; idx < 17 * 16; idx += 512) { const int pl = idx >> 4, j0 = (idx & 15) * 4; float a[4] = {0.f, 0.f, 0.f, 0.f};
#pragma unroll 4
    for (int k = 0; k < 64; ++k) { const float v = ha[pl * 64 + k]; const float4 w = *(const float4*)(w2s + k * 64 + j0); a[0] += v * w.x; a[1] += v * w.y; a[2] += v * w.z; a[3] += v * w.w; }
#pragma unroll
    for (int e = 0; e < 4; ++e) hb[pl * 64 + j0 + e] = sinf(fq[j0 + e] * (a[e] + b2[j0 + e])); }
  __syncthreads();
  for (int idx = tid; idx < 17 * 16; idx += 512) { const int pl = idx >> 4, j0 = (idx & 15) * 4; float a[4] = {0.f, 0.f, 0.f, 0.f};
#pragma unroll 4
    for (int k = 0; k < 64; ++k) { const float v = hb[pl * 64 + k]; const float4 w = *(const float4*)(w3s + k * 64 + j0); a[0] += v * w.x; a[1] += v * w.y; a[2] += v * w.z; a[3] += v * w.w; }
#pragma unroll
    for (int e = 0; e < 4; ++e) ha[pl * 64 + j0 + e] = sinf(fq[j0 + e] * (a[e] + b3[j0 + e])); }
  __syncthreads();
  const int cb = tid * 4;
  const float mind = logf(0.01f) / 1.5f, maxd = logf(0.01f) / 0.3f;
  bf16_t* G = (bf16_t*)(p.ws + OFF_G + (size_t)l * G_LAYER); float* GC = (float*)(p.ws + OFF_GC);
  float delta[4];
#pragma unroll
  for (int cc = 0; cc < 4; ++cc) delta[cc] = fabsf(mind + (float)(cb + cc) * ((maxd - mind) / 2047.f));
#pragma unroll 1
  for (int pgh = 0; pgh < 4; ++pgh) {
    const int pg = pgh >> 1; const bool isb = (pgh & 1) != 0; const int c4 = cb + (isb ? 2048 : 0);
    const int plb = pg * 8;
    float acc[8][4];
#pragma unroll
    for (int e = 0; e < 8; ++e) { acc[e][0] = 0.f; acc[e][1] = 0.f; acc[e][2] = 0.f; acc[e][3] = 0.f; }
    float4 wA[8], wB[8];
#define FILT_LOAD(buf, kb_) do { _Pragma("unroll") for (int j = 0; j < 8; ++j) buf[j] = *(const float4*)(wout + ((kb_) * 8 + j) * 4096 + c4); } while (0)
#define FILT_FMA(buf, kb_) do { _Pragma("unroll") for (int j = 0; j < 8; ++j) { const float4 wa = buf[j]; const int k = (kb_) * 8 + j; \
      _Pragma("unroll") for (int e = 0; e < 8; ++e) { const float h = ha[(plb + e) * 64 + k]; acc[e][0] += h * wa.x; acc[e][1] += h * wa.y; acc[e][2] += h * wa.z; acc[e][3] += h * wa.w; } } } while (0)
    FILT_LOAD(wA, 0);
#pragma unroll 1
    for (int kb = 0; kb < 8; kb += 2) {
      FILT_LOAD(wB, kb + 1);
      asm volatile("" ::: "memory");
      FILT_FMA(wA, kb);
      asm volatile("" ::: "memory");
      if (kb + 2 < 8) FILT_LOAD(wA, kb + 2);
      asm volatile("" ::: "memory");
      FILT_FMA(wB, kb + 1);
      asm volatile("" ::: "memory");
    }
#undef FILT_LOAD
#undef FILT_FMA
    const int pp0 = T * 16 + plb;
#pragma unroll
    for (int e = 0; e < 8; ++e) { const int pp = pp0 + e; const float tt = (float)pp / (float)(Ls - 1);
      if (pp < Ls && !(isb && pp == 0)) {
        float v[4];
#pragma unroll
        for (int cc = 0; cc < 4; ++cc) v[cc] = acc[e][cc] * __expf(-tt * delta[cc]);
        if (!isctx) { const int m = isb ? LOFF + pp : LOFF - pp; u32x2 o; o[0] = pk2(v[0], v[1]); o[1] = pk2(v[2], v[3]); *(u32x2*)(G + (size_t)m * 2048 + cb) = o; }
        else { const int idx = isb ? 256 - pp : 256 + pp;
#pragma unroll
          for (int cc = 0; cc < 4; ++cc) GC[(size_t)(cb + cc) * 512 + idx] = v[cc]; }
      }
    }
  }
  __syncthreads();
}
__device__ void phase_filters(const Params& p, unsigned char* shm) {
  for (int it = blockIdx.x; it < 528; it += gridDim.x) { const bool ic = it >= 512; filt_item(p, ic ? 0 : (it >> 8), ic ? CTXL : SEQ, ic ? it - 512 : (it & 255), ic, shm); }
}

__device__ void phase_norm(const Params& p, int l) {
  const int lane = otid(p.wid) & 63, gw = blockIdx.x * 8 + (otid(p.wid) >> 6), nw = gridDim.x * 8;
  const float* mod = (const float*)(p.ws + OFF_MOD) + (size_t)l * 5 * 6144; const float* lng = p.ln_g + l * 2048;
  bf16_t* H = (bf16_t*)(p.ws + OFF_H);
  for (int r = gw; r < MT; r += nw) {
    const float* src; int j;
    if (r < NLAT) { src = (l == 0 ? p.x : p.out) + (size_t)r * 2048; j = r >> 12; }
    else { src = (l == 0 ? p.ctx : (const float*)(p.ws + OFF_CTXR)) + (size_t)(r - NLAT) * 2048; j = 4; }
    const float* sh = mod + j * 6144; const float* sc = sh + 2048;
    float4 v[8]; float ss = 0.f;
#pragma unroll
    for (int i = 0; i < 8; ++i) { v[i] = *(const float4*)(src + i * 256 + lane * 4); ss += v[i].x * v[i].x + v[i].y * v[i].y + v[i].z * v[i].z + v[i].w * v[i].w; }
    ss = wsum(ss, lane);
    const float rs = rsqrtf(ss * (1.f / 2048.f) + 1e-6f);
#pragma unroll
    for (int i = 0; i < 8; ++i) { const int col = i * 256 + lane * 4; const float4 g = *(const float4*)(lng + col), a = *(const float4*)(sc + col), b = *(const float4*)(sh + col);
      u32x2 o; o[0] = pk2(v[i].x * rs * g.x * (1.f + a.x) + b.x, v[i].y * rs * g.y * (1.f + a.y) + b.y); o[1] = pk2(v[i].z * rs * g.z * (1.f + a.z) + b.z, v[i].w * rs * g.w * (1.f + a.w) + b.w);
      *(u32x2*)(H + (size_t)r * 2048 + col) = o; }
  }
}
__device__ void phase_final(const Params& p) {
  const int lane = otid(p.wid) & 63, gw = blockIdx.x * 8 + (otid(p.wid) >> 6), nw = gridDim.x * 8;
  for (int r = gw; r < NLAT; r += nw) {
    float* src = p.out + (size_t)r * 2048; float4 v[8]; float ss = 0.f;
#pragma unroll
    for (int i = 0; i < 8; ++i) { v[i] = *(const float4*)(src + i * 256 + lane * 4); ss += v[i].x * v[i].x + v[i].y * v[i].y + v[i].z * v[i].z + v[i].w * v[i].w; }
    ss = wsum(ss, lane);
    const float rs = rsqrtf(ss * (1.f / 2048.f) + 1e-6f);
#pragma unroll
    for (int i = 0; i < 8; ++i) { const int col = i * 256 + lane * 4; const float4 g = *(const float4*)(p.final_g + col); float4 o; o.x = v[i].x * rs * g.x; o.y = v[i].y * rs * g.y; o.z = v[i].z * rs * g.z; o.w = v[i].w * rs * g.w; *(float4*)(src + col) = o; }
  }
}

DI void tok_tile(int tk, int& b, int& t0, bool& isctx) { if (tk < 256) { b = tk >> 6; t0 = (tk & 63) * 64; isctx = false; } else { b = (tk - 256) >> 2; t0 = ((tk - 256) & 3) * 64; isctx = true; } }
DI int tok_row(int b, int t, bool isctx) { return isctx ? NLAT + b * CTXL + t : b * SEQ + t; }

__device__ void phase_prep(const Params& p, int l, unsigned char* shm, int mask) {
  const int tid = otid(p.wid), lane = tid & 63;
  unsigned char* reg2 = shm + 32768;
  (void)lane;
  if (mask & 4) { float* in = (float*)reg2;
    bf16_t* ut = (bf16_t*)(reg2 + 3 * 66 * 64 * 4);
    const bf16_t* PHY = (const bf16_t*)(p.ws + OFF_PHY); bf16_t* HV = (bf16_t*)(p.ws + OFF_HV); bf16_t* HX0 = (bf16_t*)(p.ws + OFF_HX0);
    const float* cw = p.conv_w + (size_t)l * 3 * 6144; const float* cb = p.conv_b + (size_t)l * 6144;
    const int nit = ((l == 0) ? 272 : 256) * 32;
    u32x4 pre[4];
#define PC_DECODE(it_) const int tk = (it_) >> 5, c0 = ((it_) & 31) * 64; int b, t0; bool isctx; tok_tile(tk, b, t0, isctx); const int Ls = isctx ? CTXL : SEQ; const int row0 = tok_row(b, t0, isctx);
#define PC_LOAD(it_) do { PC_DECODE(it_) _Pragma("unroll") for (int e = 0; e < 4; ++e) { const int id = tid + 512 * e; const int pi = id / 528, rem = id % 528, rr = rem >> 3, pc = rem & 7; const int t = t0 - 1 + rr; \
        u32x4 v; v[0] = 0u; v[1] = 0u; v[2] = 0u; v[3] = 0u; if (id < 1584 && t >= 0 && t < Ls) v = *(const u32x4*)(PHY + (size_t)(row0 - 1 + rr) * 6144 + pi * 2048 + c0 + pc * 8); pre[e] = v; } } while (0)
    if ((int)blockIdx.x < nit) PC_LOAD((int)blockIdx.x);
    for (int it = blockIdx.x; it < nit; it += gridDim.x) {
      PC_DECODE(it) (void)Ls;
#pragma unroll
      for (int e = 0; e < 4; ++e) { const int id = tid + 512 * e; if (id < 1584) { const int pi = id / 528, rem = id % 528, rr = rem >> 3, pc = rem & 7; const u32x4 v = pre[e];
        float* d = in + (pi * 66 + rr) * 64 + pc * 8;
        *(float4*)d = make_float4(lo2f(v[0]), hi2f(v[0]), lo2f(v[1]), hi2f(v[1])); *(float4*)(d + 4) = make_float4(lo2f(v[2]), hi2f(v[2]), lo2f(v[3]), hi2f(v[3])); } }
      if (it + (int)gridDim.x < nit) PC_LOAD(it + (int)gridDim.x);
      __syncthreads();
      { const int cg8 = (tid & 7) * 8, tok = tid >> 3;
        float cv[3][8];
#pragma unroll
        for (int pi = 0; pi < 3; ++pi) { const float* wp = cw + pi * 2048 + c0 + cg8;
          const float4 ba = *(const float4*)(cb + pi * 2048 + c0 + cg8), bb = *(const float4*)(cb + pi * 2048 + c0 + cg8 + 4);
          cv[pi][0] = ba.x; cv[pi][1] = ba.y; cv[pi][2] = ba.z; cv[pi][3] = ba.w; cv[pi][4] = bb.x; cv[pi][5] = bb.y; cv[pi][6] = bb.z; cv[pi][7] = bb.w;
#pragma unroll
          for (int k = 0; k < 3; ++k) { const float4 wa = *(const float4*)(wp + k * 6144), wb = *(const float4*)(wp + k * 6144 + 4);
            const float* ip = in + (pi * 66 + tok + k) * 64 + cg8; const float4 xa = *(const float4*)ip, xb = *(const float4*)(ip + 4);
            cv[pi][0] += xa.x * wa.x; cv[pi][1] += xa.y * wa.y; cv[pi][2] += xa.z * wa.z; cv[pi][3] += xa.w * wa.w; cv[pi][4] += xb.x * wb.x; cv[pi][5] += xb.y * wb.y; cv[pi][6] += xb.z * wb.z; cv[pi][7] += xb.w * wb.w; } }
        u32x4 hvp, hxp;
#pragma unroll
        for (int e = 0; e < 4; ++e) { hvp[e] = pk2(cv[0][2 * e] * cv[2][2 * e], cv[0][2 * e + 1] * cv[2][2 * e + 1]); hxp[e] = pk2(cv[1][2 * e], cv[1][2 * e + 1]); }
        *(u32x4*)(HV + (size_t)(row0 + tok) * 2048 + c0 + cg8) = hvp; *(u32x4*)(HX0 + (size_t)(row0 + tok) * 2048 + c0 + cg8) = hxp;
#pragma unroll
        for (int e = 0; e < 4; ++e) { ut[(cg8 + 2 * e) * 66 + tok] = (bf16_t)(hvp[e] & 0xffffu); ut[(cg8 + 2 * e + 1) * 66 + tok] = (bf16_t)(hvp[e] >> 16); } }
      __syncthreads();
      { const int c = tid >> 3, pc = tid & 7; u32x4 o;
#pragma unroll
        for (int e = 0; e < 4; ++e) o[e] = (unsigned)ut[c * 66 + pc * 8 + 2 * e] | ((unsigned)ut[c * 66 + pc * 8 + 2 * e + 1] << 16);
        bf16_t* dst = isctx ? (bf16_t*)(p.ws + OFF_UTC) + ((size_t)(c0 + c) * NB + b) * CTXL + t0 + pc * 8 : (bf16_t*)(p.ws + OFF_UT) + ((size_t)(c0 + c) * NB + b) * SEQ + t0 + pc * 8;
        *(u32x4*)dst = o; }
    }
    __syncthreads();
#undef PC_DECODE
#undef PC_LOAD
  }
}

__device__ void phase_post(const Params& p, int l, unsigned char* shm, int mask) {
  const int tid = otid(p.wid), lane = tid & 63;
  const bf16_t* HV = (const bf16_t*)(p.ws + OFF_HV); const bf16_t* HX0 = (const bf16_t*)(p.ws + OFF_HX0); const bf16_t* PHG = (const bf16_t*)(p.ws + OFF_PHG);
  bf16_t* AH = (bf16_t*)(p.ws + OFF_H); const float* hbias = p.hy_bias + l * 2048;
  if (mask & 1) { float* yt = (float*)shm;
    const bf16_t* UT = (const bf16_t*)(p.ws + OFF_UT);
    const int nit = 256 * 32; u32x4 pre;
#define PA_LOAD(it_) do { const int tk_ = (it_) >> 5, c0_ = ((it_) & 31) * 64, b_ = tk_ >> 6, t0_ = (tk_ & 63) * 64; pre = *(const u32x4*)(UT + ((size_t)(c0_ + (tid >> 3)) * NB + b_) * SEQ + t0_ + (tid & 7) * 8); } while (0)
    if ((int)blockIdx.x < nit) PA_LOAD((int)blockIdx.x);
    for (int it = blockIdx.x; it < nit; it += gridDim.x) {
      const int tk = it >> 5, c0 = (it & 31) * 64, b = tk >> 6, t0 = (tk & 63) * 64, row0 = b * SEQ + t0;
      { const int c = tid >> 3, pc = tid & 7; const u32x4 v = pre; float* d = yt + (pc * 8) * 65 + c;
        d[0] = lo2f(v[0]); d[65] = hi2f(v[0]); d[130] = lo2f(v[1]); d[195] = hi2f(v[1]); d[260] = lo2f(v[2]); d[325] = hi2f(v[2]); d[390] = lo2f(v[3]); d[455] = hi2f(v[3]); }
      if (it + (int)gridDim.x < nit) PA_LOAD(it + (int)gridDim.x);
      __syncthreads();
      { const int cg8 = (tid & 7) * 8, tok = tid >> 3; const size_t o = (size_t)(row0 + tok) * 2048 + c0 + cg8;
        const u32x4 hv = *(const u32x4*)(HV + o), hx = *(const u32x4*)(HX0 + o), hg = *(const u32x4*)(PHG + o);
        const float4 ba = *(const float4*)(hbias + c0 + cg8), bb = *(const float4*)(hbias + c0 + cg8 + 4);
        const float hb[8] = {ba.x, ba.y, ba.z, ba.w, bb.x, bb.y, bb.z, bb.w}; const float* yp = yt + tok * 65 + cg8; u32x4 r;
#pragma unroll
        for (int e = 0; e < 4; ++e) { const float a0 = (yp[2 * e] + hb[2 * e] * lo2f(hv[e])) * lo2f(hx[e]) * siluf_(lo2f(hg[e])), a1 = (yp[2 * e + 1] + hb[2 * e + 1] * hi2f(hv[e])) * hi2f(hx[e]) * siluf_(hi2f(hg[e])); r[e] = pk2(a0, a1); }
        *(u32x4*)(AH + o) = r; }
      __syncthreads();
    }
#undef PA_LOAD
  }
  if (l == 0 && (mask & 2)) { float* gc = (float*)shm; float* us = gc + 32 * 512;
    const bf16_t* UTC = (const bf16_t*)(p.ws + OFF_UTC); const float* GC = (const float*)(p.ws + OFF_GC);
    for (int it = blockIdx.x; it < 16 * 64; it += gridDim.x) {
      const int tk = it >> 6, c0 = (it & 63) * 32, b = tk >> 2, t0 = (tk & 3) * 64, row0 = NLAT + b * CTXL + t0;
#pragma unroll 8
      for (int i = tid; i < 32 * 512; i += 512) gc[i] = GC[(size_t)(c0 + (i >> 9)) * 512 + (i & 511)];
#pragma unroll 8
      for (int i = tid; i < 32 * 256; i += 512) us[i] = bf2f(UTC[((size_t)(c0 + (i >> 8)) * NB + b) * CTXL + (i & 255)]);
      __syncthreads();
      { const int t = tid & 63, cg4 = tid >> 6;
#pragma unroll 1
        for (int e = 0; e < 4; ++e) { const int c = cg4 * 4 + e; const float* g = gc + c * 512 + 256 + t0 + t; const float* u = us + c * 256; float a = 0.f;
#pragma unroll 8
          for (int s = 0; s < 256; ++s) a += u[s] * g[-s];
          const size_t o = (size_t)(row0 + t) * 2048 + c0 + c; const float hv = bf2f(HV[o]);
          AH[o] = f2bf((a + hbias[c0 + c] * hv) * bf2f(HX0[o]) * siluf_(bf2f(PHG[o]))); } }
      __syncthreads();
    }
  }
  if (mask & 4) { bf16_t* OF = (bf16_t*)(p.ws + OFF_OF); const bf16_t* OB = (const bf16_t*)(p.ws + OFF_OB); const bf16_t* RG = (const bf16_t*)(p.ws + OFF_PRG);
    const int gw = blockIdx.x * 8 + (tid >> 6), nw = gridDim.x * 8; const int nrows = (l == 0) ? MT : NLAT;
#pragma unroll 2
    for (int it = gw; it < nrows * 8; it += nw) { const size_t o = (size_t)(it >> 3) * 4096 + (it & 7) * 512 + lane * 8;
      const u32x4 a = *(const u32x4*)(OF + o), bq = *(const u32x4*)(OB + o), g = *(const u32x4*)(RG + o);
      float v[8]; float ss = 0.f;
#pragma unroll
      for (int e = 0; e < 4; ++e) { v[2 * e] = lo2f(a[e]) + lo2f(bq[e]); v[2 * e + 1] = hi2f(a[e]) + hi2f(bq[e]); ss += v[2 * e] * v[2 * e] + v[2 * e + 1] * v[2 * e + 1]; }
      ss = wsum(ss, lane);
      const float rs = rsqrtf(ss * (1.f / 512.f) + 1e-6f);
      u32x4 r;
#pragma unroll
      for (int e = 0; e < 4; ++e) r[e] = pk2(v[2 * e] * rs * siluf_(lo2f(g[e])), v[2 * e + 1] * rs * siluf_(hi2f(g[e])));
      *(u32x4*)(OF + o) = r; }
  }
}

__device__ void phase_conv(const Params& p, int l, unsigned char* shm) {
  const int tid = otid(p.wid), lane = tid & 63, wid = tid >> 6;
  bf16_t* Gs = (bf16_t*)shm;
  bf16_t* Us = (bf16_t*)(shm + 2 * GLEN * 2);
  { unsigned zz = 0u; asm volatile("" : "+v"(zz)); u32x4 z; z[0] = zz; z[1] = zz; z[2] = zz; z[3] = zz; for (int i = tid; i < 2 * 4 * USTR / 8; i += 512) ((u32x4*)Us)[i] = z; }
  __syncthreads();
  const int ch = wid >> 2, q = wid & 3, i = lane & 31, g = lane >> 5, a_l = i >> 2, b = i & 3;
  const bf16_t* G = (const bf16_t*)(p.ws + OFF_G + (size_t)l * G_LAYER); bf16_t* UT = (bf16_t*)(p.ws + OFF_UT);
  const int mb = LOFF - i + 8 * g - 128 * (8 * q + 7);
  const unsigned sh = (unsigned)(mb & 1) * 16u;
  const unsigned* Gd = (const unsigned*)(Gs + ch * GLEN) + (mb >> 1);
  const bf16_t* Ub = Us + (ch * 4 + b) * USTR + 136 * (a_l + 1) + 8 * g;
#define CONV_LDFRAG(dst, n) do { const unsigned* q_ = Gd + 8 * (n); const unsigned d0 = q_[0], d1 = q_[1], d2 = q_[2], d3 = q_[3], d4 = q_[4]; u32x4 r_; \
    r_[0] = __builtin_amdgcn_alignbit(d1, d0, sh); r_[1] = __builtin_amdgcn_alignbit(d2, d1, sh); r_[2] = __builtin_amdgcn_alignbit(d3, d2, sh); r_[3] = __builtin_amdgcn_alignbit(d4, d3, sh); \
    dst = __builtin_bit_cast(bf16x8, r_); } while (0)
  for (int pr = blockIdx.x; pr < 1024; pr += gridDim.x) {
#pragma unroll 4
    for (int m = tid; m < GLEN; m += 512) { unsigned v = *(const unsigned*)(G + (size_t)m * 2048 + 2 * pr); if (m < 33 || m > 8223) v = 0u;
      Gs[m] = (bf16_t)(v & 0xffffu); Gs[GLEN + m] = (bf16_t)(v >> 16); }
    for (int id = tid; id < 2 * 4 * 512; id += 512) { const int cc = id >> 11, bb = (id >> 9) & 3, s8 = id & 511;
      const u32x4 v = *(const u32x4*)(UT + ((size_t)(pr * 2 + cc) * 4 + bb) * SEQ + s8 * 8); const int sp = 1024 + s8 * 8;
      *(u32x4*)(Us + (cc * 4 + bb) * USTR + sp + 8 * (sp >> 7)) = v; }
    __syncthreads();
    bf16x8 W[8]; f32x16 acc[4];
#pragma unroll
    for (int h = 0; h < 4; ++h)
#pragma unroll
      for (int e = 0; e < 16; ++e) acc[h][e] = 0.f;
    CONV_LDFRAG(W[2], -6); CONV_LDFRAG(W[3], -5); CONV_LDFRAG(W[4], -4); CONV_LDFRAG(W[5], -3); CONV_LDFRAG(W[6], -2); CONV_LDFRAG(W[7], -1);
#pragma unroll 1
    for (int it = 0; it < 39; ++it) {
#pragma unroll
      for (int u = 0; u < 8; ++u) {
        CONV_LDFRAG(W[u], it * 8 + u);
        const bf16x8 bf = *(const bf16x8*)(Ub + 136 * it + 16 * u);
#pragma unroll
        for (int h = 0; h < 4; ++h) acc[h] = __builtin_amdgcn_mfma_f32_32x32x16_bf16(W[(u - 2 * h) & 7], bf, acc[h], 0, 0, 0);
      }
    }
    { bf16_t* yrow = UT + ((size_t)(pr * 2 + ch) * 4 + b) * SEQ + 128 * (8 * q + a_l) + 4 * g;
#pragma unroll
      for (int h = 0; h < 4; ++h)
#pragma unroll
        for (int rq = 0; rq < 4; ++rq) { u32x2 o; o[0] = pk2(acc[h][4 * rq], acc[h][4 * rq + 1]); o[1] = pk2(acc[h][4 * rq + 2], acc[h][4 * rq + 3]); *(u32x2*)(yrow + 32 * h + 8 * rq) = o; } }
    __syncthreads();
  }
#undef CONV_LDFRAG
}

template <int KD> DI f32x16 mma_tile(f32x16 acc, const bf16_t* A, int lda, const bf16_t* B, int ldb, int lane) {
  const int r = lane & 31, g8 = (lane >> 5) * 8; const bf16_t* ap = A + r * lda + g8; const bf16_t* bp = B + r * ldb + g8;
#pragma unroll 4
  for (int k0 = 0; k0 < KD; k0 += 16) acc = __builtin_amdgcn_mfma_f32_32x32x16_bf16(*(const bf16x8*)(ap + k0), *(const bf16x8*)(bp + k0), acc, 0, 0, 0);
  return acc;
}
DI bf16x8 tr_frag(const bf16_t* img, int ld, int lane) {
  const int h = lane >> 5, blk = (lane >> 4) & 1, q = (lane & 15) >> 2, pp = lane & 3;
  const bf16_t* a = img + (8 * h + q) * ld + 16 * blk + 4 * pp;
  const s16x4 r0 = __builtin_amdgcn_ds_read_tr16_b64_v4i16((__attribute__((address_space(3))) s16x4*)a);
  const s16x4 r1 = __builtin_amdgcn_ds_read_tr16_b64_v4i16((__attribute__((address_space(3))) s16x4*)(a + 4 * ld));
  bf16x8 f; f[0] = r0[0]; f[1] = r0[1]; f[2] = r0[2]; f[3] = r0[3]; f[4] = r1[0]; f[5] = r1[1]; f[6] = r1[2]; f[7] = r1[3]; return f;
}
__device__ void phase_ret(const Params& p, int l, unsigned char* shm) {
  constexpr int QS = 264, VS = 144, TS = 72;
  const int tid = otid(p.wid), lane = tid & 63, wid = tid >> 6, g = lane >> 5;
  bf16_t* Qs = (bf16_t*)shm; bf16_t* Ks = Qs + 64 * QS; bf16_t* Vs = Ks + 64 * QS; bf16_t* Ps = Vs + 64 * VS; bf16_t* Sts = Ps + 64 * TS;
  const bf16_t* PQ = (const bf16_t*)(p.ws + OFF_PQ); const bf16_t* PK = (const bf16_t*)(p.ws + OFF_PK); const bf16_t* PV = (const bf16_t*)(p.ws + OFF_PV);
  for (int it0 = blockIdx.x; it0 < 256; it0 += gridDim.x) {
    int it = it0;
    if (gridDim.x == 256) { const int xcd = it0 & 7, idx = it0 >> 3; it = ((xcd + 8 * (idx >> 2)) << 2) | (idx & 3); }
    const int sl = it & 3, dir = (it >> 2) & 1, h = (it >> 3) & 7, b = it >> 6;
    const float lg = -expf(p.ret_decay[(l * 2 + dir) * 8 + h]);
    bf16_t* O = (bf16_t*)(p.ws + (dir ? OFF_OB : OFF_OF));
    for (int i = tid; i < 128 * QS / 2; i += 512) ((unsigned*)Sts)[i] = 0u;
    f32x16 S[4], cross;
#pragma unroll
    for (int x = 0; x < 4; ++x)
#pragma unroll
      for (int e = 0; e < 16; ++e) S[x][e] = 0.f;
#pragma unroll
    for (int e = 0; e < 16; ++e) cross[e] = 0.f;
    const float cd = __expf(lg * 64.f);
    const int tid2 = otid(p.wid), ln2 = tid2 & 63, g2 = ln2 >> 5, w2 = tid2 >> 6;
    float mk[16], dkv[2];
#pragma unroll
    for (int e = 0; e < 2; ++e) { const int tok = (tid2 >> 4) + 32 * e; dkv[e] = __expf(lg * (float)(dir ? tok : 63 - tok)); }
    const int wq = w2 & 3, s_tj = wq >> 1, s_ti = wq & 1;
    const int o_tc = w2 >> 1, o_ti = w2 & 1;
    { const int i = s_ti * 32 + (ln2 & 31);
#pragma unroll
      for (int e = 0; e < 16; ++e) { const int j = s_tj * 32 + (e & 3) + 8 * (e >> 2) + 4 * g2; const int diff = dir ? (j - i) : (i - j); mk[e] = diff >= 0 ? __expf(lg * (float)(dir ? -i : i - 63)) : 0.f; } }
    const int qi = o_ti * 32 + (ln2 & 31);
    const float qd = __expf(lg * (float)(dir ? 64 - qi : qi + 1));
    u32x4 rq[4], rk[4], rv[2];
    const unsigned qo_l = (unsigned)(tid >> 5) * 2048u + (unsigned)(h * 256 + (tid & 31) * 8);
    const unsigned vo_l = (unsigned)(tid >> 4) * 4096u + (unsigned)(h * 512 + sl * 128 + (tid & 15) * 8);
#define RET_CHUNK(step_, isctx_, t0_) do { if ((step_) < 4) { isctx_ = true; t0_ = (dir ? 3 - (step_) : (step_)) * 64; } else { isctx_ = false; const int cn_ = (step_) - 4; t0_ = (dir ? 63 - cn_ : cn_) * 64; } } while (0)
#define RET_LOAD(step_) do { bool ic_; int t0n_; RET_CHUNK(step_, ic_, t0n_); const unsigned rw_ = (unsigned)tok_row(b, t0n_, ic_); \
      _Pragma("unroll") for (int e = 0; e < 4; ++e) { rq[e] = *(const u32x4*)(PQ + (rw_ * 2048u + qo_l + (unsigned)e * 32768u)); rk[e] = *(const u32x4*)(PK + (rw_ * 2048u + qo_l + (unsigned)e * 32768u)); } \
      _Pragma("unroll") for (int e = 0; e < 2; ++e) rv[e] = *(const u32x4*)(PV + (rw_ * 4096u + vo_l + (unsigned)e * 131072u)); } while (0)
    RET_LOAD(0);
#pragma unroll 1
    for (int step = 0; step < 68; ++step) {
      bool isctx; int t0; RET_CHUNK(step, isctx, t0);
      const int row0 = tok_row(b, t0, isctx);
      __syncthreads();
#pragma unroll
      for (int e = 0; e < 4; ++e) { const int row = (tid >> 5) + 16 * e, pc = tid & 31; *(u32x4*)(Qs + row * QS + pc * 8) = rq[e]; *(u32x4*)(Ks + row * QS + pc * 8) = rk[e]; }
#pragma unroll
      for (int e = 0; e < 2; ++e) { u32x4 o;
#pragma unroll
        for (int w = 0; w < 4; ++w) o[w] = pk2(lo2f(rv[e][w]) * dkv[e], hi2f(rv[e][w]) * dkv[e]);
        *(u32x4*)(Vs + ((tid >> 4) + 32 * e) * VS + (tid & 15) * 8) = o; }
      if (step + 1 < 68) RET_LOAD(step + 1);
      __syncthreads();
      if (wid < 4) {
        f32x16 sc;
#pragma unroll
        for (int e = 0; e < 16; ++e) sc[e] = 0.f;
        sc = mma_tile<256>(sc, Ks + s_tj * 32 * QS, QS, Qs + s_ti * 32 * QS, QS, lane);
        const int i = s_ti * 32 + (lane & 31);
#pragma unroll
        for (int r4 = 0; r4 < 4; ++r4) { u32x2 o; o[0] = pk2(sc[4 * r4] * mk[4 * r4], sc[4 * r4 + 1] * mk[4 * r4 + 1]); o[1] = pk2(sc[4 * r4 + 2] * mk[4 * r4 + 2], sc[4 * r4 + 3] * mk[4 * r4 + 3]);
          *(u32x2*)(Ps + i * TS + s_tj * 32 + 8 * r4 + 4 * g) = o; }
      }
#pragma unroll
      for (int e = 0; e < 16; ++e) cross[e] = 0.f;
      cross = mma_tile<256>(cross, Sts + o_tc * 32 * QS, QS, Qs + o_ti * 32 * QS, QS, lane);
      __syncthreads();
      { f32x16 in_;
#pragma unroll
        for (int e = 0; e < 16; ++e) in_[e] = 0.f;
        const bf16_t* pb = Ps + (o_ti * 32 + (lane & 31)) * TS + 8 * g;
#pragma unroll
        for (int ks = 0; ks < 4; ++ks) in_ = __builtin_amdgcn_mfma_f32_32x32x16_bf16(tr_frag(Vs + 16 * ks * VS + 32 * o_tc, VS, lane), *(const bf16x8*)(pb + 16 * ks), in_, 0, 0, 0);
        const unsigned ob = (unsigned)(row0 + qi) * 4096u + (unsigned)(h * 512 + sl * 128 + o_tc * 32 + 4 * g);
#pragma unroll
        for (int r4 = 0; r4 < 4; ++r4) { u32x2 o; o[0] = pk2(in_[4 * r4] + qd * cross[4 * r4], in_[4 * r4 + 1] + qd * cross[4 * r4 + 1]); o[1] = pk2(in_[4 * r4 + 2] + qd * cross[4 * r4 + 2], in_[4 * r4 + 3] + qd * cross[4 * r4 + 3]);
          *(u32x2*)(O + (ob + (unsigned)(8 * r4))) = o; } }
      { bf16x8 ka[4];
#pragma unroll
        for (int ks = 0; ks < 4; ++ks) ka[ks] = tr_frag(Ks + 16 * ks * QS + 32 * wid, QS, lane);
#pragma unroll
        for (int x = 0; x < 4; ++x) {
#pragma unroll
          for (int e = 0; e < 16; ++e) S[x][e] *= cd;
#pragma unroll
          for (int ks = 0; ks < 4; ++ks) S[x] = __builtin_amdgcn_mfma_f32_32x32x16_bf16(ka[ks], tr_frag(Vs + 16 * ks * VS + 32 * x, VS, lane), S[x], 0, 0, 0);
          const int c = x * 32 + (lane & 31);
#pragma unroll
          for (int r4 = 0; r4 < 4; ++r4) { u32x2 o; o[0] = pk2(S[x][4 * r4], S[x][4 * r4 + 1]); o[1] = pk2(S[x][4 * r4 + 2], S[x][4 * r4 + 3]); *(u32x2*)(Sts + c * QS + wid * 32 + 8 * r4 + 4 * g) = o; } } }
    }
    __syncthreads();
  }
#undef RET_CHUNK
#undef RET_LOAD
}

__global__ void __launch_bounds__(512, 2) mega(Params p_in) {
  Params p = p_in; p.wid = __builtin_amdgcn_readfirstlane((int)(threadIdx.x >> 6));
  extern __shared__ __attribute__((aligned(16))) unsigned char shm[];
  cg::grid_group grid = cg::this_grid();
  PG8_LAS unsigned char* lds = (PG8_LAS unsigned char*)shm;
  volatile XLAS unsigned* xst = (volatile XLAS unsigned*)(lds + 163824);
  if (otid(p.wid) == 0) { xst[0] = 0u; xst[1] = 0u; }
  __syncthreads();
  const XcdBarrier xb = xcd_barrier_post((unsigned*)(p.ws + OFF_BAR), xst, otid(p.wid) == 0);
  const bf16_t* H = (const bf16_t*)(p.ws + OFF_H);
#pragma unroll 1
  for (int rep = 0; rep < (PROBE == 1 ? 2 : 1); ++rep) { phase_filters(p, shm); phase_mod(p, shm); }
  grid.sync();
  for (int l = 0; l < 2; ++l) {
#pragma unroll 1
    for (int rep = 0; rep < (PROBE == 1 ? 2 : 1); ++rep) { phase_cvt(p, l, shm); phase_norm(p, l); }
    xcd_barrier(xb, otid(p.wid) == 0);
    { pg8::Gemm g; g.wid = p.wid; g.A = H; g.Bt = (const bf16_t*)(p.ws + OFF_WTIN); g.M = MT; g.N = INW; g.K = DM;
      pg8::Order S; S.init(64, 96, (int)gridDim.x, (int)blockIdx.x, 4, l == 0 ? 96 : 24, l == 0 ? 0 : 8);
      EpiG1 E; E.ws = p.ws; pg8::gemm_phase<EpiG1, pg8::Order>(lds, g, S, E); }
    xcd_barrier(xb, otid(p.wid) == 0);
#pragma unroll 1
    for (int rep = 0; rep < (PROBE == 2 ? 2 : 1); ++rep) phase_prep(p, l, shm, rep ? 4 : 7);
    xcd_barrier(xb, otid(p.wid) == 0);
    phase_conv(p, l, shm);
#pragma unroll 1
    for (int rep = 0; rep < (PROBE == 3 ? 2 : 1); ++rep) phase_ret(p, l, shm);
    xcd_barrier(xb, otid(p.wid) == 0);
#pragma unroll 1
    for (int rep = 0; rep < (PROBE == 2 ? 2 : 1); ++rep) phase_post(p, l, shm, rep ? 3 : 7);
    xcd_barrier(xb, otid(p.wid) == 0);
    { const int nM = (l == 0) ? 68 : 64;
      pg8::Order S; S.init(nM, 8, (int)gridDim.x, (int)blockIdx.x, 0, 0, 0);
#pragma unroll 1
      for (int rep = 0; rep < (PROBE == 4 ? 2 : 1); ++rep) {
      { pg8::Gemm g; g.wid = p.wid; g.A = H; g.Bt = (const bf16_t*)(p.ws + OFF_WTHY); g.M = nM * 256; g.N = DM; g.K = DM; EpiG23<0> E; E.ws = p.ws; pg8::gemm_phase<EpiG23<0>, pg8::Order>(lds, g, S, E); }
      { pg8::Gemm g; g.wid = p.wid; g.A = (const bf16_t*)(p.ws + OFF_OF); g.Bt = (const bf16_t*)(p.ws + OFF_WTRET); g.M = nM * 256; g.N = DM; g.K = 4096; EpiG23<1> E; E.ws = p.ws; pg8::gemm_phase<EpiG23<1>, pg8::Order>(lds, g, S, E); }
      }
      xcd_barrier(xb, otid(p.wid) == 0);
      { pg8::Gemm g; g.wid = p.wid; g.A = (const bf16_t*)(p.ws + OFF_T1); g.Bt = (const bf16_t*)(p.ws + OFF_WTO); g.M = nM * 256; g.N = DM; g.K = DM;
        EpiG4 E; E.xin = (l == 0) ? p.x : p.out; E.cin = p.ctx; E.xout = p.out; E.cout = (float*)(p.ws + OFF_CTXR); E.mod = (const float*)(p.ws + OFF_MOD) + (size_t)l * 5 * 6144;
        pg8::gemm_phase<EpiG4, pg8::Order>(lds, g, S, E); } }
    xcd_barrier(xb, otid(p.wid) == 0);
  }
  phase_final(p);
}

extern "C" void kernel_launch(void* const* d_in, const int* in_sizes, int n_in, void* d_out, int out_size, void* d_ws, size_t ws_size, hipStream_t stream) {
  constexpr size_t kDynLds = 163840;
  static int grid_blocks = 0;
  if (!grid_blocks) {
    hipFuncSetAttribute((const void*)mega, hipFuncAttributeMaxDynamicSharedMemorySize, (int)kDynLds);
    int dev = 0, cus = 0, per_cu = 0;
    hipGetDevice(&dev);
    hipDeviceGetAttribute(&cus, hipDeviceAttributeMultiprocessorCount, dev);
    hipOccupancyMaxActiveBlocksPerMultiprocessor(&per_cu, (const void*)mega, 512, kDynLds);
    grid_blocks = cus * (per_cu >= 1 ? 1 : 0);
    if (ws_size < WS_NEED || grid_blocks <= 0) { fprintf(stderr, "workspace %zu < %zu or no occupancy (%d)\n", ws_size, (size_t)WS_NEED, per_cu); grid_blocks = grid_blocks > 0 ? grid_blocks : 256; }
  }
  Params p{};
  p.x = (const float*)d_in[0]; p.c = (const float*)d_in[1]; p.ctx = (const float*)d_in[2]; p.c_ctx = (const float*)d_in[3]; p.ln_g = (const float*)d_in[4];
  p.ada_w = (const float*)d_in[5]; p.ada_b = (const float*)d_in[6]; p.w_in = (const float*)d_in[7]; p.conv_w = (const float*)d_in[8]; p.conv_b = (const float*)d_in[9];
  p.fw1 = (const float*)d_in[10]; p.fb1 = (const float*)d_in[11]; p.fw2 = (const float*)d_in[12]; p.fb2 = (const float*)d_in[13]; p.fw3 = (const float*)d_in[14]; p.fb3 = (const float*)d_in[15];
  p.ffreq = (const float*)d_in[16]; p.fwout = (const float*)d_in[17]; p.hy_bias = (const float*)d_in[18]; p.ret_decay = (const float*)d_in[19];
  p.w_hy_out = (const float*)d_in[20]; p.w_ret_out = (const float*)d_in[21]; p.w_o = (const float*)d_in[22]; p.final_g = (const float*)d_in[23];
  p.out = (float*)d_out; p.ws = (unsigned char*)d_ws;
  void* args[] = {&p};
  (void)hipMemsetAsync((unsigned char*)d_ws + OFF_BAR, 0, (size_t)XCD_BAR_WORDS * 4, stream);
  hipError_t e = hipLaunchCooperativeKernel((void*)mega, dim3(grid_blocks), dim3(512), args, kDynLds, stream);
  if (e != hipSuccess) fprintf(stderr, "cooperative launch failed: %s (grid %d)\n", hipGetErrorString(e), grid_blocks);
}
```

```cpp
#include <hip/hip_runtime.h>
#include <hip/hip_cooperative_groups.h>
#include <cstdio>
namespace cg = cooperative_groups;
#ifndef PROBE
#define PROBE 0
#endif

typedef unsigned short bf16_t;
typedef short bf16x8 __attribute__((ext_vector_type(8)));
typedef float f32x4 __attribute__((ext_vector_type(4)));
typedef float f32x16 __attribute__((ext_vector_type(16)));
typedef unsigned u32x4 __attribute__((ext_vector_type(4)));
typedef unsigned u32x2 __attribute__((ext_vector_type(2)));
typedef short s16x4 __attribute__((ext_vector_type(4)));
#define DI __device__ __forceinline__

DI int otid(int wid) { int t; asm volatile("v_mbcnt_lo_u32_b32 %0, -1, 0\n\tv_mbcnt_hi_u32_b32 %0, -1, %0" : "=v"(t)); return wid * 64 + t; }
DI float wsum(float v, int lane) {
#pragma unroll
  for (int o = 32; o > 0; o >>= 1) v += __int_as_float(__builtin_amdgcn_ds_bpermute((lane ^ o) << 2, __float_as_int(v)));
  return v; }
DI float bf2f(bf16_t u) { return __uint_as_float(((unsigned)u) << 16); }
typedef __bf16 bf16v2 __attribute__((ext_vector_type(2)));
typedef float f32v2 __attribute__((ext_vector_type(2)));
DI unsigned pk2(float lo, float hi) { f32v2 v = {lo, hi}; bf16v2 b = __builtin_convertvector(v, bf16v2); return __builtin_bit_cast(unsigned, b); }
DI bf16_t f2bf(float f) { return (bf16_t)(pk2(f, 0.f) & 0xffffu); }
DI float lo2f(unsigned u) { return __uint_as_float(u << 16); }
DI float hi2f(unsigned u) { return __uint_as_float(u & 0xffff0000u); }
DI float sigmoidf_(float v) { return 1.f / (1.f + __expf(-v)); }
DI float siluf_(float v) { return v / (1.f + __expf(-v)); }

constexpr int DM = 2048, NB = 4, SEQ = 4096, CTXL = 256, NLAT = NB * SEQ, NCTX = NB * CTXL, MT = NLAT + NCTX;
constexpr int INW = 24576, NH = 8, DK = 256, DV = 512, TT = SEQ + CTXL;
constexpr int LOFF = 4128, GLEN = 8320;      constexpr size_t G_LAYER = ((size_t)2048 * 8320 * 2 + 255) & ~(size_t)255;
constexpr int USTR = 6560;

constexpr size_t AL(size_t x) { return (x + 255) & ~(size_t)255; }
constexpr size_t OFF_WTIN = 0;
constexpr size_t OFF_WTHY = OFF_WTIN + AL((size_t)INW * DM * 2);
constexpr size_t OFF_WTRET = OFF_WTHY + AL((size_t)DM * DM * 2);
constexpr size_t OFF_WTO = OFF_WTRET + AL((size_t)DM * 4096 * 2);
constexpr size_t OFF_G = OFF_WTO + AL((size_t)DM * DM * 2);
constexpr size_t OFF_GC = OFF_G + 2 * AL((size_t)DM * GLEN * 2);
constexpr size_t OFF_MOD = OFF_GC + AL((size_t)DM * 512 * 4);
constexpr size_t OFF_H = OFF_MOD + AL((size_t)2 * 5 * 6144 * 4);
constexpr size_t OFF_PQ = OFF_H + AL((size_t)MT * DM * 2);
constexpr size_t OFF_PK = OFF_PQ + AL((size_t)MT * DM * 2);
constexpr size_t OFF_PV = OFF_PK + AL((size_t)MT * DM * 2);
constexpr size_t OFF_PRG = OFF_PV + AL((size_t)MT * 4096 * 2);
constexpr size_t OFF_PHY = OFF_PRG + AL((size_t)MT * 4096 * 2);
constexpr size_t OFF_PHG = OFF_PHY + AL((size_t)MT * 6144 * 2);
constexpr size_t OFF_PMG = OFF_PHG + AL((size_t)MT * DM * 2);
constexpr size_t OFF_KT = OFF_PMG + AL((size_t)MT * 4096 * 2);
constexpr size_t OFF_VT = OFF_KT + AL((size_t)NB * NH * DK * TT * 2);
constexpr size_t OFF_UT = OFF_VT + AL((size_t)NB * NH * DV * TT * 2);
constexpr size_t OFF_UTC = OFF_UT + AL((size_t)DM * NB * SEQ * 2);
constexpr size_t OFF_HV = OFF_UTC + AL((size_t)DM * NB * CTXL * 2);
constexpr size_t OFF_HX0 = OFF_HV + AL((size_t)MT * DM * 2);
constexpr size_t OFF_CTXR = OFF_HX0 + AL((size_t)MT * DM * 2);
constexpr size_t OFF_BAR = OFF_CTXR + AL((size_t)NCTX * DM * 4);
constexpr size_t OFF_CS = OFF_BAR + AL((size_t)3456 * 4);
constexpr size_t WS_NEED = OFF_CS + AL((size_t)4096 * 8);
constexpr size_t OFF_GS = OFF_KT + AL((size_t)MT * 4096 * 2);
constexpr size_t OFF_OF = OFF_KT, OFF_OB = OFF_PHY, OFF_T1 = OFF_PHY + AL((size_t)MT * 4096 * 2);

struct Params {
  const float *x, *c, *ctx, *c_ctx, *ln_g, *ada_w, *ada_b, *w_in, *conv_w, *conv_b, *fw1, *fb1, *fw2, *fb2, *fw3, *fb3, *ffreq, *fwout, *hy_bias, *ret_decay, *w_hy_out, *w_ret_out, *w_o, *final_g;
  float* out;
  unsigned char* ws;
  int wid, pad_;
};


#define XB_TMO      128
#define XB_XCNT(j)  (256  + 64 * (j))
#define XB_XSUB(j)  (1280 + 64 * (j))
#define XB_XGEN(j)  (2304 + 64 * (j))
#define XB_TOP      3328
#define XB_TOPGEN   3392
#define XCD_BAR_WORDS 3456
#define XB_SPIN_CAP (1u << 18)
#define XLAS __attribute__((address_space(3)))
DI unsigned xb_ld(unsigned* p)              { return __hip_atomic_load(p, __ATOMIC_RELAXED, __HIP_MEMORY_SCOPE_AGENT); }
DI unsigned xb_add(unsigned* p, unsigned v) { return __hip_atomic_fetch_add(p, v, __ATOMIC_RELAXED, __HIP_MEMORY_SCOPE_AGENT); }
DI unsigned xb_xcc_id() { return (unsigned)__builtin_amdgcn_s_getreg((3 << 11) | 20) & 0xFu; }
#define XB_SPIN(cond, bar) do { unsigned _sp = 0; while (cond) { __builtin_amdgcn_s_sleep(1); \
    if ((++_sp & 255u) == 0u) { if (xb_ld(&(bar)[XB_TMO])) break; if (_sp > XB_SPIN_CAP) { atomicAdd(&(bar)[XB_TMO], 1u); break; } } } } while (0)
struct XcdBarrier { unsigned* bar; unsigned x; volatile XLAS unsigned* st; };
DI XcdBarrier xcd_barrier_post(unsigned* bar, volatile XLAS unsigned* st, bool leader) {
    XcdBarrier b; b.bar = bar; b.x = xb_xcc_id(); b.st = st;
    if (leader) (void)xb_add(&bar[XB_XCNT(b.x)], 1u);
    return b;
}
DI void xcd_barrier_complete(unsigned* bar, unsigned x, unsigned& nloc, unsigned& nx) {
    const unsigned G = gridDim.x * gridDim.y * gridDim.z;
    unsigned sum, cnt, mine, sp = 0u;
    for (;;) {
        sum = 0u; cnt = 0u; mine = 0u;
#pragma unroll
        for (unsigned j = 0; j < 16; ++j) { const unsigned c = xb_ld(&bar[XB_XCNT(j)]); sum += c; cnt += (c > 0u) ? 1u : 0u; mine = (j == x) ? c : mine; }
        if (sum == G) break;
        __builtin_amdgcn_s_sleep(1);
        if ((++sp & 255u) == 0u) { if (xb_ld(&bar[XB_TMO])) break; if (sp > XB_SPIN_CAP) { atomicAdd(&bar[XB_TMO], 1u); break; } }
    }
    nloc = mine > 0u ? mine : 1u; nx = cnt > 0u ? cnt : 1u;
}
DI void xcd_barrier(const XcdBarrier& b, bool leader) {
    asm volatile("s_waitcnt vmcnt(0)" ::: "memory");
    __syncthreads();
    if (leader) {
        unsigned* bar = b.bar;
        __builtin_amdgcn_s_waitcnt(0);
        unsigned nloc = b.st[0], nx = b.st[1];
        if (nloc == 0u) { xcd_barrier_complete(bar, b.x, nloc, nx); b.st[0] = nloc; b.st[1] = nx; }
        const unsigned old = xb_add(&bar[XB_XSUB(b.x)], 1u);
        const unsigned gen = old / nloc;
        if (old + 1u == (gen + 1u) * nloc) {
            __builtin_amdgcn_fence(__ATOMIC_RELEASE, "agent");
            asm volatile("s_waitcnt vmcnt(0)" ::: "memory");
            const unsigned og = xb_add(&bar[XB_TOP], 1u);
            const unsigned tg = og / nx;
            if (og + 1u == (tg + 1u) * nx) xb_add(&bar[XB_TOPGEN], 1u);
            else XB_SPIN(xb_ld(&bar[XB_TOPGEN]) == tg, bar);
            __builtin_amdgcn_fence(__ATOMIC_ACQUIRE, "agent");
            xb_add(&bar[XB_XGEN(b.x)], 1u);
            asm volatile("s_waitcnt vmcnt(0)" ::: "memory");
        } else {
            XB_SPIN(xb_ld(&bar[XB_XGEN(b.x)]) == gen, bar);
            __builtin_amdgcn_fence(__ATOMIC_ACQUIRE, "agent");
            asm volatile("s_waitcnt vmcnt(0)" ::: "memory");
        }
    }
    __syncthreads();
}

namespace pg8 {
#define PG8_LAS __attribute__((address_space(3)))
constexpr int BM = 256, BK = 64, HALF = 128, HTB = HALF * BK * 2, STAGE_BYTES = 8 * HTB, NXCD = 8, WGM = 8;
__host__ __device__ __forceinline__ int lds_byte(int r, int c) { const int st = (r >> 4) * 2 + (c >> 5), rr = r & 15, cc = c & 31, ob = rr * 64 + cc * 2; return st * 1024 + (ob ^ (((ob >> 9) & 1) << 5)); }
__host__ __device__ __forceinline__ void stage_rc(int b, int& R, int& C) { const int st = b / 1024, sb = b % 1024, swz = sb ^ (((sb >> 9) & 1) << 5); R = (st >> 1) * 16 + swz / 64; C = (st & 1) * 32 + (swz % 64) / 2; }
__host__ __device__ __forceinline__ int perm32(int rho) { const int n = rho >> 4, i = rho & 15; return 8 * (i >> 2) + 4 * n + (i & 3); }
struct Unit { int pm, pn; };
struct Gemm { const bf16_t* A; const bf16_t* Bt; int M, N, K, wid; };
struct Order {
    int nM, nN, nwg, G, c, nx_m, nx_n, x_pn0;
    __device__ void init(int nM_, int nN_, int G_, int c_, int nx_m_, int nx_n_, int x_pn0_) { nM = nM_; nN = nN_; nwg = nM * nN; G = G_; c = c_; nx_m = nx_m_; nx_n = nx_n_; x_pn0 = x_pn0_; }
    __device__ bool next(int i, Unit& u) const {
        const long L = (long)i * G + c;
        if (L >= nwg) { const int e = (int)(L - nwg); if (e >= nx_m * nx_n) return false; u.pm = nM + e % nx_m; u.pn = x_pn0 + e / nx_m; return true; }
        int wgid = (int)L; { const int q = nwg / NXCD, r = nwg % NXCD, xcd = wgid % NXCD, off = wgid / NXCD; wgid = (xcd < r ? xcd * (q + 1) : r * (q + 1) + (xcd - r) * q) + off; }
        const int nig = WGM * nN, gid = wgid / nig, fm = gid * WGM, gsz = (nM - fm) < WGM ? (nM - fm) : WGM;
        u.pm = fm + ((wgid % nig) % gsz); u.pn = (wgid % nig) / gsz; return true;
    }
    __device__ __forceinline__ void a_ready(const Unit&) const {}
    __device__ __forceinline__ void done(const Unit&) const {}
};
template <class Epi, class Sched>
__device__ __forceinline__ void gemm_phase(PG8_LAS unsigned char* lds, const Gemm g, const Sched& S, const Epi& E) {
    const int tid = otid(g.wid), wid = __builtin_amdgcn_readfirstlane(tid >> 6), lane = tid & 63, wr = wid >> 2, wc = wid & 3, fr = lane & 15, fq = lane >> 4;
    const int K = g.K, nt = K / BK;
    unsigned voffA[2], voffB[2];
#pragma unroll
    for (int i = 0; i < 2; ++i) { int R, C; stage_rc(tid * 16 + i * 8192, R, C); const int Rb = Epi::PERM ? ((R & ~31) + perm32(R & 31)) : R;
        voffA[i] = (unsigned)(R * K + C) * 2u; voffB[i] = (unsigned)(Rb * K + C) * 2u; }
    const size_t kstep = (size_t)(BK * 2);
    const size_t hstep = (size_t)HALF * K * 2;
    const size_t tstep = 2 * hstep;
    const unsigned ldsw = (unsigned)wid * 1024u;
    const int aoff = lds_byte(wr * 64 + fr, fq * 8), boff = lds_byte(wc * 32 + fr, fq * 8);
#define PG8_SA(b, h) (((b) * 2 + (h)) * HTB)
#define PG8_SB(b, h) ((4 + (b) * 2 + (h)) * HTB)
#define PG8_STAGE(bufoff, gbase, voff) do { _Pragma("unroll") for (int _i = 0; _i < 2; ++_i) \
        __builtin_amdgcn_global_load_lds((const unsigned*)((const char*)(gbase) + (voff)[_i]), (PG8_LAS unsigned*)(lds + (bufoff) + ldsw + _i * 8192), 16, 0, 0); } while (0)
#define PG8_LDA(dst, b, h) do { _Pragma("unroll") for (int m = 0; m < 4; ++m) _Pragma("unroll") for (int k = 0; k < 2; ++k) dst[m][k] = *(const PG8_LAS bf16x8*)(lds + PG8_SA(b, h) + aoff + m * 2048 + k * 1024); } while (0)
#define PG8_LDB(dst, b, h) do { _Pragma("unroll") for (int n = 0; n < 2; ++n) _Pragma("unroll") for (int k = 0; k < 2; ++k) dst[n][k] = *(const PG8_LAS bf16x8*)(lds + PG8_SB(b, h) + boff + n * 2048 + k * 1024); } while (0)
#define PG8_MMA(ai, bj, At, Bt) do { __builtin_amdgcn_s_setprio(1); _Pragma("unroll") for (int m = 0; m < 4; ++m) _Pragma("unroll") for (int n = 0; n < 2; ++n) _Pragma("unroll") for (int k = 0; k < 2; ++k) \
        acc[ai][bj][m][n] = __builtin_amdgcn_mfma_f32_16x16x32_bf16(Bt[n][k], At[m][k], acc[ai][bj][m][n], 0, 0, 0); __builtin_amdgcn_s_setprio(0); } while (0)
#define PG8_WAIT_V(n) asm volatile("s_waitcnt vmcnt(" #n ")" ::: "memory")
#define PG8_WAIT_L(n) asm volatile("s_waitcnt lgkmcnt(" #n ")" ::: "memory")
#define PG8_BAR __builtin_amdgcn_s_barrier()
#define PG8_SCHED __builtin_amdgcn_sched_barrier(0)
    Unit cur, nxt; int ui = 0;
    if (!S.next(0, cur)) return;
    f32x4 acc[2][2][4][2];
#pragma unroll
    for (int a = 0; a < 2; ++a)
#pragma unroll
        for (int b = 0; b < 2; ++b)
#pragma unroll
            for (int m = 0; m < 4; ++m)
#pragma unroll
                for (int n = 0; n < 2; ++n) acc[a][b][m][n] = (f32x4){0.f, 0.f, 0.f, 0.f};
    bf16x8 At[4][2], B0[2][2], B1[2][2];
    const char* cA = (const char*)g.A + (size_t)cur.pm * tstep; const char* cB = (const char*)g.Bt + (size_t)cur.pn * tstep;
    S.a_ready(cur);
    PG8_STAGE(PG8_SB(0, 0), cB, voffB); PG8_STAGE(PG8_SA(0, 0), cA, voffA); PG8_STAGE(PG8_SB(0, 1), cB + hstep, voffB); PG8_STAGE(PG8_SA(0, 1), cA + hstep, voffA);
    if (wr == 1) PG8_BAR;
    PG8_WAIT_V(4); PG8_BAR;
    PG8_STAGE(PG8_SB(1, 0), cB + kstep, voffB); PG8_STAGE(PG8_SA(1, 0), cA + kstep, voffA); PG8_STAGE(PG8_SB(1, 1), cB + hstep + kstep, voffB);
    PG8_WAIT_V(6); PG8_BAR;
    for (;;) {
        const bool has_next = S.next(ui + 1, nxt);
        const char* nA = has_next ? (const char*)g.A + (size_t)nxt.pm * tstep : cA; const char* nB = has_next ? (const char*)g.Bt + (size_t)nxt.pn * tstep : cB;
        for (int t = 0; t < nt; t += 2) {
            const bool last = (t == nt - 2);
            const char* a1 = cA + (size_t)(t + 1) * kstep;
            const char* a2 = last ? nA : cA + (size_t)(t + 2) * kstep; const char* b2 = last ? nB : cB + (size_t)(t + 2) * kstep;
            const char* a3 = a2 + kstep; const char* b3 = b2 + kstep;
            if (last && has_next) S.a_ready(nxt);
            PG8_LDB(B0, 0, 0); PG8_SCHED; PG8_LDA(At, 0, 0); PG8_STAGE(PG8_SA(1, 1), a1 + hstep, voffA);
            PG8_WAIT_L(8); PG8_BAR; PG8_WAIT_L(0); PG8_MMA(0, 0, At, B0); PG8_BAR; PG8_SCHED;
            PG8_LDB(B1, 0, 1); PG8_STAGE(PG8_SB(0, 0), b2, voffB);
            PG8_BAR; PG8_WAIT_L(0); PG8_MMA(0, 1, At, B1); PG8_BAR;
            PG8_LDA(At, 0, 1); PG8_STAGE(PG8_SA(0, 0), a2, voffA);
            PG8_BAR; PG8_WAIT_L(0); PG8_MMA(1, 0, At, B0); PG8_BAR; PG8_SCHED;
            PG8_STAGE(PG8_SB(0, 1), b2 + hstep, voffB);
            PG8_WAIT_V(6); PG8_BAR; PG8_MMA(1, 1, At, B1); PG8_BAR;
            PG8_LDB(B0, 1, 0); PG8_SCHED; PG8_LDA(At, 1, 0); PG8_STAGE(PG8_SA(0, 1), a2 + hstep, voffA);
            PG8_WAIT_L(8); PG8_BAR; PG8_WAIT_L(0); PG8_MMA(0, 0, At, B0); PG8_BAR; PG8_SCHED;
            PG8_LDB(B1, 1, 1); PG8_STAGE(PG8_SB(1, 0), b3, voffB);
            PG8_BAR; PG8_WAIT_L(0); PG8_MMA(0, 1, At, B1); PG8_BAR;
            PG8_LDA(At, 1, 1); PG8_STAGE(PG8_SA(1, 0), a3, voffA);
            PG8_BAR; PG8_WAIT_L(0); PG8_MMA(1, 0, At, B0); PG8_BAR; PG8_SCHED;
            PG8_STAGE(PG8_SB(1, 1), b3 + hstep, voffB);
            PG8_WAIT_V(6); PG8_BAR; PG8_MMA(1, 1, At, B1); PG8_BAR;
        }
        if constexpr (!Epi::AFTER_DRAIN) { E(acc, cur, wr, wc, fr, fq); S.done(cur); }
        if (!has_next) break;
#pragma unroll
        for (int a = 0; a < 2; ++a)
#pragma unroll
            for (int b = 0; b < 2; ++b)
#pragma unroll
                for (int m = 0; m < 4; ++m)
#pragma unroll
                    for (int n = 0; n < 2; ++n) acc[a][b][m][n] = (f32x4){0.f, 0.f, 0.f, 0.f};
        cur = nxt; cA = nA; cB = nB; ++ui;
    }
    PG8_WAIT_V(0);
    if (wr == 0) PG8_BAR;
    PG8_BAR;
    if constexpr (Epi::AFTER_DRAIN) { E.fused(acc, cur, wr, wc, fr, fq, lds, wid, lane); S.done(cur); }
#undef PG8_SA
#undef PG8_SB
#undef PG8_STAGE
#undef PG8_LDA
#undef PG8_LDB
#undef PG8_MMA

#undef PG8_WAIT_V
#undef PG8_WAIT_L
#undef PG8_BAR
#undef PG8_SCHED
}
}

struct EpiG1 {
  static constexpr bool PERM = true, AFTER_DRAIN = false;
  unsigned char* ws;
  DI void operator()(const f32x4 (&acc)[2][2][4][2], const pg8::Unit& u, int wr, int wc, int fr, int fq) const {
    const int pn = u.pn; size_t off; int ld, c0;
    if (pn < 8) { off = OFF_PQ; ld = 2048; c0 = pn * 256; }
    else if (pn < 16) { off = OFF_PK; ld = 2048; c0 = (pn - 8) * 256; }
    else if (pn < 32) { off = OFF_PV; ld = 4096; c0 = (pn - 16) * 256; }
    else if (pn < 48) { off = OFF_PRG; ld = 4096; c0 = (pn - 32) * 256; }
    else if (pn < 72) { off = OFF_PHY; ld = 6144; c0 = (pn - 48) * 256; }
    else if (pn < 80) { off = OFF_PHG; ld = 2048; c0 = (pn - 72) * 256; }
    else { off = OFF_PMG; ld = 4096; c0 = (pn - 80) * 256; }
    bf16_t* base = (bf16_t*)(ws + off);
    const int row0 = u.pm * 256 + wr * 64 + fr, col0 = c0 + wc * 32 + 8 * fq;
    const bool rope = (pn < 16) && (u.pm < 64);
    const float4* CS = (const float4*)(ws + OFF_CS) + (wc * 4 + fq) * 2;
#pragma unroll
    for (int ai = 0; ai < 2; ++ai)
#pragma unroll
      for (int m = 0; m < 4; ++m) { const int row = row0 + ai * 128 + m * 16; bf16_t* rowp = base + (size_t)row * ld + col0;
#pragma unroll
        for (int bj = 0; bj < 2; ++bj) { f32x4 v0 = acc[ai][bj][m][0], v1 = acc[ai][bj][m][1];
          if (rope) { const int t = row & 4095, pos = bj ? (t & 63) : (t >> 6); const float4 ca = CS[pos * 32], cb = CS[pos * 32 + 1];
            const f32x4 a = v0, b = v1;
            v0[0] = a[0] * ca.x - b[0] * ca.y; v1[0] = a[0] * ca.y + b[0] * ca.x; v0[1] = a[1] * ca.z - b[1] * ca.w; v1[1] = a[1] * ca.w + b[1] * ca.z;
            v0[2] = a[2] * cb.x - b[2] * cb.y; v1[2] = a[2] * cb.y + b[2] * cb.x; v0[3] = a[3] * cb.z - b[3] * cb.w; v1[3] = a[3] * cb.w + b[3] * cb.z; }
          u32x4 o; o[0] = pk2(v0[0], v0[1]); o[1] = pk2(v0[2], v0[3]); o[2] = pk2(v1[0], v1[1]); o[3] = pk2(v1[2], v1[3]);
          *(u32x4*)(rowp + bj * 128) = o; } }
  }
};
template <int SECOND> struct EpiG23 {
  static constexpr bool PERM = true, AFTER_DRAIN = false;
  unsigned char* ws;
  DI void operator()(const f32x4 (&acc)[2][2][4][2], const pg8::Unit& u, int wr, int wc, int fr, int fq) const {
    bf16_t* T1 = (bf16_t*)(ws + OFF_T1); const bf16_t* MG = (const bf16_t*)(ws + OFF_PMG) + (SECOND ? 2048 : 0);
    const int row0 = u.pm * 256 + wr * 64 + fr, col0 = u.pn * 256 + wc * 32 + 8 * fq;
#pragma unroll
    for (int ai = 0; ai < 2; ++ai)
#pragma unroll
      for (int m = 0; m < 4; ++m) { const size_t row = (size_t)(row0 + ai * 128 + m * 16);
#pragma unroll
        for (int bj = 0; bj < 2; ++bj) { const int col = col0 + bj * 128;
          const u32x4 g = *(const u32x4*)(MG + row * 4096 + col);
          const f32x4 v0 = acc[ai][bj][m][0], v1 = acc[ai][bj][m][1];
          float r[8];
          r[0] = sigmoidf_(lo2f(g[0])) * v0[0]; r[1] = sigmoidf_(hi2f(g[0])) * v0[1]; r[2] = sigmoidf_(lo2f(g[1])) * v0[2]; r[3] = sigmoidf_(hi2f(g[1])) * v0[3];
          r[4] = sigmoidf_(lo2f(g[2])) * v1[0]; r[5] = sigmoidf_(hi2f(g[2])) * v1[1]; r[6] = sigmoidf_(lo2f(g[3])) * v1[2]; r[7] = sigmoidf_(hi2f(g[3])) * v1[3];
          if (SECOND) { const u32x4 t = *(const u32x4*)(T1 + row * 2048 + col);
            r[0] += lo2f(t[0]); r[1] += hi2f(t[0]); r[2] += lo2f(t[1]); r[3] += hi2f(t[1]); r[4] += lo2f(t[2]); r[5] += hi2f(t[2]); r[6] += lo2f(t[3]); r[7] += hi2f(t[3]); }
          u32x4 o; o[0] = pk2(r[0], r[1]); o[1] = pk2(r[2], r[3]); o[2] = pk2(r[4], r[5]); o[3] = pk2(r[6], r[7]);
          *(u32x4*)(T1 + row * 2048 + col) = o; } }
  }
};
struct EpiG4 {
  static constexpr bool PERM = false, AFTER_DRAIN = false;
  const float* xin; const float* cin; float* xout; float* cout; const float* mod;
  DI void operator()(const f32x4 (&acc)[2][2][4][2], const pg8::Unit& u, int wr, int wc, int fr, int fq) const {
    const int row0 = u.pm * 256 + wr * 64 + fr, col0 = u.pn * 256 + wc * 32 + 4 * fq;
#pragma unroll
    for (int ai = 0; ai < 2; ++ai)
#pragma unroll
      for (int m = 0; m < 4; ++m) { const int row = row0 + ai * 128 + m * 16;
        const float* src; float* dst; const float* gate;
        if (row < NLAT) { src = xin + (size_t)row * 2048; dst = xout + (size_t)row * 2048; gate = mod + (row >> 12) * 6144 + 4096; }
        else { src = cin + (size_t)(row - NLAT) * 2048; dst = cout + (size_t)(row - NLAT) * 2048; gate = mod + 4 * 6144 + 4096; }
#pragma unroll
        for (int bj = 0; bj < 2; ++bj)
#pragma unroll
          for (int n = 0; n < 2; ++n) { const int col = col0 + bj * 128 + n * 16;
            const f32x4 xv = *(const f32x4*)(src + col), gv = *(const f32x4*)(gate + col);
            *(f32x4*)(dst + col) = xv + gv * acc[ai][bj][m][n]; } }
  }
};

__device__ void phase_mod(const Params& p, unsigned char* shm) {
  float* sc = (float*)shm; float* red = sc + 5 * 2048;
  const int tid = otid(p.wid);
  for (int i = tid; i < 5 * 2048; i += 512) { const int j = i >> 11, k = i & 2047; const float v = (j < 4) ? p.c[j * 2048 + k] : p.c_ctx[k]; sc[i] = v / (1.f + expf(-v)); }
  __syncthreads();
  { const int i = blockIdx.x * 512 + tid; if (i < 4096) { const int pos = i >> 6, j = i & 63; const float inv = 1.f / powf(10000.f, (float)j / 64.f); float sn, cn; sincosf((float)pos * inv, &sn, &cn); ((float2*)(p.ws + OFF_CS))[i] = make_float2(cn, sn); } }
  float* mod = (float*)(p.ws + OFF_MOD);
  const int cq = tid & 7, ks = tid >> 3;
  for (int it = blockIdx.x; it < 384; it += gridDim.x) {
    const int l = it / 192, nb = (it % 192) * 32;
    const float* W = p.ada_w + (size_t)l * 2048 * 6144 + nb + cq * 4;
    float acc[5][4];
#pragma unroll
    for (int j = 0; j < 5; ++j) { acc[j][0] = 0.f; acc[j][1] = 0.f; acc[j][2] = 0.f; acc[j][3] = 0.f; }
#pragma unroll 4
    for (int kk = 0; kk < 32; ++kk) { const int k = ks * 32 + kk; const float4 w = *(const float4*)(W + (size_t)k * 6144);
#pragma unroll
      for (int j = 0; j < 5; ++j) { const float s = sc[j * 2048 + k]; acc[j][0] += s * w.x; acc[j][1] += s * w.y; acc[j][2] += s * w.z; acc[j][3] += s * w.w; } }
#pragma unroll
    for (int j = 0; j < 5; ++j)
#pragma unroll
      for (int e = 0; e < 4; ++e) red[ks * 160 + j * 32 + cq * 4 + e] = acc[j][e];
    __syncthreads();
    if (tid < 160) { float s = 0.f; for (int q = 0; q < 64; ++q) s += red[q * 160 + tid]; const int j = tid >> 5, n = nb + (tid & 31); mod[(l * 5 + j) * 6144 + n] = s + p.ada_b[l * 6144 + n]; }
    __syncthreads();
  }
}

__device__ void cvt_group(int wid, const float* W, bf16_t* Wt, int K, int N, int k0, int n0, float scale, float* tile, bool perm) {
  const int tid = otid(wid);
  float4 v[8];
  int nsrc = n0 + (tid & 15) * 4;
  if (perm) { const int pc = (n0 & 255) + (tid & 15) * 4, r = pc & 127; nsrc = (n0 & ~255) + (pc & 128) + (r >> 3) * 4 + 64 * ((r >> 2) & 1); }
#pragma unroll
  for (int q = 0; q < 4; ++q)
#pragma unroll
    for (int rr = 0; rr < 2; ++rr) { const int k = (tid >> 4) + 32 * rr; v[q * 2 + rr] = *(const float4*)(W + (size_t)(k0 + q * 64 + k) * N + nsrc); }
#pragma unroll
  for (int q = 0; q < 4; ++q)
#pragma unroll
    for (int rr = 0; rr < 2; ++rr) { const int k = (tid >> 4) + 32 * rr, n = (tid & 15) * 4; float* t = tile + q * 4160 + k * 65 + n; const float4 x = v[q * 2 + rr]; t[0] = x.x; t[1] = x.y; t[2] = x.z; t[3] = x.w; }
  __syncthreads();
#pragma unroll
  for (int q = 0; q < 4; ++q) { const int n = tid >> 3, k8 = (tid & 7) * 8; const float* t = tile + q * 4160; u32x4 o;
#pragma unroll
    for (int e = 0; e < 4; ++e) o[e] = pk2(t[(k8 + 2 * e) * 65 + n] * scale, t[(k8 + 2 * e + 1) * 65 + n] * scale);
    *(u32x4*)(Wt + (size_t)(n0 + n) * K + k0 + q * 64 + k8) = o; }
  __syncthreads();
}
__device__ void phase_cvt(const Params& p, int l, unsigned char* shm) {
  float* tile = (float*)shm;
  for (int it = blockIdx.x; it < 4096; it += gridDim.x) {
    if (it < 3072) { const int kg = it & 7, n0 = (it >> 3) * 64;
      cvt_group(p.wid, p.w_in + (size_t)l * DM * INW, (bf16_t*)(p.ws + OFF_WTIN), DM, INW, kg * 256, n0, (n0 >= 2048 && n0 < 4096) ? 0.0625f : 1.f, tile, n0 < 4096); }
    else if (it < 3328) { const int e = it - 3072; cvt_group(p.wid, p.w_hy_out + (size_t)l * DM * DM, (bf16_t*)(p.ws + OFF_WTHY), DM, DM, (e & 7) * 256, (e >> 3) * 64, 1.f, tile, false); }
    else if (it < 3840) { const int e = it - 3328; cvt_group(p.wid, p.w_ret_out + (size_t)l * 4096 * DM, (bf16_t*)(p.ws + OFF_WTRET), 4096, DM, (e & 15) * 256, (e >> 4) * 64, 1.f, tile, false); }
    else { const int e = it - 3840; cvt_group(p.wid, p.w_o + (size_t)l * DM * DM, (bf16_t*)(p.ws + OFF_WTO), DM, DM, (e & 7) * 256, (e >> 3) * 64, 1.f, tile, false); }
  }
}

DI void filt_item(const Params& p, int l, int Ls, int T, bool isctx, unsigned char* shm) {
  float* z = (float*)shm; float* ha = z + 17 * 36; float* hb = ha + 17 * 64;
  const int tid = otid(p.wid);
  const float* w1 = p.fw1 + l * 33 * 64; const float* b1 = p.fb1 + l * 64; const float* w2 = p.fw2 + l * 4096; const float* b2 = p.fb2 + l * 64;
  const float* w3 = p.fw3 + l * 4096; const float* b3 = p.fb3 + l * 64; const float* fq = p.ffreq + l * 64; const float* wout = p.fwout + (size_t)l * 64 * 4096;
  float* w1s = z + 2816; float* w2s = w1s + 2112; float* w3s = w2s + 4096;
  { const float4 a0 = ((const float4*)w2)[tid], a1 = ((const float4*)w2)[tid + 512], b0 = ((const float4*)w3)[tid], b1 = ((const float4*)w3)[tid + 512];
    const float4 c0 = ((const float4*)w1)[tid]; float4 c1 = c0; if (tid < 16) c1 = ((const float4*)w1)[tid + 512];
    ((float4*)w2s)[tid] = a0; ((float4*)w2s)[tid + 512] = a1; ((float4*)w3s)[tid] = b0; ((float4*)w3s)[tid + 512] = b1; ((float4*)w1s)[tid] = c0; if (tid < 16) ((float4*)w1s)[tid + 512] = c1; }
  for (int i = tid; i < 17 * 33; i += 512) { const int pl = i / 33, f = i % 33; int pp = T * 16 + pl; if (pp > Ls - 1) pp = Ls - 1;
    float val;
    if (f == 0) val = (float)pp / (float)(Ls - 1);
    else { const int j = (f - 1) & 15; const float fj = 1e-4f + (float)j * ((15.f - 1e-4f) / 15.f); const float ang = 6.283185307179586f * (float)pp / (float)Ls; const float a = fj * ang; val = (f <= 16) ? cosf(a) : -sinf(a); }
    z[pl * 36 + f] = val; }
  __syncthreads();
  for (int idx = tid; idx < 17 * 16; idx += 512) { const int pl = idx >> 4, j0 = (idx & 15) * 4; float a[4] = {0.f, 0.f, 0.f, 0.f};
#pragma unroll 3
    for (int k = 0; k < 33; ++k) { const float v = z[pl * 36 + k]; const float4 w = *(const float4*)(w1s + k * 64 + j0); a[0] += v * w.x; a[1] += v * w.y; a[2] += v * w.z; a[3] += v * w.w; }
#pragma unroll
    for (int e = 0; e < 4; ++e) ha[pl * 64 + j0 + e] = sinf(fq[j0 + e] * (a[e] + b1[j0 + e])); }
  __syncthreads();
  for (int idx = tid; idx < 17 * 16; idx += 512) { const int pl = idx >> 4, j0 = (idx & 15) * 4; float a[4] = {0.f, 0.f, 0.f, 0.f};
#pragma unroll 4
    for (int k = 0; k < 64; ++k) { const float v = ha[pl * 64 + k]; const float4 w = *(const float4*)(w2s + k * 64 + j0); a[0] += v * w.x; a[1] += v * w.y; a[2] += v * w.z; a[3] += v * w.w; }
#pragma unroll
    for (int e = 0; e < 4; ++e) hb[pl * 64 + j0 + e] = sinf(fq[j0 + e] * (a[e] + b2[j0 + e])); }
  __syncthreads();
  for (int idx = tid; idx < 17 * 16; idx += 512) { const int pl = idx >> 4, j0 = (idx & 15) * 4; float a[4] = {0.f, 0.f, 0.f, 0.f};
#pragma unroll 4
    for (int k = 0; k < 64; ++k) { const float v = hb[pl * 64 + k]; const float4 w = *(const float4*)(w3s + k * 64 + j0); a[0] += v * w.x; a[1] += v * w.y; a[2] += v * w.z; a[3] += v * w.w; }
#pragma unroll
    for (int e = 0; e < 4; ++e) ha[pl * 64 + j0 + e] = sinf(fq[j0 + e] * (a[e] + b3[j0 + e])); }
  __syncthreads();
  const int cb = tid * 4;
  const float mind = logf(0.01f) / 1.5f, maxd = logf(0.01f) / 0.3f;
  bf16_t* G = (bf16_t*)(p.ws + OFF_G + (size_t)l * G_LAYER); float* GC = (float*)(p.ws + OFF_GC);
  float delta[4];
#pragma unroll
  for (int cc = 0; cc < 4; ++cc) delta[cc] = fabsf(mind + (float)(cb + cc) * ((maxd - mind) / 2047.f));
#pragma unroll 1
  for (int pgh = 0; pgh < 4; ++pgh) {
    const int pg = pgh >> 1; const bool isb = (pgh & 1) != 0; const int c4 = cb + (isb ? 2048 : 0);
    const int plb = pg * 8;
    float acc[8][4];
#pragma unroll
    for (int e = 0; e < 8; ++e) { acc[e][0] = 0.f; acc[e][1] = 0.f; acc[e][2] = 0.f; acc[e][3] = 0.f; }
    float4 wA[8], wB[8];
#define FILT_LOAD(buf, kb_) do { _Pragma("unroll") for (int j = 0; j < 8; ++j) buf[j] = *(const float4*)(wout + ((kb_) * 8 + j) * 4096 + c4); } while (0)
#define FILT_FMA(buf, kb_) do { _Pragma("unroll") for (int j = 0; j < 8; ++j) { const float4 wa = buf[j]; const int k = (kb_) * 8 + j; \
      _Pragma("unroll") for (int e = 0; e < 8; ++e) { const float h = ha[(plb + e) * 64 + k]; acc[e][0] += h * wa.x; acc[e][1] += h * wa.y; acc[e][2] += h * wa.z; acc[e][3] += h * wa.w; } } } while (0)
    FILT_LOAD(wA, 0);
#pragma unroll 1
    for (int kb = 0; kb < 8; kb += 2) {
      FILT_LOAD(wB, kb + 1);
      asm volatile("" ::: "memory");
      FILT_FMA(wA, kb);
      asm volatile("" ::: "memory");
      if (kb + 2 < 8) FILT_LOAD(wA, kb + 2);
      asm volatile("" ::: "memory");
      FILT_FMA(wB, kb + 1);
      asm volatile("" ::: "memory");
    }
#undef FILT_LOAD
#undef FILT_FMA
    const int pp0 = T * 16 + plb;
#pragma unroll
    for (int e = 0; e < 8; ++e) { const int pp = pp0 + e; const float tt = (float)pp / (float)(Ls - 1);
      if (pp < Ls && !(isb && pp == 0)) {
        float v[4];
#pragma unroll
        for (int cc = 0; cc < 4; ++cc) v[cc] = acc[e][cc] * __expf(-tt * delta[cc]);
        if (!isctx) { const int m = isb ? LOFF + pp : LOFF - pp; u32x2 o; o[0] = pk2(v[0], v[1]); o[1] = pk2(v[2], v[3]); *(u32x2*)(G + (size_t)m * 2048 + cb) = o; }
        else { const int idx = isb ? 256 - pp : 256 + pp;
#pragma unroll
          for (int cc = 0; cc < 4; ++cc) GC[(size_t)(cb + cc) * 512 + idx] = v[cc]; }
      }
    }
  }
  __syncthreads();
}
__device__ void phase_filters(const Params& p, unsigned char* shm) {
  for (int it = blockIdx.x; it < 528; it += gridDim.x) { const bool ic = it >= 512; filt_item(p, ic ? 0 : (it >> 8), ic ? CTXL : SEQ, ic ? it - 512 : (it & 255), ic, shm); }
}

__device__ void phase_norm(const Params& p, int l) {
  const int lane = otid(p.wid) & 63, gw = blockIdx.x * 8 + (otid(p.wid) >> 6), nw = gridDim.x * 8;
  const float* mod = (const float*)(p.ws + OFF_MOD) + (size_t)l * 5 * 6144; const float* lng = p.ln_g + l * 2048;
  bf16_t* H = (bf16_t*)(p.ws + OFF_H);
  for (int r = gw; r < MT; r += nw) {
    const float* src; int j;
    if (r < NLAT) { src = (l == 0 ? p.x : p.out) + (size_t)r * 2048; j = r >> 12; }
    else { src = (l == 0 ? p.ctx : (const float*)(p.ws + OFF_CTXR)) + (size_t)(r - NLAT) * 2048; j = 4; }
    const float* sh = mod + j * 6144; const float* sc = sh + 2048;
    float4 v[8]; float ss = 0.f;
#pragma unroll
    for (int i = 0; i < 8; ++i) { v[i] = *(const float4*)(src + i * 256 + lane * 4); ss += v[i].x * v[i].x + v[i].y * v[i].y + v[i].z * v[i].z + v[i].w * v[i].w; }
    ss = wsum(ss, lane);
    const float rs = rsqrtf(ss * (1.f / 2048.f) + 1e-6f);
#pragma unroll
    for (int i = 0; i < 8; ++i) { const int col = i * 256 + lane * 4; const float4 g = *(const float4*)(lng + col), a = *(const float4*)(sc + col), b = *(const float4*)(sh + col);
      u32x2 o; o[0] = pk2(v[i].x * rs * g.x * (1.f + a.x) + b.x, v[i].y * rs * g.y * (1.f + a.y) + b.y); o[1] = pk2(v[i].z * rs * g.z * (1.f + a.z) + b.z, v[i].w * rs * g.w * (1.f + a.w) + b.w);
      *(u32x2*)(H + (size_t)r * 2048 + col) = o; }
  }
}
__device__ void phase_final(const Params& p) {
  const int lane = otid(p.wid) & 63, gw = blockIdx.x * 8 + (otid(p.wid) >> 6), nw = gridDim.x * 8;
  for (int r = gw; r < NLAT; r += nw) {
    float* src = p.out + (size_t)r * 2048; float4 v[8]; float ss = 0.f;
#pragma unroll
    for (int i = 0; i < 8; ++i) { v[i] = *(const float4*)(src + i * 256 + lane * 4); ss += v[i].x * v[i].x + v[i].y * v[i].y + v[i].z * v[i].z + v[i].w * v[i].w; }
    ss = wsum(ss, lane);
    const float rs = rsqrtf(ss * (1.f / 2048.f) + 1e-6f);
#pragma unroll
    for (int i = 0; i < 8; ++i) { const int col = i * 256 + lane * 4; const float4 g = *(const float4*)(p.final_g + col); float4 o; o.x = v[i].x * rs * g.x; o.y = v[i].y * rs * g.y; o.z = v[i].z * rs * g.z; o.w = v[i].w * rs * g.w; *(float4*)(src + col) = o; }
  }
}

DI void tok_tile(int tk, int& b, int& t0, bool& isctx) { if (tk < 256) { b = tk >> 6; t0 = (tk & 63) * 64; isctx = false; } else { b = (tk - 256) >> 2; t0 = ((tk - 256) & 3) * 64; isctx = true; } }
DI int tok_row(int b, int t, bool isctx) { return isctx ? NLAT + b * CTXL + t : b * SEQ + t; }

__device__ void phase_prep(const Params& p, int l, unsigned char* shm, int mask) {
  const int tid = otid(p.wid), lane = tid & 63;
  unsigned char* reg2 = shm + 32768;
  (void)lane;
  if (mask & 4) { float* in = (float*)reg2;
    bf16_t* ut = (bf16_t*)(reg2 + 3 * 66 * 64 * 4);
    const bf16_t* PHY = (const bf16_t*)(p.ws + OFF_PHY); bf16_t* HV = (bf16_t*)(p.ws + OFF_HV); bf16_t* HX0 = (bf16_t*)(p.ws + OFF_HX0);
    const float* cw = p.conv_w + (size_t)l * 3 * 6144; const float* cb = p.conv_b + (size_t)l * 6144;
    const int nit = ((l == 0) ? 272 : 256) * 32;
    u32x4 pre[4];
#define PC_DECODE(it_) const int tk = (it_) >> 5, c0 = ((it_) & 31) * 64; int b, t0; bool isctx; tok_tile(tk, b, t0, isctx); const int Ls = isctx ? CTXL : SEQ; const int row0 = tok_row(b, t0, isctx);
#define PC_LOAD(it_) do { PC_DECODE(it_) _Pragma("unroll") for (int e = 0; e < 4; ++e) { const int id = tid + 512 * e; const int pi = id / 528, rem = id % 528, rr = rem >> 3, pc = rem & 7; const int t = t0 - 1 + rr; \
        u32x4 v; v[0] = 0u; v[1] = 0u; v[2] = 0u; v[3] = 0u; if (id < 1584 && t >= 0 && t < Ls) v = *(const u32x4*)(PHY + (size_t)(row0 - 1 + rr) * 6144 + pi * 2048 + c0 + pc * 8); pre[e] = v; } } while (0)
    if ((int)blockIdx.x < nit) PC_LOAD((int)blockIdx.x);
    for (int it = blockIdx.x; it < nit; it += gridDim.x) {
      PC_DECODE(it) (void)Ls;
#pragma unroll
      for (int e = 0; e < 4; ++e) { const int id = tid + 512 * e; if (id < 1584) { const int pi = id / 528, rem = id % 528, rr = rem >> 3, pc = rem & 7; const u32x4 v = pre[e];
        float* d = in + (pi * 66 + rr) * 64 + pc * 8;
        *(float4*)d = make_float4(lo2f(v[0]), hi2f(v[0]), lo2f(v[1]), hi2f(v[1])); *(float4*)(d + 4) = make_float4(lo2f(v[2]), hi2f(v[2]), lo2f(v[3]), hi2f(v[3])); } }
      if (it + (int)gridDim.x < nit) PC_LOAD(it + (int)gridDim.x);
      __syncthreads();
      { const int cg8 = (tid & 7) * 8, tok = tid >> 3;
        float cv[3][8];
#pragma unroll
        for (int pi = 0; pi < 3; ++pi) { const float* wp = cw + pi * 2048 + c0 + cg8;
          const float4 ba = *(const float4*)(cb + pi * 2048 + c0 + cg8), bb = *(const float4*)(cb + pi * 2048 + c0 + cg8 + 4);
          cv[pi][0] = ba.x; cv[pi][1] = ba.y; cv[pi][2] = ba.z; cv[pi][3] = ba.w; cv[pi][4] = bb.x; cv[pi][5] = bb.y; cv[pi][6] = bb.z; cv[pi][7] = bb.w;
#pragma unroll
          for (int k = 0; k < 3; ++k) { const float4 wa = *(const float4*)(wp + k * 6144), wb = *(const float4*)(wp + k * 6144 + 4);
            const float* ip = in + (pi * 66 + tok + k) * 64 + cg8; const float4 xa = *(const float4*)ip, xb = *(const float4*)(ip + 4);
            cv[pi][0] += xa.x * wa.x; cv[pi][1] += xa.y * wa.y; cv[pi][2] += xa.z * wa.z; cv[pi][3] += xa.w * wa.w; cv[pi][4] += xb.x * wb.x; cv[pi][5] += xb.y * wb.y; cv[pi][6] += xb.z * wb.z; cv[pi][7] += xb.w * wb.w; } }
        u32x4 hvp, hxp;
#pragma unroll
        for (int e = 0; e < 4; ++e) { hvp[e] = pk2(cv[0][2 * e] * cv[2][2 * e], cv[0][2 * e + 1] * cv[2][2 * e + 1]); hxp[e] = pk2(cv[1][2 * e], cv[1][2 * e + 1]); }
        *(u32x4*)(HV + (size_t)(row0 + tok) * 2048 + c0 + cg8) = hvp; *(u32x4*)(HX0 + (size_t)(row0 + tok) * 2048 + c0 + cg8) = hxp;
#pragma unroll
        for (int e = 0; e < 4; ++e) { ut[(cg8 + 2 * e) * 66 + tok] = (bf16_t)(hvp[e] & 0xffffu); ut[(cg8 + 2 * e + 1) * 66 + tok] = (bf16_t)(hvp[e] >> 16); } }
      __syncthreads();
      { const int c = tid >> 3, pc = tid & 7; u32x4 o;
#pragma unroll
        for (int e = 0; e < 4; ++e) o[e] = (unsigned)ut[c * 66 + pc * 8 + 2 * e] | ((unsigned)ut[c * 66 + pc * 8 + 2 * e + 1] << 16);
        bf16_t* dst = isctx ? (bf16_t*)(p.ws + OFF_UTC) + ((size_t)(c0 + c) * NB + b) * CTXL + t0 + pc * 8 : (bf16_t*)(p.ws + OFF_UT) + ((size_t)(c0 + c) * NB + b) * SEQ + t0 + pc * 8;
        *(u32x4*)dst = o; }
    }
    __syncthreads();
#undef PC_DECODE
#undef PC_LOAD
  }
}

__device__ void phase_post(const Params& p, int l, unsigned char* shm, int mask) {
  const int tid = otid(p.wid), lane = tid & 63;
  const bf16_t* HV = (const bf16_t*)(p.ws + OFF_HV); const bf16_t* HX0 = (const bf16_t*)(p.ws + OFF_HX0); const bf16_t* PHG = (const bf16_t*)(p.ws + OFF_PHG);
  bf16_t* AH = (bf16_t*)(p.ws + OFF_H); const float* hbias = p.hy_bias + l * 2048;
  if (mask & 1) { float* yt = (float*)shm;
    const bf16_t* UT = (const bf16_t*)(p.ws + OFF_UT);
    const int nit = 256 * 32; u32x4 pre;
#define PA_LOAD(it_) do { const int tk_ = (it_) >> 5, c0_ = ((it_) & 31) * 64, b_ = tk_ >> 6, t0_ = (tk_ & 63) * 64; pre = *(const u32x4*)(UT + ((size_t)(c0_ + (tid >> 3)) * NB + b_) * SEQ + t0_ + (tid & 7) * 8); } while (0)
    if ((int)blockIdx.x < nit) PA_LOAD((int)blockIdx.x);
    for (int it = blockIdx.x; it < nit; it += gridDim.x) {
      const int tk = it >> 5, c0 = (it & 31) * 64, b = tk >> 6, t0 = (tk & 63) * 64, row0 = b * SEQ + t0;
      { const int c = tid >> 3, pc = tid & 7; const u32x4 v = pre; float* d = yt + (pc * 8) * 65 + c;
        d[0] = lo2f(v[0]); d[65] = hi2f(v[0]); d[130] = lo2f(v[1]); d[195] = hi2f(v[1]); d[260] = lo2f(v[2]); d[325] = hi2f(v[2]); d[390] = lo2f(v[3]); d[455] = hi2f(v[3]); }
      if (it + (int)gridDim.x < nit) PA_LOAD(it + (int)gridDim.x);
      __syncthreads();
      { const int cg8 = (tid & 7) * 8, tok = tid >> 3; const size_t o = (size_t)(row0 + tok) * 2048 + c0 + cg8;
        const u32x4 hv = *(const u32x4*)(HV + o), hx = *(const u32x4*)(HX0 + o), hg = *(const u32x4*)(PHG + o);
        const float4 ba = *(const float4*)(hbias + c0 + cg8), bb = *(const float4*)(hbias + c0 + cg8 + 4);
        const float hb[8] = {ba.x, ba.y, ba.z, ba.w, bb.x, bb.y, bb.z, bb.w}; const float* yp = yt + tok * 65 + cg8; u32x4 r;
#pragma unroll
        for (int e = 0; e < 4; ++e) { const float a0 = (yp[2 * e] + hb[2 * e] * lo2f(hv[e])) * lo2f(hx[e]) * siluf_(lo2f(hg[e])), a1 = (yp[2 * e + 1] + hb[2 * e + 1] * hi2f(hv[e])) * hi2f(hx[e]) * siluf_(hi2f(hg[e])); r[e] = pk2(a0, a1); }
        *(u32x4*)(AH + o) = r; }
      __syncthreads();
    }
#undef PA_LOAD
  }
  if (l == 0 && (mask & 2)) { float* gc = (float*)shm; float* us = gc + 32 * 512;
    const bf16_t* UTC = (const bf16_t*)(p.ws + OFF_UTC); const float* GC = (const float*)(p.ws + OFF_GC);
    for (int it = blockIdx.x; it < 16 * 64; it += gridDim.x) {
      const int tk = it >> 6, c0 = (it & 63) * 32, b = tk >> 2, t0 = (tk & 3) * 64, row0 = NLAT + b * CTXL + t0;
#pragma unroll 8
      for (int i = tid; i < 32 * 512; i += 512) gc[i] = GC[(size_t)(c0 + (i >> 9)) * 512 + (i & 511)];
#pragma unroll 8
      for (int i = tid; i < 32 * 256; i += 512) us[i] = bf2f(UTC[((size_t)(c0 + (i >> 8)) * NB + b) * CTXL + (i & 255)]);
      __syncthreads();
      { const int t = tid & 63, cg4 = tid >> 6;
#pragma unroll 1
        for (int e = 0; e < 4; ++e) { const int c = cg4 * 4 + e; const float* g = gc + c * 512 + 256 + t0 + t; const float* u = us + c * 256; float a = 0.f;
#pragma unroll 8
          for (int s = 0; s < 256; ++s) a += u[s] * g[-s];
          const size_t o = (size_t)(row0 + t) * 2048 + c0 + c; const float hv = bf2f(HV[o]);
          AH[o] = f2bf((a + hbias[c0 + c] * hv) * bf2f(HX0[o]) * siluf_(bf2f(PHG[o]))); } }
      __syncthreads();
    }
  }
  if (mask & 4) { bf16_t* OF = (bf16_t*)(p.ws + OFF_OF); const bf16_t* OB = (const bf16_t*)(p.ws + OFF_OB); const bf16_t* RG = (const bf16_t*)(p.ws + OFF_PRG);
    const int gw = blockIdx.x * 8 + (tid >> 6), nw = gridDim.x * 8; const int nrows = (l == 0) ? MT : NLAT;
#pragma unroll 2
    for (int it = gw; it < nrows * 8; it += nw) { const size_t o = (size_t)(it >> 3) * 4096 + (it & 7) * 512 + lane * 8;
      const u32x4 a = *(const u32x4*)(OF + o), bq = *(const u32x4*)(OB + o), g = *(const u32x4*)(RG + o);
      float v[8]; float ss = 0.f;
#pragma unroll
      for (int e = 0; e < 4; ++e) { v[2 * e] = lo2f(a[e]) + lo2f(bq[e]); v[2 * e + 1] = hi2f(a[e]) + hi2f(bq[e]); ss += v[2 * e] * v[2 * e] + v[2 * e + 1] * v[2 * e + 1]; }
      ss = wsum(ss, lane);
      const float rs = rsqrtf(ss * (1.f / 512.f) + 1e-6f);
      u32x4 r;
#pragma unroll
      for (int e = 0; e < 4; ++e) r[e] = pk2(v[2 * e] * rs * siluf_(lo2f(g[e])), v[2 * e + 1] * rs * siluf_(hi2f(g[e])));
      *(u32x4*)(OF + o) = r; }
  }
}

__device__ void phase_conv(const Params& p, int l, unsigned char* shm) {
  const int tid = otid(p.wid), lane = tid & 63, wid = tid >> 6;
  bf16_t* Gs = (bf16_t*)shm;
  bf16_t* Us = (bf16_t*)(shm + 2 * GLEN * 2);
  { unsigned zz = 0u; asm volatile("" : "+v"(zz)); u32x4 z; z[0] = zz; z[1] = zz; z[2] = zz; z[3] = zz; for (int i = tid; i < 2 * 4 * USTR / 8; i += 512) ((u32x4*)Us)[i] = z; }
  __syncthreads();
  const int ch = wid >> 2, q = wid & 3, i = lane & 31, g = lane >> 5, a_l = i >> 2, b = i & 3;
  const bf16_t* G = (const bf16_t*)(p.ws + OFF_G + (size_t)l * G_LAYER); bf16_t* UT = (bf16_t*)(p.ws + OFF_UT);
  const int mb = LOFF - i + 8 * g - 128 * (8 * q + 7);
  const unsigned sh = (unsigned)(mb & 1) * 16u;
  const unsigned* Gd = (const unsigned*)(Gs + ch * GLEN) + (mb >> 1);
  const bf16_t* Ub = Us + (ch * 4 + b) * USTR + 136 * (a_l + 1) + 8 * g;
#define CONV_LDFRAG(dst, n) do { const unsigned* q_ = Gd + 8 * (n); const unsigned d0 = q_[0], d1 = q_[1], d2 = q_[2], d3 = q_[3], d4 = q_[4]; u32x4 r_; \
    r_[0] = __builtin_amdgcn_alignbit(d1, d0, sh); r_[1] = __builtin_amdgcn_alignbit(d2, d1, sh); r_[2] = __builtin_amdgcn_alignbit(d3, d2, sh); r_[3] = __builtin_amdgcn_alignbit(d4, d3, sh); \
    dst = __builtin_bit_cast(bf16x8, r_); } while (0)
  unsigned pgv[17]; u32x4 puv[8];
#define CONV_PREFETCH(pr_) do { \
    _Pragma("unroll") for (int e = 0; e < 17; ++e) { const int m = tid + 512 * e; unsigned v = 0u; if (m >= 33 && m <= 8223) v = *(const unsigned*)(G + (size_t)m * 2048 + 2 * (pr_)); pgv[e] = v; } \
    _Pragma("unroll") for (int e = 0; e < 8; ++e) { const int id = tid + 512 * e, cc = id >> 11, bb = (id >> 9) & 3, s8 = id & 511; puv[e] = *(const u32x4*)(UT + ((size_t)((pr_) * 2 + cc) * 4 + bb) * SEQ + s8 * 8); } } while (0)
  if ((int)blockIdx.x < 1024) CONV_PREFETCH((int)blockIdx.x);
  for (int pr = blockIdx.x; pr < 1024; pr += gridDim.x) {
#pragma unroll
    for (int e = 0; e < 17; ++e) { const int m = tid + 512 * e; if (m < GLEN) { Gs[m] = (bf16_t)(pgv[e] & 0xffffu); Gs[GLEN + m] = (bf16_t)(pgv[e] >> 16); } }
#pragma unroll
    for (int e = 0; e < 8; ++e) { const int id = tid + 512 * e, cc = id >> 11, bb = (id >> 9) & 3, s8 = id & 511; const int sp = 1024 + s8 * 8;
      *(u32x4*)(Us + (cc * 4 + bb) * USTR + sp + 8 * (sp >> 7)) = puv[e]; }
    __syncthreads();
    if (pr + (int)gridDim.x < 1024) CONV_PREFETCH(pr + (int)gridDim.x);
    bf16x8 W[8]; f32x16 acc[4];
#pragma unroll
    for (int h = 0; h < 4; ++h)
#pragma unroll
      for (int e = 0; e < 16; ++e) acc[h][e] = 0.f;
    CONV_LDFRAG(W[2], -6); CONV_LDFRAG(W[3], -5); CONV_LDFRAG(W[4], -4); CONV_LDFRAG(W[5], -3); CONV_LDFRAG(W[6], -2); CONV_LDFRAG(W[7], -1);
#pragma unroll 1
    for (int it = 0; it < 39; ++it) {
#pragma unroll
      for (int u = 0; u < 8; ++u) {
        CONV_LDFRAG(W[u], it * 8 + u);
        const bf16x8 bf = *(const bf16x8*)(Ub + 136 * it + 16 * u);
#pragma unroll
        for (int h = 0; h < 4; ++h) acc[h] = __builtin_amdgcn_mfma_f32_32x32x16_bf16(W[(u - 2 * h) & 7], bf, acc[h], 0, 0, 0);
      }
    }
    { bf16_t* yrow = UT + ((size_t)(pr * 2 + ch) * 4 + b) * SEQ + 128 * (8 * q + a_l) + 4 * g;
#pragma unroll
      for (int h = 0; h < 4; ++h)
#pragma unroll
        for (int rq = 0; rq < 4; ++rq) { u32x2 o; o[0] = pk2(acc[h][4 * rq], acc[h][4 * rq + 1]); o[1] = pk2(acc[h][4 * rq + 2], acc[h][4 * rq + 3]); *(u32x2*)(yrow + 32 * h + 8 * rq) = o; } }
    __syncthreads();
  }
#undef CONV_LDFRAG
#undef CONV_PREFETCH
}

template <int KD> DI f32x16 mma_tile(f32x16 acc, const bf16_t* A, int lda, const bf16_t* B, int ldb, int lane) {
  const int r = lane & 31, g8 = (lane >> 5) * 8; const bf16_t* ap = A + r * lda + g8; const bf16_t* bp = B + r * ldb + g8;
#pragma unroll 4
  for (int k0 = 0; k0 < KD; k0 += 16) acc = __builtin_amdgcn_mfma_f32_32x32x16_bf16(*(const bf16x8*)(ap + k0), *(const bf16x8*)(bp + k0), acc, 0, 0, 0);
  return acc;
}
DI bf16x8 tr_frag(const bf16_t* img, int ld, int lane) {
  const int h = lane >> 5, blk = (lane >> 4) & 1, q = (lane & 15) >> 2, pp = lane & 3;
  const bf16_t* a = img + (8 * h + q) * ld + 16 * blk + 4 * pp;
  const s16x4 r0 = __builtin_amdgcn_ds_read_tr16_b64_v4i16((__attribute__((address_space(3))) s16x4*)a);
  const s16x4 r1 = __builtin_amdgcn_ds_read_tr16_b64_v4i16((__attribute__((address_space(3))) s16x4*)(a + 4 * ld));
  bf16x8 f; f[0] = r0[0]; f[1] = r0[1]; f[2] = r0[2]; f[3] = r0[3]; f[4] = r1[0]; f[5] = r1[1]; f[6] = r1[2]; f[7] = r1[3]; return f;
}
__device__ void phase_ret(const Params& p, int l, unsigned char* shm) {
  constexpr int QS = 264, VS = 144, TS = 72;
  const int tid = otid(p.wid), lane = tid & 63, wid = tid >> 6, g = lane >> 5;
  bf16_t* Qs = (bf16_t*)shm; bf16_t* Ks = Qs + 64 * QS; bf16_t* Vs = Ks + 64 * QS; bf16_t* Ps = Vs + 64 * VS; bf16_t* Sts = Ps + 64 * TS;
  const bf16_t* PQ = (const bf16_t*)(p.ws + OFF_PQ); const bf16_t* PK = (const bf16_t*)(p.ws + OFF_PK); const bf16_t* PV = (const bf16_t*)(p.ws + OFF_PV);
  for (int it0 = blockIdx.x; it0 < 256; it0 += gridDim.x) {
    int it = it0;
    if (gridDim.x == 256) { const int xcd = it0 & 7, idx = it0 >> 3; it = ((xcd + 8 * (idx >> 2)) << 2) | (idx & 3); }
    const int sl = it & 3, dir = (it >> 2) & 1, h = (it >> 3) & 7, b = it >> 6;
    const float lg = -expf(p.ret_decay[(l * 2 + dir) * 8 + h]);
    bf16_t* O = (bf16_t*)(p.ws + (dir ? OFF_OB : OFF_OF));
    for (int i = tid; i < 128 * QS / 2; i += 512) ((unsigned*)Sts)[i] = 0u;
    f32x16 S[4], cross;
#pragma unroll
    for (int x = 0; x < 4; ++x)
#pragma unroll
      for (int e = 0; e < 16; ++e) S[x][e] = 0.f;
#pragma unroll
    for (int e = 0; e < 16; ++e) cross[e] = 0.f;
    const float cd = __expf(lg * 64.f);
    const int tid2 = otid(p.wid), ln2 = tid2 & 63, g2 = ln2 >> 5, w2 = tid2 >> 6;
    float mk[16], dkv[2];
#pragma unroll
    for (int e = 0; e < 2; ++e) { const int tok = (tid2 >> 4) + 32 * e; dkv[e] = __expf(lg * (float)(dir ? tok : 63 - tok)); }
    const int wq = w2 & 3, s_tj = wq >> 1, s_ti = wq & 1;
    const int o_tc = w2 >> 1, o_ti = w2 & 1;
    { const int i = s_ti * 32 + (ln2 & 31);
#pragma unroll
      for (int e = 0; e < 16; ++e) { const int j = s_tj * 32 + (e & 3) + 8 * (e >> 2) + 4 * g2; const int diff = dir ? (j - i) : (i - j); mk[e] = diff >= 0 ? __expf(lg * (float)(dir ? -i : i - 63)) : 0.f; } }
    const int qi = o_ti * 32 + (ln2 & 31);
    const float qd = __expf(lg * (float)(dir ? 64 - qi : qi + 1));
    u32x4 rq[4], rk[4], rv[2];
    const unsigned qo_l = (unsigned)(tid >> 5) * 2048u + (unsigned)(h * 256 + (tid & 31) * 8);
    const unsigned vo_l = (unsigned)(tid >> 4) * 4096u + (unsigned)(h * 512 + sl * 128 + (tid & 15) * 8);
#define RET_CHUNK(step_, isctx_, t0_) do { if ((step_) < 4) { isctx_ = true; t0_ = (dir ? 3 - (step_) : (step_)) * 64; } else { isctx_ = false; const int cn_ = (step_) - 4; t0_ = (dir ? 63 - cn_ : cn_) * 64; } } while (0)
#define RET_LOAD(step_) do { bool ic_; int t0n_; RET_CHUNK(step_, ic_, t0n_); const unsigned rw_ = (unsigned)tok_row(b, t0n_, ic_); \
      _Pragma("unroll") for (int e = 0; e < 4; ++e) { rq[e] = *(const u32x4*)(PQ + (rw_ * 2048u + qo_l + (unsigned)e * 32768u)); rk[e] = *(const u32x4*)(PK + (rw_ * 2048u + qo_l + (unsigned)e * 32768u)); } \
      _Pragma("unroll") for (int e = 0; e < 2; ++e) rv[e] = *(const u32x4*)(PV + (rw_ * 4096u + vo_l + (unsigned)e * 131072u)); } while (0)
    RET_LOAD(0);
#pragma unroll 1
    for (int step = 0; step < 68; ++step) {
      bool isctx; int t0; RET_CHUNK(step, isctx, t0);
      const int row0 = tok_row(b, t0, isctx);
      __syncthreads();
#pragma unroll
      for (int e = 0; e < 4; ++e) { const int row = (tid >> 5) + 16 * e, pc = tid & 31; *(u32x4*)(Qs + row * QS + pc * 8) = rq[e]; *(u32x4*)(Ks + row * QS + pc * 8) = rk[e]; }
#pragma unroll
      for (int e = 0; e < 2; ++e) { u32x4 o;
#pragma unroll
        for (int w = 0; w < 4; ++w) o[w] = pk2(lo2f(rv[e][w]) * dkv[e], hi2f(rv[e][w]) * dkv[e]);
        *(u32x4*)(Vs + ((tid >> 4) + 32 * e) * VS + (tid & 15) * 8) = o; }
      if (step + 1 < 68) RET_LOAD(step + 1);
      __syncthreads();
      if (wid < 4) {
        f32x16 sc;
#pragma unroll
        for (int e = 0; e < 16; ++e) sc[e] = 0.f;
        sc = mma_tile<256>(sc, Ks + s_tj * 32 * QS, QS, Qs + s_ti * 32 * QS, QS, lane);
        const int i = s_ti * 32 + (lane & 31);
#pragma unroll
        for (int r4 = 0; r4 < 4; ++r4) { u32x2 o; o[0] = pk2(sc[4 * r4] * mk[4 * r4], sc[4 * r4 + 1] * mk[4 * r4 + 1]); o[1] = pk2(sc[4 * r4 + 2] * mk[4 * r4 + 2], sc[4 * r4 + 3] * mk[4 * r4 + 3]);
          *(u32x2*)(Ps + i * TS + s_tj * 32 + 8 * r4 + 4 * g) = o; }
      }
#pragma unroll
      for (int e = 0; e < 16; ++e) cross[e] = 0.f;
      cross = mma_tile<256>(cross, Sts + o_tc * 32 * QS, QS, Qs + o_ti * 32 * QS, QS, lane);
      __syncthreads();
      { f32x16 in_;
#pragma unroll
        for (int e = 0; e < 16; ++e) in_[e] = 0.f;
        const bf16_t* pb = Ps + (o_ti * 32 + (lane & 31)) * TS + 8 * g;
#pragma unroll
        for (int ks = 0; ks < 4; ++ks) in_ = __builtin_amdgcn_mfma_f32_32x32x16_bf16(tr_frag(Vs + 16 * ks * VS + 32 * o_tc, VS, lane), *(const bf16x8*)(pb + 16 * ks), in_, 0, 0, 0);
        const unsigned ob = (unsigned)(row0 + qi) * 4096u + (unsigned)(h * 512 + sl * 128 + o_tc * 32 + 4 * g);
#pragma unroll
        for (int r4 = 0; r4 < 4; ++r4) { u32x2 o; o[0] = pk2(in_[4 * r4] + qd * cross[4 * r4], in_[4 * r4 + 1] + qd * cross[4 * r4 + 1]); o[1] = pk2(in_[4 * r4 + 2] + qd * cross[4 * r4 + 2], in_[4 * r4 + 3] + qd * cross[4 * r4 + 3]);
          *(u32x2*)(O + (ob + (unsigned)(8 * r4))) = o; } }
      { bf16x8 ka[4];
#pragma unroll
        for (int ks = 0; ks < 4; ++ks) ka[ks] = tr_frag(Ks + 16 * ks * QS + 32 * wid, QS, lane);
#pragma unroll
        for (int x = 0; x < 4; ++x) {
#pragma unroll
          for (int e = 0; e < 16; ++e) S[x][e] *= cd;
#pragma unroll
          for (int ks = 0; ks < 4; ++ks) S[x] = __builtin_amdgcn_mfma_f32_32x32x16_bf16(ka[ks], tr_frag(Vs + 16 * ks * VS + 32 * x, VS, lane), S[x], 0, 0, 0);
          const int c = x * 32 + (lane & 31);
#pragma unroll
          for (int r4 = 0; r4 < 4; ++r4) { u32x2 o; o[0] = pk2(S[x][4 * r4], S[x][4 * r4 + 1]); o[1] = pk2(S[x][4 * r4 + 2], S[x][4 * r4 + 3]); *(u32x2*)(Sts + c * QS + wid * 32 + 8 * r4 + 4 * g) = o; } } }
    }
    __syncthreads();
  }
#undef RET_CHUNK
#undef RET_LOAD
}

template <int MODE> __device__ void ctx_gemm(const Params& p, const bf16_t* X, int ldx, const bf16_t* W, int K, unsigned char* shm) {
  constexpr int KC = 128, LD = KC + 8;
  const int tid = otid(p.wid), lane = tid & 63, wid = tid >> 6, g = lane >> 5;
  bf16_t* Xs = (bf16_t*)shm; bf16_t* Ws = Xs + 128 * LD;
  for (int tile = blockIdx.x; tile < 256; tile += gridDim.x) {
    const int tok0 = (tile >> 5) * 128, n0 = (tile & 31) * 64, wt = wid & 3, wn = wid >> 2;
    f32x16 acc;
#pragma unroll
    for (int e = 0; e < 16; ++e) acc[e] = 0.f;
    u32x4 xr[4], wr[2];
    const unsigned xo = (unsigned)(tok0 + (tid >> 4)) * (unsigned)ldx + (unsigned)((tid & 15) * 8);
    const unsigned wo = (unsigned)(n0 + (tid >> 4)) * (unsigned)K + (unsigned)((tid & 15) * 8);
#define CG_LOAD(kc_) do { _Pragma("unroll") for (int e = 0; e < 4; ++e) xr[e] = *(const u32x4*)(X + (xo + (unsigned)(32 * e) * (unsigned)ldx + (unsigned)((kc_) * KC))); \
      _Pragma("unroll") for (int e = 0; e < 2; ++e) wr[e] = *(const u32x4*)(W + (wo + (unsigned)(32 * e) * (unsigned)K + (unsigned)((kc_) * KC))); } while (0)
    CG_LOAD(0);
    const int nkc = K / KC;
#pragma unroll 1
    for (int kc = 0; kc < nkc; ++kc) {
      __syncthreads();
#pragma unroll
      for (int e = 0; e < 4; ++e) *(u32x4*)(Xs + ((tid >> 4) + 32 * e) * LD + (tid & 15) * 8) = xr[e];
#pragma unroll
      for (int e = 0; e < 2; ++e) *(u32x4*)(Ws + ((tid >> 4) + 32 * e) * LD + (tid & 15) * 8) = wr[e];
      if (kc + 1 < nkc) CG_LOAD(kc + 1);
      __syncthreads();
      acc = mma_tile<KC>(acc, Ws + wn * 32 * LD, LD, Xs + wt * 32 * LD, LD, lane);
    }
#undef CG_LOAD
    const int tok = tok0 + wt * 32 + (lane & 31), nb = n0 + wn * 32 + 4 * g;
    if (MODE < 2) {
      bf16_t* T1 = (bf16_t*)(p.ws + OFF_T1) + (size_t)(NLAT + tok) * 2048; const bf16_t* MG = (const bf16_t*)(p.ws + OFF_PMG) + (size_t)(NLAT + tok) * 4096 + (MODE ? 2048 : 0);
#pragma unroll
      for (int r4 = 0; r4 < 4; ++r4) { const int n = nb + 8 * r4; const u32x2 gg = *(const u32x2*)(MG + n);
        float r0 = sigmoidf_(lo2f(gg[0])) * acc[4 * r4], r1 = sigmoidf_(hi2f(gg[0])) * acc[4 * r4 + 1], r2 = sigmoidf_(lo2f(gg[1])) * acc[4 * r4 + 2], r3 = sigmoidf_(hi2f(gg[1])) * acc[4 * r4 + 3];
        if (MODE == 1) { const u32x2 t = *(const u32x2*)(T1 + n); r0 += lo2f(t[0]); r1 += hi2f(t[0]); r2 += lo2f(t[1]); r3 += hi2f(t[1]); }
        u32x2 o; o[0] = pk2(r0, r1); o[1] = pk2(r2, r3); *(u32x2*)(T1 + n) = o; }
    } else {
      const float* cin = p.ctx + (size_t)tok * 2048; float* cout = (float*)(p.ws + OFF_CTXR) + (size_t)tok * 2048; const float* gate = (const float*)(p.ws + OFF_MOD) + 4 * 6144 + 4096;
#pragma unroll
      for (int r4 = 0; r4 < 4; ++r4) { const int n = nb + 8 * r4; const f32x4 xv = *(const f32x4*)(cin + n), gv = *(const f32x4*)(gate + n); f32x4 a; a[0] = acc[4 * r4]; a[1] = acc[4 * r4 + 1]; a[2] = acc[4 * r4 + 2]; a[3] = acc[4 * r4 + 3];
        *(f32x4*)(cout + n) = xv + gv * a; }
    }
    __syncthreads();
  }
}

__global__ void __launch_bounds__(512, 2) mega(Params p_in) {
  Params p = p_in; p.wid = __builtin_amdgcn_readfirstlane((int)(threadIdx.x >> 6));
  extern __shared__ __attribute__((aligned(16))) unsigned char shm[];
  cg::grid_group grid = cg::this_grid();
  PG8_LAS unsigned char* lds = (PG8_LAS unsigned char*)shm;
  volatile XLAS unsigned* xst = (volatile XLAS unsigned*)(lds + 163824);
  if (otid(p.wid) == 0) { xst[0] = 0u; xst[1] = 0u; }
  __syncthreads();
  const XcdBarrier xb = xcd_barrier_post((unsigned*)(p.ws + OFF_BAR), xst, otid(p.wid) == 0);
  const bf16_t* H = (const bf16_t*)(p.ws + OFF_H);
#pragma unroll 1
  for (int rep = 0; rep < (PROBE == 1 ? 2 : 1); ++rep) { phase_filters(p, shm); phase_mod(p, shm); }
  grid.sync();
  for (int l = 0; l < 2; ++l) {
#pragma unroll 1
    for (int rep = 0; rep < (PROBE == 1 ? 2 : 1); ++rep) { phase_cvt(p, l, shm); phase_norm(p, l); }
    xcd_barrier(xb, otid(p.wid) == 0);
    { pg8::Gemm g; g.wid = p.wid; g.A = H; g.Bt = (const bf16_t*)(p.ws + OFF_WTIN); g.M = MT; g.N = INW; g.K = DM;
      pg8::Order S; S.init(64, 96, (int)gridDim.x, (int)blockIdx.x, 4, l == 0 ? 96 : 24, l == 0 ? 0 : 8);
      EpiG1 E; E.ws = p.ws; pg8::gemm_phase<EpiG1, pg8::Order>(lds, g, S, E); }
    xcd_barrier(xb, otid(p.wid) == 0);
#pragma unroll 1
    for (int rep = 0; rep < (PROBE == 2 ? 2 : 1); ++rep) phase_prep(p, l, shm, rep ? 4 : 7);
    xcd_barrier(xb, otid(p.wid) == 0);
    phase_conv(p, l, shm);
#pragma unroll 1
    for (int rep = 0; rep < (PROBE == 3 ? 2 : 1); ++rep) phase_ret(p, l, shm);
    xcd_barrier(xb, otid(p.wid) == 0);
#pragma unroll 1
    for (int rep = 0; rep < (PROBE == 2 ? 2 : 1); ++rep) phase_post(p, l, shm, rep ? 3 : 7);
    xcd_barrier(xb, otid(p.wid) == 0);
    { const int nM = 64;
      pg8::Order S; S.init(nM, 8, (int)gridDim.x, (int)blockIdx.x, 0, 0, 0);
#pragma unroll 1
      for (int rep = 0; rep < (PROBE == 4 ? 2 : 1); ++rep) {
      { pg8::Gemm g; g.wid = p.wid; g.A = H; g.Bt = (const bf16_t*)(p.ws + OFF_WTHY); g.M = nM * 256; g.N = DM; g.K = DM; EpiG23<0> E; E.ws = p.ws; pg8::gemm_phase<EpiG23<0>, pg8::Order>(lds, g, S, E); }
      { pg8::Gemm g; g.wid = p.wid; g.A = (const bf16_t*)(p.ws + OFF_OF); g.Bt = (const bf16_t*)(p.ws + OFF_WTRET); g.M = nM * 256; g.N = DM; g.K = 4096; EpiG23<1> E; E.ws = p.ws; pg8::gemm_phase<EpiG23<1>, pg8::Order>(lds, g, S, E); }
      }
      if (l == 0) { ctx_gemm<0>(p, H + (size_t)NLAT * 2048, 2048, (const bf16_t*)(p.ws + OFF_WTHY), 2048, shm);
                    ctx_gemm<1>(p, (const bf16_t*)(p.ws + OFF_OF) + (size_t)NLAT * 4096, 4096, (const bf16_t*)(p.ws + OFF_WTRET), 4096, shm); }
      xcd_barrier(xb, otid(p.wid) == 0);
      { pg8::Gemm g; g.wid = p.wid; g.A = (const bf16_t*)(p.ws + OFF_T1); g.Bt = (const bf16_t*)(p.ws + OFF_WTO); g.M = nM * 256; g.N = DM; g.K = DM;
        EpiG4 E; E.xin = (l == 0) ? p.x : p.out; E.cin = p.ctx; E.xout = p.out; E.cout = (float*)(p.ws + OFF_CTXR); E.mod = (const float*)(p.ws + OFF_MOD) + (size_t)l * 5 * 6144;
        pg8::gemm_phase<EpiG4, pg8::Order>(lds, g, S, E); }
      if (l == 0) ctx_gemm<2>(p, (const bf16_t*)(p.ws + OFF_T1) + (size_t)NLAT * 2048, 2048, (const bf16_t*)(p.ws + OFF_WTO), 2048, shm); }
    xcd_barrier(xb, otid(p.wid) == 0);
  }
  phase_final(p);
}

extern "C" void kernel_launch(void* const* d_in, const int* in_sizes, int n_in, void* d_out, int out_size, void* d_ws, size_t ws_size, hipStream_t stream) {
  constexpr size_t kDynLds = 163840;
  static int grid_blocks = 0;
  if (!grid_blocks) {
    hipFuncSetAttribute((const void*)mega, hipFuncAttributeMaxDynamicSharedMemorySize, (int)kDynLds);
    int dev = 0, cus = 0, per_cu = 0;
    hipGetDevice(&dev);
    hipDeviceGetAttribute(&cus, hipDeviceAttributeMultiprocessorCount, dev);
    hipOccupancyMaxActiveBlocksPerMultiprocessor(&per_cu, (const void*)mega, 512, kDynLds);
    grid_blocks = cus * (per_cu >= 1 ? 1 : 0);
    if (ws_size < WS_NEED || grid_blocks <= 0) { fprintf(stderr, "workspace %zu < %zu or no occupancy (%d)\n", ws_size, (size_t)WS_NEED, per_cu); grid_blocks = grid_blocks > 0 ? grid_blocks : 256; }
  }
  Params p{};
  p.x = (const float*)d_in[0]; p.c = (const float*)d_in[1]; p.ctx = (const float*)d_in[2]; p.c_ctx = (const float*)d_in[3]; p.ln_g = (const float*)d_in[4];
  p.ada_w = (const float*)d_in[5]; p.ada_b = (const float*)d_in[6]; p.w_in = (const float*)d_in[7]; p.conv_w = (const float*)d_in[8]; p.conv_b = (const float*)d_in[9];
  p.fw1 = (const float*)d_in[10]; p.fb1 = (const float*)d_in[11]; p.fw2 = (const float*)d_in[12]; p.fb2 = (const float*)d_in[13]; p.fw3 = (const float*)d_in[14]; p.fb3 = (const float*)d_in[15];
  p.ffreq = (const float*)d_in[16]; p.fwout = (const float*)d_in[17]; p.hy_bias = (const float*)d_in[18]; p.ret_decay = (const float*)d_in[19];
  p.w_hy_out = (const float*)d_in[20]; p.w_ret_out = (const float*)d_in[21]; p.w_o = (const float*)d_in[22]; p.final_g = (const float*)d_in[23];
  p.out = (float*)d_out; p.ws = (unsigned char*)d_ws;
  void* args[] = {&p};
  (void)hipMemsetAsync((unsigned char*)d_ws + OFF_BAR, 0, (size_t)XCD_BAR_WORDS * 4, stream);
  hipError_t e = hipLaunchCooperativeKernel((void*)mega, dim3(grid_blocks), dim3(512), args, kDynLds, stream);
  if (e != hipSuccess) fprintf(stderr, "cooperative launch failed: %s (grid %d)\n", hipGetErrorString(e), grid_blocks);
}
```

```cpp
#include <hip/hip_runtime.h>
#include <hip/hip_cooperative_groups.h>
#include <cstdio>
namespace cg = cooperative_groups;
#ifndef PROBE
#define PROBE 0
#endif

typedef unsigned short bf16_t;
typedef short bf16x8 __attribute__((ext_vector_type(8)));
typedef float f32x4 __attribute__((ext_vector_type(4)));
typedef float f32x16 __attribute__((ext_vector_type(16)));
typedef unsigned u32x4 __attribute__((ext_vector_type(4)));
typedef unsigned u32x2 __attribute__((ext_vector_type(2)));
typedef short s16x4 __attribute__((ext_vector_type(4)));
#define DI __device__ __forceinline__

DI int otid(int wid) { int t; asm volatile("v_mbcnt_lo_u32_b32 %0, -1, 0\n\tv_mbcnt_hi_u32_b32 %0, -1, %0" : "=v"(t)); return wid * 64 + t; }
DI float wsum(float v, int lane) {
#pragma unroll
  for (int o = 32; o > 0; o >>= 1) v += __int_as_float(__builtin_amdgcn_ds_bpermute((lane ^ o) << 2, __float_as_int(v)));
  return v; }
DI float bf2f(bf16_t u) { return __uint_as_float(((unsigned)u) << 16); }
typedef __bf16 bf16v2 __attribute__((ext_vector_type(2)));
typedef float f32v2 __attribute__((ext_vector_type(2)));
DI unsigned pk2(float lo, float hi) { f32v2 v = {lo, hi}; bf16v2 b = __builtin_convertvector(v, bf16v2); return __builtin_bit_cast(unsigned, b); }
DI bf16_t f2bf(float f) { return (bf16_t)(pk2(f, 0.f) & 0xffffu); }
DI float lo2f(unsigned u) { return __uint_as_float(u << 16); }
DI float hi2f(unsigned u) { return __uint_as_float(u & 0xffff0000u); }
DI float sigmoidf_(float v) { return 1.f / (1.f + __expf(-v)); }
DI float siluf_(float v) { return v / (1.f + __expf(-v)); }

constexpr int DM = 2048, NB = 4, SEQ = 4096, CTXL = 256, NLAT = NB * SEQ, NCTX = NB * CTXL, MT = NLAT + NCTX;
constexpr int INW = 24576, NH = 8, DK = 256, DV = 512, TT = SEQ + CTXL;
constexpr int LOFF = 4128, GLEN = 8320;      constexpr size_t G_LAYER = ((size_t)2048 * 8320 * 2 + 255) & ~(size_t)255;
constexpr int USTR = 6560;

constexpr size_t AL(size_t x) { return (x + 255) & ~(size_t)255; }
constexpr size_t OFF_WTIN = 0;
constexpr size_t OFF_WTHY = OFF_WTIN + AL((size_t)INW * DM * 2);
constexpr size_t OFF_WTRET = OFF_WTHY + AL((size_t)DM * DM * 2);
constexpr size_t OFF_WTO = OFF_WTRET + AL((size_t)DM * 4096 * 2);
constexpr size_t OFF_G = OFF_WTO + AL((size_t)DM * DM * 2);
constexpr size_t OFF_GC = OFF_G + 2 * AL((size_t)DM * GLEN * 2);
constexpr size_t OFF_MOD = OFF_GC + AL((size_t)DM * 512 * 4);
constexpr size_t OFF_H = OFF_MOD + AL((size_t)2 * 5 * 6144 * 4);
constexpr size_t OFF_PQ = OFF_H + AL((size_t)MT * DM * 2);
constexpr size_t OFF_PK = OFF_PQ + AL((size_t)MT * DM * 2);
constexpr size_t OFF_PV = OFF_PK + AL((size_t)MT * DM * 2);
constexpr size_t OFF_PRG = OFF_PV + AL((size_t)MT * 4096 * 2);
constexpr size_t OFF_PHY = OFF_PRG + AL((size_t)MT * 4096 * 2);
constexpr size_t OFF_PHG = OFF_PHY + AL((size_t)MT * 6144 * 2);
constexpr size_t OFF_PMG = OFF_PHG + AL((size_t)MT * DM * 2);
constexpr size_t OFF_KT = OFF_PMG + AL((size_t)MT * 4096 * 2);
constexpr size_t OFF_VT = OFF_KT + AL((size_t)NB * NH * DK * TT * 2);
constexpr size_t OFF_UT = OFF_VT + AL((size_t)NB * NH * DV * TT * 2);
constexpr size_t OFF_UTC = OFF_UT + AL((size_t)DM * NB * SEQ * 2);
constexpr size_t OFF_HV = OFF_UTC + AL((size_t)DM * NB * CTXL * 2);
constexpr size_t OFF_HX0 = OFF_HV + AL((size_t)MT * DM * 2);
constexpr size_t OFF_CTXR = OFF_HX0 + AL((size_t)MT * DM * 2);
constexpr size_t OFF_BAR = OFF_CTXR + AL((size_t)NCTX * DM * 4);
constexpr size_t OFF_CS = OFF_BAR + AL((size_t)3456 * 4);
constexpr size_t WS_NEED = OFF_CS + AL((size_t)4096 * 8);
constexpr size_t OFF_GS = OFF_KT + AL((size_t)MT * 4096 * 2);
constexpr size_t OFF_OF = OFF_KT, OFF_OB = OFF_PHY, OFF_T1 = OFF_PHY + AL((size_t)MT * 4096 * 2);

struct Params {
  const float *x, *c, *ctx, *c_ctx, *ln_g, *ada_w, *ada_b, *w_in, *conv_w, *conv_b, *fw1, *fb1, *fw2, *fb2, *fw3, *fb3, *ffreq, *fwout, *hy_bias, *ret_decay, *w_hy_out, *w_ret_out, *w_o, *final_g;
  float* out;
  unsigned char* ws;
  int wid, pad_;
};


#define XB_TMO      128
#define XB_XCNT(j)  (256  + 64 * (j))
#define XB_XSUB(j)  (1280 + 64 * (j))
#define XB_XGEN(j)  (2304 + 64 * (j))
#define XB_TOP      3328
#define XB_TOPGEN   3392
#define XCD_BAR_WORDS 3456
#define XB_SPIN_CAP (1u << 18)
#define XLAS __attribute__((address_space(3)))
DI unsigned xb_ld(unsigned* p)              { return __hip_atomic_load(p, __ATOMIC_RELAXED, __HIP_MEMORY_SCOPE_AGENT); }
DI unsigned xb_add(unsigned* p, unsigned v) { return __hip_atomic_fetch_add(p, v, __ATOMIC_RELAXED, __HIP_MEMORY_SCOPE_AGENT); }
DI unsigned xb_xcc_id() { return (unsigned)__builtin_amdgcn_s_getreg((3 << 11) | 20) & 0xFu; }
#define XB_SPIN(cond, bar) do { unsigned _sp = 0; while (cond) { __builtin_amdgcn_s_sleep(1); \
    if ((++_sp & 255u) == 0u) { if (xb_ld(&(bar)[XB_TMO])) break; if (_sp > XB_SPIN_CAP) { atomicAdd(&(bar)[XB_TMO], 1u); break; } } } } while (0)
struct XcdBarrier { unsigned* bar; unsigned x; volatile XLAS unsigned* st; };
DI XcdBarrier xcd_barrier_post(unsigned* bar, volatile XLAS unsigned* st, bool leader) {
    XcdBarrier b; b.bar = bar; b.x = xb_xcc_id(); b.st = st;
    if (leader) (void)xb_add(&bar[XB_XCNT(b.x)], 1u);
    return b;
}
DI void xcd_barrier_complete(unsigned* bar, unsigned x, unsigned& nloc, unsigned& nx) {
    const unsigned G = gridDim.x * gridDim.y * gridDim.z;
    unsigned sum, cnt, mine, sp = 0u;
    for (;;) {
        sum = 0u; cnt = 0u; mine = 0u;
#pragma unroll
        for (unsigned j = 0; j < 16; ++j) { const unsigned c = xb_ld(&bar[XB_XCNT(j)]); sum += c; cnt += (c > 0u) ? 1u : 0u; mine = (j == x) ? c : mine; }
        if (sum == G) break;
        __builtin_amdgcn_s_sleep(1);
        if ((++sp & 255u) == 0u) { if (xb_ld(&bar[XB_TMO])) break; if (sp > XB_SPIN_CAP) { atomicAdd(&bar[XB_TMO], 1u); break; } }
    }
    nloc = mine > 0u ? mine : 1u; nx = cnt > 0u ? cnt : 1u;
}
DI void xcd_barrier(const XcdBarrier& b, bool leader) {
    asm volatile("s_waitcnt vmcnt(0)" ::: "memory");
    __syncthreads();
    if (leader) {
        unsigned* bar = b.bar;
        __builtin_amdgcn_s_waitcnt(0);
        unsigned nloc = b.st[0], nx = b.st[1];
        if (nloc == 0u) { xcd_barrier_complete(bar, b.x, nloc, nx); b.st[0] = nloc; b.st[1] = nx; }
        const unsigned old = xb_add(&bar[XB_XSUB(b.x)], 1u);
        const unsigned gen = old / nloc;
        if (old + 1u == (gen + 1u) * nloc) {
            __builtin_amdgcn_fence(__ATOMIC_RELEASE, "agent");
            asm volatile("s_waitcnt vmcnt(0)" ::: "memory");
            const unsigned og = xb_add(&bar[XB_TOP], 1u);
            const unsigned tg = og / nx;
            if (og + 1u == (tg + 1u) * nx) xb_add(&bar[XB_TOPGEN], 1u);
            else XB_SPIN(xb_ld(&bar[XB_TOPGEN]) == tg, bar);
            __builtin_amdgcn_fence(__ATOMIC_ACQUIRE, "agent");
            xb_add(&bar[XB_XGEN(b.x)], 1u);
            asm volatile("s_waitcnt vmcnt(0)" ::: "memory");
        } else {
            XB_SPIN(xb_ld(&bar[XB_XGEN(b.x)]) == gen, bar);
            __builtin_amdgcn_fence(__ATOMIC_ACQUIRE, "agent");
            asm volatile("s_waitcnt vmcnt(0)" ::: "memory");
        }
    }
    __syncthreads();
}

namespace pg8 {
#define PG8_LAS __attribute__((address_space(3)))
constexpr int BM = 256, BK = 64, HALF = 128, HTB = HALF * BK * 2, STAGE_BYTES = 8 * HTB, NXCD = 8, WGM = 8;
__host__ __device__ __forceinline__ int lds_byte(int r, int c) { const int st = (r >> 4) * 2 + (c >> 5), rr = r & 15, cc = c & 31, ob = rr * 64 + cc * 2; return st * 1024 + (ob ^ (((ob >> 9) & 1) << 5)); }
__host__ __device__ __forceinline__ void stage_rc(int b, int& R, int& C) { const int st = b / 1024, sb = b % 1024, swz = sb ^ (((sb >> 9) & 1) << 5); R = (st >> 1) * 16 + swz / 64; C = (st & 1) * 32 + (swz % 64) / 2; }
__host__ __device__ __forceinline__ int perm32(int rho) { const int n = rho >> 4, i = rho & 15; return 8 * (i >> 2) + 4 * n + (i & 3); }
struct Unit { int pm, pn; };
struct Gemm { const bf16_t* A; const bf16_t* Bt; int M, N, K, wid; };
struct Order {
    int nM, nN, nwg, G, c, nx_m, nx_n, x_pn0;
    __device__ void init(int nM_, int nN_, int G_, int c_, int nx_m_, int nx_n_, int x_pn0_) { nM = nM_; nN = nN_; nwg = nM * nN; G = G_; c = c_; nx_m = nx_m_; nx_n = nx_n_; x_pn0 = x_pn0_; }
    __device__ bool next(int i, Unit& u) const {
        const long L = (long)i * G + c;
        if (L >= nwg) { const int e = (int)(L - nwg); if (e >= nx_m * nx_n) return false; u.pm = nM + e % nx_m; u.pn = x_pn0 + e / nx_m; return true; }
        int wgid = (int)L; { const int q = nwg / NXCD, r = nwg % NXCD, xcd = wgid % NXCD, off = wgid / NXCD; wgid = (xcd < r ? xcd * (q + 1) : r * (q + 1) + (xcd - r) * q) + off; }
        const int nig = WGM * nN, gid = wgid / nig, fm = gid * WGM, gsz = (nM - fm) < WGM ? (nM - fm) : WGM;
        u.pm = fm + ((wgid % nig) % gsz); u.pn = (wgid % nig) / gsz; return true;
    }
    __device__ __forceinline__ void a_ready(const Unit&) const {}
    __device__ __forceinline__ void done(const Unit&) const {}
};
template <class Epi, class Sched>
__device__ __forceinline__ void gemm_phase(PG8_LAS unsigned char* lds, const Gemm g, const Sched& S, const Epi& E) {
    const int tid = otid(g.wid), wid = __builtin_amdgcn_readfirstlane(tid >> 6), lane = tid & 63, wr = wid >> 2, wc = wid & 3, fr = lane & 15, fq = lane >> 4;
    const int K = g.K, nt = K / BK;
    unsigned voffA[2], voffB[2];
#pragma unroll
    for (int i = 0; i < 2; ++i) { int R, C; stage_rc(tid * 16 + i * 8192, R, C); const int Rb = Epi::PERM ? ((R & ~31) + perm32(R & 31)) : R;
        voffA[i] = (unsigned)(R * K + C) * 2u; voffB[i] = (unsigned)(Rb * K + C) * 2u; }
    const size_t kstep = (size_t)(BK * 2);
    const size_t hstep = (size_t)HALF * K * 2;
    const size_t tstep = 2 * hstep;
    const unsigned ldsw = (unsigned)wid * 1024u;
    const int aoff = lds_byte(wr * 64 + fr, fq * 8), boff = lds_byte(wc * 32 + fr, fq * 8);
#define PG8_SA(b, h) (((b) * 2 + (h)) * HTB)
#define PG8_SB(b, h) ((4 + (b) * 2 + (h)) * HTB)
#define PG8_STAGE(bufoff, gbase, voff) do { _Pragma("unroll") for (int _i = 0; _i < 2; ++_i) \
        __builtin_amdgcn_global_load_lds((const unsigned*)((const char*)(gbase) + (voff)[_i]), (PG8_LAS unsigned*)(lds + (bufoff) + ldsw + _i * 8192), 16, 0, 0); } while (0)
#define PG8_LDA(dst, b, h) do { _Pragma("unroll") for (int m = 0; m < 4; ++m) _Pragma("unroll") for (int k = 0; k < 2; ++k) dst[m][k] = *(const PG8_LAS bf16x8*)(lds + PG8_SA(b, h) + aoff + m * 2048 + k * 1024); } while (0)
#define PG8_LDB(dst, b, h) do { _Pragma("unroll") for (int n = 0; n < 2; ++n) _Pragma("unroll") for (int k = 0; k < 2; ++k) dst[n][k] = *(const PG8_LAS bf16x8*)(lds + PG8_SB(b, h) + boff + n * 2048 + k * 1024); } while (0)
#define PG8_MMA(ai, bj, At, Bt) do { __builtin_amdgcn_s_setprio(1); _Pragma("unroll") for (int m = 0; m < 4; ++m) _Pragma("unroll") for (int n = 0; n < 2; ++n) _Pragma("unroll") for (int k = 0; k < 2; ++k) \
        acc[ai][bj][m][n] = __builtin_amdgcn_mfma_f32_16x16x32_bf16(Bt[n][k], At[m][k], acc[ai][bj][m][n], 0, 0, 0); __builtin_amdgcn_s_setprio(0); } while (0)
#define PG8_WAIT_V(n) asm volatile("s_waitcnt vmcnt(" #n ")" ::: "memory")
#define PG8_WAIT_L(n) asm volatile("s_waitcnt lgkmcnt(" #n ")" ::: "memory")
#define PG8_BAR __builtin_amdgcn_s_barrier()
#define PG8_SCHED __builtin_amdgcn_sched_barrier(0)
    Unit cur, nxt; int ui = 0;
    if (!S.next(0, cur)) return;
    f32x4 acc[2][2][4][2];
#pragma unroll
    for (int a = 0; a < 2; ++a)
#pragma unroll
        for (int b = 0; b < 2; ++b)
#pragma unroll
            for (int m = 0; m < 4; ++m)
#pragma unroll
                for (int n = 0; n < 2; ++n) acc[a][b][m][n] = (f32x4){0.f, 0.f, 0.f, 0.f};
    bf16x8 At[4][2], B0[2][2], B1[2][2];
    const char* cA = (const char*)g.A + (size_t)cur.pm * tstep; const char* cB = (const char*)g.Bt + (size_t)cur.pn * tstep;
    S.a_ready(cur);
    PG8_STAGE(PG8_SB(0, 0), cB, voffB); PG8_STAGE(PG8_SA(0, 0), cA, voffA); PG8_STAGE(PG8_SB(0, 1), cB + hstep, voffB); PG8_STAGE(PG8_SA(0, 1), cA + hstep, voffA);
    if (wr == 1) PG8_BAR;
    PG8_WAIT_V(4); PG8_BAR;
    PG8_STAGE(PG8_SB(1, 0), cB + kstep, voffB); PG8_STAGE(PG8_SA(1, 0), cA + kstep, voffA); PG8_STAGE(PG8_SB(1, 1), cB + hstep + kstep, voffB);
    PG8_WAIT_V(6); PG8_BAR;
    for (;;) {
        const bool has_next = S.next(ui + 1, nxt);
        const char* nA = has_next ? (const char*)g.A + (size_t)nxt.pm * tstep : cA; const char* nB = has_next ? (const char*)g.Bt + (size_t)nxt.pn * tstep : cB;
        for (int t = 0; t < nt; t += 2) {
            const bool last = (t == nt - 2);
            const char* a1 = cA + (size_t)(t + 1) * kstep;
            const char* a2 = last ? nA : cA + (size_t)(t + 2) * kstep; const char* b2 = last ? nB : cB + (size_t)(t + 2) * kstep;
            const char* a3 = a2 + kstep; const char* b3 = b2 + kstep;
            if (last && has_next) S.a_ready(nxt);
            PG8_LDB(B0, 0, 0); PG8_SCHED; PG8_LDA(At, 0, 0); PG8_STAGE(PG8_SA(1, 1), a1 + hstep, voffA);
            PG8_WAIT_L(8); PG8_BAR; PG8_WAIT_L(0); PG8_MMA(0, 0, At, B0); PG8_BAR; PG8_SCHED;
            PG8_LDB(B1, 0, 1); PG8_STAGE(PG8_SB(0, 0), b2, voffB);
            PG8_BAR; PG8_WAIT_L(0); PG8_MMA(0, 1, At, B1); PG8_BAR;
            PG8_LDA(At, 0, 1); PG8_STAGE(PG8_SA(0, 0), a2, voffA);
            PG8_BAR; PG8_WAIT_L(0); PG8_MMA(1, 0, At, B0); PG8_BAR; PG8_SCHED;
            PG8_STAGE(PG8_SB(0, 1), b2 + hstep, voffB);
            PG8_WAIT_V(6); PG8_BAR; PG8_MMA(1, 1, At, B1); PG8_BAR;
            PG8_LDB(B0, 1, 0); PG8_SCHED; PG8_LDA(At, 1, 0); PG8_STAGE(PG8_SA(0, 1), a2 + hstep, voffA);
            PG8_WAIT_L(8); PG8_BAR; PG8_WAIT_L(0); PG8_MMA(0, 0, At, B0); PG8_BAR; PG8_SCHED;
            PG8_LDB(B1, 1, 1); PG8_STAGE(PG8_SB(1, 0), b3, voffB);
            PG8_BAR; PG8_WAIT_L(0); PG8_MMA(0, 1, At, B1); PG8_BAR;
            PG8_LDA(At, 1, 1); PG8_STAGE(PG8_SA(1, 0), a3, voffA);
            PG8_BAR; PG8_WAIT_L(0); PG8_MMA(1, 0, At, B0); PG8_BAR; PG8_SCHED;
            PG8_STAGE(PG8_SB(1, 1), b3 + hstep, voffB);
            PG8_WAIT_V(6); PG8_BAR; PG8_MMA(1, 1, At, B1); PG8_BAR;
        }
        if constexpr (!Epi::AFTER_DRAIN) { E(acc, cur, wr, wc, fr, fq); S.done(cur); }
        if (!has_next) break;
#pragma unroll
        for (int a = 0; a < 2; ++a)
#pragma unroll
            for (int b = 0; b < 2; ++b)
#pragma unroll
                for (int m = 0; m < 4; ++m)
#pragma unroll
                    for (int n = 0; n < 2; ++n) acc[a][b][m][n] = (f32x4){0.f, 0.f, 0.f, 0.f};
        cur = nxt; cA = nA; cB = nB; ++ui;
    }
    PG8_WAIT_V(0);
    if (wr == 0) PG8_BAR;
    PG8_BAR;
    if constexpr (Epi::AFTER_DRAIN) { E.fused(acc, cur, wr, wc, fr, fq, lds, wid, lane); S.done(cur); }
#undef PG8_SA
#undef PG8_SB
#undef PG8_STAGE
#undef PG8_LDA
#undef PG8_LDB
#undef PG8_MMA

#undef PG8_WAIT_V
#undef PG8_WAIT_L
#undef PG8_BAR
#undef PG8_SCHED
}
}

struct EpiG1 {
  static constexpr bool PERM = true, AFTER_DRAIN = false;
  unsigned char* ws;
  DI void operator()(const f32x4 (&acc)[2][2][4][2], const pg8::Unit& u, int wr, int wc, int fr, int fq) const {
    const int pn = u.pn; size_t off; int ld, c0;
    if (pn < 8) { off = OFF_PQ; ld = 2048; c0 = pn * 256; }
    else if (pn < 16) { off = OFF_PK; ld = 2048; c0 = (pn - 8) * 256; }
    else if (pn < 32) { off = OFF_PV; ld = 4096; c0 = (pn - 16) * 256; }
    else if (pn < 48) { off = OFF_PRG; ld = 4096; c0 = (pn - 32) * 256; }
    else if (pn < 72) { off = OFF_PHY; ld = 6144; c0 = (pn - 48) * 256; }
    else if (pn < 80) { off = OFF_PHG; ld = 2048; c0 = (pn - 72) * 256; }
    else { off = OFF_PMG; ld = 4096; c0 = (pn - 80) * 256; }
    bf16_t* base = (bf16_t*)(ws + off);
    const int row0 = u.pm * 256 + wr * 64 + fr, col0 = c0 + wc * 32 + 8 * fq;
    const bool rope = (pn < 16) && (u.pm < 64);
    const float4* CS = (const float4*)(ws + OFF_CS) + (wc * 4 + fq) * 2;
#pragma unroll
    for (int ai = 0; ai < 2; ++ai)
#pragma unroll
      for (int m = 0; m < 4; ++m) { const int row = row0 + ai * 128 + m * 16; bf16_t* rowp = base + (size_t)row * ld + col0;
#pragma unroll
        for (int bj = 0; bj < 2; ++bj) { f32x4 v0 = acc[ai][bj][m][0], v1 = acc[ai][bj][m][1];
          if (rope) { const int t = row & 4095, pos = bj ? (t & 63) : (t >> 6); const float4 ca = CS[pos * 32], cb = CS[pos * 32 + 1];
            const f32x4 a = v0, b = v1;
            v0[0] = a[0] * ca.x - b[0] * ca.y; v1[0] = a[0] * ca.y + b[0] * ca.x; v0[1] = a[1] * ca.z - b[1] * ca.w; v1[1] = a[1] * ca.w + b[1] * ca.z;
            v0[2] = a[2] * cb.x - b[2] * cb.y; v1[2] = a[2] * cb.y + b[2] * cb.x; v0[3] = a[3] * cb.z - b[3] * cb.w; v1[3] = a[3] * cb.w + b[3] * cb.z; }
          u32x4 o; o[0] = pk2(v0[0], v0[1]); o[1] = pk2(v0[2], v0[3]); o[2] = pk2(v1[0], v1[1]); o[3] = pk2(v1[2], v1[3]);
          *(u32x4*)(rowp + bj * 128) = o; } }
  }
};
template <int SECOND> struct EpiG23 {
  static constexpr bool PERM = true, AFTER_DRAIN = false;
  unsigned char* ws;
  DI void operator()(const f32x4 (&acc)[2][2][4][2], const pg8::Unit& u, int wr, int wc, int fr, int fq) const {
    bf16_t* T1 = (bf16_t*)(ws + OFF_T1); const bf16_t* MG = (const bf16_t*)(ws + OFF_PMG) + (SECOND ? 2048 : 0);
    const int row0 = u.pm * 256 + wr * 64 + fr, col0 = u.pn * 256 + wc * 32 + 8 * fq;
#pragma unroll
    for (int ai = 0; ai < 2; ++ai)
#pragma unroll
      for (int m = 0; m < 4; ++m) { const size_t row = (size_t)(row0 + ai * 128 + m * 16);
#pragma unroll
        for (int bj = 0; bj < 2; ++bj) { const int col = col0 + bj * 128;
          const u32x4 g = *(const u32x4*)(MG + row * 4096 + col);
          const f32x4 v0 = acc[ai][bj][m][0], v1 = acc[ai][bj][m][1];
          float r[8];
          r[0] = sigmoidf_(lo2f(g[0])) * v0[0]; r[1] = sigmoidf_(hi2f(g[0])) * v0[1]; r[2] = sigmoidf_(lo2f(g[1])) * v0[2]; r[3] = sigmoidf_(hi2f(g[1])) * v0[3];
          r[4] = sigmoidf_(lo2f(g[2])) * v1[0]; r[5] = sigmoidf_(hi2f(g[2])) * v1[1]; r[6] = sigmoidf_(lo2f(g[3])) * v1[2]; r[7] = sigmoidf_(hi2f(g[3])) * v1[3];
          if (SECOND) { const u32x4 t = *(const u32x4*)(T1 + row * 2048 + col);
            r[0] += lo2f(t[0]); r[1] += hi2f(t[0]); r[2] += lo2f(t[1]); r[3] += hi2f(t[1]); r[4] += lo2f(t[2]); r[5] += hi2f(t[2]); r[6] += lo2f(t[3]); r[7] += hi2f(t[3]); }
          u32x4 o; o[0] = pk2(r[0], r[1]); o[1] = pk2(r[2], r[3]); o[2] = pk2(r[4], r[5]); o[3] = pk2(r[6], r[7]);
          *(u32x4*)(T1 + row * 2048 + col) = o; } }
  }
};
struct EpiG4 {
  static constexpr bool PERM = false, AFTER_DRAIN = false;
  const float* xin; const float* cin; float* xout; float* cout; const float* mod;
  DI void operator()(const f32x4 (&acc)[2][2][4][2], const pg8::Unit& u, int wr, int wc, int fr, int fq) const {
    const int row0 = u.pm * 256 + wr * 64 + fr, col0 = u.pn * 256 + wc * 32 + 4 * fq;
#pragma unroll
    for (int ai = 0; ai < 2; ++ai)
#pragma unroll
      for (int m = 0; m < 4; ++m) { const int row = row0 + ai * 128 + m * 16;
        const float* src; float* dst; const float* gate;
        if (row < NLAT) { src = xin + (size_t)row * 2048; dst = xout + (size_t)row * 2048; gate = mod + (row >> 12) * 6144 + 4096; }
        else { src = cin + (size_t)(row - NLAT) * 2048; dst = cout + (size_t)(row - NLAT) * 2048; gate = mod + 4 * 6144 + 4096; }
#pragma unroll
        for (int bj = 0; bj < 2; ++bj)
#pragma unroll
          for (int n = 0; n < 2; ++n) { const int col = col0 + bj * 128 + n * 16;
            const f32x4 xv = *(const f32x4*)(src + col), gv = *(const f32x4*)(gate + col);
            *(f32x4*)(dst + col) = xv + gv * acc[ai][bj][m][n]; } }
  }
};

__device__ void phase_mod(const Params& p, unsigned char* shm) {
  float* sc = (float*)shm; float* red = sc + 5 * 2048;
  const int tid = otid(p.wid);
  for (int i = tid; i < 5 * 2048; i += 512) { const int j = i >> 11, k = i & 2047; const float v = (j < 4) ? p.c[j * 2048 + k] : p.c_ctx[k]; sc[i] = v / (1.f + expf(-v)); }
  __syncthreads();
  { const int i = blockIdx.x * 512 + tid; if (i < 4096) { const int pos = i >> 6, j = i & 63; const float inv = 1.f / powf(10000.f, (float)j / 64.f); float sn, cn; sincosf((float)pos * inv, &sn, &cn); ((float2*)(p.ws + OFF_CS))[i] = make_float2(cn, sn); } }
  float* mod = (float*)(p.ws + OFF_MOD);
  const int cq = tid & 7, ks = tid >> 3;
  for (int it = blockIdx.x; it < 384; it += gridDim.x) {
    const int l = it / 192, nb = (it % 192) * 32;
    const float* W = p.ada_w + (size_t)l * 2048 * 6144 + nb + cq * 4;
    float acc[5][4];
#pragma unroll
    for (int j = 0; j < 5; ++j) { acc[j][0] = 0.f; acc[j][1] = 0.f; acc[j][2] = 0.f; acc[j][3] = 0.f; }
#pragma unroll 4
    for (int kk = 0; kk < 32; ++kk) { const int k = ks * 32 + kk; const float4 w = *(const float4*)(W + (size_t)k * 6144);
#pragma unroll
      for (int j = 0; j < 5; ++j) { const float s = sc[j * 2048 + k]; acc[j][0] += s * w.x; acc[j][1] += s * w.y; acc[j][2] += s * w.z; acc[j][3] += s * w.w; } }
#pragma unroll
    for (int j = 0; j < 5; ++j)
#pragma unroll
      for (int e = 0; e < 4; ++e) red[ks * 160 + j * 32 + cq * 4 + e] = acc[j][e];
    __syncthreads();
    if (tid < 160) { float s = 0.f; for (int q = 0; q < 64; ++q) s += red[q * 160 + tid]; const int j = tid >> 5, n = nb + (tid & 31); mod[(l * 5 + j) * 6144 + n] = s + p.ada_b[l * 6144 + n]; }
    __syncthreads();
  }
}

__device__ void cvt_group(int wid, const float* W, bf16_t* Wt, int K, int N, int k0, int n0, float scale, float* tile, bool perm) {
  const int tid = otid(wid);
  float4 v[8];
  int nsrc = n0 + (tid & 15) * 4;
  if (perm) { const int pc = (n0 & 255) + (tid & 15) * 4, r = pc & 127; nsrc = (n0 & ~255) + (pc & 128) + (r >> 3) * 4 + 64 * ((r >> 2) & 1); }
#pragma unroll
  for (int q = 0; q < 4; ++q)
#pragma unroll
    for (int rr = 0; rr < 2; ++rr) { const int k = (tid >> 4) + 32 * rr; v[q * 2 + rr] = *(const float4*)(W + (size_t)(k0 + q * 64 + k) * N + nsrc); }
#pragma unroll
  for (int q = 0; q < 4; ++q)
#pragma unroll
    for (int rr = 0; rr < 2; ++rr) { const int k = (tid >> 4) + 32 * rr, n = (tid & 15) * 4; float* t = tile + q * 4160 + k * 65 + n; const float4 x = v[q * 2 + rr]; t[0] = x.x; t[1] = x.y; t[2] = x.z; t[3] = x.w; }
  __syncthreads();
#pragma unroll
  for (int q = 0; q < 4; ++q) { const int n = tid >> 3, k8 = (tid & 7) * 8; const float* t = tile + q * 4160; u32x4 o;
#pragma unroll
    for (int e = 0; e < 4; ++e) o[e] = pk2(t[(k8 + 2 * e) * 65 + n] * scale, t[(k8 + 2 * e + 1) * 65 + n] * scale);
    *(u32x4*)(Wt + (size_t)(n0 + n) * K + k0 + q * 64 + k8) = o; }
  __syncthreads();
}
__device__ void phase_cvt(const Params& p, int l, unsigned char* shm) {
  float* tile = (float*)shm;
  for (int it = blockIdx.x; it < 4096; it += gridDim.x) {
    if (it < 3072) { const int kg = it & 7, n0 = (it >> 3) * 64;
      cvt_group(p.wid, p.w_in + (size_t)l * DM * INW, (bf16_t*)(p.ws + OFF_WTIN), DM, INW, kg * 256, n0, (n0 >= 2048 && n0 < 4096) ? 0.0625f : 1.f, tile, n0 < 4096); }
    else if (it < 3328) { const int e = it - 3072; cvt_group(p.wid, p.w_hy_out + (size_t)l * DM * DM, (bf16_t*)(p.ws + OFF_WTHY), DM, DM, (e & 7) * 256, (e >> 3) * 64, 1.f, tile, false); }
    else if (it < 3840) { const int e = it - 3328; cvt_group(p.wid, p.w_ret_out + (size_t)l * 4096 * DM, (bf16_t*)(p.ws + OFF_WTRET), 4096, DM, (e & 15) * 256, (e >> 4) * 64, 1.f, tile, false); }
    else { const int e = it - 3840; cvt_group(p.wid, p.w_o + (size_t)l * DM * DM, (bf16_t*)(p.ws + OFF_WTO), DM, DM, (e & 7) * 256, (e >> 3) * 64, 1.f, tile, false); }
  }
}

DI void filt_item(const Params& p, int l, int Ls, int T, bool isctx, unsigned char* shm) {
  float* z = (float*)shm; float* ha = z + 17 * 36; float* hb = ha + 17 * 64;
  const int tid = otid(p.wid);
  const float* w1 = p.fw1 + l * 33 * 64; const float* b1 = p.fb1 + l * 64; const float* w2 = p.fw2 + l * 4096; const float* b2 = p.fb2 + l * 64;
  const float* w3 = p.fw3 + l * 4096; const float* b3 = p.fb3 + l * 64; const float* fq = p.ffreq + l * 64; const float* wout = p.fwout + (size_t)l * 64 * 4096;
  float* w1s = z + 2816; float* w2s = w1s + 2112; float* w3s = w2s + 4096;
  { const float4 a0 = ((const float4*)w2)[tid], a1 = ((const float4*)w2)[tid + 512], b0 = ((const float4*)w3)[tid], b1 = ((const float4*)w3)[tid + 512];
    const float4 c0 = ((const float4*)w1)[tid]; float4 c1 = c0; if (tid < 16) c1 = ((const float4*)w1)[tid + 512];
    ((float4*)w2s)[tid] = a0; ((float4*)w2s)[tid + 512] = a1; ((float4*)w3s)[tid] = b0; ((float4*)w3s)[tid + 512] = b1; ((float4*)w1s)[tid] = c0; if (tid < 16) ((float4*)w1s)[tid + 512] = c1; }
  for (int i = tid; i < 17 * 33; i += 512) { const int pl = i / 33, f = i % 33; int pp = T * 16 + pl; if (pp > Ls - 1) pp = Ls - 1;
    float val;
    if (f == 0) val = (float)pp / (float)(Ls - 1);
    else { const int j = (f - 1) & 15; const float fj = 1e-4f + (float)j * ((15.f - 1e-4f) / 15.f); const float ang = 6.283185307179586f * (float)pp / (float)Ls; const float a = fj * ang; val = (f <= 16) ? cosf(a) : -sinf(a); }
    z[pl * 36 + f] = val; }
  __syncthreads();
  for (int idx = tid; idx < 17 * 16; idx += 512) { const int pl = idx >> 4, j0 = (idx & 15) * 4; float a[4] = {0.f, 0.f, 0.f, 0.f};
#pragma unroll 3
    for (int k = 0; k < 33; ++k) { const float v = z[pl * 36 + k]; const float4 w = *(const float4*)(w1s + k * 64 + j0); a[0] += v * w.x; a[1] += v * w.y; a[2] += v * w.z; a[3] += v * w.w; }
#pragma unroll
    for (int e = 0; e < 4; ++e) ha[pl * 64 + j0 + e] = sinf(fq[j0 + e] * (a[e] + b1[j0 + e])); }
  __syncthreads();
  for (int idx = tid; idx < 17 * 16; idx += 512) { const int pl = idx >> 4, j0 = (idx & 15) * 4; float a[4] = {0.f, 0.f, 0.f, 0.f};
#pragma unroll 4
    for (int k = 0; k < 64; ++k) { const float v = ha[pl * 64 + k]; const float4 w = *(const float4*)(w2s + k * 64 + j0); a[0] += v * w.x; a[1] += v * w.y; a[2] += v * w.z; a[3] += v * w.w; }
#pragma unroll
    for (int e = 0; e < 4; ++e) hb[pl * 64 + j0 + e] = sinf(fq[j0 + e] * (a[e] + b2[j0 + e])); }
  __syncthreads();
  for (int idx = tid; idx < 17 * 16; idx += 512) { const int pl = idx >> 4, j0 = (idx & 15) * 4; float a[4] = {0.f, 0.f, 0.f, 0.f};
#pragma unroll 4
    for (int k = 0; k < 64; ++k) { const float v = hb[pl * 64 + k]; const float4 w = *(const float4*)(w3s + k * 64 + j0); a[0] += v * w.x; a[1] += v * w.y; a[2] += v * w.z; a[3] += v * w.w; }
#pragma unroll
    for (int e = 0; e < 4; ++e) ha[pl * 64 + j0 + e] = sinf(fq[j0 + e] * (a[e] + b3[j0 + e])); }
  __syncthreads();
  const int cb = tid * 4;
  const float mind = logf(0.01f) / 1.5f, maxd = logf(0.01f) / 0.3f;
  bf16_t* G = (bf16_t*)(p.ws + OFF_G + (size_t)l * G_LAYER); float* GC = (float*)(p.ws + OFF_GC);
  float delta[4];
#pragma unroll
  for (int cc = 0; cc < 4; ++cc) delta[cc] = fabsf(mind + (float)(cb + cc) * ((maxd - mind) / 2047.f));
#pragma unroll 1
  for (int pgh = 0; pgh < 4; ++pgh) {
    const int pg = pgh >> 1; const bool isb = (pgh & 1) != 0; const int c4 = cb + (isb ? 2048 : 0);
    const int plb = pg * 8;
    float acc[8][4];
#pragma unroll
    for (int e = 0; e < 8; ++e) { acc[e][0] = 0.f; acc[e][1] = 0.f; acc[e][2] = 0.f; acc[e][3] = 0.f; }
    float4 wA[8], wB[8];
#define FILT_LOAD(buf, kb_) do { _Pragma("unroll") for (int j = 0; j < 8; ++j) buf[j] = *(const float4*)(wout + ((kb_) * 8 + j) * 4096 + c4); } while (0)
#define FILT_FMA(buf, kb_) do { _Pragma("unroll") for (int j = 0; j < 8; ++j) { const float4 wa = buf[j]; const int k = (kb_) * 8 + j; \
      _Pragma("unroll") for (int e = 0; e < 8; ++e) { const float h = ha[(plb + e) * 64 + k]; acc[e][0] += h * wa.x; acc[e][1] += h * wa.y; acc[e][2] += h * wa.z; acc[e][3] += h * wa.w; } } } while (0)
    FILT_LOAD(wA, 0);
#pragma unroll 1
    for (int kb = 0; kb < 8; kb += 2) {
      FILT_LOAD(wB, kb + 1);
      asm volatile("" ::: "memory");
      FILT_FMA(wA, kb);
      asm volatile("" ::: "memory");
      if (kb + 2 < 8) FILT_LOAD(wA, kb + 2);
      asm volatile("" ::: "memory");
      FILT_FMA(wB, kb + 1);
      asm volatile("" ::: "memory");
    }
#undef FILT_LOAD
#undef FILT_FMA
    const int pp0 = T * 16 + plb;
#pragma unroll
    for (int e = 0; e < 8; ++e) { const int pp = pp0 + e; const float tt = (float)pp / (float)(Ls - 1);
      if (pp < Ls && !(isb && pp == 0)) {
        float v[4];
#pragma unroll
        for (int cc = 0; cc < 4; ++cc) v[cc] = acc[e][cc] * __expf(-tt * delta[cc]);
        if (!isb && pp == 0) {
#pragma unroll
          for (int cc = 0; cc < 4; ++cc) v[cc] += p.hy_bias[l * 2048 + cb + cc]; }
        if (!isctx) { const int m = isb ? LOFF + pp : LOFF - pp; u32x2 o; o[0] = pk2(v[0], v[1]); o[1] = pk2(v[2], v[3]); *(u32x2*)(G + (size_t)m * 2048 + cb) = o; }
        else { const int idx = isb ? 256 - pp : 256 + pp;
#pragma unroll
          for (int cc = 0; cc < 4; ++cc) GC[(size_t)(cb + cc) * 512 + idx] = v[cc]; }
      }
    }
  }
  __syncthreads();
}
__device__ void phase_filters(const Params& p, unsigned char* shm) {
  for (int it = blockIdx.x; it < 528; it += gridDim.x) { const bool ic = it >= 512; filt_item(p, ic ? 0 : (it >> 8), ic ? CTXL : SEQ, ic ? it - 512 : (it & 255), ic, shm); }
}

__device__ void phase_norm(const Params& p, int l) {
  const int lane = otid(p.wid) & 63, gw = blockIdx.x * 8 + (otid(p.wid) >> 6), nw = gridDim.x * 8;
  const float* mod = (const float*)(p.ws + OFF_MOD) + (size_t)l * 5 * 6144; const float* lng = p.ln_g + l * 2048;
  bf16_t* H = (bf16_t*)(p.ws + OFF_H);
  for (int r = gw; r < MT; r += nw) {
    const float* src; int j;
    if (r < NLAT) { src = (l == 0 ? p.x : p.out) + (size_t)r * 2048; j = r >> 12; }
    else { src = (l == 0 ? p.ctx : (const float*)(p.ws + OFF_CTXR)) + (size_t)(r - NLAT) * 2048; j = 4; }
    const float* sh = mod + j * 6144; const float* sc = sh + 2048;
    float4 v[8]; float ss = 0.f;
#pragma unroll
    for (int i = 0; i < 8; ++i) { v[i] = *(const float4*)(src + i * 256 + lane * 4); ss += v[i].x * v[i].x + v[i].y * v[i].y + v[i].z * v[i].z + v[i].w * v[i].w; }
    ss = wsum(ss, lane);
    const float rs = rsqrtf(ss * (1.f / 2048.f) + 1e-6f);
#pragma unroll
    for (int i = 0; i < 8; ++i) { const int col = i * 256 + lane * 4; const float4 g = *(const float4*)(lng + col), a = *(const float4*)(sc + col), b = *(const float4*)(sh + col);
      u32x2 o; o[0] = pk2(v[i].x * rs * g.x * (1.f + a.x) + b.x, v[i].y * rs * g.y * (1.f + a.y) + b.y); o[1] = pk2(v[i].z * rs * g.z * (1.f + a.z) + b.z, v[i].w * rs * g.w * (1.f + a.w) + b.w);
      *(u32x2*)(H + (size_t)r * 2048 + col) = o; }
  }
}
__device__ void phase_final(const Params& p) {
  const int lane = otid(p.wid) & 63, gw = blockIdx.x * 8 + (otid(p.wid) >> 6), nw = gridDim.x * 8;
  for (int r = gw; r < NLAT; r += nw) {
    float* src = p.out + (size_t)r * 2048; float4 v[8]; float ss = 0.f;
#pragma unroll
    for (int i = 0; i < 8; ++i) { v[i] = *(const float4*)(src + i * 256 + lane * 4); ss += v[i].x * v[i].x + v[i].y * v[i].y + v[i].z * v[i].z + v[i].w * v[i].w; }
    ss = wsum(ss, lane);
    const float rs = rsqrtf(ss * (1.f / 2048.f) + 1e-6f);
#pragma unroll
    for (int i = 0; i < 8; ++i) { const int col = i * 256 + lane * 4; const float4 g = *(const float4*)(p.final_g + col); float4 o; o.x = v[i].x * rs * g.x; o.y = v[i].y * rs * g.y; o.z = v[i].z * rs * g.z; o.w = v[i].w * rs * g.w; *(float4*)(src + col) = o; }
  }
}

DI void tok_tile(int tk, int& b, int& t0, bool& isctx) { if (tk < 256) { b = tk >> 6; t0 = (tk & 63) * 64; isctx = false; } else { b = (tk - 256) >> 2; t0 = ((tk - 256) & 3) * 64; isctx = true; } }
DI int tok_row(int b, int t, bool isctx) { return isctx ? NLAT + b * CTXL + t : b * SEQ + t; }

__device__ void phase_prep(const Params& p, int l, unsigned char* shm, int mask) {
  const int tid = otid(p.wid), lane = tid & 63;
  unsigned char* reg2 = shm + 32768;
  (void)lane;
  if (mask & 4) { float* in = (float*)reg2;
    bf16_t* ut = (bf16_t*)(reg2 + 3 * 66 * 64 * 4);
    const bf16_t* PHY = (const bf16_t*)(p.ws + OFF_PHY); const bf16_t* PHG = (const bf16_t*)(p.ws + OFF_PHG); bf16_t* HX0 = (bf16_t*)(p.ws + OFF_HX0);
    const float* cw = p.conv_w + (size_t)l * 3 * 6144; const float* cb = p.conv_b + (size_t)l * 6144;
    const int nit = ((l == 0) ? 272 : 256) * 32;
    u32x4 pre[4];
#define PC_DECODE(it_) const int tk = (it_) >> 5, c0 = ((it_) & 31) * 64; int b, t0; bool isctx; tok_tile(tk, b, t0, isctx); const int Ls = isctx ? CTXL : SEQ; const int row0 = tok_row(b, t0, isctx);
#define PC_LOAD(it_) do { PC_DECODE(it_) _Pragma("unroll") for (int e = 0; e < 4; ++e) { const int id = tid + 512 * e; const int pi = id / 528, rem = id % 528, rr = rem >> 3, pc = rem & 7; const int t = t0 - 1 + rr; \
        u32x4 v; v[0] = 0u; v[1] = 0u; v[2] = 0u; v[3] = 0u; if (id < 1584 && t >= 0 && t < Ls) v = *(const u32x4*)(PHY + (size_t)(row0 - 1 + rr) * 6144 + pi * 2048 + c0 + pc * 8); pre[e] = v; } } while (0)
    if ((int)blockIdx.x < nit) PC_LOAD((int)blockIdx.x);
    for (int it = blockIdx.x; it < nit; it += gridDim.x) {
      PC_DECODE(it) (void)Ls;
#pragma unroll
      for (int e = 0; e < 4; ++e) { const int id = tid + 512 * e; if (id < 1584) { const int pi = id / 528, rem = id % 528, rr = rem >> 3, pc = rem & 7; const u32x4 v = pre[e];
        float* d = in + (pi * 66 + rr) * 64 + pc * 8;
        *(float4*)d = make_float4(lo2f(v[0]), hi2f(v[0]), lo2f(v[1]), hi2f(v[1])); *(float4*)(d + 4) = make_float4(lo2f(v[2]), hi2f(v[2]), lo2f(v[3]), hi2f(v[3])); } }
      if (it + (int)gridDim.x < nit) PC_LOAD(it + (int)gridDim.x);
      __syncthreads();
      { const int cg8 = (tid & 7) * 8, tok = tid >> 3;
        float cv[3][8];
#pragma unroll
        for (int pi = 0; pi < 3; ++pi) { const float* wp = cw + pi * 2048 + c0 + cg8;
          const float4 ba = *(const float4*)(cb + pi * 2048 + c0 + cg8), bb = *(const float4*)(cb + pi * 2048 + c0 + cg8 + 4);
          cv[pi][0] = ba.x; cv[pi][1] = ba.y; cv[pi][2] = ba.z; cv[pi][3] = ba.w; cv[pi][4] = bb.x; cv[pi][5] = bb.y; cv[pi][6] = bb.z; cv[pi][7] = bb.w;
#pragma unroll
          for (int k = 0; k < 3; ++k) { const float4 wa = *(const float4*)(wp + k * 6144), wb = *(const float4*)(wp + k * 6144 + 4);
            const float* ip = in + (pi * 66 + tok + k) * 64 + cg8; const float4 xa = *(const float4*)ip, xb = *(const float4*)(ip + 4);
            cv[pi][0] += xa.x * wa.x; cv[pi][1] += xa.y * wa.y; cv[pi][2] += xa.z * wa.z; cv[pi][3] += xa.w * wa.w; cv[pi][4] += xb.x * wb.x; cv[pi][5] += xb.y * wb.y; cv[pi][6] += xb.z * wb.z; cv[pi][7] += xb.w * wb.w; } }
        u32x4 hvp, hxp; const u32x4 hg = *(const u32x4*)(PHG + (size_t)(row0 + tok) * 2048 + c0 + cg8);
#pragma unroll
        for (int e = 0; e < 4; ++e) { hvp[e] = pk2(cv[0][2 * e] * cv[2][2 * e], cv[0][2 * e + 1] * cv[2][2 * e + 1]); hxp[e] = pk2(cv[1][2 * e] * siluf_(lo2f(hg[e])), cv[1][2 * e + 1] * siluf_(hi2f(hg[e]))); }
        *(u32x4*)(HX0 + (size_t)(row0 + tok) * 2048 + c0 + cg8) = hxp;
#pragma unroll
        for (int e = 0; e < 4; ++e) { ut[(cg8 + 2 * e) * 66 + tok] = (bf16_t)(hvp[e] & 0xffffu); ut[(cg8 + 2 * e + 1) * 66 + tok] = (bf16_t)(hvp[e] >> 16); } }
      __syncthreads();
      { const int c = tid >> 3, pc = tid & 7; u32x4 o;
#pragma unroll
        for (int e = 0; e < 4; ++e) o[e] = (unsigned)ut[c * 66 + pc * 8 + 2 * e] | ((unsigned)ut[c * 66 + pc * 8 + 2 * e + 1] << 16);
        bf16_t* dst = isctx ? (bf16_t*)(p.ws + OFF_UTC) + ((size_t)(c0 + c) * NB + b) * CTXL + t0 + pc * 8 : (bf16_t*)(p.ws + OFF_UT) + ((size_t)(c0 + c) * NB + b) * SEQ + t0 + pc * 8;
        *(u32x4*)dst = o; }
    }
    __syncthreads();
#undef PC_DECODE
#undef PC_LOAD
  }
}

__device__ void phase_post(const Params& p, int l, unsigned char* shm, int mask) {
  const int tid = otid(p.wid), lane = tid & 63;
  const bf16_t* HX0 = (const bf16_t*)(p.ws + OFF_HX0);
  bf16_t* AH = (bf16_t*)(p.ws + OFF_H);
  if (mask & 1) { float* yt = (float*)shm;
    const bf16_t* UT = (const bf16_t*)(p.ws + OFF_UT);
    const int nit = 256 * 32; u32x4 pre;
#define PA_LOAD(it_) do { const int tk_ = (it_) >> 5, c0_ = ((it_) & 31) * 64, b_ = tk_ >> 6, t0_ = (tk_ & 63) * 64; pre = *(const u32x4*)(UT + ((size_t)(c0_ + (tid >> 3)) * NB + b_) * SEQ + t0_ + (tid & 7) * 8); } while (0)
    if ((int)blockIdx.x < nit) PA_LOAD((int)blockIdx.x);
    for (int it = blockIdx.x; it < nit; it += gridDim.x) {
      const int tk = it >> 5, c0 = (it & 31) * 64, b = tk >> 6, t0 = (tk & 63) * 64, row0 = b * SEQ + t0;
      { const int c = tid >> 3, pc = tid & 7; const u32x4 v = pre; float* d = yt + (pc * 8) * 65 + c;
        d[0] = lo2f(v[0]); d[65] = hi2f(v[0]); d[130] = lo2f(v[1]); d[195] = hi2f(v[1]); d[260] = lo2f(v[2]); d[325] = hi2f(v[2]); d[390] = lo2f(v[3]); d[455] = hi2f(v[3]); }
      if (it + (int)gridDim.x < nit) PA_LOAD(it + (int)gridDim.x);
      __syncthreads();
      { const int cg8 = (tid & 7) * 8, tok = tid >> 3; const size_t o = (size_t)(row0 + tok) * 2048 + c0 + cg8;
        const u32x4 m1 = *(const u32x4*)(HX0 + o); const float* yp = yt + tok * 65 + cg8; u32x4 r;
#pragma unroll
        for (int e = 0; e < 4; ++e) r[e] = pk2(yp[2 * e] * lo2f(m1[e]), yp[2 * e + 1] * hi2f(m1[e]));
        *(u32x4*)(AH + o) = r; }
      __syncthreads();
    }
#undef PA_LOAD
  }
  if (l == 0 && (mask & 2)) { constexpr int GST = 513, UST = 257; float* gc = (float*)shm; float* us = gc + 32 * GST;
    const bf16_t* UTC = (const bf16_t*)(p.ws + OFF_UTC); const float* GC = (const float*)(p.ws + OFF_GC);
    for (int it = blockIdx.x; it < 16 * 64; it += gridDim.x) {
      const int tk = it >> 6, c0 = (it & 63) * 32, b = tk >> 2, t0 = (tk & 3) * 64, row0 = NLAT + b * CTXL + t0;
#pragma unroll 8
      for (int i = tid; i < 32 * 512; i += 512) gc[(i >> 9) * GST + (i & 511)] = GC[(size_t)(c0 + (i >> 9)) * 512 + (i & 511)];
#pragma unroll 8
      for (int i = tid; i < 32 * 256; i += 512) us[(i >> 8) * UST + (i & 255)] = bf2f(UTC[((size_t)(c0 + (i >> 8)) * NB + b) * CTXL + (i & 255)]);
      __syncthreads();
      { const int c = tid >> 4, t = (tid & 15) * 4; const float* gp = gc + c * GST + 256 + t0 + t; const float* up = us + c * UST;
        float a0 = 0.f, a1 = 0.f, a2 = 0.f, a3 = 0.f; float w0 = gp[0], w1 = gp[1], w2 = gp[2], w3 = gp[3];
#pragma unroll 4
        for (int s = 0; s < 256; s += 4) {
          const float u0 = up[s], u1 = up[s + 1], u2 = up[s + 2], u3 = up[s + 3];
          const float n1 = gp[-(s + 1)], n2 = gp[-(s + 2)], n3 = gp[-(s + 3)], n4 = gp[-(s + 4)];
          a0 += u0 * w0; a1 += u0 * w1; a2 += u0 * w2; a3 += u0 * w3;
          a0 += u1 * n1; a1 += u1 * w0; a2 += u1 * w1; a3 += u1 * w2;
          a0 += u2 * n2; a1 += u2 * n1; a2 += u2 * w0; a3 += u2 * w1;
          a0 += u3 * n3; a1 += u3 * n2; a2 += u3 * n1; a3 += u3 * w0;
          w3 = n1; w2 = n2; w1 = n3; w0 = n4; }
        const float av[4] = {a0, a1, a2, a3};
#pragma unroll
        for (int j = 0; j < 4; ++j) { const size_t o = (size_t)(row0 + t + j) * 2048 + c0 + c; AH[o] = f2bf(av[j] * bf2f(HX0[o])); } }
      __syncthreads();
    }
  }
  if (mask & 4) { bf16_t* OF = (bf16_t*)(p.ws + OFF_OF); const bf16_t* OB = (const bf16_t*)(p.ws + OFF_OB); const bf16_t* RG = (const bf16_t*)(p.ws + OFF_PRG);
    const int gw = blockIdx.x * 8 + (tid >> 6), nw = gridDim.x * 8; const int nrows = (l == 0) ? MT : NLAT;
#pragma unroll 2
    for (int it = gw; it < nrows * 8; it += nw) { const size_t o = (size_t)(it >> 3) * 4096 + (it & 7) * 512 + lane * 8;
      const u32x4 a = *(const u32x4*)(OF + o), bq = *(const u32x4*)(OB + o), g = *(const u32x4*)(RG + o);
      float v[8]; float ss = 0.f;
#pragma unroll
      for (int e = 0; e < 4; ++e) { v[2 * e] = lo2f(a[e]) + lo2f(bq[e]); v[2 * e + 1] = hi2f(a[e]) + hi2f(bq[e]); ss += v[2 * e] * v[2 * e] + v[2 * e + 1] * v[2 * e + 1]; }
      ss = wsum(ss, lane);
      const float rs = rsqrtf(ss * (1.f / 512.f) + 1e-6f);
      u32x4 r;
#pragma unroll
      for (int e = 0; e < 4; ++e) r[e] = pk2(v[2 * e] * rs * siluf_(lo2f(g[e])), v[2 * e + 1] * rs * siluf_(hi2f(g[e])));
      *(u32x4*)(OF + o) = r; }
  }
}

__device__ void phase_conv(const Params& p, int l, unsigned char* shm) {
  const int tid = otid(p.wid), lane = tid & 63, wid = tid >> 6;
  bf16_t* Gs = (bf16_t*)shm;
  bf16_t* Us = (bf16_t*)(shm + 2 * GLEN * 2);
  { unsigned zz = 0u; asm volatile("" : "+v"(zz)); u32x4 z; z[0] = zz; z[1] = zz; z[2] = zz; z[3] = zz; for (int i = tid; i < 2 * 4 * USTR / 8; i += 512) ((u32x4*)Us)[i] = z; }
  __syncthreads();
  const int ch = wid >> 2, q = wid & 3, i = lane & 31, g = lane >> 5, a_l = i >> 2, b = i & 3;
  const bf16_t* G = (const bf16_t*)(p.ws + OFF_G + (size_t)l * G_LAYER); bf16_t* UT = (bf16_t*)(p.ws + OFF_UT);
  const int mb = LOFF - i + 8 * g - 128 * (8 * q + 7);
  const unsigned sh = (unsigned)(mb & 1) * 16u;
  const unsigned* Gd = (const unsigned*)(Gs + ch * GLEN) + (mb >> 1);
  const bf16_t* Ub = Us + (ch * 4 + b) * USTR + 136 * (a_l + 1) + 8 * g;
#define CONV_LDFRAG(dst, n) do { const unsigned* q_ = Gd + 8 * (n); const unsigned d0 = q_[0], d1 = q_[1], d2 = q_[2], d3 = q_[3], d4 = q_[4]; u32x4 r_; \
    r_[0] = __builtin_amdgcn_alignbit(d1, d0, sh); r_[1] = __builtin_amdgcn_alignbit(d2, d1, sh); r_[2] = __builtin_amdgcn_alignbit(d3, d2, sh); r_[3] = __builtin_amdgcn_alignbit(d4, d3, sh); \
    dst = __builtin_bit_cast(bf16x8, r_); } while (0)
  unsigned pgv[17]; u32x4 puv[8];
#define CONV_PREFETCH(pr_) do { \
    _Pragma("unroll") for (int e = 0; e < 17; ++e) { const int m = tid + 512 * e; unsigned v = 0u; if (m >= 33 && m <= 8223) v = *(const unsigned*)(G + (size_t)m * 2048 + 2 * (pr_)); pgv[e] = v; } \
    _Pragma("unroll") for (int e = 0; e < 8; ++e) { const int id = tid + 512 * e, cc = id >> 11, bb = (id >> 9) & 3, s8 = id & 511; puv[e] = *(const u32x4*)(UT + ((size_t)((pr_) * 2 + cc) * 4 + bb) * SEQ + s8 * 8); } } while (0)
  if ((int)blockIdx.x < 1024) CONV_PREFETCH((int)blockIdx.x);
  for (int pr = blockIdx.x; pr < 1024; pr += gridDim.x) {
#pragma unroll
    for (int e = 0; e < 17; ++e) { const int m = tid + 512 * e; if (m < GLEN) { Gs[m] = (bf16_t)(pgv[e] & 0xffffu); Gs[GLEN + m] = (bf16_t)(pgv[e] >> 16); } }
#pragma unroll
    for (int e = 0; e < 8; ++e) { const int id = tid + 512 * e, cc = id >> 11, bb = (id >> 9) & 3, s8 = id & 511; const int sp = 1024 + s8 * 8;
      *(u32x4*)(Us + (cc * 4 + bb) * USTR + sp + 8 * (sp >> 7)) = puv[e]; }
    __syncthreads();
    if (pr + (int)gridDim.x < 1024) CONV_PREFETCH(pr + (int)gridDim.x);
    bf16x8 W[8]; f32x16 acc[4];
#pragma unroll
    for (int h = 0; h < 4; ++h)
#pragma unroll
      for (int e = 0; e < 16; ++e) acc[h][e] = 0.f;
    CONV_LDFRAG(W[2], -6); CONV_LDFRAG(W[3], -5); CONV_LDFRAG(W[4], -4); CONV_LDFRAG(W[5], -3); CONV_LDFRAG(W[6], -2); CONV_LDFRAG(W[7], -1);
#pragma unroll 1
    for (int it = 0; it < 39; ++it) {
#pragma unroll
      for (int u = 0; u < 8; ++u) {
        CONV_LDFRAG(W[u], it * 8 + u);
        const bf16x8 bf = *(const bf16x8*)(Ub + 136 * it + 16 * u);
#pragma unroll
        for (int h = 0; h < 4; ++h) acc[h] = __builtin_amdgcn_mfma_f32_32x32x16_bf16(W[(u - 2 * h) & 7], bf, acc[h], 0, 0, 0);
      }
    }
    { bf16_t* yrow = UT + ((size_t)(pr * 2 + ch) * 4 + b) * SEQ + 128 * (8 * q + a_l) + 4 * g;
#pragma unroll
      for (int h = 0; h < 4; ++h)
#pragma unroll
        for (int rq = 0; rq < 4; ++rq) { u32x2 o; o[0] = pk2(acc[h][4 * rq], acc[h][4 * rq + 1]); o[1] = pk2(acc[h][4 * rq + 2], acc[h][4 * rq + 3]); *(u32x2*)(yrow + 32 * h + 8 * rq) = o; } }
    __syncthreads();
  }
#undef CONV_LDFRAG
#undef CONV_PREFETCH
}

template <int KD> DI f32x16 mma_tile(f32x16 acc, const bf16_t* A, int lda, const bf16_t* B, int ldb, int lane) {
  const int r = lane & 31, g8 = (lane >> 5) * 8; const bf16_t* ap = A + r * lda + g8; const bf16_t* bp = B + r * ldb + g8;
#pragma unroll 4
  for (int k0 = 0; k0 < KD; k0 += 16) acc = __builtin_amdgcn_mfma_f32_32x32x16_bf16(*(const bf16x8*)(ap + k0), *(const bf16x8*)(bp + k0), acc, 0, 0, 0);
  return acc;
}
DI bf16x8 tr_frag(const bf16_t* img, int ld, int lane) {
  const int h = lane >> 5, blk = (lane >> 4) & 1, q = (lane & 15) >> 2, pp = lane & 3;
  const bf16_t* a = img + (8 * h + q) * ld + 16 * blk + 4 * pp;
  const s16x4 r0 = __builtin_amdgcn_ds_read_tr16_b64_v4i16((__attribute__((address_space(3))) s16x4*)a);
  const s16x4 r1 = __builtin_amdgcn_ds_read_tr16_b64_v4i16((__attribute__((address_space(3))) s16x4*)(a + 4 * ld));
  bf16x8 f; f[0] = r0[0]; f[1] = r0[1]; f[2] = r0[2]; f[3] = r0[3]; f[4] = r1[0]; f[5] = r1[1]; f[6] = r1[2]; f[7] = r1[3]; return f;
}
__device__ void phase_ret(const Params& p, int l, unsigned char* shm) {
  constexpr int QS = 264, VS = 144, TS = 72;
  const int tid = otid(p.wid), lane = tid & 63, wid = tid >> 6, g = lane >> 5;
  bf16_t* Qs = (bf16_t*)shm; bf16_t* Ks = Qs + 64 * QS; bf16_t* Vs = Ks + 64 * QS; bf16_t* Ps = Vs + 64 * VS; bf16_t* Sts = Ps + 64 * TS;
  const bf16_t* PQ = (const bf16_t*)(p.ws + OFF_PQ); const bf16_t* PK = (const bf16_t*)(p.ws + OFF_PK); const bf16_t* PV = (const bf16_t*)(p.ws + OFF_PV);
  for (int it0 = blockIdx.x; it0 < 256; it0 += gridDim.x) {
    int it = it0;
    if (gridDim.x == 256) { const int xcd = it0 & 7, idx = it0 >> 3; it = ((xcd + 8 * (idx >> 2)) << 2) | (idx & 3); }
    const int sl = it & 3, dir = (it >> 2) & 1, h = (it >> 3) & 7, b = it >> 6;
    const float lg = -expf(p.ret_decay[(l * 2 + dir) * 8 + h]);
    bf16_t* O = (bf16_t*)(p.ws + (dir ? OFF_OB : OFF_OF));
    for (int i = tid; i < 128 * QS / 2; i += 512) ((unsigned*)Sts)[i] = 0u;
    f32x16 S[4], cross;
#pragma unroll
    for (int x = 0; x < 4; ++x)
#pragma unroll
      for (int e = 0; e < 16; ++e) S[x][e] = 0.f;
#pragma unroll
    for (int e = 0; e < 16; ++e) cross[e] = 0.f;
    const float cd = __expf(lg * 64.f);
    const int tid2 = otid(p.wid), ln2 = tid2 & 63, g2 = ln2 >> 5, w2 = tid2 >> 6;
    float mk[16], dkv[2];
#pragma unroll
    for (int e = 0; e < 2; ++e) { const int tok = (tid2 >> 4) + 32 * e; dkv[e] = __expf(lg * (float)(dir ? tok : 63 - tok)); }
    const int wq = w2 & 3, s_tj = wq >> 1, s_ti = wq & 1;
    const int o_tc = w2 >> 1, o_ti = w2 & 1;
    { const int i = s_ti * 32 + (ln2 & 31);
#pragma unroll
      for (int e = 0; e < 16; ++e) { const int j = s_tj * 32 + (e & 3) + 8 * (e >> 2) + 4 * g2; const int diff = dir ? (j - i) : (i - j); mk[e] = diff >= 0 ? __expf(lg * (float)(dir ? -i : i - 63)) : 0.f; } }
    const int qi = o_ti * 32 + (ln2 & 31);
    const float qd = __expf(lg * (float)(dir ? 64 - qi : qi + 1));
    u32x4 rq[4], rk[4], rv[2];
    const unsigned qo_l = (unsigned)(tid >> 5) * 2048u + (unsigned)(h * 256 + (tid & 31) * 8);
    const unsigned vo_l = (unsigned)(tid >> 4) * 4096u + (unsigned)(h * 512 + sl * 128 + (tid & 15) * 8);
#define RET_CHUNK(step_, isctx_, t0_) do { if ((step_) < 4) { isctx_ = true; t0_ = (dir ? 3 - (step_) : (step_)) * 64; } else { isctx_ = false; const int cn_ = (step_) - 4; t0_ = (dir ? 63 - cn_ : cn_) * 64; } } while (0)
#define RET_LOAD(step_) do { bool ic_; int t0n_; RET_CHUNK(step_, ic_, t0n_); const unsigned rw_ = (unsigned)tok_row(b, t0n_, ic_); \
      _Pragma("unroll") for (int e = 0; e < 4; ++e) { rq[e] = *(const u32x4*)(PQ + (rw_ * 2048u + qo_l + (unsigned)e * 32768u)); rk[e] = *(const u32x4*)(PK + (rw_ * 2048u + qo_l + (unsigned)e * 32768u)); } \
      _Pragma("unroll") for (int e = 0; e < 2; ++e) rv[e] = *(const u32x4*)(PV + (rw_ * 4096u + vo_l + (unsigned)e * 131072u)); } while (0)
    RET_LOAD(0);
#pragma unroll 1
    for (int step = 0; step < 68; ++step) {
      bool isctx; int t0; RET_CHUNK(step, isctx, t0);
      const int row0 = tok_row(b, t0, isctx);
      __syncthreads();
#pragma unroll
      for (int e = 0; e < 4; ++e) { const int row = (tid >> 5) + 16 * e, pc = tid & 31; *(u32x4*)(Qs + row * QS + pc * 8) = rq[e]; *(u32x4*)(Ks + row * QS + pc * 8) = rk[e]; }
#pragma unroll
      for (int e = 0; e < 2; ++e) { u32x4 o;
#pragma unroll
        for (int w = 0; w < 4; ++w) o[w] = pk2(lo2f(rv[e][w]) * dkv[e], hi2f(rv[e][w]) * dkv[e]);
        *(u32x4*)(Vs + ((tid >> 4) + 32 * e) * VS + (tid & 15) * 8) = o; }
      if (step + 1 < 68) RET_LOAD(step + 1);
      __syncthreads();
      if (wid < 4) {
        f32x16 sc;
#pragma unroll
        for (int e = 0; e < 16; ++e) sc[e] = 0.f;
        sc = mma_tile<256>(sc, Ks + s_tj * 32 * QS, QS, Qs + s_ti * 32 * QS, QS, lane);
        const int i = s_ti * 32 + (lane & 31);
#pragma unroll
        for (int r4 = 0; r4 < 4; ++r4) { u32x2 o; o[0] = pk2(sc[4 * r4] * mk[4 * r4], sc[4 * r4 + 1] * mk[4 * r4 + 1]); o[1] = pk2(sc[4 * r4 + 2] * mk[4 * r4 + 2], sc[4 * r4 + 3] * mk[4 * r4 + 3]);
          *(u32x2*)(Ps + i * TS + s_tj * 32 + 8 * r4 + 4 * g) = o; }
      }
#pragma unroll
      for (int e = 0; e < 16; ++e) cross[e] = 0.f;
      cross = mma_tile<256>(cross, Sts + o_tc * 32 * QS, QS, Qs + o_ti * 32 * QS, QS, lane);
      __syncthreads();
      { f32x16 in_;
#pragma unroll
        for (int e = 0; e < 16; ++e) in_[e] = 0.f;
        const bf16_t* pb = Ps + (o_ti * 32 + (lane & 31)) * TS + 8 * g;
#pragma unroll
        for (int ks = 0; ks < 4; ++ks) in_ = __builtin_amdgcn_mfma_f32_32x32x16_bf16(tr_frag(Vs + 16 * ks * VS + 32 * o_tc, VS, lane), *(const bf16x8*)(pb + 16 * ks), in_, 0, 0, 0);
        const unsigned ob = (unsigned)(row0 + qi) * 4096u + (unsigned)(h * 512 + sl * 128 + o_tc * 32 + 4 * g);
#pragma unroll
        for (int r4 = 0; r4 < 4; ++r4) { u32x2 o; o[0] = pk2(in_[4 * r4] + qd * cross[4 * r4], in_[4 * r4 + 1] + qd * cross[4 * r4 + 1]); o[1] = pk2(in_[4 * r4 + 2] + qd * cross[4 * r4 + 2], in_[4 * r4 + 3] + qd * cross[4 * r4 + 3]);
          *(u32x2*)(O + (ob + (unsigned)(8 * r4))) = o; } }
      { bf16x8 ka[4];
#pragma unroll
        for (int ks = 0; ks < 4; ++ks) ka[ks] = tr_frag(Ks + 16 * ks * QS + 32 * wid, QS, lane);
#pragma unroll
        for (int x = 0; x < 4; ++x) {
#pragma unroll
          for (int e = 0; e < 16; ++e) S[x][e] *= cd;
#pragma unroll
          for (int ks = 0; ks < 4; ++ks) S[x] = __builtin_amdgcn_mfma_f32_32x32x16_bf16(ka[ks], tr_frag(Vs + 16 * ks * VS + 32 * x, VS, lane), S[x], 0, 0, 0);
          const int c = x * 32 + (lane & 31);
#pragma unroll
          for (int r4 = 0; r4 < 4; ++r4) { u32x2 o; o[0] = pk2(S[x][4 * r4], S[x][4 * r4 + 1]); o[1] = pk2(S[x][4 * r4 + 2], S[x][4 * r4 + 3]); *(u32x2*)(Sts + c * QS + wid * 32 + 8 * r4 + 4 * g) = o; } } }
    }
    __syncthreads();
  }
#undef RET_CHUNK
#undef RET_LOAD
}

template <int MODE> __device__ void ctx_gemm(const Params& p, const bf16_t* X, int ldx, const bf16_t* W, int K, unsigned char* shm) {
  constexpr int KC = 128, LD = KC + 8;
  const int tid = otid(p.wid), lane = tid & 63, wid = tid >> 6, g = lane >> 5;
  bf16_t* Xs = (bf16_t*)shm; bf16_t* Ws = Xs + 128 * LD;
  for (int tile = blockIdx.x; tile < 256; tile += gridDim.x) {
    const int tok0 = (tile >> 5) * 128, n0 = (tile & 31) * 64, wt = wid & 3, wn = wid >> 2;
    f32x16 acc;
#pragma unroll
    for (int e = 0; e < 16; ++e) acc[e] = 0.f;
    u32x4 xr[4], wr[2];
    const unsigned xo = (unsigned)(tok0 + (tid >> 4)) * (unsigned)ldx + (unsigned)((tid & 15) * 8);
    const unsigned wo = (unsigned)(n0 + (tid >> 4)) * (unsigned)K + (unsigned)((tid & 15) * 8);
#define CG_LOAD(kc_) do { _Pragma("unroll") for (int e = 0; e < 4; ++e) xr[e] = *(const u32x4*)(X + (xo + (unsigned)(32 * e) * (unsigned)ldx + (unsigned)((kc_) * KC))); \
      _Pragma("unroll") for (int e = 0; e < 2; ++e) wr[e] = *(const u32x4*)(W + (wo + (unsigned)(32 * e) * (unsigned)K + (unsigned)((kc_) * KC))); } while (0)
    CG_LOAD(0);
    const int nkc = K / KC;
#pragma unroll 1
    for (int kc = 0; kc < nkc; ++kc) {
      __syncthreads();
#pragma unroll
      for (int e = 0; e < 4; ++e) *(u32x4*)(Xs + ((tid >> 4) + 32 * e) * LD + (tid & 15) * 8) = xr[e];
#pragma unroll
      for (int e = 0; e < 2; ++e) *(u32x4*)(Ws + ((tid >> 4) + 32 * e) * LD + (tid & 15) * 8) = wr[e];
      if (kc + 1 < nkc) CG_LOAD(kc + 1);
      __syncthreads();
      acc = mma_tile<KC>(acc, Ws + wn * 32 * LD, LD, Xs + wt * 32 * LD, LD, lane);
    }
#undef CG_LOAD
    const int tok = tok0 + wt * 32 + (lane & 31), nb = n0 + wn * 32 + 4 * g;
    if (MODE < 2) {
      bf16_t* T1 = (bf16_t*)(p.ws + OFF_T1) + (size_t)(NLAT + tok) * 2048; const bf16_t* MG = (const bf16_t*)(p.ws + OFF_PMG) + (size_t)(NLAT + tok) * 4096 + (MODE ? 2048 : 0);
#pragma unroll
      for (int r4 = 0; r4 < 4; ++r4) { const int n = nb + 8 * r4; const u32x2 gg = *(const u32x2*)(MG + n);
        float r0 = sigmoidf_(lo2f(gg[0])) * acc[4 * r4], r1 = sigmoidf_(hi2f(gg[0])) * acc[4 * r4 + 1], r2 = sigmoidf_(lo2f(gg[1])) * acc[4 * r4 + 2], r3 = sigmoidf_(hi2f(gg[1])) * acc[4 * r4 + 3];
        if (MODE == 1) { const u32x2 t = *(const u32x2*)(T1 + n); r0 += lo2f(t[0]); r1 += hi2f(t[0]); r2 += lo2f(t[1]); r3 += hi2f(t[1]); }
        u32x2 o; o[0] = pk2(r0, r1); o[1] = pk2(r2, r3); *(u32x2*)(T1 + n) = o; }
    } else {
      const float* cin = p.ctx + (size_t)tok * 2048; float* cout = (float*)(p.ws + OFF_CTXR) + (size_t)tok * 2048; const float* gate = (const float*)(p.ws + OFF_MOD) + 4 * 6144 + 4096;
#pragma unroll
      for (int r4 = 0; r4 < 4; ++r4) { const int n = nb + 8 * r4; const f32x4 xv = *(const f32x4*)(cin + n), gv = *(const f32x4*)(gate + n); f32x4 a; a[0] = acc[4 * r4]; a[1] = acc[4 * r4 + 1]; a[2] = acc[4 * r4 + 2]; a[3] = acc[4 * r4 + 3];
        *(f32x4*)(cout + n) = xv + gv * a; }
    }
    __syncthreads();
  }
}

__global__ void __launch_bounds__(512, 2) mega(Params p_in) {
  Params p = p_in; p.wid = __builtin_amdgcn_readfirstlane((int)(threadIdx.x >> 6));
  extern __shared__ __attribute__((aligned(16))) unsigned char shm[];
  cg::grid_group grid = cg::this_grid();
  PG8_LAS unsigned char* lds = (PG8_LAS unsigned char*)shm;
  volatile XLAS unsigned* xst = (volatile XLAS unsigned*)(lds + 163824);
  if (otid(p.wid) == 0) { xst[0] = 0u; xst[1] = 0u; }
  __syncthreads();
  const XcdBarrier xb = xcd_barrier_post((unsigned*)(p.ws + OFF_BAR), xst, otid(p.wid) == 0);
  const bf16_t* H = (const bf16_t*)(p.ws + OFF_H);
#pragma unroll 1
  for (int rep = 0; rep < (PROBE == 1 ? 2 : 1); ++rep) { phase_filters(p, shm); phase_mod(p, shm); }
  grid.sync();
  for (int l = 0; l < 2; ++l) {
#pragma unroll 1
    for (int rep = 0; rep < (PROBE == 1 ? 2 : 1); ++rep) { phase_cvt(p, l, shm); phase_norm(p, l); }
    xcd_barrier(xb, otid(p.wid) == 0);
    { pg8::Gemm g; g.wid = p.wid; g.A = H; g.Bt = (const bf16_t*)(p.ws + OFF_WTIN); g.M = MT; g.N = INW; g.K = DM;
      pg8::Order S; S.init(64, 96, (int)gridDim.x, (int)blockIdx.x, 4, l == 0 ? 96 : 24, l == 0 ? 0 : 8);
      EpiG1 E; E.ws = p.ws; pg8::gemm_phase<EpiG1, pg8::Order>(lds, g, S, E); }
    xcd_barrier(xb, otid(p.wid) == 0);
#pragma unroll 1
    for (int rep = 0; rep < (PROBE == 2 ? 2 : 1); ++rep) phase_prep(p, l, shm, rep ? 4 : 7);
    xcd_barrier(xb, otid(p.wid) == 0);
    phase_conv(p, l, shm);
#pragma unroll 1
    for (int rep = 0; rep < (PROBE == 3 ? 2 : 1); ++rep) phase_ret(p, l, shm);
    xcd_barrier(xb, otid(p.wid) == 0);
#pragma unroll 1
    for (int rep = 0; rep < (PROBE == 2 ? 2 : 1); ++rep) phase_post(p, l, shm, rep ? 3 : 7);
    xcd_barrier(xb, otid(p.wid) == 0);
    { const int nM = 64;
      pg8::Order S; S.init(nM, 8, (int)gridDim.x, (int)blockIdx.x, 0, 0, 0);
#pragma unroll 1
      for (int rep = 0; rep < (PROBE == 4 ? 2 : 1); ++rep) {
      { pg8::Gemm g; g.wid = p.wid; g.A = H; g.Bt = (const bf16_t*)(p.ws + OFF_WTHY); g.M = nM * 256; g.N = DM; g.K = DM; EpiG23<0> E; E.ws = p.ws; pg8::gemm_phase<EpiG23<0>, pg8::Order>(lds, g, S, E); }
      { pg8::Gemm g; g.wid = p.wid; g.A = (const bf16_t*)(p.ws + OFF_OF); g.Bt = (const bf16_t*)(p.ws + OFF_WTRET); g.M = nM * 256; g.N = DM; g.K = 4096; EpiG23<1> E; E.ws = p.ws; pg8::gemm_phase<EpiG23<1>, pg8::Order>(lds, g, S, E); }
      }
      if (l == 0) { ctx_gemm<0>(p, H + (size_t)NLAT * 2048, 2048, (const bf16_t*)(p.ws + OFF_WTHY), 2048, shm);
                    ctx_gemm<1>(p, (const bf16_t*)(p.ws + OFF_OF) + (size_t)NLAT * 4096, 4096, (const bf16_t*)(p.ws + OFF_WTRET), 4096, shm); }
      xcd_barrier(xb, otid(p.wid) == 0);
      { pg8::Gemm g; g.wid = p.wid; g.A = (const bf16_t*)(p.ws + OFF_T1); g.Bt = (const bf16_t*)(p.ws + OFF_WTO); g.M = nM * 256; g.N = DM; g.K = DM;
        EpiG4 E; E.xin = (l == 0) ? p.x : p.out; E.cin = p.ctx; E.xout = p.out; E.cout = (float*)(p.ws + OFF_CTXR); E.mod = (const float*)(p.ws + OFF_MOD) + (size_t)l * 5 * 6144;
        pg8::gemm_phase<EpiG4, pg8::Order>(lds, g, S, E); }
      if (l == 0) ctx_gemm<2>(p, (const bf16_t*)(p.ws + OFF_T1) + (size_t)NLAT * 2048, 2048, (const bf16_t*)(p.ws + OFF_WTO), 2048, shm); }
    xcd_barrier(xb, otid(p.wid) == 0);
  }
  phase_final(p);
}

extern "C" void kernel_launch(void* const* d_in, const int* in_sizes, int n_in, void* d_out, int out_size, void* d_ws, size_t ws_size, hipStream_t stream) {
  constexpr size_t kDynLds = 163840;
  static int grid_blocks = 0;
  if (!grid_blocks) {
    hipFuncSetAttribute((const void*)mega, hipFuncAttributeMaxDynamicSharedMemorySize, (int)kDynLds);
    int dev = 0, cus = 0, per_cu = 0;
    hipGetDevice(&dev);
    hipDeviceGetAttribute(&cus, hipDeviceAttributeMultiprocessorCount, dev);
    hipOccupancyMaxActiveBlocksPerMultiprocessor(&per_cu, (const void*)mega, 512, kDynLds);
    grid_blocks = cus * (per_cu >= 1 ? 1 : 0);
    if (ws_size < WS_NEED || grid_blocks <= 0) { fprintf(stderr, "workspace %zu < %zu or no occupancy (%d)\n", ws_size, (size_t)WS_NEED, per_cu); grid_blocks = grid_blocks > 0 ? grid_blocks : 256; }
  }
  Params p{};
  p.x = (const float*)d_in[0]; p.c = (const float*)d_in[1]; p.ctx = (const float*)d_in[2]; p.c_ctx = (const float*)d_in[3]; p.ln_g = (const float*)d_in[4];
  p.ada_w = (const float*)d_in[5]; p.ada_b = (const float*)d_in[6]; p.w_in = (const float*)d_in[7]; p.conv_w = (const float*)d_in[8]; p.conv_b = (const float*)d_in[9];
  p.fw1 = (const float*)d_in[10]; p.fb1 = (const float*)d_in[11]; p.fw2 = (const float*)d_in[12]; p.fb2 = (const float*)d_in[13]; p.fw3 = (const float*)d_in[14]; p.fb3 = (const float*)d_in[15];
  p.ffreq = (const float*)d_in[16]; p.fwout = (const float*)d_in[17]; p.hy_bias = (const float*)d_in[18]; p.ret_decay = (const float*)d_in[19];
  p.w_hy_out = (const float*)d_in[20]; p.w_ret_out = (const float*)d_in[21]; p.w_o = (const float*)d_in[22]; p.final_g = (const float*)d_in[23];
  p.out = (float*)d_out; p.ws = (unsigned char*)d_ws;
  void* args[] = {&p};
  (void)hipMemsetAsync((unsigned char*)d_ws + OFF_BAR, 0, (size_t)XCD_BAR_WORDS * 4, stream);
  hipError_t e = hipLaunchCooperativeKernel((void*)mega, dim3(grid_blocks), dim3(512), args, kDynLds, stream);
  if (e != hipSuccess) fprintf(stderr, "cooperative launch failed: %s (grid %d)\n", hipGetErrorString(e), grid_blocks);
}
```

```cpp
#include <hip/hip_runtime.h>
#include <hip/hip_cooperative_groups.h>
#include <cstdio>
namespace cg = cooperative_groups;
#ifndef PROBE
#define PROBE 0
#endif

typedef unsigned short bf16_t;
typedef short bf16x8 __attribute__((ext_vector_type(8)));
typedef float f32x4 __attribute__((ext_vector_type(4)));
typedef float f32x16 __attribute__((ext_vector_type(16)));
typedef unsigned u32x4 __attribute__((ext_vector_type(4)));
typedef unsigned u32x2 __attribute__((ext_vector_type(2)));
typedef short s16x4 __attribute__((ext_vector_type(4)));
#define DI __device__ __forceinline__

DI int otid(int wid) { int t; asm volatile("v_mbcnt_lo_u32_b32 %0, -1, 0\n\tv_mbcnt_hi_u32_b32 %0, -1, %0" : "=v"(t)); return wid * 64 + t; }
DI float wsum(float v, int lane) {
#pragma unroll
  for (int o = 32; o > 0; o >>= 1) v += __int_as_float(__builtin_amdgcn_ds_bpermute((lane ^ o) << 2, __float_as_int(v)));
  return v; }
DI float bf2f(bf16_t u) { return __uint_as_float(((unsigned)u) << 16); }
typedef __bf16 bf16v2 __attribute__((ext_vector_type(2)));
typedef float f32v2 __attribute__((ext_vector_type(2)));
DI unsigned pk2(float lo, float hi) { f32v2 v = {lo, hi}; bf16v2 b = __builtin_convertvector(v, bf16v2); return __builtin_bit_cast(unsigned, b); }
DI bf16_t f2bf(float f) { return (bf16_t)(pk2(f, 0.f) & 0xffffu); }
DI float lo2f(unsigned u) { return __uint_as_float(u << 16); }
DI float hi2f(unsigned u) { return __uint_as_float(u & 0xffff0000u); }
DI float sigmoidf_(float v) { return 1.f / (1.f + __expf(-v)); }
DI float siluf_(float v) { return v / (1.f + __expf(-v)); }

constexpr int DM = 2048, NB = 4, SEQ = 4096, CTXL = 256, NLAT = NB * SEQ, NCTX = NB * CTXL, MT = NLAT + NCTX;
constexpr int INW = 24576, NH = 8, DK = 256, DV = 512, TT = SEQ + CTXL;
constexpr int LOFF = 4128, GLEN = 8320;      constexpr size_t G_LAYER = ((size_t)2048 * 8320 * 2 + 255) & ~(size_t)255;
constexpr int USTR = 6560;

constexpr size_t AL(size_t x) { return (x + 255) & ~(size_t)255; }
constexpr size_t OFF_WTIN = 0;
constexpr size_t OFF_WTHY = OFF_WTIN + AL((size_t)INW * DM * 2);
constexpr size_t OFF_WTRET = OFF_WTHY + AL((size_t)DM * DM * 2);
constexpr size_t OFF_WTO = OFF_WTRET + AL((size_t)DM * 4096 * 2);
constexpr size_t OFF_G = OFF_WTO + AL((size_t)DM * DM * 2);
constexpr size_t OFF_GC = OFF_G + 2 * AL((size_t)DM * GLEN * 2);
constexpr size_t OFF_MOD = OFF_GC + AL((size_t)DM * 512 * 4);
constexpr size_t OFF_H = OFF_MOD + AL((size_t)2 * 5 * 6144 * 4);
constexpr size_t OFF_PQ = OFF_H + AL((size_t)MT * DM * 2);
constexpr size_t OFF_PK = OFF_PQ + AL((size_t)MT * DM * 2);
constexpr size_t OFF_PV = OFF_PK + AL((size_t)MT * DM * 2);
constexpr size_t OFF_PRG = OFF_PV + AL((size_t)MT * 4096 * 2);
constexpr size_t OFF_PHY = OFF_PRG + AL((size_t)MT * 4096 * 2);
constexpr size_t OFF_PHG = OFF_PHY + AL((size_t)MT * 6144 * 2);
constexpr size_t OFF_PMG = OFF_PHG + AL((size_t)MT * DM * 2);
constexpr size_t OFF_KT = OFF_PMG + AL((size_t)MT * 4096 * 2);
constexpr size_t OFF_VT = OFF_KT + AL((size_t)NB * NH * DK * TT * 2);
constexpr size_t OFF_UT = OFF_VT + AL((size_t)NB * NH * DV * TT * 2);
constexpr size_t OFF_UTC = OFF_UT + AL((size_t)DM * NB * SEQ * 2);
constexpr size_t OFF_HV = OFF_UTC + AL((size_t)DM * NB * CTXL * 2);
constexpr size_t OFF_HX0 = OFF_HV + AL((size_t)MT * DM * 2);
constexpr size_t OFF_CTXR = OFF_HX0 + AL((size_t)MT * DM * 2);
constexpr size_t OFF_BAR = OFF_CTXR + AL((size_t)NCTX * DM * 4);
constexpr size_t OFF_CS = OFF_BAR + AL((size_t)3456 * 4);
constexpr size_t WS_NEED = OFF_CS + AL((size_t)4096 * 8);
constexpr size_t OFF_GS = OFF_KT + AL((size_t)MT * 4096 * 2);
constexpr size_t OFF_OF = OFF_KT, OFF_OB = OFF_PHY, OFF_T1 = OFF_PHY + AL((size_t)MT * 4096 * 2);

struct Params {
  const float *x, *c, *ctx, *c_ctx, *ln_g, *ada_w, *ada_b, *w_in, *conv_w, *conv_b, *fw1, *fb1, *fw2, *fb2, *fw3, *fb3, *ffreq, *fwout, *hy_bias, *ret_decay, *w_hy_out, *w_ret_out, *w_o, *final_g;
  float* out;
  unsigned char* ws;
  int wid, pad_;
};


#define XB_TMO      128
#define XB_XCNT(j)  (256  + 64 * (j))
#define XB_XSUB(j)  (1280 + 64 * (j))
#define XB_XGEN(j)  (2304 + 64 * (j))
#define XB_TOP      3328
#define XB_TOPGEN   3392
#define XCD_BAR_WORDS 3456
#define XB_SPIN_CAP (1u << 18)
#define XLAS __attribute__((address_space(3)))
DI unsigned xb_ld(unsigned* p)              { return __hip_atomic_load(p, __ATOMIC_RELAXED, __HIP_MEMORY_SCOPE_AGENT); }
DI unsigned xb_add(unsigned* p, unsigned v) { return __hip_atomic_fetch_add(p, v, __ATOMIC_RELAXED, __HIP_MEMORY_SCOPE_AGENT); }
DI unsigned xb_xcc_id() { return (unsigned)__builtin_amdgcn_s_getreg((3 << 11) | 20) & 0xFu; }
#define XB_SPIN(cond, bar) do { unsigned _sp = 0; while (cond) { __builtin_amdgcn_s_sleep(1); \
    if ((++_sp & 255u) == 0u) { if (xb_ld(&(bar)[XB_TMO])) break; if (_sp > XB_SPIN_CAP) { atomicAdd(&(bar)[XB_TMO], 1u); break; } } } } while (0)
struct XcdBarrier { unsigned* bar; unsigned x; volatile XLAS unsigned* st; };
DI XcdBarrier xcd_barrier_post(unsigned* bar, volatile XLAS unsigned* st, bool leader) {
    XcdBarrier b; b.bar = bar; b.x = xb_xcc_id(); b.st = st;
    if (leader) (void)xb_add(&bar[XB_XCNT(b.x)], 1u);
    return b;
}
DI void xcd_barrier_complete(unsigned* bar, unsigned x, unsigned& nloc, unsigned& nx) {
    const unsigned G = gridDim.x * gridDim.y * gridDim.z;
    unsigned sum, cnt, mine, sp = 0u;
    for (;;) {
        sum = 0u; cnt = 0u; mine = 0u;
#pragma unroll
        for (unsigned j = 0; j < 16; ++j) { const unsigned c = xb_ld(&bar[XB_XCNT(j)]); sum += c; cnt += (c > 0u) ? 1u : 0u; mine = (j == x) ? c : mine; }
        if (sum == G) break;
        __builtin_amdgcn_s_sleep(1);
        if ((++sp & 255u) == 0u) { if (xb_ld(&bar[XB_TMO])) break; if (sp > XB_SPIN_CAP) { atomicAdd(&bar[XB_TMO], 1u); break; } }
    }
    nloc = mine > 0u ? mine : 1u; nx = cnt > 0u ? cnt : 1u;
}
DI void xcd_barrier(const XcdBarrier& b, bool leader) {
    asm volatile("s_waitcnt vmcnt(0)" ::: "memory");
    __syncthreads();
    if (leader) {
        unsigned* bar = b.bar;
        __builtin_amdgcn_s_waitcnt(0);
        unsigned nloc = b.st[0], nx = b.st[1];
        if (nloc == 0u) { xcd_barrier_complete(bar, b.x, nloc, nx); b.st[0] = nloc; b.st[1] = nx; }
        const unsigned old = xb_add(&bar[XB_XSUB(b.x)], 1u);
        const unsigned gen = old / nloc;
        if (old + 1u == (gen + 1u) * nloc) {
            __builtin_amdgcn_fence(__ATOMIC_RELEASE, "agent");
            asm volatile("s_waitcnt vmcnt(0)" ::: "memory");
            const unsigned og = xb_add(&bar[XB_TOP], 1u);
            const unsigned tg = og / nx;
            if (og + 1u == (tg + 1u) * nx) xb_add(&bar[XB_TOPGEN], 1u);
            else XB_SPIN(xb_ld(&bar[XB_TOPGEN]) == tg, bar);
            __builtin_amdgcn_fence(__ATOMIC_ACQUIRE, "agent");
            xb_add(&bar[XB_XGEN(b.x)], 1u);
            asm volatile("s_waitcnt vmcnt(0)" ::: "memory");
        } else {
            XB_SPIN(xb_ld(&bar[XB_XGEN(b.x)]) == gen, bar);
            __builtin_amdgcn_fence(__ATOMIC_ACQUIRE, "agent");
            asm volatile("s_waitcnt vmcnt(0)" ::: "memory");
        }
    }
    __syncthreads();
}

namespace pg8 {
#define PG8_LAS __attribute__((address_space(3)))
constexpr int BM = 256, BK = 64, HALF = 128, HTB = HALF * BK * 2, STAGE_BYTES = 8 * HTB, NXCD = 8, WGM = 8;
__host__ __device__ __forceinline__ int lds_byte(int r, int c) { const int st = (r >> 4) * 2 + (c >> 5), rr = r & 15, cc = c & 31, ob = rr * 64 + cc * 2; return st * 1024 + (ob ^ (((ob >> 9) & 1) << 5)); }
__host__ __device__ __forceinline__ void stage_rc(int b, int& R, int& C) { const int st = b / 1024, sb = b % 1024, swz = sb ^ (((sb >> 9) & 1) << 5); R = (st >> 1) * 16 + swz / 64; C = (st & 1) * 32 + (swz % 64) / 2; }
__host__ __device__ __forceinline__ int perm32(int rho) { const int n = rho >> 4, i = rho & 15; return 8 * (i >> 2) + 4 * n + (i & 3); }
struct Unit { int pm, pn; };
struct Gemm { const bf16_t* A; const bf16_t* Bt; int M, N, K, wid; };
struct Order {
    int nM, nN, nwg, G, c, nx_m, nx_n, x_pn0;
    __device__ void init(int nM_, int nN_, int G_, int c_, int nx_m_, int nx_n_, int x_pn0_) { nM = nM_; nN = nN_; nwg = nM * nN; G = G_; c = c_; nx_m = nx_m_; nx_n = nx_n_; x_pn0 = x_pn0_; }
    __device__ bool next(int i, Unit& u) const {
        const long L = (long)i * G + c;
        if (L >= nwg) { const int e = (int)(L - nwg); if (e >= nx_m * nx_n) return false; u.pm = nM + e % nx_m; u.pn = x_pn0 + e / nx_m; return true; }
        int wgid = (int)L; { const int q = nwg / NXCD, r = nwg % NXCD, xcd = wgid % NXCD, off = wgid / NXCD; wgid = (xcd < r ? xcd * (q + 1) : r * (q + 1) + (xcd - r) * q) + off; }
        const int nig = WGM * nN, gid = wgid / nig, fm = gid * WGM, gsz = (nM - fm) < WGM ? (nM - fm) : WGM;
        u.pm = fm + ((wgid % nig) % gsz); u.pn = (wgid % nig) / gsz; return true;
    }
    __device__ __forceinline__ void a_ready(const Unit&) const {}
    __device__ __forceinline__ void done(const Unit&) const {}
};
template <class Epi, class Sched>
__device__ __forceinline__ void gemm_phase(PG8_LAS unsigned char* lds, const Gemm g, const Sched& S, const Epi& E) {
    const int tid = otid(g.wid), wid = __builtin_amdgcn_readfirstlane(tid >> 6), lane = tid & 63, wr = wid >> 2, wc = wid & 3, fr = lane & 15, fq = lane >> 4;
    const int K = g.K, nt = K / BK;
    unsigned voffA[2], voffB[2];
#pragma unroll
    for (int i = 0; i < 2; ++i) { int R, C; stage_rc(tid * 16 + i * 8192, R, C); const int Rb = Epi::PERM ? ((R & ~31) + perm32(R & 31)) : R;
        voffA[i] = (unsigned)(R * K + C) * 2u; voffB[i] = (unsigned)(Rb * K + C) * 2u; }
    const size_t kstep = (size_t)(BK * 2);
    const size_t hstep = (size_t)HALF * K * 2;
    const size_t tstep = 2 * hstep;
    const unsigned ldsw = (unsigned)wid * 1024u;
    const int aoff = lds_byte(wr * 64 + fr, fq * 8), boff = lds_byte(wc * 32 + fr, fq * 8);
#define PG8_SA(b, h) (((b) * 2 + (h)) * HTB)
#define PG8_SB(b, h) ((4 + (b) * 2 + (h)) * HTB)
#define PG8_STAGE(bufoff, gbase, voff) do { _Pragma("unroll") for (int _i = 0; _i < 2; ++_i) \
        __builtin_amdgcn_global_load_lds((const unsigned*)((const char*)(gbase) + (voff)[_i]), (PG8_LAS unsigned*)(lds + (bufoff) + ldsw + _i * 8192), 16, 0, 0); } while (0)
#define PG8_LDA(dst, b, h) do { _Pragma("unroll") for (int m = 0; m < 4; ++m) _Pragma("unroll") for (int k = 0; k < 2; ++k) dst[m][k] = *(const PG8_LAS bf16x8*)(lds + PG8_SA(b, h) + aoff + m * 2048 + k * 1024); } while (0)
#define PG8_LDB(dst, b, h) do { _Pragma("unroll") for (int n = 0; n < 2; ++n) _Pragma("unroll") for (int k = 0; k < 2; ++k) dst[n][k] = *(const PG8_LAS bf16x8*)(lds + PG8_SB(b, h) + boff + n * 2048 + k * 1024); } while (0)
#define PG8_MMA(ai, bj, At, Bt) do { __builtin_amdgcn_s_setprio(1); _Pragma("unroll") for (int m = 0; m < 4; ++m) _Pragma("unroll") for (int n = 0; n < 2; ++n) _Pragma("unroll") for (int k = 0; k < 2; ++k) \
        acc[ai][bj][m][n] = __builtin_amdgcn_mfma_f32_16x16x32_bf16(Bt[n][k], At[m][k], acc[ai][bj][m][n], 0, 0, 0); __builtin_amdgcn_s_setprio(0); } while (0)
#define PG8_WAIT_V(n) asm volatile("s_waitcnt vmcnt(" #n ")" ::: "memory")
#define PG8_WAIT_L(n) asm volatile("s_waitcnt lgkmcnt(" #n ")" ::: "memory")
#define PG8_BAR __builtin_amdgcn_s_barrier()
#define PG8_SCHED __builtin_amdgcn_sched_barrier(0)
    Unit cur, nxt; int ui = 0;
    if (!S.next(0, cur)) return;
    f32x4 acc[2][2][4][2];
#pragma unroll
    for (int a = 0; a < 2; ++a)
#pragma unroll
        for (int b = 0; b < 2; ++b)
#pragma unroll
            for (int m = 0; m < 4; ++m)
#pragma unroll
                for (int n = 0; n < 2; ++n) acc[a][b][m][n] = (f32x4){0.f, 0.f, 0.f, 0.f};
    bf16x8 At[4][2], B0[2][2], B1[2][2];
    const char* cA = (const char*)g.A + (size_t)cur.pm * tstep; const char* cB = (const char*)g.Bt + (size_t)cur.pn * tstep;
    S.a_ready(cur);
    PG8_STAGE(PG8_SB(0, 0), cB, voffB); PG8_STAGE(PG8_SA(0, 0), cA, voffA); PG8_STAGE(PG8_SB(0, 1), cB + hstep, voffB); PG8_STAGE(PG8_SA(0, 1), cA + hstep, voffA);
    if (wr == 1) PG8_BAR;
    PG8_WAIT_V(4); PG8_BAR;
    PG8_STAGE(PG8_SB(1, 0), cB + kstep, voffB); PG8_STAGE(PG8_SA(1, 0), cA + kstep, voffA); PG8_STAGE(PG8_SB(1, 1), cB + hstep + kstep, voffB);
    PG8_WAIT_V(6); PG8_BAR;
    for (;;) {
        const bool has_next = S.next(ui + 1, nxt);
        const char* nA = has_next ? (const char*)g.A + (size_t)nxt.pm * tstep : cA; const char* nB = has_next ? (const char*)g.Bt + (size_t)nxt.pn * tstep : cB;
        for (int t = 0; t < nt; t += 2) {
            const bool last = (t == nt - 2);
            const char* a1 = cA + (size_t)(t + 1) * kstep;
            const char* a2 = last ? nA : cA + (size_t)(t + 2) * kstep; const char* b2 = last ? nB : cB + (size_t)(t + 2) * kstep;
            const char* a3 = a2 + kstep; const char* b3 = b2 + kstep;
            if (last && has_next) S.a_ready(nxt);
            PG8_LDB(B0, 0, 0); PG8_SCHED; PG8_LDA(At, 0, 0); PG8_STAGE(PG8_SA(1, 1), a1 + hstep, voffA);
            PG8_WAIT_L(8); PG8_BAR; PG8_WAIT_L(0); PG8_MMA(0, 0, At, B0); PG8_BAR; PG8_SCHED;
            PG8_LDB(B1, 0, 1); PG8_STAGE(PG8_SB(0, 0), b2, voffB);
            PG8_BAR; PG8_WAIT_L(0); PG8_MMA(0, 1, At, B1); PG8_BAR;
            PG8_LDA(At, 0, 1); PG8_STAGE(PG8_SA(0, 0), a2, voffA);
            PG8_BAR; PG8_WAIT_L(0); PG8_MMA(1, 0, At, B0); PG8_BAR; PG8_SCHED;
            PG8_STAGE(PG8_SB(0, 1), b2 + hstep, voffB);
            PG8_WAIT_V(6); PG8_BAR; PG8_MMA(1, 1, At, B1); PG8_BAR;
            PG8_LDB(B0, 1, 0); PG8_SCHED; PG8_LDA(At, 1, 0); PG8_STAGE(PG8_SA(0, 1), a2 + hstep, voffA);
            PG8_WAIT_L(8); PG8_BAR; PG8_WAIT_L(0); PG8_MMA(0, 0, At, B0); PG8_BAR; PG8_SCHED;
            PG8_LDB(B1, 1, 1); PG8_STAGE(PG8_SB(1, 0), b3, voffB);
            PG8_BAR; PG8_WAIT_L(0); PG8_MMA(0, 1, At, B1); PG8_BAR;
            PG8_LDA(At, 1, 1); PG8_STAGE(PG8_SA(1, 0), a3, voffA);
            PG8_BAR; PG8_WAIT_L(0); PG8_MMA(1, 0, At, B0); PG8_BAR; PG8_SCHED;
            PG8_STAGE(PG8_SB(1, 1), b3 + hstep, voffB);
            PG8_WAIT_V(6); PG8_BAR; PG8_MMA(1, 1, At, B1); PG8_BAR;
        }
        if constexpr (!Epi::AFTER_DRAIN) { E(acc, cur, wr, wc, fr, fq); S.done(cur); }
        if (!has_next) break;
#pragma unroll
        for (int a = 0; a < 2; ++a)
#pragma unroll
            for (int b = 0; b < 2; ++b)
#pragma unroll
                for (int m = 0; m < 4; ++m)
#pragma unroll
                    for (int n = 0; n < 2; ++n) acc[a][b][m][n] = (f32x4){0.f, 0.f, 0.f, 0.f};
        cur = nxt; cA = nA; cB = nB; ++ui;
    }
    PG8_WAIT_V(0);
    if (wr == 0) PG8_BAR;
    PG8_BAR;
    if constexpr (Epi::AFTER_DRAIN) { E.fused(acc, cur, wr, wc, fr, fq, lds, wid, lane); S.done(cur); }
#undef PG8_SA
#undef PG8_SB
#undef PG8_STAGE
#undef PG8_LDA
#undef PG8_LDB
#undef PG8_MMA

#undef PG8_WAIT_V
#undef PG8_WAIT_L
#undef PG8_BAR
#undef PG8_SCHED
}
}

struct EpiG1 {
  static constexpr bool PERM = true, AFTER_DRAIN = false;
  unsigned char* ws;
  DI void operator()(const f32x4 (&acc)[2][2][4][2], const pg8::Unit& u, int wr, int wc, int fr, int fq) const {
    const int pn = u.pn; size_t off; int ld, c0;
    if (pn < 8) { off = OFF_PQ; ld = 2048; c0 = pn * 256; }
    else if (pn < 16) { off = OFF_PK; ld = 2048; c0 = (pn - 8) * 256; }
    else if (pn < 32) { off = OFF_PV; ld = 4096; c0 = (pn - 16) * 256; }
    else if (pn < 48) { off = OFF_PRG; ld = 4096; c0 = (pn - 32) * 256; }
    else if (pn < 72) { off = OFF_PHY; ld = 6144; c0 = (pn - 48) * 256; }
    else if (pn < 80) { off = OFF_PHG; ld = 2048; c0 = (pn - 72) * 256; }
    else { off = OFF_PMG; ld = 4096; c0 = (pn - 80) * 256; }
    bf16_t* base = (bf16_t*)(ws + off);
    const int row0 = u.pm * 256 + wr * 64 + fr, col0 = c0 + wc * 32 + 8 * fq;
    const bool rope = (pn < 16) && (u.pm < 64);
    const float4* CS = (const float4*)(ws + OFF_CS) + (wc * 4 + fq) * 2;
#pragma unroll
    for (int ai = 0; ai < 2; ++ai)
#pragma unroll
      for (int m = 0; m < 4; ++m) { const int row = row0 + ai * 128 + m * 16; bf16_t* rowp = base + (size_t)row * ld + col0;
#pragma unroll
        for (int bj = 0; bj < 2; ++bj) { f32x4 v0 = acc[ai][bj][m][0], v1 = acc[ai][bj][m][1];
          if (rope) { const int t = row & 4095, pos = bj ? (t & 63) : (t >> 6); const float4 ca = CS[pos * 32], cb = CS[pos * 32 + 1];
            const f32x4 a = v0, b = v1;
            v0[0] = a[0] * ca.x - b[0] * ca.y; v1[0] = a[0] * ca.y + b[0] * ca.x; v0[1] = a[1] * ca.z - b[1] * ca.w; v1[1] = a[1] * ca.w + b[1] * ca.z;
            v0[2] = a[2] * cb.x - b[2] * cb.y; v1[2] = a[2] * cb.y + b[2] * cb.x; v0[3] = a[3] * cb.z - b[3] * cb.w; v1[3] = a[3] * cb.w + b[3] * cb.z; }
          u32x4 o; o[0] = pk2(v0[0], v0[1]); o[1] = pk2(v0[2], v0[3]); o[2] = pk2(v1[0], v1[1]); o[3] = pk2(v1[2], v1[3]);
          *(u32x4*)(rowp + bj * 128) = o; } }
  }
};
template <int SECOND> struct EpiG23 {
  static constexpr bool PERM = true, AFTER_DRAIN = false;
  unsigned char* ws;
  DI void operator()(const f32x4 (&acc)[2][2][4][2], const pg8::Unit& u, int wr, int wc, int fr, int fq) const {
    bf16_t* T1 = (bf16_t*)(ws + OFF_T1); const bf16_t* MG = (const bf16_t*)(ws + OFF_PMG) + (SECOND ? 2048 : 0);
    const int row0 = u.pm * 256 + wr * 64 + fr, col0 = u.pn * 256 + wc * 32 + 8 * fq;
#pragma unroll
    for (int ai = 0; ai < 2; ++ai)
#pragma unroll
      for (int m = 0; m < 4; ++m) { const size_t row = (size_t)(row0 + ai * 128 + m * 16);
#pragma unroll
        for (int bj = 0; bj < 2; ++bj) { const int col = col0 + bj * 128;
          const u32x4 g = *(const u32x4*)(MG + row * 4096 + col);
          const f32x4 v0 = acc[ai][bj][m][0], v1 = acc[ai][bj][m][1];
          float r[8];
          r[0] = sigmoidf_(lo2f(g[0])) * v0[0]; r[1] = sigmoidf_(hi2f(g[0])) * v0[1]; r[2] = sigmoidf_(lo2f(g[1])) * v0[2]; r[3] = sigmoidf_(hi2f(g[1])) * v0[3];
          r[4] = sigmoidf_(lo2f(g[2])) * v1[0]; r[5] = sigmoidf_(hi2f(g[2])) * v1[1]; r[6] = sigmoidf_(lo2f(g[3])) * v1[2]; r[7] = sigmoidf_(hi2f(g[3])) * v1[3];
          if (SECOND) { const u32x4 t = *(const u32x4*)(T1 + row * 2048 + col);
            r[0] += lo2f(t[0]); r[1] += hi2f(t[0]); r[2] += lo2f(t[1]); r[3] += hi2f(t[1]); r[4] += lo2f(t[2]); r[5] += hi2f(t[2]); r[6] += lo2f(t[3]); r[7] += hi2f(t[3]); }
          u32x4 o; o[0] = pk2(r[0], r[1]); o[1] = pk2(r[2], r[3]); o[2] = pk2(r[4], r[5]); o[3] = pk2(r[6], r[7]);
          *(u32x4*)(T1 + row * 2048 + col) = o; } }
  }
};
struct EpiG4 {
  static constexpr bool PERM = false, AFTER_DRAIN = false;
  const float* xin; const float* cin; float* xout; float* cout; const float* mod;
  DI void operator()(const f32x4 (&acc)[2][2][4][2], const pg8::Unit& u, int wr, int wc, int fr, int fq) const {
    const int row0 = u.pm * 256 + wr * 64 + fr, col0 = u.pn * 256 + wc * 32 + 4 * fq;
#pragma unroll
    for (int ai = 0; ai < 2; ++ai)
#pragma unroll
      for (int m = 0; m < 4; ++m) { const int row = row0 + ai * 128 + m * 16;
        const float* src; float* dst; const float* gate;
        if (row < NLAT) { src = xin + (size_t)row * 2048; dst = xout + (size_t)row * 2048; gate = mod + (row >> 12) * 6144 + 4096; }
        else { src = cin + (size_t)(row - NLAT) * 2048; dst = cout + (size_t)(row - NLAT) * 2048; gate = mod + 4 * 6144 + 4096; }
#pragma unroll
        for (int bj = 0; bj < 2; ++bj)
#pragma unroll
          for (int n = 0; n < 2; ++n) { const int col = col0 + bj * 128 + n * 16;
            const f32x4 xv = *(const f32x4*)(src + col), gv = *(const f32x4*)(gate + col);
            *(f32x4*)(dst + col) = xv + gv * acc[ai][bj][m][n]; } }
  }
};

__device__ void phase_mod(const Params& p, unsigned char* shm) {
  float* sc = (float*)shm; float* red = sc + 5 * 2048;
  const int tid = otid(p.wid);
  for (int i = tid; i < 5 * 2048; i += 512) { const int j = i >> 11, k = i & 2047; const float v = (j < 4) ? p.c[j * 2048 + k] : p.c_ctx[k]; sc[i] = v / (1.f + expf(-v)); }
  __syncthreads();
  { const int i = blockIdx.x * 512 + tid; if (i < 4096) { const int pos = i >> 6, j = i & 63; const float inv = 1.f / powf(10000.f, (float)j / 64.f); float sn, cn; sincosf((float)pos * inv, &sn, &cn); ((float2*)(p.ws + OFF_CS))[i] = make_float2(cn, sn); } }
  float* mod = (float*)(p.ws + OFF_MOD);
  const int cq = tid & 7, ks = tid >> 3;
  for (int it = blockIdx.x; it < 384; it += gridDim.x) {
    const int l = it / 192, nb = (it % 192) * 32;
    const float* W = p.ada_w + (size_t)l * 2048 * 6144 + nb + cq * 4;
    float acc[5][4];
#pragma unroll
    for (int j = 0; j < 5; ++j) { acc[j][0] = 0.f; acc[j][1] = 0.f; acc[j][2] = 0.f; acc[j][3] = 0.f; }
#pragma unroll 4
    for (int kk = 0; kk < 32; ++kk) { const int k = ks * 32 + kk; const float4 w = *(const float4*)(W + (size_t)k * 6144);
#pragma unroll
      for (int j = 0; j < 5; ++j) { const float s = sc[j * 2048 + k]; acc[j][0] += s * w.x; acc[j][1] += s * w.y; acc[j][2] += s * w.z; acc[j][3] += s * w.w; } }
#pragma unroll
    for (int j = 0; j < 5; ++j)
#pragma unroll
      for (int e = 0; e < 4; ++e) red[ks * 160 + j * 32 + cq * 4 + e] = acc[j][e];
    __syncthreads();
    if (tid < 160) { float s = 0.f; for (int q = 0; q < 64; ++q) s += red[q * 160 + tid]; const int j = tid >> 5, n = nb + (tid & 31); mod[(l * 5 + j) * 6144 + n] = s + p.ada_b[l * 6144 + n]; }
    __syncthreads();
  }
}

__device__ void cvt_group(int wid, const float* W, bf16_t* Wt, int K, int N, int k0, int n0, float scale, float* tile, bool perm) {
  const int tid = otid(wid);
  float4 v[8];
  int nsrc = n0 + (tid & 15) * 4;
  if (perm) { const int pc = (n0 & 255) + (tid & 15) * 4, r = pc & 127; nsrc = (n0 & ~255) + (pc & 128) + (r >> 3) * 4 + 64 * ((r >> 2) & 1); }
#pragma unroll
  for (int q = 0; q < 4; ++q)
#pragma unroll
    for (int rr = 0; rr < 2; ++rr) { const int k = (tid >> 4) + 32 * rr; v[q * 2 + rr] = *(const float4*)(W + (size_t)(k0 + q * 64 + k) * N + nsrc); }
#pragma unroll
  for (int q = 0; q < 4; ++q)
#pragma unroll
    for (int rr = 0; rr < 2; ++rr) { const int k = (tid >> 4) + 32 * rr, n = (tid & 15) * 4; float* t = tile + q * 4160 + k * 65 + n; const float4 x = v[q * 2 + rr]; t[0] = x.x; t[1] = x.y; t[2] = x.z; t[3] = x.w; }
  __syncthreads();
#pragma unroll
  for (int q = 0; q < 4; ++q) { const int n = tid >> 3, k8 = (tid & 7) * 8; const float* t = tile + q * 4160; u32x4 o;
#pragma unroll
    for (int e = 0; e < 4; ++e) o[e] = pk2(t[(k8 + 2 * e) * 65 + n] * scale, t[(k8 + 2 * e + 1) * 65 + n] * scale);
    *(u32x4*)(Wt + (size_t)(n0 + n) * K + k0 + q * 64 + k8) = o; }
  __syncthreads();
}
__device__ void phase_cvt(const Params& p, int l, unsigned char* shm) {
  float* tile = (float*)shm;
  for (int it = blockIdx.x; it < 4096; it += gridDim.x) {
    if (it < 3072) { const int kg = it & 7, n0 = (it >> 3) * 64;
      cvt_group(p.wid, p.w_in + (size_t)l * DM * INW, (bf16_t*)(p.ws + OFF_WTIN), DM, INW, kg * 256, n0, (n0 >= 2048 && n0 < 4096) ? 0.0625f : 1.f, tile, n0 < 4096); }
    else if (it < 3328) { const int e = it - 3072; cvt_group(p.wid, p.w_hy_out + (size_t)l * DM * DM, (bf16_t*)(p.ws + OFF_WTHY), DM, DM, (e & 7) * 256, (e >> 3) * 64, 1.f, tile, false); }
    else if (it < 3840) { const int e = it - 3328; cvt_group(p.wid, p.w_ret_out + (size_t)l * 4096 * DM, (bf16_t*)(p.ws + OFF_WTRET), 4096, DM, (e & 15) * 256, (e >> 4) * 64, 1.f, tile, false); }
    else { const int e = it - 3840; cvt_group(p.wid, p.w_o + (size_t)l * DM * DM, (bf16_t*)(p.ws + OFF_WTO), DM, DM, (e & 7) * 256, (e >> 3) * 64, 1.f, tile, false); }
  }
}

DI void filt_item(const Params& p, int l, int Ls, int T, bool isctx, unsigned char* shm) {
  float* z = (float*)shm; float* ha = z + 17 * 36; float* hb = ha + 17 * 64;
  const int tid = otid(p.wid);
  const float* w1 = p.fw1 + l * 33 * 64; const float* b1 = p.fb1 + l * 64; const float* w2 = p.fw2 + l * 4096; const float* b2 = p.fb2 + l * 64;
  const float* w3 = p.fw3 + l * 4096; const float* b3 = p.fb3 + l * 64; const float* fq = p.ffreq + l * 64; const float* wout = p.fwout + (size_t)l * 64 * 4096;
  float* w1s = z + 2816; float* w2s = w1s + 2112; float* w3s = w2s + 4096;
  { const float4 a0 = ((const float4*)w2)[tid], a1 = ((const float4*)w2)[tid + 512], b0 = ((const float4*)w3)[tid], b1 = ((const float4*)w3)[tid + 512];
    const float4 c0 = ((const float4*)w1)[tid]; float4 c1 = c0; if (tid < 16) c1 = ((const float4*)w1)[tid + 512];
    ((float4*)w2s)[tid] = a0; ((float4*)w2s)[tid + 512] = a1; ((float4*)w3s)[tid] = b0; ((float4*)w3s)[tid + 512] = b1; ((float4*)w1s)[tid] = c0; if (tid < 16) ((float4*)w1s)[tid + 512] = c1; }
  for (int i = tid; i < 17 * 33; i += 512) { const int pl = i / 33, f = i % 33; int pp = T * 16 + pl; if (pp > Ls - 1) pp = Ls - 1;
    float val;
    if (f == 0) val = (float)pp / (float)(Ls - 1);
    else { const int j = (f - 1) & 15; const float fj = 1e-4f + (float)j * ((15.f - 1e-4f) / 15.f); const float ang = 6.283185307179586f * (float)pp / (float)Ls; const float a = fj * ang; val = (f <= 16) ? cosf(a) : -sinf(a); }
    z[pl * 36 + f] = val; }
  __syncthreads();
  for (int idx = tid; idx < 17 * 16; idx += 512) { const int pl = idx >> 4, j0 = (idx & 15) * 4; float a[4] = {0.f, 0.f, 0.f, 0.f};
#pragma unroll 3
    for (int k = 0; k < 33; ++k) { const float v = z[pl * 36 + k]; const float4 w = *(const float4*)(w1s + k * 64 + j0); a[0] += v * w.x; a[1] += v * w.y; a[2] += v * w.z; a[3] += v * w.w; }
#pragma unroll
    for (int e = 0; e < 4; ++e) ha[pl * 64 + j0 + e] = sinf(fq[j0 + e] * (a[e] + b1[j0 + e])); }
  __syncthreads();
  for (int idx = tid; idx < 17 * 16; idx += 512) { const int pl = idx >> 4, j0 = (idx & 15) * 4; float a[4] = {0.f, 0.f, 0.f, 0.f};
#pragma unroll 4
    for (int k = 0; k < 64; ++k) { const float v = ha[pl * 64 + k]; const float4 w = *(const float4*)(w2s + k * 64 + j0); a[0] += v * w.x; a[1] += v * w.y; a[2] += v * w.z; a[3] += v * w.w; }
#pragma unroll
    for (int e = 0; e < 4; ++e) hb[pl * 64 + j0 + e] = sinf(fq[j0 + e] * (a[e] + b2[j0 + e])); }
  __syncthreads();
  for (int idx = tid; idx < 17 * 16; idx += 512) { const int pl = idx >> 4, j0 = (idx & 15) * 4; float a[4] = {0.f, 0.f, 0.f, 0.f};
#pragma unroll 4
    for (int k = 0; k < 64; ++k) { const float v = hb[pl * 64 + k]; const float4 w = *(const float4*)(w3s + k * 64 + j0); a[0] += v * w.x; a[1] += v * w.y; a[2] += v * w.z; a[3] += v * w.w; }
#pragma unroll
    for (int e = 0; e < 4; ++e) ha[pl * 64 + j0 + e] = sinf(fq[j0 + e] * (a[e] + b3[j0 + e])); }
  __syncthreads();
  const int cb = tid * 4;
  const float mind = logf(0.01f) / 1.5f, maxd = logf(0.01f) / 0.3f;
  bf16_t* G = (bf16_t*)(p.ws + OFF_G + (size_t)l * G_LAYER); float* GC = (float*)(p.ws + OFF_GC);
  float delta[4];
#pragma unroll
  for (int cc = 0; cc < 4; ++cc) delta[cc] = fabsf(mind + (float)(cb + cc) * ((maxd - mind) / 2047.f));
#pragma unroll 1
  for (int pgh = 0; pgh < 4; ++pgh) {
    const int pg = pgh >> 1; const bool isb = (pgh & 1) != 0; const int c4 = cb + (isb ? 2048 : 0);
    const int plb = pg * 8;
    float acc[8][4];
#pragma unroll
    for (int e = 0; e < 8; ++e) { acc[e][0] = 0.f; acc[e][1] = 0.f; acc[e][2] = 0.f; acc[e][3] = 0.f; }
    float4 wA[8], wB[8];
#define FILT_LOAD(buf, kb_) do { _Pragma("unroll") for (int j = 0; j < 8; ++j) buf[j] = *(const float4*)(wout + ((kb_) * 8 + j) * 4096 + c4); } while (0)
#define FILT_FMA(buf, kb_) do { _Pragma("unroll") for (int j = 0; j < 8; ++j) { const float4 wa = buf[j]; const int k = (kb_) * 8 + j; \
      _Pragma("unroll") for (int e = 0; e < 8; ++e) { const float h = ha[(plb + e) * 64 + k]; acc[e][0] += h * wa.x; acc[e][1] += h * wa.y; acc[e][2] += h * wa.z; acc[e][3] += h * wa.w; } } } while (0)
    FILT_LOAD(wA, 0);
#pragma unroll 1
    for (int kb = 0; kb < 8; kb += 2) {
      FILT_LOAD(wB, kb + 1);
      asm volatile("" ::: "memory");
      FILT_FMA(wA, kb);
      asm volatile("" ::: "memory");
      if (kb + 2 < 8) FILT_LOAD(wA, kb + 2);
      asm volatile("" ::: "memory");
      FILT_FMA(wB, kb + 1);
      asm volatile("" ::: "memory");
    }
#undef FILT_LOAD
#undef FILT_FMA
    const int pp0 = T * 16 + plb;
#pragma unroll
    for (int e = 0; e < 8; ++e) { const int pp = pp0 + e; const float tt = (float)pp / (float)(Ls - 1);
      if (pp < Ls && !(isb && pp == 0)) {
        float v[4];
#pragma unroll
        for (int cc = 0; cc < 4; ++cc) v[cc] = acc[e][cc] * __expf(-tt * delta[cc]);
        if (!isb && pp == 0) {
#pragma unroll
          for (int cc = 0; cc < 4; ++cc) v[cc] += p.hy_bias[l * 2048 + cb + cc]; }
        if (!isctx) { const int m = isb ? LOFF + pp : LOFF - pp; u32x2 o; o[0] = pk2(v[0], v[1]); o[1] = pk2(v[2], v[3]); *(u32x2*)(G + (size_t)m * 2048 + cb) = o; }
        else { const int idx = isb ? 256 - pp : 256 + pp;
#pragma unroll
          for (int cc = 0; cc < 4; ++cc) GC[(size_t)(cb + cc) * 512 + idx] = v[cc]; }
      }
    }
  }
  __syncthreads();
}
__device__ void phase_filters(const Params& p, unsigned char* shm, bool ctxpass) {
  if (!ctxpass) { for (int it = blockIdx.x; it < 512; it += gridDim.x) filt_item(p, it >> 8, SEQ, it & 255, false, shm); }
  else { const int first = (int)gridDim.x >= 16 ? (int)gridDim.x - 16 : 0; for (int it = (int)blockIdx.x - first; it >= 0 && it < 16; it += (int)gridDim.x - first) filt_item(p, 0, CTXL, it, true, shm); }
}

__device__ void phase_norm(const Params& p, int l) {
  const int lane = otid(p.wid) & 63, gw = blockIdx.x * 8 + (otid(p.wid) >> 6), nw = gridDim.x * 8;
  const float* mod = (const float*)(p.ws + OFF_MOD) + (size_t)l * 5 * 6144; const float* lng = p.ln_g + l * 2048;
  bf16_t* H = (bf16_t*)(p.ws + OFF_H);
  for (int r = gw; r < MT; r += nw) {
    const float* src; int j;
    if (r < NLAT) { src = (l == 0 ? p.x : p.out) + (size_t)r * 2048; j = r >> 12; }
    else { src = (l == 0 ? p.ctx : (const float*)(p.ws + OFF_CTXR)) + (size_t)(r - NLAT) * 2048; j = 4; }
    const float* sh = mod + j * 6144; const float* sc = sh + 2048;
    float4 v[8]; float ss = 0.f;
#pragma unroll
    for (int i = 0; i < 8; ++i) { v[i] = *(const float4*)(src + i * 256 + lane * 4); ss += v[i].x * v[i].x + v[i].y * v[i].y + v[i].z * v[i].z + v[i].w * v[i].w; }
    ss = wsum(ss, lane);
    const float rs = rsqrtf(ss * (1.f / 2048.f) + 1e-6f);
#pragma unroll
    for (int i = 0; i < 8; ++i) { const int col = i * 256 + lane * 4; const float4 g = *(const float4*)(lng + col), a = *(const float4*)(sc + col), b = *(const float4*)(sh + col);
      u32x2 o; o[0] = pk2(v[i].x * rs * g.x * (1.f + a.x) + b.x, v[i].y * rs * g.y * (1.f + a.y) + b.y); o[1] = pk2(v[i].z * rs * g.z * (1.f + a.z) + b.z, v[i].w * rs * g.w * (1.f + a.w) + b.w);
      *(u32x2*)(H + (size_t)r * 2048 + col) = o; }
  }
}
__device__ void phase_final(const Params& p) {
  const int lane = otid(p.wid) & 63, gw = blockIdx.x * 8 + (otid(p.wid) >> 6), nw = gridDim.x * 8;
  for (int r = gw; r < NLAT; r += nw) {
    float* src = p.out + (size_t)r * 2048; float4 v[8]; float ss = 0.f;
#pragma unroll
    for (int i = 0; i < 8; ++i) { v[i] = *(const float4*)(src + i * 256 + lane * 4); ss += v[i].x * v[i].x + v[i].y * v[i].y + v[i].z * v[i].z + v[i].w * v[i].w; }
    ss = wsum(ss, lane);
    const float rs = rsqrtf(ss * (1.f / 2048.f) + 1e-6f);
#pragma unroll
    for (int i = 0; i < 8; ++i) { const int col = i * 256 + lane * 4; const float4 g = *(const float4*)(p.final_g + col); float4 o; o.x = v[i].x * rs * g.x; o.y = v[i].y * rs * g.y; o.z = v[i].z * rs * g.z; o.w = v[i].w * rs * g.w; *(float4*)(src + col) = o; }
  }
}

DI void tok_tile(int tk, int& b, int& t0, bool& isctx) { if (tk < 256) { b = tk >> 6; t0 = (tk & 63) * 64; isctx = false; } else { b = (tk - 256) >> 2; t0 = ((tk - 256) & 3) * 64; isctx = true; } }
DI int tok_row(int b, int t, bool isctx) { return isctx ? NLAT + b * CTXL + t : b * SEQ + t; }

__device__ void phase_prep(const Params& p, int l, unsigned char* shm, int mask) {
  const int tid = otid(p.wid), lane = tid & 63;
  unsigned char* reg2 = shm + 32768;
  (void)lane;
  if (mask & 4) { float* in = (float*)reg2;
    bf16_t* ut = (bf16_t*)(reg2 + 3 * 66 * 64 * 4);
    const bf16_t* PHY = (const bf16_t*)(p.ws + OFF_PHY); const bf16_t* PHG = (const bf16_t*)(p.ws + OFF_PHG); bf16_t* HX0 = (bf16_t*)(p.ws + OFF_HX0);
    const float* cw = p.conv_w + (size_t)l * 3 * 6144; const float* cb = p.conv_b + (size_t)l * 6144;
    const int nit = ((l == 0) ? 272 : 256) * 32;
    u32x4 pre[4];
#define PC_DECODE(it_) const int tk = (it_) >> 5, c0 = ((it_) & 31) * 64; int b, t0; bool isctx; tok_tile(tk, b, t0, isctx); const int Ls = isctx ? CTXL : SEQ; const int row0 = tok_row(b, t0, isctx);
#define PC_LOAD(it_) do { PC_DECODE(it_) _Pragma("unroll") for (int e = 0; e < 4; ++e) { const int id = tid + 512 * e; const int pi = id / 528, rem = id % 528, rr = rem >> 3, pc = rem & 7; const int t = t0 - 1 + rr; \
        u32x4 v; v[0] = 0u; v[1] = 0u; v[2] = 0u; v[3] = 0u; if (id < 1584 && t >= 0 && t < Ls) v = *(const u32x4*)(PHY + (size_t)(row0 - 1 + rr) * 6144 + pi * 2048 + c0 + pc * 8); pre[e] = v; } } while (0)
    if ((int)blockIdx.x < nit) PC_LOAD((int)blockIdx.x);
    for (int it = blockIdx.x; it < nit; it += gridDim.x) {
      PC_DECODE(it) (void)Ls;
#pragma unroll
      for (int e = 0; e < 4; ++e) { const int id = tid + 512 * e; if (id < 1584) { const int pi = id / 528, rem = id % 528, rr = rem >> 3, pc = rem & 7; const u32x4 v = pre[e];
        float* d = in + (pi * 66 + rr) * 64 + pc * 8;
        *(float4*)d = make_float4(lo2f(v[0]), hi2f(v[0]), lo2f(v[1]), hi2f(v[1])); *(float4*)(d + 4) = make_float4(lo2f(v[2]), hi2f(v[2]), lo2f(v[3]), hi2f(v[3])); } }
      if (it + (int)gridDim.x < nit) PC_LOAD(it + (int)gridDim.x);
      __syncthreads();
      { const int cg8 = (tid & 7) * 8, tok = tid >> 3;
        float cv[3][8];
#pragma unroll
        for (int pi = 0; pi < 3; ++pi) { const float* wp = cw + pi * 2048 + c0 + cg8;
          const float4 ba = *(const float4*)(cb + pi * 2048 + c0 + cg8), bb = *(const float4*)(cb + pi * 2048 + c0 + cg8 + 4);
          cv[pi][0] = ba.x; cv[pi][1] = ba.y; cv[pi][2] = ba.z; cv[pi][3] = ba.w; cv[pi][4] = bb.x; cv[pi][5] = bb.y; cv[pi][6] = bb.z; cv[pi][7] = bb.w;
#pragma unroll
          for (int k = 0; k < 3; ++k) { const float4 wa = *(const float4*)(wp + k * 6144), wb = *(const float4*)(wp + k * 6144 + 4);
            const float* ip = in + (pi * 66 + tok + k) * 64 + cg8; const float4 xa = *(const float4*)ip, xb = *(const float4*)(ip + 4);
            cv[pi][0] += xa.x * wa.x; cv[pi][1] += xa.y * wa.y; cv[pi][2] += xa.z * wa.z; cv[pi][3] += xa.w * wa.w; cv[pi][4] += xb.x * wb.x; cv[pi][5] += xb.y * wb.y; cv[pi][6] += xb.z * wb.z; cv[pi][7] += xb.w * wb.w; } }
        u32x4 hvp, hxp; const u32x4 hg = *(const u32x4*)(PHG + (size_t)(row0 + tok) * 2048 + c0 + cg8);
#pragma unroll
        for (int e = 0; e < 4; ++e) { hvp[e] = pk2(cv[0][2 * e] * cv[2][2 * e], cv[0][2 * e + 1] * cv[2][2 * e + 1]); hxp[e] = pk2(cv[1][2 * e] * siluf_(lo2f(hg[e])), cv[1][2 * e + 1] * siluf_(hi2f(hg[e]))); }
        *(u32x4*)(HX0 + (size_t)(row0 + tok) * 2048 + c0 + cg8) = hxp;
#pragma unroll
        for (int e = 0; e < 4; ++e) { ut[(cg8 + 2 * e) * 66 + tok] = (bf16_t)(hvp[e] & 0xffffu); ut[(cg8 + 2 * e + 1) * 66 + tok] = (bf16_t)(hvp[e] >> 16); } }
      __syncthreads();
      { const int c = tid >> 3, pc = tid & 7; u32x4 o;
#pragma unroll
        for (int e = 0; e < 4; ++e) o[e] = (unsigned)ut[c * 66 + pc * 8 + 2 * e] | ((unsigned)ut[c * 66 + pc * 8 + 2 * e + 1] << 16);
        bf16_t* dst = isctx ? (bf16_t*)(p.ws + OFF_UTC) + ((size_t)(c0 + c) * NB + b) * CTXL + t0 + pc * 8 : (bf16_t*)(p.ws + OFF_UT) + ((size_t)(c0 + c) * NB + b) * SEQ + t0 + pc * 8;
        *(u32x4*)dst = o; }
    }
    __syncthreads();
#undef PC_DECODE
#undef PC_LOAD
  }
}

__device__ void phase_post(const Params& p, int l, unsigned char* shm, int mask) {
  const int tid = otid(p.wid), lane = tid & 63;
  const bf16_t* HX0 = (const bf16_t*)(p.ws + OFF_HX0);
  bf16_t* AH = (bf16_t*)(p.ws + OFF_H);
  if (mask & 1) { float* yt = (float*)shm;
    const bf16_t* UT = (const bf16_t*)(p.ws + OFF_UT);
    const int nit = 256 * 32; u32x4 pre;
#define PA_LOAD(it_) do { const int tk_ = (it_) >> 5, c0_ = ((it_) & 31) * 64, b_ = tk_ >> 6, t0_ = (tk_ & 63) * 64; pre = *(const u32x4*)(UT + ((size_t)(c0_ + (tid >> 3)) * NB + b_) * SEQ + t0_ + (tid & 7) * 8); } while (0)
    if ((int)blockIdx.x < nit) PA_LOAD((int)blockIdx.x);
    for (int it = blockIdx.x; it < nit; it += gridDim.x) {
      const int tk = it >> 5, c0 = (it & 31) * 64, b = tk >> 6, t0 = (tk & 63) * 64, row0 = b * SEQ + t0;
      { const int c = tid >> 3, pc = tid & 7; const u32x4 v = pre; float* d = yt + (pc * 8) * 65 + c;
        d[0] = lo2f(v[0]); d[65] = hi2f(v[0]); d[130] = lo2f(v[1]); d[195] = hi2f(v[1]); d[260] = lo2f(v[2]); d[325] = hi2f(v[2]); d[390] = lo2f(v[3]); d[455] = hi2f(v[3]); }
      if (it + (int)gridDim.x < nit) PA_LOAD(it + (int)gridDim.x);
      __syncthreads();
      { const int cg8 = (tid & 7) * 8, tok = tid >> 3; const size_t o = (size_t)(row0 + tok) * 2048 + c0 + cg8;
        const u32x4 m1 = *(const u32x4*)(HX0 + o); const float* yp = yt + tok * 65 + cg8; u32x4 r;
#pragma unroll
        for (int e = 0; e < 4; ++e) r[e] = pk2(yp[2 * e] * lo2f(m1[e]), yp[2 * e + 1] * hi2f(m1[e]));
        *(u32x4*)(AH + o) = r; }
      __syncthreads();
    }
#undef PA_LOAD
  }
  if (l == 0 && (mask & 2)) { constexpr int GST = 513, UST = 257; float* gc = (float*)shm; float* us = gc + 32 * GST;
    const bf16_t* UTC = (const bf16_t*)(p.ws + OFF_UTC); const float* GC = (const float*)(p.ws + OFF_GC);
    for (int it = blockIdx.x; it < 16 * 64; it += gridDim.x) {
      const int tk = it >> 6, c0 = (it & 63) * 32, b = tk >> 2, t0 = (tk & 3) * 64, row0 = NLAT + b * CTXL + t0;
#pragma unroll 8
      for (int i = tid; i < 32 * 512; i += 512) gc[(i >> 9) * GST + (i & 511)] = GC[(size_t)(c0 + (i >> 9)) * 512 + (i & 511)];
#pragma unroll 8
      for (int i = tid; i < 32 * 256; i += 512) us[(i >> 8) * UST + (i & 255)] = bf2f(UTC[((size_t)(c0 + (i >> 8)) * NB + b) * CTXL + (i & 255)]);
      __syncthreads();
      { const int c = tid >> 4, t = (tid & 15) * 4; const float* gp = gc + c * GST + 256 + t0 + t; const float* up = us + c * UST;
        float a0 = 0.f, a1 = 0.f, a2 = 0.f, a3 = 0.f; float w0 = gp[0], w1 = gp[1], w2 = gp[2], w3 = gp[3];
#pragma unroll 4
        for (int s = 0; s < 256; s += 4) {
          const float u0 = up[s], u1 = up[s + 1], u2 = up[s + 2], u3 = up[s + 3];
          const float n1 = gp[-(s + 1)], n2 = gp[-(s + 2)], n3 = gp[-(s + 3)], n4 = gp[-(s + 4)];
          a0 += u0 * w0; a1 += u0 * w1; a2 += u0 * w2; a3 += u0 * w3;
          a0 += u1 * n1; a1 += u1 * w0; a2 += u1 * w1; a3 += u1 * w2;
          a0 += u2 * n2; a1 += u2 * n1; a2 += u2 * w0; a3 += u2 * w1;
          a0 += u3 * n3; a1 += u3 * n2; a2 += u3 * n1; a3 += u3 * w0;
          w3 = n1; w2 = n2; w1 = n3; w0 = n4; }
        const float av[4] = {a0, a1, a2, a3};
#pragma unroll
        for (int j = 0; j < 4; ++j) { const size_t o = (size_t)(row0 + t + j) * 2048 + c0 + c; AH[o] = f2bf(av[j] * bf2f(HX0[o])); } }
      __syncthreads();
    }
  }
  if (mask & 4) { bf16_t* OF = (bf16_t*)(p.ws + OFF_OF); const bf16_t* OB = (const bf16_t*)(p.ws + OFF_OB); const bf16_t* RG = (const bf16_t*)(p.ws + OFF_PRG);
    const int gw = blockIdx.x * 8 + (tid >> 6), nw = gridDim.x * 8; const int nrows = (l == 0) ? MT : NLAT;
#pragma unroll 2
    for (int it = gw; it < nrows * 8; it += nw) { const size_t o = (size_t)(it >> 3) * 4096 + (it & 7) * 512 + lane * 8;
      const u32x4 a = *(const u32x4*)(OF + o), bq = *(const u32x4*)(OB + o), g = *(const u32x4*)(RG + o);
      float v[8]; float ss = 0.f;
#pragma unroll
      for (int e = 0; e < 4; ++e) { v[2 * e] = lo2f(a[e]) + lo2f(bq[e]); v[2 * e + 1] = hi2f(a[e]) + hi2f(bq[e]); ss += v[2 * e] * v[2 * e] + v[2 * e + 1] * v[2 * e + 1]; }
      ss = wsum(ss, lane);
      const float rs = rsqrtf(ss * (1.f / 512.f) + 1e-6f);
      u32x4 r;
#pragma unroll
      for (int e = 0; e < 4; ++e) r[e] = pk2(v[2 * e] * rs * siluf_(lo2f(g[e])), v[2 * e + 1] * rs * siluf_(hi2f(g[e])));
      *(u32x4*)(OF + o) = r; }
  }
}

__device__ void phase_conv(const Params& p, int l, unsigned char* shm) {
  const int tid = otid(p.wid), lane = tid & 63, wid = tid >> 6;
  bf16_t* Gs = (bf16_t*)shm;
  bf16_t* Us = (bf16_t*)(shm + 2 * GLEN * 2);
  { unsigned zz = 0u; asm volatile("" : "+v"(zz)); u32x4 z; z[0] = zz; z[1] = zz; z[2] = zz; z[3] = zz; for (int i = tid; i < 2 * 4 * USTR / 8; i += 512) ((u32x4*)Us)[i] = z; }
  __syncthreads();
  const int ch = wid >> 2, q = wid & 3, i = lane & 31, g = lane >> 5, a_l = i >> 2, b = i & 3;
  const bf16_t* G = (const bf16_t*)(p.ws + OFF_G + (size_t)l * G_LAYER); bf16_t* UT = (bf16_t*)(p.ws + OFF_UT);
  const int mb = LOFF - i + 8 * g - 128 * (8 * q + 7);
  const unsigned sh = (unsigned)(mb & 1) * 16u;
  const unsigned* Gd = (const unsigned*)(Gs + ch * GLEN) + (mb >> 1);
  const bf16_t* Ub = Us + (ch * 4 + b) * USTR + 136 * (a_l + 1) + 8 * g;
#define CONV_LDFRAG(dst, n) do { const unsigned* q_ = Gd + 8 * (n); const unsigned d0 = q_[0], d1 = q_[1], d2 = q_[2], d3 = q_[3], d4 = q_[4]; u32x4 r_; \
    r_[0] = __builtin_amdgcn_alignbit(d1, d0, sh); r_[1] = __builtin_amdgcn_alignbit(d2, d1, sh); r_[2] = __builtin_amdgcn_alignbit(d3, d2, sh); r_[3] = __builtin_amdgcn_alignbit(d4, d3, sh); \
    dst = __builtin_bit_cast(bf16x8, r_); } while (0)
  unsigned pgv[17]; u32x4 puv[8];
#define CONV_PREFETCH(pr_) do { \
    _Pragma("unroll") for (int e = 0; e < 17; ++e) { const int m = tid + 512 * e; unsigned v = 0u; if (m >= 33 && m <= 8223) v = *(const unsigned*)(G + (size_t)m * 2048 + 2 * (pr_)); pgv[e] = v; } \
    _Pragma("unroll") for (int e = 0; e < 8; ++e) { const int id = tid + 512 * e, cc = id >> 11, bb = (id >> 9) & 3, s8 = id & 511; puv[e] = *(const u32x4*)(UT + ((size_t)((pr_) * 2 + cc) * 4 + bb) * SEQ + s8 * 8); } } while (0)
  if ((int)blockIdx.x < 1024) CONV_PREFETCH((int)blockIdx.x);
  for (int pr = blockIdx.x; pr < 1024; pr += gridDim.x) {
#pragma unroll
    for (int e = 0; e < 17; ++e) { const int m = tid + 512 * e; if (m < GLEN) { Gs[m] = (bf16_t)(pgv[e] & 0xffffu); Gs[GLEN + m] = (bf16_t)(pgv[e] >> 16); } }
#pragma unroll
    for (int e = 0; e < 8; ++e) { const int id = tid + 512 * e, cc = id >> 11, bb = (id >> 9) & 3, s8 = id & 511; const int sp = 1024 + s8 * 8;
      *(u32x4*)(Us + (cc * 4 + bb) * USTR + sp + 8 * (sp >> 7)) = puv[e]; }
    __syncthreads();
    if (pr + (int)gridDim.x < 1024) CONV_PREFETCH(pr + (int)gridDim.x);
    bf16x8 W[8]; f32x16 acc[4];
#pragma unroll
    for (int h = 0; h < 4; ++h)
#pragma unroll
      for (int e = 0; e < 16; ++e) acc[h][e] = 0.f;
    CONV_LDFRAG(W[2], -6); CONV_LDFRAG(W[3], -5); CONV_LDFRAG(W[4], -4); CONV_LDFRAG(W[5], -3); CONV_LDFRAG(W[6], -2); CONV_LDFRAG(W[7], -1);
#pragma unroll 1
    for (int it = 0; it < 39; ++it) {
#pragma unroll
      for (int u = 0; u < 8; ++u) {
        CONV_LDFRAG(W[u], it * 8 + u);
        const bf16x8 bf = *(const bf16x8*)(Ub + 136 * it + 16 * u);
#pragma unroll
        for (int h = 0; h < 4; ++h) acc[h] = __builtin_amdgcn_mfma_f32_32x32x16_bf16(W[(u - 2 * h) & 7], bf, acc[h], 0, 0, 0);
      }
    }
    { bf16_t* yrow = UT + ((size_t)(pr * 2 + ch) * 4 + b) * SEQ + 128 * (8 * q + a_l) + 4 * g;
#pragma unroll
      for (int h = 0; h < 4; ++h)
#pragma unroll
        for (int rq = 0; rq < 4; ++rq) { u32x2 o; o[0] = pk2(acc[h][4 * rq], acc[h][4 * rq + 1]); o[1] = pk2(acc[h][4 * rq + 2], acc[h][4 * rq + 3]); *(u32x2*)(yrow + 32 * h + 8 * rq) = o; } }
    __syncthreads();
  }
#undef CONV_LDFRAG
#undef CONV_PREFETCH
}

template <int KD> DI f32x16 mma_tile(f32x16 acc, const bf16_t* A, int lda, const bf16_t* B, int ldb, int lane) {
  const int r = lane & 31, g8 = (lane >> 5) * 8; const bf16_t* ap = A + r * lda + g8; const bf16_t* bp = B + r * ldb + g8;
#pragma unroll 4
  for (int k0 = 0; k0 < KD; k0 += 16) acc = __builtin_amdgcn_mfma_f32_32x32x16_bf16(*(const bf16x8*)(ap + k0), *(const bf16x8*)(bp + k0), acc, 0, 0, 0);
  return acc;
}
DI bf16x8 tr_frag(const bf16_t* img, int ld, int lane) {
  const int h = lane >> 5, blk = (lane >> 4) & 1, q = (lane & 15) >> 2, pp = lane & 3;
  const bf16_t* a = img + (8 * h + q) * ld + 16 * blk + 4 * pp;
  const s16x4 r0 = __builtin_amdgcn_ds_read_tr16_b64_v4i16((__attribute__((address_space(3))) s16x4*)a);
  const s16x4 r1 = __builtin_amdgcn_ds_read_tr16_b64_v4i16((__attribute__((address_space(3))) s16x4*)(a + 4 * ld));
  bf16x8 f; f[0] = r0[0]; f[1] = r0[1]; f[2] = r0[2]; f[3] = r0[3]; f[4] = r1[0]; f[5] = r1[1]; f[6] = r1[2]; f[7] = r1[3]; return f;
}
__device__ void phase_ret(const Params& p, int l, unsigned char* shm) {
  constexpr int QS = 264, VS = 144, TS = 72;
  const int tid = otid(p.wid), lane = tid & 63, wid = tid >> 6, g = lane >> 5;
  bf16_t* Qs = (bf16_t*)shm; bf16_t* Ks = Qs + 64 * QS; bf16_t* Vs = Ks + 64 * QS; bf16_t* Ps = Vs + 64 * VS; bf16_t* Sts = Ps + 64 * TS;
  const bf16_t* PQ = (const bf16_t*)(p.ws + OFF_PQ); const bf16_t* PK = (const bf16_t*)(p.ws + OFF_PK); const bf16_t* PV = (const bf16_t*)(p.ws + OFF_PV);
  for (int it0 = blockIdx.x; it0 < 256; it0 += gridDim.x) {
    int it = it0;
    if (gridDim.x == 256) { const int xcd = it0 & 7, idx = it0 >> 3; it = ((xcd + 8 * (idx >> 2)) << 2) | (idx & 3); }
    const int sl = it & 3, dir = (it >> 2) & 1, h = (it >> 3) & 7, b = it >> 6;
    const float lg = -expf(p.ret_decay[(l * 2 + dir) * 8 + h]);
    bf16_t* O = (bf16_t*)(p.ws + (dir ? OFF_OB : OFF_OF));
    for (int i = tid; i < 128 * QS / 2; i += 512) ((unsigned*)Sts)[i] = 0u;
    f32x16 S[4], cross;
#pragma unroll
    for (int x = 0; x < 4; ++x)
#pragma unroll
      for (int e = 0; e < 16; ++e) S[x][e] = 0.f;
#pragma unroll
    for (int e = 0; e < 16; ++e) cross[e] = 0.f;
    const float cd = __expf(lg * 64.f);
    const int tid2 = otid(p.wid), ln2 = tid2 & 63, g2 = ln2 >> 5, w2 = tid2 >> 6;
    float mk[16], dkv[2];
#pragma unroll
    for (int e = 0; e < 2; ++e) { const int tok = (tid2 >> 4) + 32 * e; dkv[e] = __expf(lg * (float)(dir ? tok : 63 - tok)); }
    const int wq = w2 & 3, s_tj = wq >> 1, s_ti = wq & 1;
    const int o_tc = w2 >> 1, o_ti = w2 & 1;
    { const int i = s_ti * 32 + (ln2 & 31);
#pragma unroll
      for (int e = 0; e < 16; ++e) { const int j = s_tj * 32 + (e & 3) + 8 * (e >> 2) + 4 * g2; const int diff = dir ? (j - i) : (i - j); mk[e] = diff >= 0 ? __expf(lg * (float)(dir ? -i : i - 63)) : 0.f; } }
    const int qi = o_ti * 32 + (ln2 & 31);
    const float qd = __expf(lg * (float)(dir ? 64 - qi : qi + 1));
    u32x4 rq[4], rk[4], rv[2];
    const unsigned qo_l = (unsigned)(tid >> 5) * 2048u + (unsigned)(h * 256 + (tid & 31) * 8);
    const unsigned vo_l = (unsigned)(tid >> 4) * 4096u + (unsigned)(h * 512 + sl * 128 + (tid & 15) * 8);
#define RET_CHUNK(step_, isctx_, t0_) do { if ((step_) < 4) { isctx_ = true; t0_ = (dir ? 3 - (step_) : (step_)) * 64; } else { isctx_ = false; const int cn_ = (step_) - 4; t0_ = (dir ? 63 - cn_ : cn_) * 64; } } while (0)
#define RET_LOAD(step_) do { bool ic_; int t0n_; RET_CHUNK(step_, ic_, t0n_); const unsigned rw_ = (unsigned)tok_row(b, t0n_, ic_); \
      _Pragma("unroll") for (int e = 0; e < 4; ++e) { rq[e] = *(const u32x4*)(PQ + (rw_ * 2048u + qo_l + (unsigned)e * 32768u)); rk[e] = *(const u32x4*)(PK + (rw_ * 2048u + qo_l + (unsigned)e * 32768u)); } \
      _Pragma("unroll") for (int e = 0; e < 2; ++e) rv[e] = *(const u32x4*)(PV + (rw_ * 4096u + vo_l + (unsigned)e * 131072u)); } while (0)
    RET_LOAD(0);
#pragma unroll 1
    for (int step = 0; step < 68; ++step) {
      bool isctx; int t0; RET_CHUNK(step, isctx, t0);
      const int row0 = tok_row(b, t0, isctx);
      __syncthreads();
#pragma unroll
      for (int e = 0; e < 4; ++e) { const int row = (tid >> 5) + 16 * e, pc = tid & 31; *(u32x4*)(Qs + row * QS + pc * 8) = rq[e]; *(u32x4*)(Ks + row * QS + pc * 8) = rk[e]; }
#pragma unroll
      for (int e = 0; e < 2; ++e) { u32x4 o;
#pragma unroll
        for (int w = 0; w < 4; ++w) o[w] = pk2(lo2f(rv[e][w]) * dkv[e], hi2f(rv[e][w]) * dkv[e]);
        *(u32x4*)(Vs + ((tid >> 4) + 32 * e) * VS + (tid & 15) * 8) = o; }
      if (step + 1 < 68) RET_LOAD(step + 1);
      __syncthreads();
      if (wid < 4) {
        f32x16 sc;
#pragma unroll
        for (int e = 0; e < 16; ++e) sc[e] = 0.f;
        sc = mma_tile<256>(sc, Ks + s_tj * 32 * QS, QS, Qs + s_ti * 32 * QS, QS, lane);
        const int i = s_ti * 32 + (lane & 31);
#pragma unroll
        for (int r4 = 0; r4 < 4; ++r4) { u32x2 o; o[0] = pk2(sc[4 * r4] * mk[4 * r4], sc[4 * r4 + 1] * mk[4 * r4 + 1]); o[1] = pk2(sc[4 * r4 + 2] * mk[4 * r4 + 2], sc[4 * r4 + 3] * mk[4 * r4 + 3]);
          *(u32x2*)(Ps + i * TS + s_tj * 32 + 8 * r4 + 4 * g) = o; }
      }
#pragma unroll
      for (int e = 0; e < 16; ++e) cross[e] = 0.f;
      cross = mma_tile<256>(cross, Sts + o_tc * 32 * QS, QS, Qs + o_ti * 32 * QS, QS, lane);
      __syncthreads();
      { f32x16 in_;
#pragma unroll
        for (int e = 0; e < 16; ++e) in_[e] = 0.f;
        const bf16_t* pb = Ps + (o_ti * 32 + (lane & 31)) * TS + 8 * g;
#pragma unroll
        for (int ks = 0; ks < 4; ++ks) in_ = __builtin_amdgcn_mfma_f32_32x32x16_bf16(tr_frag(Vs + 16 * ks * VS + 32 * o_tc, VS, lane), *(const bf16x8*)(pb + 16 * ks), in_, 0, 0, 0);
        const unsigned ob = (unsigned)(row0 + qi) * 4096u + (unsigned)(h * 512 + sl * 128 + o_tc * 32 + 4 * g);
#pragma unroll
        for (int r4 = 0; r4 < 4; ++r4) { u32x2 o; o[0] = pk2(in_[4 * r4] + qd * cross[4 * r4], in_[4 * r4 + 1] + qd * cross[4 * r4 + 1]); o[1] = pk2(in_[4 * r4 + 2] + qd * cross[4 * r4 + 2], in_[4 * r4 + 3] + qd * cross[4 * r4 + 3]);
          *(u32x2*)(O + (ob + (unsigned)(8 * r4))) = o; } }
      { bf16x8 ka[4];
#pragma unroll
        for (int ks = 0; ks < 4; ++ks) ka[ks] = tr_frag(Ks + 16 * ks * QS + 32 * wid, QS, lane);
#pragma unroll
        for (int x = 0; x < 4; ++x) {
#pragma unroll
          for (int e = 0; e < 16; ++e) S[x][e] *= cd;
#pragma unroll
          for (int ks = 0; ks < 4; ++ks) S[x] = __builtin_amdgcn_mfma_f32_32x32x16_bf16(ka[ks], tr_frag(Vs + 16 * ks * VS + 32 * x, VS, lane), S[x], 0, 0, 0);
          const int c = x * 32 + (lane & 31);
#pragma unroll
          for (int r4 = 0; r4 < 4; ++r4) { u32x2 o; o[0] = pk2(S[x][4 * r4], S[x][4 * r4 + 1]); o[1] = pk2(S[x][4 * r4 + 2], S[x][4 * r4 + 3]); *(u32x2*)(Sts + c * QS + wid * 32 + 8 * r4 + 4 * g) = o; } } }
    }
    __syncthreads();
  }
#undef RET_CHUNK
#undef RET_LOAD
}

template <int MODE> __device__ void ctx_gemm(const Params& p, const bf16_t* X, int ldx, const bf16_t* W, int K, unsigned char* shm) {
  constexpr int KC = 128, LD = KC + 8;
  const int tid = otid(p.wid), lane = tid & 63, wid = tid >> 6, g = lane >> 5;
  bf16_t* Xs = (bf16_t*)shm; bf16_t* Ws = Xs + 128 * LD;
  for (int tile = blockIdx.x; tile < 256; tile += gridDim.x) {
    const int tok0 = (tile >> 5) * 128, n0 = (tile & 31) * 64, wt = wid & 3, wn = wid >> 2;
    f32x16 acc;
#pragma unroll
    for (int e = 0; e < 16; ++e) acc[e] = 0.f;
    u32x4 xr[4], wr[2];
    const unsigned xo = (unsigned)(tok0 + (tid >> 4)) * (unsigned)ldx + (unsigned)((tid & 15) * 8);
    const unsigned wo = (unsigned)(n0 + (tid >> 4)) * (unsigned)K + (unsigned)((tid & 15) * 8);
#define CG_LOAD(kc_) do { _Pragma("unroll") for (int e = 0; e < 4; ++e) xr[e] = *(const u32x4*)(X + (xo + (unsigned)(32 * e) * (unsigned)ldx + (unsigned)((kc_) * KC))); \
      _Pragma("unroll") for (int e = 0; e < 2; ++e) wr[e] = *(const u32x4*)(W + (wo + (unsigned)(32 * e) * (unsigned)K + (unsigned)((kc_) * KC))); } while (0)
    CG_LOAD(0);
    const int nkc = K / KC;
#pragma unroll 1
    for (int kc = 0; kc < nkc; ++kc) {
      __syncthreads();
#pragma unroll
      for (int e = 0; e < 4; ++e) *(u32x4*)(Xs + ((tid >> 4) + 32 * e) * LD + (tid & 15) * 8) = xr[e];
#pragma unroll
      for (int e = 0; e < 2; ++e) *(u32x4*)(Ws + ((tid >> 4) + 32 * e) * LD + (tid & 15) * 8) = wr[e];
      if (kc + 1 < nkc) CG_LOAD(kc + 1);
      __syncthreads();
      acc = mma_tile<KC>(acc, Ws + wn * 32 * LD, LD, Xs + wt * 32 * LD, LD, lane);
    }
#undef CG_LOAD
    const int tok = tok0 + wt * 32 + (lane & 31), nb = n0 + wn * 32 + 4 * g;
    if (MODE < 2) {
      bf16_t* T1 = (bf16_t*)(p.ws + OFF_T1) + (size_t)(NLAT + tok) * 2048; const bf16_t* MG = (const bf16_t*)(p.ws + OFF_PMG) + (size_t)(NLAT + tok) * 4096 + (MODE ? 2048 : 0);
#pragma unroll
      for (int r4 = 0; r4 < 4; ++r4) { const int n = nb + 8 * r4; const u32x2 gg = *(const u32x2*)(MG + n);
        float r0 = sigmoidf_(lo2f(gg[0])) * acc[4 * r4], r1 = sigmoidf_(hi2f(gg[0])) * acc[4 * r4 + 1], r2 = sigmoidf_(lo2f(gg[1])) * acc[4 * r4 + 2], r3 = sigmoidf_(hi2f(gg[1])) * acc[4 * r4 + 3];
        if (MODE == 1) { const u32x2 t = *(const u32x2*)(T1 + n); r0 += lo2f(t[0]); r1 += hi2f(t[0]); r2 += lo2f(t[1]); r3 += hi2f(t[1]); }
        u32x2 o; o[0] = pk2(r0, r1); o[1] = pk2(r2, r3); *(u32x2*)(T1 + n) = o; }
    } else {
      const float* cin = p.ctx + (size_t)tok * 2048; float* cout = (float*)(p.ws + OFF_CTXR) + (size_t)tok * 2048; const float* gate = (const float*)(p.ws + OFF_MOD) + 4 * 6144 + 4096;
#pragma unroll
      for (int r4 = 0; r4 < 4; ++r4) { const int n = nb + 8 * r4; const f32x4 xv = *(const f32x4*)(cin + n), gv = *(const f32x4*)(gate + n); f32x4 a; a[0] = acc[4 * r4]; a[1] = acc[4 * r4 + 1]; a[2] = acc[4 * r4 + 2]; a[3] = acc[4 * r4 + 3];
        *(f32x4*)(cout + n) = xv + gv * a; }
    }
    __syncthreads();
  }
}

__global__ void __launch_bounds__(512, 2) mega(Params p_in) {
  Params p = p_in; p.wid = __builtin_amdgcn_readfirstlane((int)(threadIdx.x >> 6));
  extern __shared__ __attribute__((aligned(16))) unsigned char shm[];
  cg::grid_group grid = cg::this_grid();
  PG8_LAS unsigned char* lds = (PG8_LAS unsigned char*)shm;
  volatile XLAS unsigned* xst = (volatile XLAS unsigned*)(lds + 163824);
  if (otid(p.wid) == 0) { xst[0] = 0u; xst[1] = 0u; }
  __syncthreads();
  const XcdBarrier xb = xcd_barrier_post((unsigned*)(p.ws + OFF_BAR), xst, otid(p.wid) == 0);
  const bf16_t* H = (const bf16_t*)(p.ws + OFF_H);
#pragma unroll 1
  for (int rep = 0; rep < (PROBE == 1 ? 2 : 1); ++rep) { phase_filters(p, shm, false); phase_mod(p, shm); }
  grid.sync();
  for (int l = 0; l < 2; ++l) {
#pragma unroll 1
    for (int rep = 0; rep < (PROBE == 1 ? 2 : 1); ++rep) { phase_cvt(p, l, shm); phase_norm(p, l); }
    xcd_barrier(xb, otid(p.wid) == 0);
    { pg8::Gemm g; g.wid = p.wid; g.A = H; g.Bt = (const bf16_t*)(p.ws + OFF_WTIN); g.M = MT; g.N = INW; g.K = DM;
      pg8::Order S; S.init(64, 96, (int)gridDim.x, (int)blockIdx.x, 4, l == 0 ? 96 : 24, l == 0 ? 0 : 8);
      EpiG1 E; E.ws = p.ws; pg8::gemm_phase<EpiG1, pg8::Order>(lds, g, S, E); }
    if (l == 0) phase_filters(p, shm, true);
    xcd_barrier(xb, otid(p.wid) == 0);
#pragma unroll 1
    for (int rep = 0; rep < (PROBE == 2 ? 2 : 1); ++rep) phase_prep(p, l, shm, rep ? 4 : 7);
    xcd_barrier(xb, otid(p.wid) == 0);
    phase_conv(p, l, shm);
#pragma unroll 1
    for (int rep = 0; rep < (PROBE == 3 ? 2 : 1); ++rep) phase_ret(p, l, shm);
    xcd_barrier(xb, otid(p.wid) == 0);
#pragma unroll 1
    for (int rep = 0; rep < (PROBE == 2 ? 2 : 1); ++rep) phase_post(p, l, shm, rep ? 3 : 7);
    xcd_barrier(xb, otid(p.wid) == 0);
    { const int nM = 64;
      pg8::Order S; S.init(nM, 8, (int)gridDim.x, (int)blockIdx.x, 0, 0, 0);
#pragma unroll 1
      for (int rep = 0; rep < (PROBE == 4 ? 2 : 1); ++rep) {
      { pg8::Gemm g; g.wid = p.wid; g.A = H; g.Bt = (const bf16_t*)(p.ws + OFF_WTHY); g.M = nM * 256; g.N = DM; g.K = DM; EpiG23<0> E; E.ws = p.ws; pg8::gemm_phase<EpiG23<0>, pg8::Order>(lds, g, S, E); }
      { pg8::Gemm g; g.wid = p.wid; g.A = (const bf16_t*)(p.ws + OFF_OF); g.Bt = (const bf16_t*)(p.ws + OFF_WTRET); g.M = nM * 256; g.N = DM; g.K = 4096; EpiG23<1> E; E.ws = p.ws; pg8::gemm_phase<EpiG23<1>, pg8::Order>(lds, g, S, E); }
      }
      if (l == 0) { ctx_gemm<0>(p, H + (size_t)NLAT * 2048, 2048, (const bf16_t*)(p.ws + OFF_WTHY), 2048, shm);
                    ctx_gemm<1>(p, (const bf16_t*)(p.ws + OFF_OF) + (size_t)NLAT * 4096, 4096, (const bf16_t*)(p.ws + OFF_WTRET), 4096, shm); }
      xcd_barrier(xb, otid(p.wid) == 0);
      { pg8::Gemm g; g.wid = p.wid; g.A = (const bf16_t*)(p.ws + OFF_T1); g.Bt = (const bf16_t*)(p.ws + OFF_WTO); g.M = nM * 256; g.N = DM; g.K = DM;
        EpiG4 E; E.xin = (l == 0) ? p.x : p.out; E.cin = p.ctx; E.xout = p.out; E.cout = (float*)(p.ws + OFF_CTXR); E.mod = (const float*)(p.ws + OFF_MOD) + (size_t)l * 5 * 6144;
        pg8::gemm_phase<EpiG4, pg8::Order>(lds, g, S, E); }
      if (l == 0) ctx_gemm<2>(p, (const bf16_t*)(p.ws + OFF_T1) + (size_t)NLAT * 2048, 2048, (const bf16_t*)(p.ws + OFF_WTO), 2048, shm); }
    xcd_barrier(xb, otid(p.wid) == 0);
  }
  phase_final(p);
}

extern "C" void kernel_launch(void* const* d_in, const int* in_sizes, int n_in, void* d_out, int out_size, void* d_ws, size_t ws_size, hipStream_t stream) {
  constexpr size_t kDynLds = 163840;
  static int grid_blocks = 0;
  if (!grid_blocks) {
    hipFuncSetAttribute((const void*)mega, hipFuncAttributeMaxDynamicSharedMemorySize, (int)kDynLds);
    int dev = 0, cus = 0, per_cu = 0;
    hipGetDevice(&dev);
    hipDeviceGetAttribute(&cus, hipDeviceAttributeMultiprocessorCount, dev);
    hipOccupancyMaxActiveBlocksPerMultiprocessor(&per_cu, (const void*)mega, 512, kDynLds);
    grid_blocks = cus * (per_cu >= 1 ? 1 : 0);
    if (ws_size < WS_NEED || grid_blocks <= 0) { fprintf(stderr, "workspace %zu < %zu or no occupancy (%d)\n", ws_size, (size_t)WS_NEED, per_cu); grid_blocks = grid_blocks > 0 ? grid_blocks : 256; }
  }
  Params p{};
  p.x = (const float*)d_in[0]; p.c = (const float*)d_in[1]; p.ctx = (const float*)d_in[2]; p.c_ctx = (const float*)d_in[3]; p.ln_g = (const float*)d_in[4];
  p.ada_w = (const float*)d_in[5]; p.ada_b = (const float*)d_in[6]; p.w_in = (const float*)d_in[7]; p.conv_w = (const float*)d_in[8]; p.conv_b = (const float*)d_in[9];
  p.fw1 = (const float*)d_in[10]; p.fb1 = (const float*)d_in[11]; p.fw2 = (const float*)d_in[12]; p.fb2 = (const float*)d_in[13]; p.fw3 = (const float*)d_in[14]; p.fb3 = (const float*)d_in[15];
  p.ffreq = (const float*)d_in[16]; p.fwout = (const float*)d_in[17]; p.hy_bias = (const float*)d_in[18]; p.ret_decay = (const float*)d_in[19];
  p.w_hy_out = (const float*)d_in[20]; p.w_ret_out = (const float*)d_in[21]; p.w_o = (const float*)d_in[22]; p.final_g = (const float*)d_in[23];
  p.out = (float*)d_out; p.ws = (unsigned char*)d_ws;
  void* args[] = {&p};
  (void)hipMemsetAsync((unsigned char*)d_ws + OFF_BAR, 0, (size_t)XCD_BAR_WORDS * 4, stream);
  hipError_t e = hipLaunchCooperativeKernel((void*)mega, dim3(grid_blocks), dim3(512), args, kDynLds, stream);
  if (e != hipSuccess) fprintf(stderr, "cooperative launch failed: %s (grid %d)\n", hipGetErrorString(e), grid_blocks);
}
```

```cpp
#include <hip/hip_runtime.h>
#include <hip/hip_cooperative_groups.h>
#include <cstdio>
namespace cg = cooperative_groups;
#ifndef PROBE
#define PROBE 0
#endif

typedef unsigned short bf16_t;
typedef short bf16x8 __attribute__((ext_vector_type(8)));
typedef float f32x4 __attribute__((ext_vector_type(4)));
typedef float f32x16 __attribute__((ext_vector_type(16)));
typedef unsigned u32x4 __attribute__((ext_vector_type(4)));
typedef unsigned u32x2 __attribute__((ext_vector_type(2)));
typedef short s16x4 __attribute__((ext_vector_type(4)));
#define DI __device__ __forceinline__

DI int otid(int wid) { int t; asm volatile("v_mbcnt_lo_u32_b32 %0, -1, 0\n\tv_mbcnt_hi_u32_b32 %0, -1, %0" : "=v"(t)); return wid * 64 + t; }
DI float wsum(float v, int lane) {
#pragma unroll
  for (int o = 32; o > 0; o >>= 1) v += __int_as_float(__builtin_amdgcn_ds_bpermute((lane ^ o) << 2, __float_as_int(v)));
  return v; }
DI float bf2f(bf16_t u) { return __uint_as_float(((unsigned)u) << 16); }
typedef __bf16 bf16v2 __attribute__((ext_vector_type(2)));
typedef float f32v2 __attribute__((ext_vector_type(2)));
DI unsigned pk2(float lo, float hi) { f32v2 v = {lo, hi}; bf16v2 b = __builtin_convertvector(v, bf16v2); return __builtin_bit_cast(unsigned, b); }
DI bf16_t f2bf(float f) { return (bf16_t)(pk2(f, 0.f) & 0xffffu); }
DI float lo2f(unsigned u) { return __uint_as_float(u << 16); }
DI float hi2f(unsigned u) { return __uint_as_float(u & 0xffff0000u); }
DI float sigmoidf_(float v) { return 1.f / (1.f + __expf(-v)); }
DI float siluf_(float v) { return v / (1.f + __expf(-v)); }

constexpr int DM = 2048, NB = 4, SEQ = 4096, CTXL = 256, NLAT = NB * SEQ, NCTX = NB * CTXL, MT = NLAT + NCTX;
constexpr int INW = 24576, NH = 8, DK = 256, DV = 512, TT = SEQ + CTXL;
constexpr int LOFF = 4128, GLEN = 8320;      constexpr size_t G_LAYER = ((size_t)2048 * 8320 * 2 + 255) & ~(size_t)255;
constexpr int USTR = 6560;

constexpr size_t AL(size_t x) { return (x + 255) & ~(size_t)255; }
constexpr size_t OFF_WTIN = 0;
constexpr size_t OFF_WTHY = OFF_WTIN + AL((size_t)INW * DM * 2);
constexpr size_t OFF_WTRET = OFF_WTHY + AL((size_t)DM * DM * 2);
constexpr size_t OFF_WTO = OFF_WTRET + AL((size_t)DM * 4096 * 2);
constexpr size_t OFF_G = OFF_WTO + AL((size_t)DM * DM * 2);
constexpr size_t OFF_GC = OFF_G + 2 * AL((size_t)DM * GLEN * 2);
constexpr size_t OFF_MOD = OFF_GC + AL((size_t)DM * 512 * 4);
constexpr size_t OFF_H = OFF_MOD + AL((size_t)2 * 5 * 6144 * 4);
constexpr size_t OFF_PQ = OFF_H + AL((size_t)MT * DM * 2);
constexpr size_t OFF_PK = OFF_PQ + AL((size_t)MT * DM * 2);
constexpr size_t OFF_PV = OFF_PK + AL((size_t)MT * DM * 2);
constexpr size_t OFF_PRG = OFF_PV + AL((size_t)MT * 4096 * 2);
constexpr size_t OFF_PHY = OFF_PRG + AL((size_t)MT * 4096 * 2);
constexpr size_t OFF_PHG = OFF_PHY + AL((size_t)MT * 6144 * 2);
constexpr size_t OFF_PMG = OFF_PHG + AL((size_t)MT * DM * 2);
constexpr size_t OFF_KT = OFF_PMG + AL((size_t)MT * 4096 * 2);
constexpr size_t OFF_VT = OFF_KT + AL((size_t)NB * NH * DK * TT * 2);
constexpr size_t OFF_UT = OFF_VT + AL((size_t)NB * NH * DV * TT * 2);
constexpr size_t OFF_UTC = OFF_UT + AL((size_t)DM * NB * SEQ * 2);
constexpr size_t OFF_HV = OFF_UTC + AL((size_t)DM * NB * CTXL * 2);
constexpr size_t OFF_HX0 = OFF_HV + AL((size_t)MT * DM * 2);
constexpr size_t OFF_CTXR = OFF_HX0 + AL((size_t)MT * DM * 2);
constexpr size_t OFF_BAR = OFF_CTXR + AL((size_t)NCTX * DM * 4);
constexpr size_t OFF_CS = OFF_BAR + AL((size_t)3456 * 4);
constexpr size_t WS_NEED = OFF_CS + AL((size_t)4096 * 8);
constexpr size_t OFF_GS = OFF_KT + AL((size_t)MT * 4096 * 2);
constexpr size_t OFF_OF = OFF_KT, OFF_OB = OFF_PHY, OFF_T1 = OFF_PHY + AL((size_t)MT * 4096 * 2);

struct Params {
  const float *x, *c, *ctx, *c_ctx, *ln_g, *ada_w, *ada_b, *w_in, *conv_w, *conv_b, *fw1, *fb1, *fw2, *fb2, *fw3, *fb3, *ffreq, *fwout, *hy_bias, *ret_decay, *w_hy_out, *w_ret_out, *w_o, *final_g;
  float* out;
  unsigned char* ws;
  int wid, pad_;
};


#define XB_TMO      128
#define XB_XCNT(j)  (256  + 64 * (j))
#define XB_XSUB(j)  (1280 + 64 * (j))
#define XB_XGEN(j)  (2304 + 64 * (j))
#define XB_TOP      3328
#define XB_TOPGEN   3392
#define XCD_BAR_WORDS 3456
#define XB_SPIN_CAP (1u << 18)
#define XLAS __attribute__((address_space(3)))
DI unsigned xb_ld(unsigned* p)              { return __hip_atomic_load(p, __ATOMIC_RELAXED, __HIP_MEMORY_SCOPE_AGENT); }
DI unsigned xb_add(unsigned* p, unsigned v) { return __hip_atomic_fetch_add(p, v, __ATOMIC_RELAXED, __HIP_MEMORY_SCOPE_AGENT); }
DI unsigned xb_xcc_id() { return (unsigned)__builtin_amdgcn_s_getreg((3 << 11) | 20) & 0xFu; }
#define XB_SPIN(cond, bar) do { unsigned _sp = 0; while (cond) { __builtin_amdgcn_s_sleep(1); \
    if ((++_sp & 255u) == 0u) { if (xb_ld(&(bar)[XB_TMO])) break; if (_sp > XB_SPIN_CAP) { atomicAdd(&(bar)[XB_TMO], 1u); break; } } } } while (0)
struct XcdBarrier { unsigned* bar; unsigned x; volatile XLAS unsigned* st; };
DI XcdBarrier xcd_barrier_post(unsigned* bar, volatile XLAS unsigned* st, bool leader) {
    XcdBarrier b; b.bar = bar; b.x = xb_xcc_id(); b.st = st;
    if (leader) (void)xb_add(&bar[XB_XCNT(b.x)], 1u);
    return b;
}
DI void xcd_barrier_complete(unsigned* bar, unsigned x, unsigned& nloc, unsigned& nx) {
    const unsigned G = gridDim.x * gridDim.y * gridDim.z;
    unsigned sum, cnt, mine, sp = 0u;
    for (;;) {
        sum = 0u; cnt = 0u; mine = 0u;
#pragma unroll
        for (unsigned j = 0; j < 16; ++j) { const unsigned c = xb_ld(&bar[XB_XCNT(j)]); sum += c; cnt += (c > 0u) ? 1u : 0u; mine = (j == x) ? c : mine; }
        if (sum == G) break;
        __builtin_amdgcn_s_sleep(1);
        if ((++sp & 255u) == 0u) { if (xb_ld(&bar[XB_TMO])) break; if (sp > XB_SPIN_CAP) { atomicAdd(&bar[XB_TMO], 1u); break; } }
    }
    nloc = mine > 0u ? mine : 1u; nx = cnt > 0u ? cnt : 1u;
}
DI void xcd_barrier(const XcdBarrier& b, bool leader) {
    asm volatile("s_waitcnt vmcnt(0)" ::: "memory");
    __syncthreads();
    if (leader) {
        unsigned* bar = b.bar;
        __builtin_amdgcn_s_waitcnt(0);
        unsigned nloc = b.st[0], nx = b.st[1];
        if (nloc == 0u) { xcd_barrier_complete(bar, b.x, nloc, nx); b.st[0] = nloc; b.st[1] = nx; }
        const unsigned old = xb_add(&bar[XB_XSUB(b.x)], 1u);
        const unsigned gen = old / nloc;
        if (old + 1u == (gen + 1u) * nloc) {
            __builtin_amdgcn_fence(__ATOMIC_RELEASE, "agent");
            asm volatile("s_waitcnt vmcnt(0)" ::: "memory");
            const unsigned og = xb_add(&bar[XB_TOP], 1u);
            const unsigned tg = og / nx;
            if (og + 1u == (tg + 1u) * nx) xb_add(&bar[XB_TOPGEN], 1u);
            else XB_SPIN(xb_ld(&bar[XB_TOPGEN]) == tg, bar);
            __builtin_amdgcn_fence(__ATOMIC_ACQUIRE, "agent");
            xb_add(&bar[XB_XGEN(b.x)], 1u);
            asm volatile("s_waitcnt vmcnt(0)" ::: "memory");
        } else {
            XB_SPIN(xb_ld(&bar[XB_XGEN(b.x)]) == gen, bar);
            __builtin_amdgcn_fence(__ATOMIC_ACQUIRE, "agent");
            asm volatile("s_waitcnt vmcnt(0)" ::: "memory");
        }
    }
    __syncthreads();
}

namespace pg8 {
#define PG8_LAS __attribute__((address_space(3)))
constexpr int BM = 256, BK = 64, HALF = 128, HTB = HALF * BK * 2, STAGE_BYTES = 8 * HTB, NXCD = 8, WGM = 8;
__host__ __device__ __forceinline__ int lds_byte(int r, int c) { const int st = (r >> 4) * 2 + (c >> 5), rr = r & 15, cc = c & 31, ob = rr * 64 + cc * 2; return st * 1024 + (ob ^ (((ob >> 9) & 1) << 5)); }
__host__ __device__ __forceinline__ void stage_rc(int b, int& R, int& C) { const int st = b / 1024, sb = b % 1024, swz = sb ^ (((sb >> 9) & 1) << 5); R = (st >> 1) * 16 + swz / 64; C = (st & 1) * 32 + (swz % 64) / 2; }
__host__ __device__ __forceinline__ int perm32(int rho) { const int n = rho >> 4, i = rho & 15; return 8 * (i >> 2) + 4 * n + (i & 3); }
struct Unit { int pm, pn; };
struct Gemm { const bf16_t* A; const bf16_t* Bt; int M, N, K, wid; };
struct Order {
    int nM, nN, nwg, G, c, nx_m, nx_n, x_pn0;
    __device__ void init(int nM_, int nN_, int G_, int c_, int nx_m_, int nx_n_, int x_pn0_) { nM = nM_; nN = nN_; nwg = nM * nN; G = G_; c = c_; nx_m = nx_m_; nx_n = nx_n_; x_pn0 = x_pn0_; }
    __device__ bool next(int i, Unit& u) const {
        const long L = (long)i * G + c;
        if (L >= nwg) { const int e = (int)(L - nwg); if (e >= nx_m * nx_n) return false; u.pm = nM + e % nx_m; u.pn = x_pn0 + e / nx_m; return true; }
        int wgid = (int)L; { const int q = nwg / NXCD, r = nwg % NXCD, xcd = wgid % NXCD, off = wgid / NXCD; wgid = (xcd < r ? xcd * (q + 1) : r * (q + 1) + (xcd - r) * q) + off; }
        const int nig = WGM * nN, gid = wgid / nig, fm = gid * WGM, gsz = (nM - fm) < WGM ? (nM - fm) : WGM;
        u.pm = fm + ((wgid % nig) % gsz); u.pn = (wgid % nig) / gsz; return true;
    }
    __device__ __forceinline__ void a_ready(const Unit&) const {}
    __device__ __forceinline__ void done(const Unit&) const {}
};
template <class Epi, class Sched>
__device__ __forceinline__ void gemm_phase(PG8_LAS unsigned char* lds, const Gemm g, const Sched& S, const Epi& E) {
    const int tid = otid(g.wid), wid = __builtin_amdgcn_readfirstlane(tid >> 6), lane = tid & 63, wr = wid >> 2, wc = wid & 3, fr = lane & 15, fq = lane >> 4;
    const int K = g.K, nt = K / BK;
    unsigned voffA[2], voffB[2];
#pragma unroll
    for (int i = 0; i < 2; ++i) { int R, C; stage_rc(tid * 16 + i * 8192, R, C); const int Rb = Epi::PERM ? ((R & ~31) + perm32(R & 31)) : R;
        voffA[i] = (unsigned)(R * K + C) * 2u; voffB[i] = (unsigned)(Rb * K + C) * 2u; }
    const size_t kstep = (size_t)(BK * 2);
    const size_t hstep = (size_t)HALF * K * 2;
    const size_t tstep = 2 * hstep;
    const unsigned ldsw = (unsigned)wid * 1024u;
    const int aoff = lds_byte(wr * 64 + fr, fq * 8), boff = lds_byte(wc * 32 + fr, fq * 8);
#define PG8_SA(b, h) (((b) * 2 + (h)) * HTB)
#define PG8_SB(b, h) ((4 + (b) * 2 + (h)) * HTB)
#define PG8_STAGE(bufoff, gbase, voff) do { _Pragma("unroll") for (int _i = 0; _i < 2; ++_i) \
        __builtin_amdgcn_global_load_lds((const unsigned*)((const char*)(gbase) + (voff)[_i]), (PG8_LAS unsigned*)(lds + (bufoff) + ldsw + _i * 8192), 16, 0, 0); } while (0)
#define PG8_LDA(dst, b, h) do { _Pragma("unroll") for (int m = 0; m < 4; ++m) _Pragma("unroll") for (int k = 0; k < 2; ++k) dst[m][k] = *(const PG8_LAS bf16x8*)(lds + PG8_SA(b, h) + aoff + m * 2048 + k * 1024); } while (0)
#define PG8_LDB(dst, b, h) do { _Pragma("unroll") for (int n = 0; n < 2; ++n) _Pragma("unroll") for (int k = 0; k < 2; ++k) dst[n][k] = *(const PG8_LAS bf16x8*)(lds + PG8_SB(b, h) + boff + n * 2048 + k * 1024); } while (0)
#define PG8_MMA(ai, bj, At, Bt) do { __builtin_amdgcn_s_setprio(1); _Pragma("unroll") for (int m = 0; m < 4; ++m) _Pragma("unroll") for (int n = 0; n < 2; ++n) _Pragma("unroll") for (int k = 0; k < 2; ++k) \
        acc[ai][bj][m][n] = __builtin_amdgcn_mfma_f32_16x16x32_bf16(Bt[n][k], At[m][k], acc[ai][bj][m][n], 0, 0, 0); __builtin_amdgcn_s_setprio(0); } while (0)
#define PG8_WAIT_V(n) asm volatile("s_waitcnt vmcnt(" #n ")" ::: "memory")
#define PG8_WAIT_L(n) asm volatile("s_waitcnt lgkmcnt(" #n ")" ::: "memory")
#define PG8_BAR __builtin_amdgcn_s_barrier()
#define PG8_SCHED __builtin_amdgcn_sched_barrier(0)
    Unit cur, nxt; int ui = 0;
    if (!S.next(0, cur)) return;
    f32x4 acc[2][2][4][2];
#pragma unroll
    for (int a = 0; a < 2; ++a)
#pragma unroll
        for (int b = 0; b < 2; ++b)
#pragma unroll
            for (int m = 0; m < 4; ++m)
#pragma unroll
                for (int n = 0; n < 2; ++n) acc[a][b][m][n] = (f32x4){0.f, 0.f, 0.f, 0.f};
    bf16x8 At[4][2], B0[2][2], B1[2][2];
    const char* cA = (const char*)g.A + (size_t)cur.pm * tstep; const char* cB = (const char*)g.Bt + (size_t)cur.pn * tstep;
    S.a_ready(cur);
    PG8_STAGE(PG8_SB(0, 0), cB, voffB); PG8_STAGE(PG8_SA(0, 0), cA, voffA); PG8_STAGE(PG8_SB(0, 1), cB + hstep, voffB); PG8_STAGE(PG8_SA(0, 1), cA + hstep, voffA);
    if (wr == 1) PG8_BAR;
    PG8_WAIT_V(4); PG8_BAR;
    PG8_STAGE(PG8_SB(1, 0), cB + kstep, voffB); PG8_STAGE(PG8_SA(1, 0), cA + kstep, voffA); PG8_STAGE(PG8_SB(1, 1), cB + hstep + kstep, voffB);
    PG8_WAIT_V(6); PG8_BAR;
    for (;;) {
        const bool has_next = S.next(ui + 1, nxt);
        const char* nA = has_next ? (const char*)g.A + (size_t)nxt.pm * tstep : cA; const char* nB = has_next ? (const char*)g.Bt + (size_t)nxt.pn * tstep : cB;
        for (int t = 0; t < nt; t += 2) {
            const bool last = (t == nt - 2);
            const char* a1 = cA + (size_t)(t + 1) * kstep;
            const char* a2 = last ? nA : cA + (size_t)(t + 2) * kstep; const char* b2 = last ? nB : cB + (size_t)(t + 2) * kstep;
            const char* a3 = a2 + kstep; const char* b3 = b2 + kstep;
            if (last && has_next) S.a_ready(nxt);
            PG8_LDB(B0, 0, 0); PG8_SCHED; PG8_LDA(At, 0, 0); PG8_STAGE(PG8_SA(1, 1), a1 + hstep, voffA);
            PG8_WAIT_L(8); PG8_BAR; PG8_WAIT_L(0); PG8_MMA(0, 0, At, B0); PG8_BAR; PG8_SCHED;
            PG8_LDB(B1, 0, 1); PG8_STAGE(PG8_SB(0, 0), b2, voffB);
            PG8_BAR; PG8_WAIT_L(0); PG8_MMA(0, 1, At, B1); PG8_BAR;
            PG8_LDA(At, 0, 1); PG8_STAGE(PG8_SA(0, 0), a2, voffA);
            PG8_BAR; PG8_WAIT_L(0); PG8_MMA(1, 0, At, B0); PG8_BAR; PG8_SCHED;
            PG8_STAGE(PG8_SB(0, 1), b2 + hstep, voffB);
            PG8_WAIT_V(6); PG8_BAR; PG8_MMA(1, 1, At, B1); PG8_BAR;
            PG8_LDB(B0, 1, 0); PG8_SCHED; PG8_LDA(At, 1, 0); PG8_STAGE(PG8_SA(0, 1), a2 + hstep, voffA);
            PG8_WAIT_L(8); PG8_BAR; PG8_WAIT_L(0); PG8_MMA(0, 0, At, B0); PG8_BAR; PG8_SCHED;
            PG8_LDB(B1, 1, 1); PG8_STAGE(PG8_SB(1, 0), b3, voffB);
            PG8_BAR; PG8_WAIT_L(0); PG8_MMA(0, 1, At, B1); PG8_BAR;
            PG8_LDA(At, 1, 1); PG8_STAGE(PG8_SA(1, 0), a3, voffA);
            PG8_BAR; PG8_WAIT_L(0); PG8_MMA(1, 0, At, B0); PG8_BAR; PG8_SCHED;
            PG8_STAGE(PG8_SB(1, 1), b3 + hstep, voffB);
            PG8_WAIT_V(6); PG8_BAR; PG8_MMA(1, 1, At, B1); PG8_BAR;
        }
        if constexpr (!Epi::AFTER_DRAIN) { E(acc, cur, wr, wc, fr, fq); S.done(cur); }
        if (!has_next) break;
#pragma unroll
        for (int a = 0; a < 2; ++a)
#pragma unroll
            for (int b = 0; b < 2; ++b)
#pragma unroll
                for (int m = 0; m < 4; ++m)
#pragma unroll
                    for (int n = 0; n < 2; ++n) acc[a][b][m][n] = (f32x4){0.f, 0.f, 0.f, 0.f};
        cur = nxt; cA = nA; cB = nB; ++ui;
    }
    PG8_WAIT_V(0);
    if (wr == 0) PG8_BAR;
    PG8_BAR;
    if constexpr (Epi::AFTER_DRAIN) { E.fused(acc, cur, wr, wc, fr, fq, lds, wid, lane); S.done(cur); }
#undef PG8_SA
#undef PG8_SB
#undef PG8_STAGE
#undef PG8_LDA
#undef PG8_LDB
#undef PG8_MMA

#undef PG8_WAIT_V
#undef PG8_WAIT_L
#undef PG8_BAR
#undef PG8_SCHED
}
}

struct EpiG1 {
  static constexpr bool PERM = true, AFTER_DRAIN = false;
  unsigned char* ws;
  DI void operator()(const f32x4 (&acc)[2][2][4][2], const pg8::Unit& u, int wr, int wc, int fr, int fq) const {
    const int pn = u.pn; size_t off; int ld, c0;
    if (pn < 8) { off = OFF_PQ; ld = 2048; c0 = pn * 256; }
    else if (pn < 16) { off = OFF_PK; ld = 2048; c0 = (pn - 8) * 256; }
    else if (pn < 32) { off = OFF_PV; ld = 4096; c0 = (pn - 16) * 256; }
    else if (pn < 48) { off = OFF_PRG; ld = 4096; c0 = (pn - 32) * 256; }
    else if (pn < 72) { off = OFF_PHY; ld = 6144; c0 = (pn - 48) * 256; }
    else if (pn < 80) { off = OFF_PHG; ld = 2048; c0 = (pn - 72) * 256; }
    else { off = OFF_PMG; ld = 4096; c0 = (pn - 80) * 256; }
    bf16_t* base = (bf16_t*)(ws + off);
    const int row0 = u.pm * 256 + wr * 64 + fr, col0 = c0 + wc * 32 + 8 * fq;
    const bool rope = (pn < 16) && (u.pm < 64);
    const float4* CS = (const float4*)(ws + OFF_CS) + (wc * 4 + fq) * 2;
#pragma unroll
    for (int ai = 0; ai < 2; ++ai)
#pragma unroll
      for (int m = 0; m < 4; ++m) { const int row = row0 + ai * 128 + m * 16; bf16_t* rowp = base + (size_t)row * ld + col0;
#pragma unroll
        for (int bj = 0; bj < 2; ++bj) { f32x4 v0 = acc[ai][bj][m][0], v1 = acc[ai][bj][m][1];
          if (rope) { const int t = row & 4095, pos = bj ? (t & 63) : (t >> 6); const float4 ca = CS[pos * 32], cb = CS[pos * 32 + 1];
            const f32x4 a = v0, b = v1;
            v0[0] = a[0] * ca.x - b[0] * ca.y; v1[0] = a[0] * ca.y + b[0] * ca.x; v0[1] = a[1] * ca.z - b[1] * ca.w; v1[1] = a[1] * ca.w + b[1] * ca.z;
            v0[2] = a[2] * cb.x - b[2] * cb.y; v1[2] = a[2] * cb.y + b[2] * cb.x; v0[3] = a[3] * cb.z - b[3] * cb.w; v1[3] = a[3] * cb.w + b[3] * cb.z; }
          u32x4 o; o[0] = pk2(v0[0], v0[1]); o[1] = pk2(v0[2], v0[3]); o[2] = pk2(v1[0], v1[1]); o[3] = pk2(v1[2], v1[3]);
          *(u32x4*)(rowp + bj * 128) = o; } }
  }
};
template <int SECOND> struct EpiG23 {
  static constexpr bool PERM = true, AFTER_DRAIN = false;
  unsigned char* ws;
  DI void operator()(const f32x4 (&acc)[2][2][4][2], const pg8::Unit& u, int wr, int wc, int fr, int fq) const {
    bf16_t* T1 = (bf16_t*)(ws + OFF_T1); const bf16_t* MG = (const bf16_t*)(ws + OFF_PMG) + (SECOND ? 2048 : 0);
    const int row0 = u.pm * 256 + wr * 64 + fr, col0 = u.pn * 256 + wc * 32 + 8 * fq;
#pragma unroll
    for (int ai = 0; ai < 2; ++ai)
#pragma unroll
      for (int m = 0; m < 4; ++m) { const size_t row = (size_t)(row0 + ai * 128 + m * 16);
#pragma unroll
        for (int bj = 0; bj < 2; ++bj) { const int col = col0 + bj * 128;
          const u32x4 g = *(const u32x4*)(MG + row * 4096 + col);
          const f32x4 v0 = acc[ai][bj][m][0], v1 = acc[ai][bj][m][1];
          float r[8];
          r[0] = sigmoidf_(lo2f(g[0])) * v0[0]; r[1] = sigmoidf_(hi2f(g[0])) * v0[1]; r[2] = sigmoidf_(lo2f(g[1])) * v0[2]; r[3] = sigmoidf_(hi2f(g[1])) * v0[3];
          r[4] = sigmoidf_(lo2f(g[2])) * v1[0]; r[5] = sigmoidf_(hi2f(g[2])) * v1[1]; r[6] = sigmoidf_(lo2f(g[3])) * v1[2]; r[7] = sigmoidf_(hi2f(g[3])) * v1[3];
          if (SECOND) { const u32x4 t = *(const u32x4*)(T1 + row * 2048 + col);
            r[0] += lo2f(t[0]); r[1] += hi2f(t[0]); r[2] += lo2f(t[1]); r[3] += hi2f(t[1]); r[4] += lo2f(t[2]); r[5] += hi2f(t[2]); r[6] += lo2f(t[3]); r[7] += hi2f(t[3]); }
          u32x4 o; o[0] = pk2(r[0], r[1]); o[1] = pk2(r[2], r[3]); o[2] = pk2(r[4], r[5]); o[3] = pk2(r[6], r[7]);
          *(u32x4*)(T1 + row * 2048 + col) = o; } }
  }
};
struct EpiG4 {
  static constexpr bool PERM = false, AFTER_DRAIN = false;
  const float* xin; const float* cin; float* xout; float* cout; const float* mod;
  DI void operator()(const f32x4 (&acc)[2][2][4][2], const pg8::Unit& u, int wr, int wc, int fr, int fq) const {
    const int row0 = u.pm * 256 + wr * 64 + fr, col0 = u.pn * 256 + wc * 32 + 4 * fq;
#pragma unroll
    for (int ai = 0; ai < 2; ++ai)
#pragma unroll
      for (int m = 0; m < 4; ++m) { const int row = row0 + ai * 128 + m * 16;
        const float* src; float* dst; const float* gate;
        if (row < NLAT) { src = xin + (size_t)row * 2048; dst = xout + (size_t)row * 2048; gate = mod + (row >> 12) * 6144 + 4096; }
        else { src = cin + (size_t)(row - NLAT) * 2048; dst = cout + (size_t)(row - NLAT) * 2048; gate = mod + 4 * 6144 + 4096; }
#pragma unroll
        for (int bj = 0; bj < 2; ++bj)
#pragma unroll
          for (int n = 0; n < 2; ++n) { const int col = col0 + bj * 128 + n * 16;
            const f32x4 xv = *(const f32x4*)(src + col), gv = *(const f32x4*)(gate + col);
            *(f32x4*)(dst + col) = xv + gv * acc[ai][bj][m][n]; } }
  }
};

__device__ void phase_mod(const Params& p, unsigned char* shm) {
  float* sc = (float*)shm; float* red = sc + 5 * 2048;
  const int tid = otid(p.wid);
  for (int i = tid; i < 5 * 2048; i += 512) { const int j = i >> 11, k = i & 2047; const float v = (j < 4) ? p.c[j * 2048 + k] : p.c_ctx[k]; sc[i] = v / (1.f + expf(-v)); }
  __syncthreads();
  { const int i = blockIdx.x * 512 + tid; if (i < 4096) { const int pos = i >> 6, j = i & 63; const float inv = 1.f / powf(10000.f, (float)j / 64.f); float sn, cn; sincosf((float)pos * inv, &sn, &cn); ((float2*)(p.ws + OFF_CS))[i] = make_float2(cn, sn); } }
  float* mod = (float*)(p.ws + OFF_MOD);
  const int cq = tid & 7, ks = tid >> 3;
  for (int it = blockIdx.x; it < 384; it += gridDim.x) {
    const int l = it / 192, nb = (it % 192) * 32;
    const float* W = p.ada_w + (size_t)l * 2048 * 6144 + nb + cq * 4;
    float acc[5][4];
#pragma unroll
    for (int j = 0; j < 5; ++j) { acc[j][0] = 0.f; acc[j][1] = 0.f; acc[j][2] = 0.f; acc[j][3] = 0.f; }
#pragma unroll 4
    for (int kk = 0; kk < 32; ++kk) { const int k = ks * 32 + kk; const float4 w = *(const float4*)(W + (size_t)k * 6144);
#pragma unroll
      for (int j = 0; j < 5; ++j) { const float s = sc[j * 2048 + k]; acc[j][0] += s * w.x; acc[j][1] += s * w.y; acc[j][2] += s * w.z; acc[j][3] += s * w.w; } }
#pragma unroll
    for (int j = 0; j < 5; ++j)
#pragma unroll
      for (int e = 0; e < 4; ++e) red[ks * 160 + j * 32 + cq * 4 + e] = acc[j][e];
    __syncthreads();
    if (tid < 160) { float s = 0.f; for (int q = 0; q < 64; ++q) s += red[q * 160 + tid]; const int j = tid >> 5, n = nb + (tid & 31); mod[(l * 5 + j) * 6144 + n] = s + p.ada_b[l * 6144 + n]; }
    __syncthreads();
  }
}

struct CvtG { const float* W; bf16_t* Wt; int K, N, k0, n0; float scale; bool perm; };
DI CvtG cvt_decode(const Params& p, int l, int it) {
  CvtG g;
  if (it < 3072) { g.W = p.w_in + (size_t)l * DM * INW; g.Wt = (bf16_t*)(p.ws + OFF_WTIN); g.K = DM; g.N = INW; g.k0 = (it & 7) * 256; g.n0 = (it >> 3) * 64; g.scale = (g.n0 >= 2048 && g.n0 < 4096) ? 0.0625f : 1.f; g.perm = g.n0 < 4096; }
  else if (it < 3328) { const int e = it - 3072; g.W = p.w_hy_out + (size_t)l * DM * DM; g.Wt = (bf16_t*)(p.ws + OFF_WTHY); g.K = DM; g.N = DM; g.k0 = (e & 7) * 256; g.n0 = (e >> 3) * 64; g.scale = 1.f; g.perm = false; }
  else if (it < 3840) { const int e = it - 3328; g.W = p.w_ret_out + (size_t)l * 4096 * DM; g.Wt = (bf16_t*)(p.ws + OFF_WTRET); g.K = 4096; g.N = DM; g.k0 = (e & 15) * 256; g.n0 = (e >> 4) * 64; g.scale = 1.f; g.perm = false; }
  else { const int e = it - 3840; g.W = p.w_o + (size_t)l * DM * DM; g.Wt = (bf16_t*)(p.ws + OFF_WTO); g.K = DM; g.N = DM; g.k0 = (e & 7) * 256; g.n0 = (e >> 3) * 64; g.scale = 1.f; g.perm = false; }
  return g;
}
#define CVT_LOAD(v, g, tid) do { int nsrc_ = (g).n0 + ((tid) & 15) * 4; \
    if ((g).perm) { const int pc_ = ((g).n0 & 255) + ((tid) & 15) * 4, r_ = pc_ & 127; nsrc_ = ((g).n0 & ~255) + (pc_ & 128) + (r_ >> 3) * 4 + 64 * ((r_ >> 2) & 1); } \
    _Pragma("unroll") for (int q = 0; q < 4; ++q) _Pragma("unroll") for (int rr = 0; rr < 2; ++rr) { const int k = ((tid) >> 4) + 32 * rr; v[q * 2 + rr] = *(const float4*)((g).W + (size_t)((g).k0 + q * 64 + k) * (g).N + nsrc_); } } while (0)
__device__ void phase_cvt(const Params& p, int l, unsigned char* shm) {
  float* tile = (float*)shm; const int tid = otid(p.wid);
  float4 v[8];
  int it = blockIdx.x;
  if (it < 4096) { const CvtG g0 = cvt_decode(p, l, it); CVT_LOAD(v, g0, tid); }
  for (; it < 4096; it += gridDim.x) {
    const CvtG g = cvt_decode(p, l, it);
#pragma unroll
    for (int q = 0; q < 4; ++q)
#pragma unroll
      for (int rr = 0; rr < 2; ++rr) { const int k = (tid >> 4) + 32 * rr, n = (tid & 15) * 4; float* t = tile + q * 4160 + k * 65 + n; const float4 x = v[q * 2 + rr]; t[0] = x.x; t[1] = x.y; t[2] = x.z; t[3] = x.w; }
    if (it + (int)gridDim.x < 4096) { const CvtG gn = cvt_decode(p, l, it + (int)gridDim.x); CVT_LOAD(v, gn, tid); }
    __syncthreads();
#pragma unroll
    for (int q = 0; q < 4; ++q) { const int n = tid >> 3, k8 = (tid & 7) * 8; const float* t = tile + q * 4160; u32x4 o;
#pragma unroll
      for (int e = 0; e < 4; ++e) o[e] = pk2(t[(k8 + 2 * e) * 65 + n] * g.scale, t[(k8 + 2 * e + 1) * 65 + n] * g.scale);
      *(u32x4*)(g.Wt + (size_t)(g.n0 + n) * g.K + g.k0 + q * 64 + k8) = o; }
    __syncthreads();
  }
}
#undef CVT_LOAD

DI void filt_item(const Params& p, int l, int Ls, int T, bool isctx, unsigned char* shm) {
  float* z = (float*)shm; float* ha = z + 17 * 36; float* hb = ha + 17 * 64;
  const int tid = otid(p.wid);
  const float* w1 = p.fw1 + l * 33 * 64; const float* b1 = p.fb1 + l * 64; const float* w2 = p.fw2 + l * 4096; const float* b2 = p.fb2 + l * 64;
  const float* w3 = p.fw3 + l * 4096; const float* b3 = p.fb3 + l * 64; const float* fq = p.ffreq + l * 64; const float* wout = p.fwout + (size_t)l * 64 * 4096;
  float* w1s = z + 2816; float* w2s = w1s + 2112; float* w3s = w2s + 4096;
  { const float4 a0 = ((const float4*)w2)[tid], a1 = ((const float4*)w2)[tid + 512], b0 = ((const float4*)w3)[tid], b1 = ((const float4*)w3)[tid + 512];
    const float4 c0 = ((const float4*)w1)[tid]; float4 c1 = c0; if (tid < 16) c1 = ((const float4*)w1)[tid + 512];
    ((float4*)w2s)[tid] = a0; ((float4*)w2s)[tid + 512] = a1; ((float4*)w3s)[tid] = b0; ((float4*)w3s)[tid + 512] = b1; ((float4*)w1s)[tid] = c0; if (tid < 16) ((float4*)w1s)[tid + 512] = c1; }
  for (int i = tid; i < 17 * 33; i += 512) { const int pl = i / 33, f = i % 33; int pp = T * 16 + pl; if (pp > Ls - 1) pp = Ls - 1;
    float val;
    if (f == 0) val = (float)pp / (float)(Ls - 1);
    else { const int j = (f - 1) & 15; const float fj = 1e-4f + (float)j * ((15.f - 1e-4f) / 15.f); const float ang = 6.283185307179586f * (float)pp / (float)Ls; const float a = fj * ang; val = (f <= 16) ? cosf(a) : -sinf(a); }
    z[pl * 36 + f] = val; }
  __syncthreads();
  for (int idx = tid; idx < 17 * 16; idx += 512) { const int pl = idx >> 4, j0 = (idx & 15) * 4; float a[4] = {0.f, 0.f, 0.f, 0.f};
#pragma unroll 3
    for (int k = 0; k < 33; ++k) { const float v = z[pl * 36 + k]; const float4 w = *(const float4*)(w1s + k * 64 + j0); a[0] += v * w.x; a[1] += v * w.y; a[2] += v * w.z; a[3] += v * w.w; }
#pragma unroll
    for (int e = 0; e < 4; ++e) ha[pl * 64 + j0 + e] = sinf(fq[j0 + e] * (a[e] + b1[j0 + e])); }
  __syncthreads();
  for (int idx = tid; idx < 17 * 16; idx += 512) { const int pl = idx >> 4, j0 = (idx & 15) * 4; float a[4] = {0.f, 0.f, 0.f, 0.f};
#pragma unroll 4
    for (int k = 0; k < 64; ++k) { const float v = ha[pl * 64 + k]; const float4 w = *(const float4*)(w2s + k * 64 + j0); a[0] += v * w.x; a[1] += v * w.y; a[2] += v * w.z; a[3] += v * w.w; }
#pragma unroll
    for (int e = 0; e < 4; ++e) hb[pl * 64 + j0 + e] = sinf(fq[j0 + e] * (a[e] + b2[j0 + e])); }
  __syncthreads();
  for (int idx = tid; idx < 17 * 16; idx += 512) { const int pl = idx >> 4, j0 = (idx & 15) * 4; float a[4] = {0.f, 0.f, 0.f, 0.f};
#pragma unroll 4
    for (int k = 0; k < 64; ++k) { const float v = hb[pl * 64 + k]; const float4 w = *(const float4*)(w3s + k * 64 + j0); a[0] += v * w.x; a[1] += v * w.y; a[2] += v * w.z; a[3] += v * w.w; }
#pragma unroll
    for (int e = 0; e < 4; ++e) ha[pl * 64 + j0 + e] = sinf(fq[j0 + e] * (a[e] + b3[j0 + e])); }
  __syncthreads();
  const int cb = tid * 4;
  const float mind = logf(0.01f) / 1.5f, maxd = logf(0.01f) / 0.3f;
  bf16_t* G = (bf16_t*)(p.ws + OFF_G + (size_t)l * G_LAYER); float* GC = (float*)(p.ws + OFF_GC);
  float delta[4];
#pragma unroll
  for (int cc = 0; cc < 4; ++cc) delta[cc] = fabsf(mind + (float)(cb + cc) * ((maxd - mind) / 2047.f));
#pragma unroll 1
  for (int pgh = 0; pgh < 4; ++pgh) {
    const int pg = pgh >> 1; const bool isb = (pgh & 1) != 0; const int c4 = cb + (isb ? 2048 : 0);
    const int plb = pg * 8;
    float acc[8][4];
#pragma unroll
    for (int e = 0; e < 8; ++e) { acc[e][0] = 0.f; acc[e][1] = 0.f; acc[e][2] = 0.f; acc[e][3] = 0.f; }
    float4 wA[8], wB[8];
#define FILT_LOAD(buf, kb_) do { _Pragma("unroll") for (int j = 0; j < 8; ++j) buf[j] = *(const float4*)(wout + ((kb_) * 8 + j) * 4096 + c4); } while (0)
#define FILT_FMA(buf, kb_) do { _Pragma("unroll") for (int j = 0; j < 8; ++j) { const float4 wa = buf[j]; const int k = (kb_) * 8 + j; \
      _Pragma("unroll") for (int e = 0; e < 8; ++e) { const float h = ha[(plb + e) * 64 + k]; acc[e][0] += h * wa.x; acc[e][1] += h * wa.y; acc[e][2] += h * wa.z; acc[e][3] += h * wa.w; } } } while (0)
    FILT_LOAD(wA, 0);
#pragma unroll 1
    for (int kb = 0; kb < 8; kb += 2) {
      FILT_LOAD(wB, kb + 1);
      asm volatile("" ::: "memory");
      FILT_FMA(wA, kb);
      asm volatile("" ::: "memory");
      if (kb + 2 < 8) FILT_LOAD(wA, kb + 2);
      asm volatile("" ::: "memory");
      FILT_FMA(wB, kb + 1);
      asm volatile("" ::: "memory");
    }
#undef FILT_LOAD
#undef FILT_FMA
    const int pp0 = T * 16 + plb;
#pragma unroll
    for (int e = 0; e < 8; ++e) { const int pp = pp0 + e; const float tt = (float)pp / (float)(Ls - 1);
      if (pp < Ls && !(isb && pp == 0)) {
        float v[4];
#pragma unroll
        for (int cc = 0; cc < 4; ++cc) v[cc] = acc[e][cc] * __expf(-tt * delta[cc]);
        if (!isb && pp == 0) {
#pragma unroll
          for (int cc = 0; cc < 4; ++cc) v[cc] += p.hy_bias[l * 2048 + cb + cc]; }
        if (!isctx) { const int m = isb ? LOFF + pp : LOFF - pp; u32x2 o; o[0] = pk2(v[0], v[1]); o[1] = pk2(v[2], v[3]); *(u32x2*)(G + (size_t)m * 2048 + cb) = o; }
        else { const int idx = isb ? 256 - pp : 256 + pp;
#pragma unroll
          for (int cc = 0; cc < 4; ++cc) GC[(size_t)(cb + cc) * 512 + idx] = v[cc]; }
      }
    }
  }
  __syncthreads();
}
__device__ void phase_filters(const Params& p, unsigned char* shm, bool ctxpass) {
  if (!ctxpass) { for (int it = blockIdx.x; it < 512; it += gridDim.x) filt_item(p, it >> 8, SEQ, it & 255, false, shm); }
  else { const int first = (int)gridDim.x >= 16 ? (int)gridDim.x - 16 : 0; for (int it = (int)blockIdx.x - first; it >= 0 && it < 16; it += (int)gridDim.x - first) filt_item(p, 0, CTXL, it, true, shm); }
}

__device__ void phase_norm(const Params& p, int l) {
  const int lane = otid(p.wid) & 63, gw = blockIdx.x * 8 + (otid(p.wid) >> 6), nw = gridDim.x * 8;
  const float* mod = (const float*)(p.ws + OFF_MOD) + (size_t)l * 5 * 6144; const float* lng = p.ln_g + l * 2048;
  bf16_t* H = (bf16_t*)(p.ws + OFF_H);
  for (int r = gw; r < MT; r += nw) {
    const float* src; int j;
    if (r < NLAT) { src = (l == 0 ? p.x : p.out) + (size_t)r * 2048; j = r >> 12; }
    else { src = (l == 0 ? p.ctx : (const float*)(p.ws + OFF_CTXR)) + (size_t)(r - NLAT) * 2048; j = 4; }
    const float* sh = mod + j * 6144; const float* sc = sh + 2048;
    float4 v[8]; float ss = 0.f;
#pragma unroll
    for (int i = 0; i < 8; ++i) { v[i] = *(const float4*)(src + i * 256 + lane * 4); ss += v[i].x * v[i].x + v[i].y * v[i].y + v[i].z * v[i].z + v[i].w * v[i].w; }
    ss = wsum(ss, lane);
    const float rs = rsqrtf(ss * (1.f / 2048.f) + 1e-6f);
#pragma unroll
    for (int i = 0; i < 8; ++i) { const int col = i * 256 + lane * 4; const float4 g = *(const float4*)(lng + col), a = *(const float4*)(sc + col), b = *(const float4*)(sh + col);
      u32x2 o; o[0] = pk2(v[i].x * rs * g.x * (1.f + a.x) + b.x, v[i].y * rs * g.y * (1.f + a.y) + b.y); o[1] = pk2(v[i].z * rs * g.z * (1.f + a.z) + b.z, v[i].w * rs * g.w * (1.f + a.w) + b.w);
      *(u32x2*)(H + (size_t)r * 2048 + col) = o; }
  }
}
__device__ void phase_final(const Params& p) {
  const int lane = otid(p.wid) & 63, gw = blockIdx.x * 8 + (otid(p.wid) >> 6), nw = gridDim.x * 8;
  for (int r = gw; r < NLAT; r += nw) {
    float* src = p.out + (size_t)r * 2048; float4 v[8]; float ss = 0.f;
#pragma unroll
    for (int i = 0; i < 8; ++i) { v[i] = *(const float4*)(src + i * 256 + lane * 4); ss += v[i].x * v[i].x + v[i].y * v[i].y + v[i].z * v[i].z + v[i].w * v[i].w; }
    ss = wsum(ss, lane);
    const float rs = rsqrtf(ss * (1.f / 2048.f) + 1e-6f);
#pragma unroll
    for (int i = 0; i < 8; ++i) { const int col = i * 256 + lane * 4; const float4 g = *(const float4*)(p.final_g + col); float4 o; o.x = v[i].x * rs * g.x; o.y = v[i].y * rs * g.y; o.z = v[i].z * rs * g.z; o.w = v[i].w * rs * g.w; *(float4*)(src + col) = o; }
  }
}

DI void tok_tile(int tk, int& b, int& t0, bool& isctx) { if (tk < 256) { b = tk >> 6; t0 = (tk & 63) * 64; isctx = false; } else { b = (tk - 256) >> 2; t0 = ((tk - 256) & 3) * 64; isctx = true; } }
DI int tok_row(int b, int t, bool isctx) { return isctx ? NLAT + b * CTXL + t : b * SEQ + t; }

__device__ void phase_prep(const Params& p, int l, unsigned char* shm, int mask) {
  const int tid = otid(p.wid), lane = tid & 63;
  unsigned char* reg2 = shm + 32768;
  (void)lane;
  if (mask & 4) { float* in = (float*)reg2;
    bf16_t* ut = (bf16_t*)(reg2 + 3 * 66 * 64 * 4);
    const bf16_t* PHY = (const bf16_t*)(p.ws + OFF_PHY); const bf16_t* PHG = (const bf16_t*)(p.ws + OFF_PHG); bf16_t* HX0 = (bf16_t*)(p.ws + OFF_HX0);
    const float* cw = p.conv_w + (size_t)l * 3 * 6144; const float* cb = p.conv_b + (size_t)l * 6144;
    const int nit = ((l == 0) ? 272 : 256) * 32;
    u32x4 pre[4];
#define PC_DECODE(it_) const int tk = (it_) >> 5, c0 = ((it_) & 31) * 64; int b, t0; bool isctx; tok_tile(tk, b, t0, isctx); const int Ls = isctx ? CTXL : SEQ; const int row0 = tok_row(b, t0, isctx);
#define PC_LOAD(it_) do { PC_DECODE(it_) _Pragma("unroll") for (int e = 0; e < 4; ++e) { const int id = tid + 512 * e; const int pi = id / 528, rem = id % 528, rr = rem >> 3, pc = rem & 7; const int t = t0 - 1 + rr; \
        u32x4 v; v[0] = 0u; v[1] = 0u; v[2] = 0u; v[3] = 0u; if (id < 1584 && t >= 0 && t < Ls) v = *(const u32x4*)(PHY + (size_t)(row0 - 1 + rr) * 6144 + pi * 2048 + c0 + pc * 8); pre[e] = v; } } while (0)
    if ((int)blockIdx.x < nit) PC_LOAD((int)blockIdx.x);
    for (int it = blockIdx.x; it < nit; it += gridDim.x) {
      PC_DECODE(it) (void)Ls;
#pragma unroll
      for (int e = 0; e < 4; ++e) { const int id = tid + 512 * e; if (id < 1584) { const int pi = id / 528, rem = id % 528, rr = rem >> 3, pc = rem & 7; const u32x4 v = pre[e];
        float* d = in + (pi * 66 + rr) * 64 + pc * 8;
        *(float4*)d = make_float4(lo2f(v[0]), hi2f(v[0]), lo2f(v[1]), hi2f(v[1])); *(float4*)(d + 4) = make_float4(lo2f(v[2]), hi2f(v[2]), lo2f(v[3]), hi2f(v[3])); } }
      if (it + (int)gridDim.x < nit) PC_LOAD(it + (int)gridDim.x);
      __syncthreads();
      { const int cg8 = (tid & 7) * 8, tok = tid >> 3;
        float cv[3][8];
#pragma unroll
        for (int pi = 0; pi < 3; ++pi) { const float* wp = cw + pi * 2048 + c0 + cg8;
          const float4 ba = *(const float4*)(cb + pi * 2048 + c0 + cg8), bb = *(const float4*)(cb + pi * 2048 + c0 + cg8 + 4);
          cv[pi][0] = ba.x; cv[pi][1] = ba.y; cv[pi][2] = ba.z; cv[pi][3] = ba.w; cv[pi][4] = bb.x; cv[pi][5] = bb.y; cv[pi][6] = bb.z; cv[pi][7] = bb.w;
#pragma unroll
          for (int k = 0; k < 3; ++k) { const float4 wa = *(const float4*)(wp + k * 6144), wb = *(const float4*)(wp + k * 6144 + 4);
            const float* ip = in + (pi * 66 + tok + k) * 64 + cg8; const float4 xa = *(const float4*)ip, xb = *(const float4*)(ip + 4);
            cv[pi][0] += xa.x * wa.x; cv[pi][1] += xa.y * wa.y; cv[pi][2] += xa.z * wa.z; cv[pi][3] += xa.w * wa.w; cv[pi][4] += xb.x * wb.x; cv[pi][5] += xb.y * wb.y; cv[pi][6] += xb.z * wb.z; cv[pi][7] += xb.w * wb.w; } }
        u32x4 hvp, hxp; const u32x4 hg = *(const u32x4*)(PHG + (size_t)(row0 + tok) * 2048 + c0 + cg8);
#pragma unroll
        for (int e = 0; e < 4; ++e) { hvp[e] = pk2(cv[0][2 * e] * cv[2][2 * e], cv[0][2 * e + 1] * cv[2][2 * e + 1]); hxp[e] = pk2(cv[1][2 * e] * siluf_(lo2f(hg[e])), cv[1][2 * e + 1] * siluf_(hi2f(hg[e]))); }
        *(u32x4*)(HX0 + (size_t)(row0 + tok) * 2048 + c0 + cg8) = hxp;
#pragma unroll
        for (int e = 0; e < 4; ++e) { ut[(cg8 + 2 * e) * 66 + tok] = (bf16_t)(hvp[e] & 0xffffu); ut[(cg8 + 2 * e + 1) * 66 + tok] = (bf16_t)(hvp[e] >> 16); } }
      __syncthreads();
      { const int c = tid >> 3, pc = tid & 7; u32x4 o;
#pragma unroll
        for (int e = 0; e < 4; ++e) o[e] = (unsigned)ut[c * 66 + pc * 8 + 2 * e] | ((unsigned)ut[c * 66 + pc * 8 + 2 * e + 1] << 16);
        bf16_t* dst = isctx ? (bf16_t*)(p.ws + OFF_UTC) + ((size_t)(c0 + c) * NB + b) * CTXL + t0 + pc * 8 : (bf16_t*)(p.ws + OFF_UT) + ((size_t)(c0 + c) * NB + b) * SEQ + t0 + pc * 8;
        *(u32x4*)dst = o; }
    }
    __syncthreads();
#undef PC_DECODE
#undef PC_LOAD
  }
}

__device__ void phase_post(const Params& p, int l, unsigned char* shm, int mask) {
  const int tid = otid(p.wid), lane = tid & 63;
  const bf16_t* HX0 = (const bf16_t*)(p.ws + OFF_HX0);
  bf16_t* AH = (bf16_t*)(p.ws + OFF_H);
  if (mask & 1) { float* yt = (float*)shm;
    const bf16_t* UT = (const bf16_t*)(p.ws + OFF_UT);
    const int nit = 256 * 32; u32x4 pre;
#define PA_LOAD(it_) do { const int tk_ = (it_) >> 5, c0_ = ((it_) & 31) * 64, b_ = tk_ >> 6, t0_ = (tk_ & 63) * 64; pre = *(const u32x4*)(UT + ((size_t)(c0_ + (tid >> 3)) * NB + b_) * SEQ + t0_ + (tid & 7) * 8); } while (0)
    if ((int)blockIdx.x < nit) PA_LOAD((int)blockIdx.x);
    for (int it = blockIdx.x; it < nit; it += gridDim.x) {
      const int tk = it >> 5, c0 = (it & 31) * 64, b = tk >> 6, t0 = (tk & 63) * 64, row0 = b * SEQ + t0;
      { const int c = tid >> 3, pc = tid & 7; const u32x4 v = pre; float* d = yt + (pc * 8) * 65 + c;
        d[0] = lo2f(v[0]); d[65] = hi2f(v[0]); d[130] = lo2f(v[1]); d[195] = hi2f(v[1]); d[260] = lo2f(v[2]); d[325] = hi2f(v[2]); d[390] = lo2f(v[3]); d[455] = hi2f(v[3]); }
      if (it + (int)gridDim.x < nit) PA_LOAD(it + (int)gridDim.x);
      __syncthreads();
      { const int cg8 = (tid & 7) * 8, tok = tid >> 3; const size_t o = (size_t)(row0 + tok) * 2048 + c0 + cg8;
        const u32x4 m1 = *(const u32x4*)(HX0 + o); const float* yp = yt + tok * 65 + cg8; u32x4 r;
#pragma unroll
        for (int e = 0; e < 4; ++e) r[e] = pk2(yp[2 * e] * lo2f(m1[e]), yp[2 * e + 1] * hi2f(m1[e]));
        *(u32x4*)(AH + o) = r; }
      __syncthreads();
    }
#undef PA_LOAD
  }
  if (l == 0 && (mask & 2)) { constexpr int GST = 513, UST = 257; float* gc = (float*)shm; float* us = gc + 32 * GST;
    const bf16_t* UTC = (const bf16_t*)(p.ws + OFF_UTC); const float* GC = (const float*)(p.ws + OFF_GC);
    for (int it = blockIdx.x; it < 16 * 64; it += gridDim.x) {
      const int tk = it >> 6, c0 = (it & 63) * 32, b = tk >> 2, t0 = (tk & 3) * 64, row0 = NLAT + b * CTXL + t0;
#pragma unroll 8
      for (int i = tid; i < 32 * 512; i += 512) gc[(i >> 9) * GST + (i & 511)] = GC[(size_t)(c0 + (i >> 9)) * 512 + (i & 511)];
#pragma unroll 8
      for (int i = tid; i < 32 * 256; i += 512) us[(i >> 8) * UST + (i & 255)] = bf2f(UTC[((size_t)(c0 + (i >> 8)) * NB + b) * CTXL + (i & 255)]);
      __syncthreads();
      { const int c = tid >> 4, t = (tid & 15) * 4; const float* gp = gc + c * GST + 256 + t0 + t; const float* up = us + c * UST;
        float a0 = 0.f, a1 = 0.f, a2 = 0.f, a3 = 0.f; float w0 = gp[0], w1 = gp[1], w2 = gp[2], w3 = gp[3];
#pragma unroll 4
        for (int s = 0; s < 256; s += 4) {
          const float u0 = up[s], u1 = up[s + 1], u2 = up[s + 2], u3 = up[s + 3];
          const float n1 = gp[-(s + 1)], n2 = gp[-(s + 2)], n3 = gp[-(s + 3)], n4 = gp[-(s + 4)];
          a0 += u0 * w0; a1 += u0 * w1; a2 += u0 * w2; a3 += u0 * w3;
          a0 += u1 * n1; a1 += u1 * w0; a2 += u1 * w1; a3 += u1 * w2;
          a0 += u2 * n2; a1 += u2 * n1; a2 += u2 * w0; a3 += u2 * w1;
          a0 += u3 * n3; a1 += u3 * n2; a2 += u3 * n1; a3 += u3 * w0;
          w3 = n1; w2 = n2; w1 = n3; w0 = n4; }
        const float av[4] = {a0, a1, a2, a3};
#pragma unroll
        for (int j = 0; j < 4; ++j) { const size_t o = (size_t)(row0 + t + j) * 2048 + c0 + c; AH[o] = f2bf(av[j] * bf2f(HX0[o])); } }
      __syncthreads();
    }
  }
  if (mask & 4) { bf16_t* OF = (bf16_t*)(p.ws + OFF_OF); const bf16_t* OB = (const bf16_t*)(p.ws + OFF_OB); const bf16_t* RG = (const bf16_t*)(p.ws + OFF_PRG);
    const int gw = blockIdx.x * 8 + (tid >> 6), nw = gridDim.x * 8; const int nrows = (l == 0) ? MT : NLAT;
#pragma unroll 2
    for (int it = gw; it < nrows * 8; it += nw) { const size_t o = (size_t)(it >> 3) * 4096 + (it & 7) * 512 + lane * 8;
      const u32x4 a = *(const u32x4*)(OF + o), bq = *(const u32x4*)(OB + o), g = *(const u32x4*)(RG + o);
      float v[8]; float ss = 0.f;
#pragma unroll
      for (int e = 0; e < 4; ++e) { v[2 * e] = lo2f(a[e]) + lo2f(bq[e]); v[2 * e + 1] = hi2f(a[e]) + hi2f(bq[e]); ss += v[2 * e] * v[2 * e] + v[2 * e + 1] * v[2 * e + 1]; }
      ss = wsum(ss, lane);
      const float rs = rsqrtf(ss * (1.f / 512.f) + 1e-6f);
      u32x4 r;
#pragma unroll
      for (int e = 0; e < 4; ++e) r[e] = pk2(v[2 * e] * rs * siluf_(lo2f(g[e])), v[2 * e + 1] * rs * siluf_(hi2f(g[e])));
      *(u32x4*)(OF + o) = r; }
  }
}

__device__ void phase_conv(const Params& p, int l, unsigned char* shm) {
  const int tid = otid(p.wid), lane = tid & 63, wid = tid >> 6;
  bf16_t* Gs = (bf16_t*)shm;
  bf16_t* Us = (bf16_t*)(shm + 2 * GLEN * 2);
  { unsigned zz = 0u; asm volatile("" : "+v"(zz)); u32x4 z; z[0] = zz; z[1] = zz; z[2] = zz; z[3] = zz; for (int i = tid; i < 2 * 4 * USTR / 8; i += 512) ((u32x4*)Us)[i] = z; }
  __syncthreads();
  const int ch = wid >> 2, q = wid & 3, i = lane & 31, g = lane >> 5, a_l = i >> 2, b = i & 3;
  const bf16_t* G = (const bf16_t*)(p.ws + OFF_G + (size_t)l * G_LAYER); bf16_t* UT = (bf16_t*)(p.ws + OFF_UT);
  const int mb = LOFF - i + 8 * g - 128 * (8 * q + 7);
  const unsigned sh = (unsigned)(mb & 1) * 16u;
  const unsigned* Gd = (const unsigned*)(Gs + ch * GLEN) + (mb >> 1);
  const bf16_t* Ub = Us + (ch * 4 + b) * USTR + 136 * (a_l + 1) + 8 * g;
#define CONV_LDFRAG(dst, n) do { const unsigned* q_ = Gd + 8 * (n); const unsigned d0 = q_[0], d1 = q_[1], d2 = q_[2], d3 = q_[3], d4 = q_[4]; u32x4 r_; \
    r_[0] = __builtin_amdgcn_alignbit(d1, d0, sh); r_[1] = __builtin_amdgcn_alignbit(d2, d1, sh); r_[2] = __builtin_amdgcn_alignbit(d3, d2, sh); r_[3] = __builtin_amdgcn_alignbit(d4, d3, sh); \
    dst = __builtin_bit_cast(bf16x8, r_); } while (0)
  unsigned pgv[17]; u32x4 puv[8];
#define CONV_PREFETCH(pr_) do { \
    _Pragma("unroll") for (int e = 0; e < 17; ++e) { const int m = tid + 512 * e; unsigned v = 0u; if (m >= 33 && m <= 8223) v = *(const unsigned*)(G + (size_t)m * 2048 + 2 * (pr_)); pgv[e] = v; } \
    _Pragma("unroll") for (int e = 0; e < 8; ++e) { const int id = tid + 512 * e, cc = id >> 11, bb = (id >> 9) & 3, s8 = id & 511; puv[e] = *(const u32x4*)(UT + ((size_t)((pr_) * 2 + cc) * 4 + bb) * SEQ + s8 * 8); } } while (0)
  if ((int)blockIdx.x < 1024) CONV_PREFETCH((int)blockIdx.x);
  for (int pr = blockIdx.x; pr < 1024; pr += gridDim.x) {
#pragma unroll
    for (int e = 0; e < 17; ++e) { const int m = tid + 512 * e; if (m < GLEN) { Gs[m] = (bf16_t)(pgv[e] & 0xffffu); Gs[GLEN + m] = (bf16_t)(pgv[e] >> 16); } }
#pragma unroll
    for (int e = 0; e < 8; ++e) { const int id = tid + 512 * e, cc = id >> 11, bb = (id >> 9) & 3, s8 = id & 511; const int sp = 1024 + s8 * 8;
      *(u32x4*)(Us + (cc * 4 + bb) * USTR + sp + 8 * (sp >> 7)) = puv[e]; }
    __syncthreads();
    if (pr + (int)gridDim.x < 1024) CONV_PREFETCH(pr + (int)gridDim.x);
    bf16x8 W[8]; f32x16 acc[4];
#pragma unroll
    for (int h = 0; h < 4; ++h)
#pragma unroll
      for (int e = 0; e < 16; ++e) acc[h][e] = 0.f;
    CONV_LDFRAG(W[2], -6); CONV_LDFRAG(W[3], -5); CONV_LDFRAG(W[4], -4); CONV_LDFRAG(W[5], -3); CONV_LDFRAG(W[6], -2); CONV_LDFRAG(W[7], -1);
#pragma unroll 1
    for (int it = 0; it < 39; ++it) {
#pragma unroll
      for (int u = 0; u < 8; ++u) {
        CONV_LDFRAG(W[u], it * 8 + u);
        const bf16x8 bf = *(const bf16x8*)(Ub + 136 * it + 16 * u);
#pragma unroll
        for (int h = 0; h < 4; ++h) acc[h] = __builtin_amdgcn_mfma_f32_32x32x16_bf16(W[(u - 2 * h) & 7], bf, acc[h], 0, 0, 0);
      }
    }
    { bf16_t* yrow = UT + ((size_t)(pr * 2 + ch) * 4 + b) * SEQ + 128 * (8 * q + a_l) + 4 * g;
#pragma unroll
      for (int h = 0; h < 4; ++h)
#pragma unroll
        for (int rq = 0; rq < 4; ++rq) { u32x2 o; o[0] = pk2(acc[h][4 * rq], acc[h][4 * rq + 1]); o[1] = pk2(acc[h][4 * rq + 2], acc[h][4 * rq + 3]); *(u32x2*)(yrow + 32 * h + 8 * rq) = o; } }
    __syncthreads();
  }
#undef CONV_LDFRAG
#undef CONV_PREFETCH
}

template <int KD> DI f32x16 mma_tile(f32x16 acc, const bf16_t* A, int lda, const bf16_t* B, int ldb, int lane) {
  const int r = lane & 31, g8 = (lane >> 5) * 8; const bf16_t* ap = A + r * lda + g8; const bf16_t* bp = B + r * ldb + g8;
#pragma unroll 4
  for (int k0 = 0; k0 < KD; k0 += 16) acc = __builtin_amdgcn_mfma_f32_32x32x16_bf16(*(const bf16x8*)(ap + k0), *(const bf16x8*)(bp + k0), acc, 0, 0, 0);
  return acc;
}
DI bf16x8 tr_frag(const bf16_t* img, int ld, int lane) {
  const int h = lane >> 5, blk = (lane >> 4) & 1, q = (lane & 15) >> 2, pp = lane & 3;
  const bf16_t* a = img + (8 * h + q) * ld + 16 * blk + 4 * pp;
  const s16x4 r0 = __builtin_amdgcn_ds_read_tr16_b64_v4i16((__attribute__((address_space(3))) s16x4*)a);
  const s16x4 r1 = __builtin_amdgcn_ds_read_tr16_b64_v4i16((__attribute__((address_space(3))) s16x4*)(a + 4 * ld));
  bf16x8 f; f[0] = r0[0]; f[1] = r0[1]; f[2] = r0[2]; f[3] = r0[3]; f[4] = r1[0]; f[5] = r1[1]; f[6] = r1[2]; f[7] = r1[3]; return f;
}
__device__ void phase_ret(const Params& p, int l, unsigned char* shm) {
  constexpr int QS = 264, VS = 144, TS = 72;
  const int tid = otid(p.wid), lane = tid & 63, wid = tid >> 6, g = lane >> 5;
  bf16_t* Qs = (bf16_t*)shm; bf16_t* Ks = Qs + 64 * QS; bf16_t* Vs = Ks + 64 * QS; bf16_t* Ps = Vs + 64 * VS; bf16_t* Sts = Ps + 64 * TS;
  const bf16_t* PQ = (const bf16_t*)(p.ws + OFF_PQ); const bf16_t* PK = (const bf16_t*)(p.ws + OFF_PK); const bf16_t* PV = (const bf16_t*)(p.ws + OFF_PV);
  for (int it0 = blockIdx.x; it0 < 256; it0 += gridDim.x) {
    int it = it0;
    if (gridDim.x == 256) { const int xcd = it0 & 7, idx = it0 >> 3; it = ((xcd + 8 * (idx >> 2)) << 2) | (idx & 3); }
    const int sl = it & 3, dir = (it >> 2) & 1, h = (it >> 3) & 7, b = it >> 6;
    const float lg = -expf(p.ret_decay[(l * 2 + dir) * 8 + h]);
    bf16_t* O = (bf16_t*)(p.ws + (dir ? OFF_OB : OFF_OF));
    for (int i = tid; i < 128 * QS / 2; i += 512) ((unsigned*)Sts)[i] = 0u;
    f32x16 S[4], cross;
#pragma unroll
    for (int x = 0; x < 4; ++x)
#pragma unroll
      for (int e = 0; e < 16; ++e) S[x][e] = 0.f;
#pragma unroll
    for (int e = 0; e < 16; ++e) cross[e] = 0.f;
    const float cd = __expf(lg * 64.f);
    const int tid2 = otid(p.wid), ln2 = tid2 & 63, g2 = ln2 >> 5, w2 = tid2 >> 6;
    float mk[16], dkv[2];
#pragma unroll
    for (int e = 0; e < 2; ++e) { const int tok = (tid2 >> 4) + 32 * e; dkv[e] = __expf(lg * (float)(dir ? tok : 63 - tok)); }
    const int wq = w2 & 3, s_tj = wq >> 1, s_ti = wq & 1;
    const int o_tc = w2 >> 1, o_ti = w2 & 1;
    { const int i = s_ti * 32 + (ln2 & 31);
#pragma unroll
      for (int e = 0; e < 16; ++e) { const int j = s_tj * 32 + (e & 3) + 8 * (e >> 2) + 4 * g2; const int diff = dir ? (j - i) : (i - j); mk[e] = diff >= 0 ? __expf(lg * (float)(dir ? -i : i - 63)) : 0.f; } }
    const int qi = o_ti * 32 + (ln2 & 31);
    const float qd = __expf(lg * (float)(dir ? 64 - qi : qi + 1));
    u32x4 rq[4], rk[4], rv[2];
    const unsigned qo_l = (unsigned)(tid >> 5) * 2048u + (unsigned)(h * 256 + (tid & 31) * 8);
    const unsigned vo_l = (unsigned)(tid >> 4) * 4096u + (unsigned)(h * 512 + sl * 128 + (tid & 15) * 8);
#define RET_CHUNK(step_, isctx_, t0_) do { if ((step_) < 4) { isctx_ = true; t0_ = (dir ? 3 - (step_) : (step_)) * 64; } else { isctx_ = false; const int cn_ = (step_) - 4; t0_ = (dir ? 63 - cn_ : cn_) * 64; } } while (0)
#define RET_LOAD(step_) do { bool ic_; int t0n_; RET_CHUNK(step_, ic_, t0n_); const unsigned rw_ = (unsigned)tok_row(b, t0n_, ic_); \
      _Pragma("unroll") for (int e = 0; e < 4; ++e) { rq[e] = *(const u32x4*)(PQ + (rw_ * 2048u + qo_l + (unsigned)e * 32768u)); rk[e] = *(const u32x4*)(PK + (rw_ * 2048u + qo_l + (unsigned)e * 32768u)); } \
      _Pragma("unroll") for (int e = 0; e < 2; ++e) rv[e] = *(const u32x4*)(PV + (rw_ * 4096u + vo_l + (unsigned)e * 131072u)); } while (0)
    RET_LOAD(0);
#pragma unroll 1
    for (int step = 0; step < 68; ++step) {
      bool isctx; int t0; RET_CHUNK(step, isctx, t0);
      const int row0 = tok_row(b, t0, isctx);
      __syncthreads();
#pragma unroll
      for (int e = 0; e < 4; ++e) { const int row = (tid >> 5) + 16 * e, pc = tid & 31; *(u32x4*)(Qs + row * QS + pc * 8) = rq[e]; *(u32x4*)(Ks + row * QS + pc * 8) = rk[e]; }
#pragma unroll
      for (int e = 0; e < 2; ++e) { u32x4 o;
#pragma unroll
        for (int w = 0; w < 4; ++w) o[w] = pk2(lo2f(rv[e][w]) * dkv[e], hi2f(rv[e][w]) * dkv[e]);
        *(u32x4*)(Vs + ((tid >> 4) + 32 * e) * VS + (tid & 15) * 8) = o; }
      if (step + 1 < 68) RET_LOAD(step + 1);
      __syncthreads();
      if (wid < 4) {
        f32x16 sc;
#pragma unroll
        for (int e = 0; e < 16; ++e) sc[e] = 0.f;
        sc = mma_tile<256>(sc, Ks + s_tj * 32 * QS, QS, Qs + s_ti * 32 * QS, QS, lane);
        const int i = s_ti * 32 + (lane & 31);
#pragma unroll
        for (int r4 = 0; r4 < 4; ++r4) { u32x2 o; o[0] = pk2(sc[4 * r4] * mk[4 * r4], sc[4 * r4 + 1] * mk[4 * r4 + 1]); o[1] = pk2(sc[4 * r4 + 2] * mk[4 * r4 + 2], sc[4 * r4 + 3] * mk[4 * r4 + 3]);
          *(u32x2*)(Ps + i * TS + s_tj * 32 + 8 * r4 + 4 * g) = o; }
      }
#pragma unroll
      for (int e = 0; e < 16; ++e) cross[e] = 0.f;
      cross = mma_tile<256>(cross, Sts + o_tc * 32 * QS, QS, Qs + o_ti * 32 * QS, QS, lane);
      __syncthreads();
      { f32x16 in_;
#pragma unroll
        for (int e = 0; e < 16; ++e) in_[e] = 0.f;
        const bf16_t* pb = Ps + (o_ti * 32 + (lane & 31)) * TS + 8 * g;
#pragma unroll
        for (int ks = 0; ks < 4; ++ks) in_ = __builtin_amdgcn_mfma_f32_32x32x16_bf16(tr_frag(Vs + 16 * ks * VS + 32 * o_tc, VS, lane), *(const bf16x8*)(pb + 16 * ks), in_, 0, 0, 0);
        const unsigned ob = (unsigned)(row0 + qi) * 4096u + (unsigned)(h * 512 + sl * 128 + o_tc * 32 + 4 * g);
#pragma unroll
        for (int r4 = 0; r4 < 4; ++r4) { u32x2 o; o[0] = pk2(in_[4 * r4] + qd * cross[4 * r4], in_[4 * r4 + 1] + qd * cross[4 * r4 + 1]); o[1] = pk2(in_[4 * r4 + 2] + qd * cross[4 * r4 + 2], in_[4 * r4 + 3] + qd * cross[4 * r4 + 3]);
          *(u32x2*)(O + (ob + (unsigned)(8 * r4))) = o; } }
      { bf16x8 ka[4];
#pragma unroll
        for (int ks = 0; ks < 4; ++ks) ka[ks] = tr_frag(Ks + 16 * ks * QS + 32 * wid, QS, lane);
#pragma unroll
        for (int x = 0; x < 4; ++x) {
#pragma unroll
          for (int e = 0; e < 16; ++e) S[x][e] *= cd;
#pragma unroll
          for (int ks = 0; ks < 4; ++ks) S[x] = __builtin_amdgcn_mfma_f32_32x32x16_bf16(ka[ks], tr_frag(Vs + 16 * ks * VS + 32 * x, VS, lane), S[x], 0, 0, 0);
          const int c = x * 32 + (lane & 31);
#pragma unroll
          for (int r4 = 0; r4 < 4; ++r4) { u32x2 o; o[0] = pk2(S[x][4 * r4], S[x][4 * r4 + 1]); o[1] = pk2(S[x][4 * r4 + 2], S[x][4 * r4 + 3]); *(u32x2*)(Sts + c * QS + wid * 32 + 8 * r4 + 4 * g) = o; } } }
    }
    __syncthreads();
  }
#undef RET_CHUNK
#undef RET_LOAD
}

template <int MODE> __device__ void ctx_gemm(const Params& p, const bf16_t* X, int ldx, const bf16_t* W, int K, unsigned char* shm) {
  constexpr int KC = 128, LD = KC + 8;
  const int tid = otid(p.wid), lane = tid & 63, wid = tid >> 6, g = lane >> 5;
  bf16_t* Xs = (bf16_t*)shm; bf16_t* Ws = Xs + 128 * LD;
  for (int tile = blockIdx.x; tile < 256; tile += gridDim.x) {
    const int tok0 = (tile >> 5) * 128, n0 = (tile & 31) * 64, wt = wid & 3, wn = wid >> 2;
    f32x16 acc;
#pragma unroll
    for (int e = 0; e < 16; ++e) acc[e] = 0.f;
    u32x4 xr[4], wr[2];
    const unsigned xo = (unsigned)(tok0 + (tid >> 4)) * (unsigned)ldx + (unsigned)((tid & 15) * 8);
    const unsigned wo = (unsigned)(n0 + (tid >> 4)) * (unsigned)K + (unsigned)((tid & 15) * 8);
#define CG_LOAD(kc_) do { _Pragma("unroll") for (int e = 0; e < 4; ++e) xr[e] = *(const u32x4*)(X + (xo + (unsigned)(32 * e) * (unsigned)ldx + (unsigned)((kc_) * KC))); \
      _Pragma("unroll") for (int e = 0; e < 2; ++e) wr[e] = *(const u32x4*)(W + (wo + (unsigned)(32 * e) * (unsigned)K + (unsigned)((kc_) * KC))); } while (0)
    CG_LOAD(0);
    const int nkc = K / KC;
#pragma unroll 1
    for (int kc = 0; kc < nkc; ++kc) {
      __syncthreads();
#pragma unroll
      for (int e = 0; e < 4; ++e) *(u32x4*)(Xs + ((tid >> 4) + 32 * e) * LD + (tid & 15) * 8) = xr[e];
#pragma unroll
      for (int e = 0; e < 2; ++e) *(u32x4*)(Ws + ((tid >> 4) + 32 * e) * LD + (tid & 15) * 8) = wr[e];
      if (kc + 1 < nkc) CG_LOAD(kc + 1);
      __syncthreads();
      acc = mma_tile<KC>(acc, Ws + wn * 32 * LD, LD, Xs + wt * 32 * LD, LD, lane);
    }
#undef CG_LOAD
    const int tok = tok0 + wt * 32 + (lane & 31), nb = n0 + wn * 32 + 4 * g;
    if (MODE < 2) {
      bf16_t* T1 = (bf16_t*)(p.ws + OFF_T1) + (size_t)(NLAT + tok) * 2048; const bf16_t* MG = (const bf16_t*)(p.ws + OFF_PMG) + (size_t)(NLAT + tok) * 4096 + (MODE ? 2048 : 0);
#pragma unroll
      for (int r4 = 0; r4 < 4; ++r4) { const int n = nb + 8 * r4; const u32x2 gg = *(const u32x2*)(MG + n);
        float r0 = sigmoidf_(lo2f(gg[0])) * acc[4 * r4], r1 = sigmoidf_(hi2f(gg[0])) * acc[4 * r4 + 1], r2 = sigmoidf_(lo2f(gg[1])) * acc[4 * r4 + 2], r3 = sigmoidf_(hi2f(gg[1])) * acc[4 * r4 + 3];
        if (MODE == 1) { const u32x2 t = *(const u32x2*)(T1 + n); r0 += lo2f(t[0]); r1 += hi2f(t[0]); r2 += lo2f(t[1]); r3 += hi2f(t[1]); }
        u32x2 o; o[0] = pk2(r0, r1); o[1] = pk2(r2, r3); *(u32x2*)(T1 + n) = o; }
    } else {
      const float* cin = p.ctx + (size_t)tok * 2048; float* cout = (float*)(p.ws + OFF_CTXR) + (size_t)tok * 2048; const float* gate = (const float*)(p.ws + OFF_MOD) + 4 * 6144 + 4096;
#pragma unroll
      for (int r4 = 0; r4 < 4; ++r4) { const int n = nb + 8 * r4; const f32x4 xv = *(const f32x4*)(cin + n), gv = *(const f32x4*)(gate + n); f32x4 a; a[0] = acc[4 * r4]; a[1] = acc[4 * r4 + 1]; a[2] = acc[4 * r4 + 2]; a[3] = acc[4 * r4 + 3];
        *(f32x4*)(cout + n) = xv + gv * a; }
    }
    __syncthreads();
  }
}

__global__ void __launch_bounds__(512, 2) mega(Params p_in) {
  Params p = p_in; p.wid = __builtin_amdgcn_readfirstlane((int)(threadIdx.x >> 6));
  extern __shared__ __attribute__((aligned(16))) unsigned char shm[];
  cg::grid_group grid = cg::this_grid();
  PG8_LAS unsigned char* lds = (PG8_LAS unsigned char*)shm;
  volatile XLAS unsigned* xst = (volatile XLAS unsigned*)(lds + 163824);
  if (otid(p.wid) == 0) { xst[0] = 0u; xst[1] = 0u; }
  __syncthreads();
  const XcdBarrier xb = xcd_barrier_post((unsigned*)(p.ws + OFF_BAR), xst, otid(p.wid) == 0);
  const bf16_t* H = (const bf16_t*)(p.ws + OFF_H);
#pragma unroll 1
  for (int rep = 0; rep < (PROBE == 1 ? 2 : 1); ++rep) { phase_filters(p, shm, false); phase_mod(p, shm); }
  grid.sync();
  for (int l = 0; l < 2; ++l) {
#pragma unroll 1
    for (int rep = 0; rep < (PROBE == 1 ? 2 : 1); ++rep) { phase_cvt(p, l, shm); phase_norm(p, l); }
    xcd_barrier(xb, otid(p.wid) == 0);
    { pg8::Gemm g; g.wid = p.wid; g.A = H; g.Bt = (const bf16_t*)(p.ws + OFF_WTIN); g.M = MT; g.N = INW; g.K = DM;
      pg8::Order S; S.init(64, 96, (int)gridDim.x, (int)blockIdx.x, 4, l == 0 ? 96 : 24, l == 0 ? 0 : 8);
      EpiG1 E; E.ws = p.ws; pg8::gemm_phase<EpiG1, pg8::Order>(lds, g, S, E); }
    if (l == 0) phase_filters(p, shm, true);
    xcd_barrier(xb, otid(p.wid) == 0);
#pragma unroll 1
    for (int rep = 0; rep < (PROBE == 2 ? 2 : 1); ++rep) phase_prep(p, l, shm, rep ? 4 : 7);
    xcd_barrier(xb, otid(p.wid) == 0);
    phase_conv(p, l, shm);
#pragma unroll 1
    for (int rep = 0; rep < (PROBE == 3 ? 2 : 1); ++rep) phase_ret(p, l, shm);
    xcd_barrier(xb, otid(p.wid) == 0);
#pragma unroll 1
    for (int rep = 0; rep < (PROBE == 2 ? 2 : 1); ++rep) phase_post(p, l, shm, rep ? 3 : 7);
    xcd_barrier(xb, otid(p.wid) == 0);
    { const int nM = 64;
      pg8::Order S; S.init(nM, 8, (int)gridDim.x, (int)blockIdx.x, 0, 0, 0);
#pragma unroll 1
      for (int rep = 0; rep < (PROBE == 4 ? 2 : 1); ++rep) {
      { pg8::Gemm g; g.wid = p.wid; g.A = H; g.Bt = (const bf16_t*)(p.ws + OFF_WTHY); g.M = nM * 256; g.N = DM; g.K = DM; EpiG23<0> E; E.ws = p.ws; pg8::gemm_phase<EpiG23<0>, pg8::Order>(lds, g, S, E); }
      { pg8::Gemm g; g.wid = p.wid; g.A = (const bf16_t*)(p.ws + OFF_OF); g.Bt = (const bf16_t*)(p.ws + OFF_WTRET); g.M = nM * 256; g.N = DM; g.K = 4096; EpiG23<1> E; E.ws = p.ws; pg8::gemm_phase<EpiG23<1>, pg8::Order>(lds, g, S, E); }
      }
      if (l == 0) { ctx_gemm<0>(p, H + (size_t)NLAT * 2048, 2048, (const bf16_t*)(p.ws + OFF_WTHY), 2048, shm);
                    ctx_gemm<1>(p, (const bf16_t*)(p.ws + OFF_OF) + (size_t)NLAT * 4096, 4096, (const bf16_t*)(p.ws + OFF_WTRET), 4096, shm); }
      xcd_barrier(xb, otid(p.wid) == 0);
      { pg8::Gemm g; g.wid = p.wid; g.A = (const bf16_t*)(p.ws + OFF_T1); g.Bt = (const bf16_t*)(p.ws + OFF_WTO); g.M = nM * 256; g.N = DM; g.K = DM;
        EpiG4 E; E.xin = (l == 0) ? p.x : p.out; E.cin = p.ctx; E.xout = p.out; E.cout = (float*)(p.ws + OFF_CTXR); E.mod = (const float*)(p.ws + OFF_MOD) + (size_t)l * 5 * 6144;
        pg8::gemm_phase<EpiG4, pg8::Order>(lds, g, S, E); }
      if (l == 0) ctx_gemm<2>(p, (const bf16_t*)(p.ws + OFF_T1) + (size_t)NLAT * 2048, 2048, (const bf16_t*)(p.ws + OFF_WTO), 2048, shm); }
    xcd_barrier(xb, otid(p.wid) == 0);
  }
  phase_final(p);
}

extern "C" void kernel_launch(void* const* d_in, const int* in_sizes, int n_in, void* d_out, int out_size, void* d_ws, size_t ws_size, hipStream_t stream) {
  constexpr size_t kDynLds = 163840;
  static int grid_blocks = 0;
  if (!grid_blocks) {
    hipFuncSetAttribute((const void*)mega, hipFuncAttributeMaxDynamicSharedMemorySize, (int)kDynLds);
    int dev = 0, cus = 0, per_cu = 0;
    hipGetDevice(&dev);
    hipDeviceGetAttribute(&cus, hipDeviceAttributeMultiprocessorCount, dev);
    hipOccupancyMaxActiveBlocksPerMultiprocessor(&per_cu, (const void*)mega, 512, kDynLds);
    grid_blocks = cus * (per_cu >= 1 ? 1 : 0);
    if (ws_size < WS_NEED || grid_blocks <= 0) { fprintf(stderr, "workspace %zu < %zu or no occupancy (%d)\n", ws_size, (size_t)WS_NEED, per_cu); grid_blocks = grid_blocks > 0 ? grid_blocks : 256; }
  }
  Params p{};
  p.x = (const float*)d_in[0]; p.c = (const float*)d_in[1]; p.ctx = (const float*)d_in[2]; p.c_ctx = (const float*)d_in[3]; p.ln_g = (const float*)d_in[4];
  p.ada_w = (const float*)d_in[5]; p.ada_b = (const float*)d_in[6]; p.w_in = (const float*)d_in[7]; p.conv_w = (const float*)d_in[8]; p.conv_b = (const float*)d_in[9];
  p.fw1 = (const float*)d_in[10]; p.fb1 = (const float*)d_in[11]; p.fw2 = (const float*)d_in[12]; p.fb2 = (const float*)d_in[13]; p.fw3 = (const float*)d_in[14]; p.fb3 = (const float*)d_in[15];
  p.ffreq = (const float*)d_in[16]; p.fwout = (const float*)d_in[17]; p.hy_bias = (const float*)d_in[18]; p.ret_decay = (const float*)d_in[19];
  p.w_hy_out = (const float*)d_in[20]; p.w_ret_out = (const float*)d_in[21]; p.w_o = (const float*)d_in[22]; p.final_g = (const float*)d_in[23];
  p.out = (float*)d_out; p.ws = (unsigned char*)d_ws;
  void* args[] = {&p};
  (void)hipMemsetAsync((unsigned char*)d_ws + OFF_BAR, 0, (size_t)XCD_BAR_WORDS * 4, stream);
  hipError_t e = hipLaunchCooperativeKernel((void*)mega, dim3(grid_blocks), dim3(512), args, kDynLds, stream);
  if (e != hipSuccess) fprintf(stderr, "cooperative launch failed: %s (grid %d)\n", hipGetErrorString(e), grid_blocks);
}
```
